# Optimizing an MI355X kernel written in HIP

```python
import jax, jax.numpy as jnp
from jax import lax
import numpy as np

D_MODEL = 1024
BATCH = 8
SEQ = 4096
DEPTH = 4

GRID_W = 64
CTX_LEN = 256

A_HEADS = 12
A_NOPE = 64
A_ROPE = 32
A_QK = A_NOPE + A_ROPE
A_V = 64
A_Q_RANK = 256
A_KV_RANK = 128
F_GROUPS = 4
F_CH = 64
F_WIDTH = F_GROUPS * F_CH
Q_END = A_Q_RANK
KV_END = Q_END + A_KV_RANK
R_END = KV_END + A_ROPE
A_IN = R_END + F_WIDTH
A_MIX = A_HEADS * A_V + F_WIDTH
C_HEADS = 16
C_DH = 64
C_WIDTH = C_HEADS * C_DH
WIN_R = 8
WIN_C = 16
D_FF = 2816
N_EXPERTS = 8
TOP_K = 2
D_FF_EXPERT = 1408

ROPE_THETA = 10000.0
EPS = 1e-6
Q_BLOCK = 128

kernel_name = "hybrid_mla_fourier_natten_moe_dit"


def rms_norm(x, g):
    x32 = x.astype(jnp.float32)
    y = x32 * lax.rsqrt(jnp.mean(x32 * x32, axis=-1, keepdims=True) + EPS)
    return (y * g.astype(jnp.float32)).astype(x.dtype)


def _axial_rope(t, rows, cols):
    n_pairs = A_ROPE // 2
    per_axis = n_pairs // 2
    inv = ROPE_THETA ** (-jnp.arange(per_axis, dtype=jnp.float32) / per_axis)
    ang = jnp.concatenate([rows.astype(jnp.float32)[:, None] * inv, cols.astype(jnp.float32)[:, None] * inv], axis=-1)
    cos = jnp.cos(ang)[:, None, :].astype(t.dtype)
    sin = jnp.sin(ang)[:, None, :].astype(t.dtype)
    tp = t.reshape(*t.shape[:-1], n_pairs, 2)
    t0, t1 = tp[..., 0], tp[..., 1]
    return jnp.stack([t0 * cos - t1 * sin, t0 * sin + t1 * cos], axis=-1).reshape(t.shape)


def _rope_tail(t, rows, cols):
    return jnp.concatenate([t[..., :A_NOPE], _axial_rope(t[..., A_NOPE:], rows, cols)], axis=-1)


def block_attention(q, k, v, scale):
    B, N, H, dq = q.shape
    nb = N // Q_BLOCK
    qb = q.reshape(B, nb, Q_BLOCK, H, dq).transpose(1, 0, 2, 3, 4)

    def one(qi):
        s = jnp.einsum('bqhd,bkhd->bhqk', qi, k).astype(jnp.float32) * scale
        p = jax.nn.softmax(s, axis=-1).astype(v.dtype)
        return jnp.einsum('bhqk,bkhd->bqhd', p, v)

    o = lax.map(one, qb)
    return o.transpose(1, 0, 2, 3, 4).reshape(B, N, H, v.shape[-1])


def _fourier(f):
    B, N, _ = f.shape
    f32 = f.astype(jnp.float32).reshape(B, N, F_GROUPS, F_CH)
    y = jnp.fft.fft2(f32, axes=(1, 3), norm='ortho').real
    return y.reshape(B, N, F_WIDTH).astype(f.dtype)


def _mla_q(q_lat, g_cq, w_uq, g_q):
    B, N, _ = q_lat.shape
    q = (rms_norm(q_lat, g_cq) @ w_uq).reshape(B, N, A_HEADS, A_QK)
    return rms_norm(q, g_q)


def _mla_kv(kv_lat, k_rope, g_ckv, w_ukv, g_k):
    B, N, _ = kv_lat.shape
    kv = (rms_norm(kv_lat, g_ckv) @ w_ukv).reshape(B, N, A_HEADS, A_NOPE + A_V)
    k_nope, v = kv[..., :A_NOPE], kv[..., A_NOPE:]
    k_r = jnp.broadcast_to(k_rope[:, :, None, :], (B, N, A_HEADS, A_ROPE))
    k = rms_norm(jnp.concatenate([k_nope, k_r], axis=-1), g_k)
    return k, v


def _mla_fourier_mixer(xn, cn, rows, cols, w_in, g_cq, g_ckv, w_uq, w_ukv, g_q, g_k, w_out, need_ctx):
    B, S, _ = xn.shape
    L = cn.shape[1]
    scale = A_QK ** -0.5
    px = xn @ w_in
    qx = _rope_tail(_mla_q(px[..., :Q_END], g_cq, w_uq, g_q), rows, cols)
    kx, vx = _mla_kv(px[..., Q_END:KV_END], px[..., KV_END:R_END], g_ckv, w_ukv, g_k)
    kx = _rope_tail(kx, rows, cols)
    if need_ctx:
        pc = cn @ w_in
        kc, vc = _mla_kv(pc[..., Q_END:KV_END], pc[..., KV_END:R_END], g_ckv, w_ukv, g_k)
    else:
        pc = cn @ w_in[:, Q_END:R_END]
        kc, vc = _mla_kv(pc[..., :A_KV_RANK], pc[..., A_KV_RANK:], g_ckv, w_ukv, g_k)
    k_all = jnp.concatenate([kx, kc], axis=1)
    v_all = jnp.concatenate([vx, vc], axis=1)
    ax = block_attention(qx, k_all, v_all, scale).reshape(B, S, A_HEADS * A_V)
    ox = jnp.concatenate([ax, _fourier(px[..., R_END:])], axis=-1) @ w_out
    if need_ctx:
        qc = _mla_q(pc[..., :Q_END], g_cq, w_uq, g_q)
        ac = block_attention(qc, kc, vc, scale).reshape(B, L, A_HEADS * A_V)
        oc = jnp.concatenate([ac, _fourier(pc[..., R_END:])], axis=-1) @ w_out
    else:
        oc = None
    return ox, oc


def _na_mixer(xn, cn, w_in, g_q, g_k, rpb, w_out, need_ctx):
    B, S, _ = xn.shape
    L = cn.shape[1]
    rows_n = S // GRID_W
    wr = min(WIN_R, rows_n)
    wc = min(WIN_C, GRID_W)
    scale = C_DH ** -0.5
    px = (xn @ w_in).reshape(B, S, 3, C_HEADS, C_DH)
    qx = rms_norm(px[:, :, 0], g_q)
    kx = rms_norm(px[:, :, 1], g_k)
    vx = px[:, :, 2]
    if need_ctx:
        pc = (cn @ w_in).reshape(B, L, 3, C_HEADS, C_DH)
        qc = rms_norm(pc[:, :, 0], g_q)
        kc = rms_norm(pc[:, :, 1], g_k)
        vc = pc[:, :, 2]
    else:
        pc = (cn @ w_in[:, C_WIDTH:]).reshape(B, L, 2, C_HEADS, C_DH)
        kc = rms_norm(pc[:, :, 0], g_k)
        vc = pc[:, :, 1]
    row_start = jnp.clip(jnp.arange(rows_n) - wr // 2, 0, rows_n - wr)
    col_pos = jnp.arange(GRID_W)
    col_idx = jnp.clip(col_pos - wc // 2, 0, GRID_W - wc)[:, None] + jnp.arange(wc)[None, :]
    rpb_c = rpb[:, :, col_idx - col_pos[:, None] + (WIN_C - 1)]
    k_grid = kx.reshape(B, rows_n, GRID_W, C_HEADS, C_DH)
    v_grid = vx.reshape(B, rows_n, GRID_W, C_HEADS, C_DH)
    q_rows = qx.reshape(B, rows_n, GRID_W, C_HEADS, C_DH).transpose(1, 0, 2, 3, 4)

    def one_row(args):
        r, qr = args
        start = row_start[r]
        kb = lax.dynamic_slice_in_dim(k_grid, start, wr, axis=1)
        vb = lax.dynamic_slice_in_dim(v_grid, start, wr, axis=1)
        ks = jnp.take(kb, col_idx, axis=2)
        vs = jnp.take(vb, col_idx, axis=2)
        dr = start + jnp.arange(wr) - r + (WIN_R - 1)
        bias = jnp.take(rpb_c, dr, axis=1).transpose(0, 2, 1, 3)
        s_loc = jnp.einsum('bqhd,baqchd->bhqac', qr, ks).astype(jnp.float32) * scale + bias[None].astype(jnp.float32)
        s_ctx = jnp.einsum('bqhd,blhd->bhql', qr, kc).astype(jnp.float32) * scale
        s = jnp.concatenate([s_loc.reshape(B, C_HEADS, GRID_W, wr * wc), s_ctx], axis=-1)
        p = jax.nn.softmax(s, axis=-1).astype(vs.dtype)
        p_loc = p[..., :wr * wc].reshape(B, C_HEADS, GRID_W, wr, wc)
        p_ctx = p[..., wr * wc:]
        return jnp.einsum('bhqac,baqchd->bqhd', p_loc, vs) + jnp.einsum('bhql,blhd->bqhd', p_ctx, vc)

    o = lax.map(one_row, (jnp.arange(rows_n), q_rows))
    ox = o.transpose(1, 0, 2, 3, 4).reshape(B, S, C_WIDTH) @ w_out
    if need_ctx:
        oc = block_attention(qc, kc, vc, scale).reshape(B, L, C_WIDTH) @ w_out
    else:
        oc = None
    return ox, oc


def _swiglu(h, wg, wu, wd):
    return (jax.nn.silu(h @ wg) * (h @ wu)) @ wd


def _moe(h, w_router, wg, wu, wd):
    logits = (h @ w_router).astype(jnp.float32)
    top_v, top_i = lax.top_k(logits, TOP_K)
    gates = jax.nn.softmax(top_v, axis=-1)
    combine = jnp.sum(jax.nn.one_hot(top_i, N_EXPERTS, dtype=jnp.float32) * gates[..., None], axis=-2).astype(h.dtype)
    out = jnp.zeros_like(h)
    for e in range(N_EXPERTS):
        out = out + combine[..., e, None] * _swiglu(h, wg[e], wu[e], wd[e])
    return out


def setup_inputs(seed: int = 0) -> dict:
    key = jax.random.key(seed)
    ks = iter(jax.random.split(key, 32))
    ne, no = (DEPTH + 1) // 2, DEPTH // 2

    def nrm(shape, scale):
        return jax.random.normal(next(ks), shape, jnp.float32) * scale

    def gain(shape):
        return 1.0 + nrm(shape, 0.05)

    D = D_MODEL
    return {
        "x": nrm((BATCH, SEQ, D), 1.0),
        "c": nrm((BATCH, D), 1.0),
        "ctx": nrm((BATCH, CTX_LEN, D), 1.0),
        "c_ctx": nrm((D,), 1.0),
        "w_mod": nrm((DEPTH, D, 6 * D), D ** -0.5),
        "b_mod": nrm((DEPTH, 6 * D), 0.01),
        "norm_g": gain((DEPTH, 2, D)),
        "a_w_in": nrm((ne, D, A_IN), D ** -0.5),
        "a_g_cq": gain((ne, A_Q_RANK)),
        "a_g_ckv": gain((ne, A_KV_RANK)),
        "a_w_uq": nrm((ne, A_Q_RANK, A_HEADS * A_QK), A_Q_RANK ** -0.5),
        "a_w_ukv": nrm((ne, A_KV_RANK, A_HEADS * (A_NOPE + A_V)), A_KV_RANK ** -0.5),
        "a_g_q": gain((ne, A_QK)),
        "a_g_k": gain((ne, A_QK)),
        "a_w_out": nrm((ne, A_MIX, D), A_MIX ** -0.5),
        "f_w_gate": nrm((ne, D, D_FF), D ** -0.5),
        "f_w_up": nrm((ne, D, D_FF), D ** -0.5),
        "f_w_down": nrm((ne, D_FF, D), D_FF ** -0.5),
        "c_w_in": nrm((no, D, 3 * C_WIDTH), D ** -0.5),
        "c_g_q": gain((no, C_DH)),
        "c_g_k": gain((no, C_DH)),
        "c_rpb": nrm((no, C_HEADS, 2 * WIN_R - 1, 2 * WIN_C - 1), 0.2),
        "c_w_out": nrm((no, C_WIDTH, D), C_WIDTH ** -0.5),
        "m_w_router": nrm((no, D, N_EXPERTS), D ** -0.5),
        "m_w_gate": nrm((no, N_EXPERTS, D, D_FF_EXPERT), D ** -0.5),
        "m_w_up": nrm((no, N_EXPERTS, D, D_FF_EXPERT), D ** -0.5),
        "m_w_down": nrm((no, N_EXPERTS, D_FF_EXPERT, D), D_FF_EXPERT ** -0.5),
    }


def reference(x, c, ctx, c_ctx, w_mod, b_mod, norm_g, a_w_in, a_g_cq, a_g_ckv, a_w_uq, a_w_ukv, a_g_q, a_g_k, a_w_out,
              f_w_gate, f_w_up, f_w_down, c_w_in, c_g_q, c_g_k, c_rpb, c_w_out, m_w_router, m_w_gate, m_w_up, m_w_down):
    B, S, D = x.shape
    L = ctx.shape[1]
    t = jnp.arange(S)
    rows = t // GRID_W
    cols = t % GRID_W
    sc = jax.nn.silu(c)
    scc = jax.nn.silu(c_ctx)[None]
    hx, hc = x, ctx
    for i in range(DEPTH):
        last = i == DEPTH - 1
        j = i // 2
        mx = (sc @ w_mod[i] + b_mod[i]).reshape(B, 6, D)
        mc = (scc @ w_mod[i] + b_mod[i]).reshape(1, 6, D)
        shx1, scx1, gx1, shx2, scx2, gx2 = [mx[:, k, None, :] for k in range(6)]
        shc1, scc1, gc1, shc2, scc2, gc2 = [mc[:, k, None, :] for k in range(6)]
        xn = rms_norm(hx, norm_g[i, 0]) * (1 + scx1) + shx1
        cn = rms_norm(hc, norm_g[i, 0]) * (1 + scc1) + shc1
        if i % 2 == 0:
            ox, oc = _mla_fourier_mixer(xn, cn, rows, cols, a_w_in[j], a_g_cq[j], a_g_ckv[j], a_w_uq[j], a_w_ukv[j],
                                        a_g_q[j], a_g_k[j], a_w_out[j], not last)
        else:
            ox, oc = _na_mixer(xn, cn, c_w_in[j], c_g_q[j], c_g_k[j], c_rpb[j], c_w_out[j], not last)
        hx = hx + gx1 * ox
        xn2 = rms_norm(hx, norm_g[i, 1]) * (1 + scx2) + shx2
        if last:
            h_all = xn2
        else:
            hc = hc + gc1 * oc
            cn2 = rms_norm(hc, norm_g[i, 1]) * (1 + scc2) + shc2
            h_all = jnp.concatenate([cn2, xn2], axis=1)
        if i % 2 == 0:
            y = _swiglu(h_all, f_w_gate[j], f_w_up[j], f_w_down[j])
        else:
            y = _moe(h_all, m_w_router[j], m_w_gate[j], m_w_up[j], m_w_down[j])
        if last:
            hx = hx + gx2 * y
        else:
            hc = hc + gc2 * y[:, :L]
            hx = hx + gx2 * y[:, L:]
    return hx
```

```cpp
#include <hip/hip_runtime.h>
#include <cstdio>
#include <cstdint>

#define LAS __attribute__((address_space(3)))
#define GAS __attribute__((address_space(1)))
typedef unsigned short bf16;
typedef short bf16x8 __attribute__((ext_vector_type(8)));
typedef short bf16x4 __attribute__((ext_vector_type(4)));
typedef float f32x4 __attribute__((ext_vector_type(4)));
typedef float f32x2 __attribute__((ext_vector_type(2)));
typedef float f32x16 __attribute__((ext_vector_type(16)));
typedef unsigned u32x4 __attribute__((ext_vector_type(4)));
typedef unsigned u32x2 __attribute__((ext_vector_type(2)));

#define DBG 0

constexpr int DM = 1024, NB = 8, SEQ = 4096, CTXL = 256;
constexpr int NLAT = NB * SEQ, NCTX = NB * CTXL, NTOK = NLAT + NCTX;
constexpr int KPOS = SEQ + CTXL;
constexpr int A_HEADS = 12, A_QK = 96, A_IN_SRC = 672;
constexpr int C_HEADS = 16;
constexpr int DFF = 2816, NEXP = 8, DFFE = 1408;
constexpr int MOE_SLOTS = 2 * NTOK + NEXP * 256;
constexpr float EPS = 1e-6f;
constexpr float LOG2E = 1.4426950408889634f;

__device__ __forceinline__ unsigned f2bf(float f) { unsigned u = __builtin_bit_cast(unsigned, f); return (u + 0x7fffu + ((u >> 16) & 1u)) >> 16; }
__device__ __forceinline__ unsigned pk2(float lo, float hi) { return f2bf(lo) | (f2bf(hi) << 16); }
__device__ __forceinline__ float bf2f(unsigned short h) { return __builtin_bit_cast(float, (unsigned)h << 16); }
__device__ __forceinline__ float bflo(unsigned w) { return __builtin_bit_cast(float, w << 16); }
__device__ __forceinline__ float bfhi(unsigned w) { return __builtin_bit_cast(float, w & 0xffff0000u); }

namespace pg8 {
typedef unsigned u32x4 __attribute__((ext_vector_type(4)));
#define PG8_LAS __attribute__((address_space(3)))
constexpr int GN_LDS_OFF = 131648;
constexpr int BM = 256, BK = 64, HALF = 128, HTB = HALF * BK * 2  , STAGE_BYTES = 8 * HTB, NXCD = 8, WGM = 8;

__host__ __device__ __forceinline__ int lds_byte(int r, int c) { const int st = (r >> 4) * 2 + (c >> 5), rr = r & 15, cc = c & 31, ob = rr * 64 + cc * 2; return st * 1024 + (ob ^ (((ob >> 9) & 1) << 5)); }
__host__ __device__ __forceinline__ void stage_rc(int b, int& R, int& C) { const int st = b / 1024, sb = b % 1024, swz = sb ^ (((sb >> 9) & 1) << 5); R = (st >> 1) * 16 + swz / 64; C = (st & 1) * 32 + (swz % 64) / 2; }
__host__ __device__ __forceinline__ int perm32(int rho) { const int n = rho >> 4, i = rho & 15; return 8 * (i >> 2) + 4 * n + (i & 3); }

struct Unit { int pm, pn; };

__device__ __forceinline__ bool static_next(int i, int G, int c, int nM, int nN, Unit& u) {
    const int nwg = nM * nN;
    const long L = (long)i * G + c; if (L >= nwg) return false;
    int wgid = (int)L; { const int q = nwg / NXCD, r = nwg % NXCD, xcd = wgid % NXCD, off = wgid / NXCD; wgid = (xcd < r ? xcd * (q + 1) : r * (q + 1) + (xcd - r) * q) + off; }
    const int nig = WGM * nN, gid = wgid / nig, fm = gid * WGM, gsz = (nM - fm) < WGM ? (nM - fm) : WGM;
    u.pm = fm + ((wgid % nig) % gsz); u.pn = (wgid % nig) / gsz; return true;
}

template <class Epi, class Sched, bool ALIGN_EPI = true, bool SP2 = true>
__device__ __forceinline__ void gemm_phase(PG8_LAS unsigned char* lds, const int K, const Sched& S, const Epi& E, const int tid) {
    const int wid = __builtin_amdgcn_readfirstlane(tid >> 6), lane = tid & 63, wr = wid >> 2, wc = wid & 3, fr = lane & 15, fq = lane >> 4;
    const int nt = K / BK;
    unsigned voffB[2], voffA[2];
    const unsigned lda = (unsigned)S.lda;
#pragma unroll
    for (int i = 0; i < 2; ++i) { int R, C; stage_rc(tid * 16 + i * 8192, R, C); const int Rb = Epi::PERM ? ((R & ~31) + perm32(R & 31)) : R;
        voffB[i] = (unsigned)(Rb * K + C) * 2u; voffA[i] = ((unsigned)R * lda + (unsigned)C) * 2u; }
    const char* const Ab = (const char*)S.A;
    const size_t kstep = (size_t)(BK * 2);
    const size_t hstep = (size_t)HALF * K * 2;
    const size_t hstepA = (size_t)HALF * lda * 2;
    const unsigned ldsw = (unsigned)wid * 1024u;
    const int aoff = lds_byte(wr * 64 + fr, fq * 8), boff = lds_byte(wc * 32 + fr, fq * 8);
#define PG8_SA(b, h) (((b) * 2 + (h)) * HTB)
#define PG8_SB(b, h) ((4 + (b) * 2 + (h)) * HTB)
#define PG8_STAGE(bufoff, gbase, voff) do { _Pragma("unroll") for (int _i = 0; _i < 2; ++_i) \
        __builtin_amdgcn_global_load_lds((const unsigned*)((const char*)(gbase) + (voff)[_i]), (PG8_LAS unsigned*)(lds + (bufoff) + ldsw + _i * 8192), 16, 0, 0); } while (0)
#define PG8_LDA(dst, b, h) do { _Pragma("unroll") for (int m = 0; m < 4; ++m) _Pragma("unroll") for (int k = 0; k < 2; ++k) dst[m][k] = *(const PG8_LAS bf16x8*)(lds + PG8_SA(b, h) + aoff + m * 2048 + k * 1024); } while (0)
#define PG8_LDB(dst, b, h) do { _Pragma("unroll") for (int n = 0; n < 2; ++n) _Pragma("unroll") for (int k = 0; k < 2; ++k) dst[n][k] = *(const PG8_LAS bf16x8*)(lds + PG8_SB(b, h) + boff + n * 2048 + k * 1024); } while (0)
#define PG8_MMA(ai, bj, At, Bt) do { __builtin_amdgcn_s_setprio(1); _Pragma("unroll") for (int m = 0; m < 4; ++m) _Pragma("unroll") for (int n = 0; n < 2; ++n) _Pragma("unroll") for (int k = 0; k < 2; ++k) \
        acc[ai][bj][m][n] = __builtin_amdgcn_mfma_f32_16x16x32_bf16(Bt[n][k], At[m][k], acc[ai][bj][m][n], 0, 0, 0); __builtin_amdgcn_s_setprio(0); } while (0)
#define PG8_WAIT_V(n) asm volatile("s_waitcnt vmcnt(" #n ")" ::: "memory")
#define PG8_WAIT_L(n) asm volatile("s_waitcnt lgkmcnt(" #n ")" ::: "memory")
#define PG8_BAR __builtin_amdgcn_s_barrier()
#define PG8_SCHED __builtin_amdgcn_sched_barrier(0)
    Unit cur, nxt; int ui = 0;
    if (!S.next(0, cur)) return;
    f32x4 acc[2][2][4][2];
    bf16x8 At[4][2], B0[2][2], B1[2][2];
    constexpr bool GATHER = Sched::GATHER;
    const char* cA = Ab; const char* nA = Ab;
    unsigned ga0[2] = {0u, 0u}, ga1[2] = {0u, 0u};
    PG8_LAS u32x4* const gnslot = (PG8_LAS u32x4*)(lds + GN_LDS_OFF) + tid;
    if constexpr (GATHER) {
#pragma unroll
        for (int i = 0; i < 2; ++i) { int R, C; stage_rc(tid * 16 + i * 8192, R, C); ga0[i] = (S.a_row(cur, R) * lda + (unsigned)C) * 2u; ga1[i] = (S.a_row(cur, HALF + R) * lda + (unsigned)C) * 2u; }
    } else { cA = Ab + (size_t)S.a_row(cur, 0) * lda * 2; }
    const char* cB = S.b_base(cur);
#define PG8_STAGE_A(bufoff, h, uptr, kb, g0, g1) do { if constexpr (GATHER) { if (h) PG8_STAGE(bufoff, Ab + (kb), g1); else PG8_STAGE(bufoff, Ab + (kb), g0); } \
        else { PG8_STAGE(bufoff, (uptr) + (h) * hstepA + (kb), voffA); } } while (0)
    static_assert(SP2, "only the SP2 loop is carried here");
    PG8_STAGE(PG8_SB(0, 0), cB, voffB); PG8_STAGE(PG8_SB(0, 1), cB + hstep, voffB); PG8_STAGE_A(PG8_SA(0, 0), 0, cA, 0, ga0, ga1); PG8_STAGE_A(PG8_SA(0, 1), 1, cA, 0, ga0, ga1);
    if (wr == 1) PG8_BAR;
    PG8_WAIT_V(2); PG8_BAR;
    PG8_STAGE(PG8_SB(1, 0), cB + kstep, voffB); PG8_STAGE_A(PG8_SA(1, 0), 0, cA, kstep, ga0, ga1); PG8_STAGE(PG8_SB(1, 1), cB + hstep + kstep, voffB);
    PG8_WAIT_V(6); PG8_BAR;
    for (;;) {
        const bool has_next = S.next(ui + 1, nxt);
        const char* nB = has_next ? S.b_base(nxt) : cB;
        if constexpr (GATHER) {
            u32x4 gn = (u32x4){ga0[0], ga0[1], ga1[0], ga1[1]};
            if (has_next) { int R0, C0, R1, C1; stage_rc(tid * 16, R0, C0); stage_rc(tid * 16 + 8192, R1, C1);
                gn.x = (S.a_row(nxt, R0) * lda + (unsigned)C0) * 2u; gn.y = (S.a_row(nxt, R1) * lda + (unsigned)C1) * 2u;
                gn.z = (S.a_row(nxt, HALF + R0) * lda + (unsigned)C0) * 2u; gn.w = (S.a_row(nxt, HALF + R1) * lda + (unsigned)C1) * 2u; }
            *gnslot = gn;
        } else { nA = has_next ? Ab + (size_t)S.a_row(nxt, 0) * lda * 2 : cA; }
#pragma unroll
        for (int a = 0; a < 2; ++a)
#pragma unroll
            for (int b = 0; b < 2; ++b)
#pragma unroll
                for (int m = 0; m < 4; ++m)
#pragma unroll
                    for (int n = 0; n < 2; ++n) acc[a][b][m][n] = (f32x4){0.f, 0.f, 0.f, 0.f};
#pragma nounroll
        for (int t = 0; t < nt; t += 2) {
            const bool last = (t == nt - 2);
            const size_t k1 = (size_t)(t + 1) * kstep, k2 = last ? 0 : (size_t)(t + 2) * kstep, k3 = k2 + kstep;
            const char* u2 = last ? nA : cA;
            const char* b2 = last ? nB : cB + (size_t)(t + 2) * kstep; const char* b3 = b2 + kstep;
            unsigned o20[2] = {0u, 0u}, o21[2] = {0u, 0u};
            if constexpr (GATHER) {
                if (last) { const u32x4 gn = *gnslot; o20[0] = gn.x; o20[1] = gn.y; o21[0] = gn.z; o21[1] = gn.w; }
                else { o20[0] = ga0[0]; o20[1] = ga0[1]; o21[0] = ga1[0]; o21[1] = ga1[1]; }
            }
            PG8_LDB(B0, 0, 0); PG8_LDB(B1, 0, 1); PG8_SCHED; PG8_LDA(At, 0, 0); PG8_STAGE_A(PG8_SA(1, 1), 1, cA, k1, ga0, ga1);
            PG8_WAIT_V(8); PG8_WAIT_L(0); PG8_BAR; PG8_MMA(0, 0, At, B0); PG8_MMA(0, 1, At, B1); PG8_BAR; PG8_SCHED;
            PG8_LDA(At, 0, 1); PG8_STAGE(PG8_SB(0, 0), b2, voffB); PG8_STAGE(PG8_SB(0, 1), b2 + hstep, voffB); PG8_STAGE_A(PG8_SA(0, 0), 0, u2, k2, o20, o21);
            PG8_WAIT_V(8); PG8_WAIT_L(0); PG8_BAR; PG8_MMA(1, 0, At, B0); PG8_MMA(1, 1, At, B1); PG8_BAR; PG8_SCHED;
            PG8_LDB(B0, 1, 0); PG8_LDB(B1, 1, 1); PG8_SCHED; PG8_LDA(At, 1, 0); PG8_STAGE_A(PG8_SA(0, 1), 1, u2, k2, o20, o21);
            PG8_WAIT_V(8); PG8_WAIT_L(0); PG8_BAR; PG8_MMA(0, 0, At, B0); PG8_MMA(0, 1, At, B1); PG8_BAR; PG8_SCHED;
            PG8_LDA(At, 1, 1); PG8_STAGE(PG8_SB(1, 0), b3, voffB); PG8_STAGE(PG8_SB(1, 1), b3 + hstep, voffB); PG8_STAGE_A(PG8_SA(1, 0), 0, u2, k3, o20, o21);
            PG8_WAIT_V(8); PG8_WAIT_L(0); PG8_BAR; PG8_MMA(1, 0, At, B0); PG8_MMA(1, 1, At, B1); PG8_BAR; PG8_SCHED;
        }
        if constexpr (ALIGN_EPI) { if (wr == 0) PG8_BAR; }
        { int fr_ = fr, fq_ = fq, wr_ = wr, wc_ = wc; asm volatile("" : "+v"(fr_), "+v"(fq_), "+s"(wr_), "+s"(wc_));
          E(acc, cur, wr_, wc_, fr_, fq_); }
        if (!has_next) break;
        cur = nxt; cB = nB; cA = nA; ++ui;
        if constexpr (GATHER) { const u32x4 gn = *gnslot; ga0[0] = gn.x; ga0[1] = gn.y; ga1[0] = gn.z; ga1[1] = gn.w; }
        if constexpr (ALIGN_EPI) { if (wr == 1) PG8_BAR; }
    }
    PG8_WAIT_V(0);
    if constexpr (!ALIGN_EPI) { if (wr == 0) PG8_BAR; }
    PG8_BAR;
#undef PG8_SA
#undef PG8_SB
#undef PG8_STAGE
#undef PG8_STAGE_A
#undef PG8_LDA
#undef PG8_LDB
#undef PG8_MMA
#undef PG8_WAIT_V
#undef PG8_WAIT_L
#undef PG8_BAR
#undef PG8_SCHED
}
}

constexpr size_t MiB = 1u << 20;
constexpr size_t WS_CTL = 0, CTL_ZERO_BYTES = 1 * MiB;
constexpr size_t WS_MOD = 1 * MiB;
constexpr size_t WS_ROPE = 2 * MiB;
constexpr size_t WS_ROUTE = 3 * MiB;
constexpr size_t WS_LIST = 4 * MiB;
constexpr size_t WS_SNAP = 6 * MiB;
constexpr size_t WS_HC = 8 * MiB;
constexpr size_t WS_W = 16 * MiB;
constexpr size_t WS_DFT = 114 * MiB;
constexpr size_t WS_DFTC = WS_DFT + 64 * MiB;
constexpr size_t WS_SCR = 180 * MiB;
constexpr size_t WS_ACT = WS_SCR;
constexpr size_t WS_PX = WS_SCR + 68 * MiB;
constexpr size_t WS_GT = WS_SCR + 102 * MiB;
constexpr size_t WS_GTC = WS_SCR + 134 * MiB;
constexpr size_t WS_K = WS_SCR + 136 * MiB;
constexpr size_t WS_VT = WS_SCR + 213 * MiB;
constexpr size_t WS_HMID = WS_SCR + 68 * MiB;
constexpr size_t WS_QN = WS_SCR + 68 * MiB;
constexpr size_t WS_KN = WS_SCR + 136 * MiB;
constexpr size_t WS_VTN = WS_SCR + 204 * MiB;
constexpr size_t WS_HMOE = WS_SCR + 68 * MiB;
constexpr size_t WS_Y = WS_SCR + 261 * MiB;
constexpr size_t WS_END = WS_SCR + 401 * MiB;
static_assert((size_t)NTOK * 1024 * 2 <= 68 * MiB && (size_t)NTOK * 512 * 2 <= 34 * MiB && (size_t)NB * A_HEADS * KPOS * 96 * 2 <= 77 * MiB && (size_t)NB * A_HEADS * 64 * KPOS * 2 <= 51 * MiB, "even map");
static_assert((size_t)NTOK * DFF * 2 <= 196 * MiB && (size_t)NB * C_HEADS * 64 * KPOS * 2 <= 68 * MiB + 4 * MiB && (size_t)MOE_SLOTS * DFFE * 2 <= 193 * MiB && (size_t)MOE_SLOTS * 1024 * 2 <= 140 * MiB, "odd map");
constexpr size_t WO_WIN_E = 0, WO_WUKV = 2 * MiB, WO_WUQ = 3 * MiB, WO_WOUT_E = 4 * MiB, WO_WGU_E = 6 * MiB, WO_WDN_E = 17 * MiB;
constexpr size_t WO_WIN_O = 23 * MiB, WO_WOUT_O = 29 * MiB, WO_WGU_M = 31 * MiB, WO_WDN_M = 75 * MiB;
constexpr int CW_BAR = 4096;
constexpr int CW_MOECNT = 8192;
constexpr int CW_ATTQ = 8192 + 256;
constexpr int CW_CHK = 16384;

constexpr int RING_OFF = 0, RING_BYTES = 131072;
constexpr int LDSCTL_OFF = RING_BYTES, MISC_OFF = LDSCTL_OFF + 320;
constexpr int MOE_LDS_OFF = MISC_OFF + 128;
constexpr int LDS_BYTES = 147456;
static_assert(MOE_LDS_OFF + 128 == pg8::GN_LDS_OFF && pg8::GN_LDS_OFF % 16 == 0 && pg8::GN_LDS_OFF + 512 * 16 <= LDS_BYTES, "LDS map");
constexpr int NWAVES = 8;

#define CAS __attribute__((address_space(4)))
typedef GAS unsigned gu32;
#define RLX_AGENT __ATOMIC_RELAXED, __HIP_MEMORY_SCOPE_AGENT
#define LDS_WAIT() asm volatile("s_waitcnt lgkmcnt(0)" ::: "memory")
#define VM_WAIT() asm volatile("s_waitcnt vmcnt(0)" ::: "memory")

#define XB_TMO      128
#define XB_XCNT(j)  (256  + 64 * (j))
#define XB_XSUB(j)  (1280 + 64 * (j))
#define XB_XGEN(j)  (2304 + 64 * (j))
#define XB_TOP      3328
#define XB_TOPGEN   3392
#define XCD_BAR_WORDS 3456
#define XB_SPIN_CAP (1u << 18)

__device__ __forceinline__ unsigned xb_ld(unsigned* p)              { return __hip_atomic_load(p, __ATOMIC_RELAXED, __HIP_MEMORY_SCOPE_AGENT); }
__device__ __forceinline__ unsigned xb_add(unsigned* p, unsigned v) { return __hip_atomic_fetch_add(p, v, __ATOMIC_RELAXED, __HIP_MEMORY_SCOPE_AGENT); }
__device__ __forceinline__ unsigned xb_xcc_id() { return (unsigned)__builtin_amdgcn_s_getreg((3 << 11) | 20) & 0xFu; }
#define XB_SPIN(cond, bar) do { unsigned _sp = 0; while (cond) { __builtin_amdgcn_s_sleep(1); \
    if ((++_sp & 255u) == 0u) { if (xb_ld(&(bar)[XB_TMO])) break; if (_sp > XB_SPIN_CAP) { atomicAdd(&(bar)[XB_TMO], 1u); break; } } } } while (0)

struct XcdBarrier {
    unsigned* bar; unsigned x;
    volatile LAS unsigned* st;
};
__device__ __forceinline__ XcdBarrier xcd_barrier_post(unsigned* bar, volatile LAS unsigned* st) {
    XcdBarrier b; b.bar = bar; b.x = xb_xcc_id(); b.st = st;
    if (threadIdx.x == 0) (void)xb_add(&bar[XB_XCNT(b.x)], 1u);
    return b;
}
__device__ __forceinline__ void xcd_barrier_complete(unsigned* bar, unsigned x, unsigned& nloc, unsigned& nx) {
    const unsigned G = gridDim.x * gridDim.y * gridDim.z;
    unsigned sum, cnt, mine, sp = 0u;
    for (;;) {
        sum = 0u; cnt = 0u; mine = 0u;
#pragma unroll
        for (unsigned j = 0; j < 16; ++j) { const unsigned c = xb_ld(&bar[XB_XCNT(j)]); sum += c; cnt += (c > 0u) ? 1u : 0u; mine = (j == x) ? c : mine; }
        if (sum == G) break;
        __builtin_amdgcn_s_sleep(1);
        if ((++sp & 255u) == 0u) { if (xb_ld(&bar[XB_TMO])) break; if (sp > XB_SPIN_CAP) { atomicAdd(&bar[XB_TMO], 1u); break; } }
    }
    nloc = mine > 0u ? mine : 1u; nx = cnt > 0u ? cnt : 1u;
}
__device__ __forceinline__ void xcd_barrier(const XcdBarrier& b) {
    asm volatile("s_waitcnt vmcnt(0)" ::: "memory");
    __syncthreads();
    if (threadIdx.x == 0) {
        unsigned* bar = b.bar;
        __builtin_amdgcn_s_waitcnt(0);
        unsigned nloc = b.st[0], nx = b.st[1];
        if (nloc == 0u) { xcd_barrier_complete(bar, b.x, nloc, nx); b.st[0] = nloc; b.st[1] = nx; }
        const unsigned old = xb_add(&bar[XB_XSUB(b.x)], 1u);
        const unsigned gen = old / nloc;
        if (old + 1u == (gen + 1u) * nloc) {
            __builtin_amdgcn_fence(__ATOMIC_RELEASE, "agent");
            asm volatile("s_waitcnt vmcnt(0)" ::: "memory");
            const unsigned og = xb_add(&bar[XB_TOP], 1u);
            const unsigned tg = og / nx;
            if (og + 1u == (tg + 1u) * nx) xb_add(&bar[XB_TOPGEN], 1u);
            else XB_SPIN(xb_ld(&bar[XB_TOPGEN]) == tg, bar);
            __builtin_amdgcn_fence(__ATOMIC_ACQUIRE, "agent");
            xb_add(&bar[XB_XGEN(b.x)], 1u);
            asm volatile("s_waitcnt vmcnt(0)" ::: "memory");
        } else {
            XB_SPIN(xb_ld(&bar[XB_XGEN(b.x)]) == gen, bar);
            __builtin_amdgcn_fence(__ATOMIC_ACQUIRE, "agent");
            asm volatile("s_waitcnt vmcnt(0)" ::: "memory");
        }
    }
    __syncthreads();
}

struct Inputs {
    const float *x, *c, *ctx, *c_ctx, *w_mod, *b_mod, *norm_g;
    const float *a_w_in, *a_g_cq, *a_g_ckv, *a_w_uq, *a_w_ukv, *a_g_q, *a_g_k, *a_w_out;
    const float *f_w_gate, *f_w_up, *f_w_down;
    const float *c_w_in, *c_g_q, *c_g_k, *c_rpb, *c_w_out;
    const float *m_w_router, *m_w_gate, *m_w_up, *m_w_down;
};
struct Frame {
    LAS unsigned char* lds;
    volatile LAS unsigned* MISC;
    gu32* ctl;
    unsigned char* ws;
    float* out;
    float* hc;
    int tid, lane, wave, G, bid;
    const CAS Inputs* in;
};
__device__ __forceinline__ float* hrow(const Frame& F, int r) { return r < NLAT ? F.out + (size_t)r * DM : F.hc + (size_t)(r - NLAT) * DM; }
__device__ __forceinline__ int row_b9(int r) { return r < NLAT ? (r >> 12) : 8; }
__device__ __forceinline__ const float* modp(const Frame& F, int layer, int b9, int k) { return (const float*)(F.ws + WS_MOD) + ((size_t)layer * 9 + b9) * 6144 + k * 1024; }

__device__ __forceinline__ float wave_sum(float v) {
#pragma unroll
    for (int o = 1; o < 64; o <<= 1) v += __shfl_xor(v, o);
    return v;
}

struct WMap { int which; int col; };
__device__ __forceinline__ WMap wmap(int mode, int n, int nsrc) {
    WMap r; r.which = 0;
    const int pn = n >> 8, ct = n & 255, bj = ct >> 7, wc = (ct >> 5) & 3, w = ct & 31;
    if (mode == 0) { r.col = n < nsrc ? n : -1; }
    else if (mode == 1) { const int head = 2 * pn + (wc >> 1), part = wc & 1; r.col = head * 128 + part * 64 + 32 * bj + w; }
    else if (mode == 2) { const int nn = (ct >> 4) & 1, fq = (ct >> 2) & 3, e = ct & 3; r.which = nn; r.col = pn * 128 + bj * 64 + wc * 16 + fq * 4 + e; }
    else { r.col = (pn * 4 + wc) * 64 + 32 * bj + w; }
    return r;
}
__device__ __forceinline__ void wconv_item(const float* W0, const float* W1, int ld, int Ksrc, int nsrc, const float* kscale, bf16* WT, int Kdst, int mode, int kb, int nb, LAS float* scr, int lane) {
    const int k0 = 64 * kb, n0 = 32 * nb;
    const WMap mp = wmap(mode, n0 + (lane & 31), nsrc);
    const float* W = mp.which ? W1 : W0;
#pragma unroll 8
    for (int i = 0; i < 32; ++i) { const int kk = 2 * i + (lane >> 5), k = k0 + kk; float v = 0.f;
        if (mp.col >= 0 && k < Ksrc) { v = W[(size_t)k * ld + mp.col]; if (kscale) v *= kscale[k]; }
        scr[kk * 33 + (lane & 31)] = v; }
    LDS_WAIT(); asm volatile("" ::: "memory");
    const int c = lane & 7;
#pragma unroll
    for (int j = 0; j < 4; ++j) { const int n = (lane >> 3) + 8 * j; const LAS float* s = scr + (8 * c) * 33 + n;
        u32x4 o; o.x = pk2(s[0 * 33], s[1 * 33]); o.y = pk2(s[2 * 33], s[3 * 33]); o.z = pk2(s[4 * 33], s[5 * 33]); o.w = pk2(s[6 * 33], s[7 * 33]);
        *(GAS u32x4*)(WT + (size_t)(n0 + n) * Kdst + k0 + 8 * c) = o; }
    LDS_WAIT(); asm volatile("" ::: "memory");
}
struct WJob { const float* W0; const float* W1; int ld, Ksrc, nsrc; const float* kscale; bf16* WT; int Kdst, Ndst, mode; };
__device__ __forceinline__ bool wjob_run(const WJob& J, int& r, LAS float* scr, int lane) {
    const int nblk = J.Ndst / 32, items = (J.Kdst / 64) * nblk;
    if (r < items) { wconv_item(J.W0, J.W1, J.ld, J.Ksrc, J.nsrc, J.kscale, J.WT, J.Kdst, J.mode, r / nblk, r % nblk, scr, lane); return true; }
    r -= items; return false;
}

__device__ __forceinline__ void prep_phase(Frame& F, int j) {
    const CAS Inputs& I = *F.in;
    unsigned char* W = F.ws + WS_W;
    if (j == 0) {
        LAS float* sv = (LAS float*)(F.lds);
        LAS float* red = (LAS float*)(F.lds + 40960);
        for (int idx = F.tid; idx < 9 * 1024; idx += NWAVES * 64) { const int r = idx >> 10, k = idx & 1023; const float cv = r < 8 ? I.c[r * 1024 + k] : I.c_ctx[k]; sv[idx] = cv / (1.f + __expf(-cv)); }
        __syncthreads();
        for (int it = F.bid; it < 4 * 96; it += F.G) {
            const int layer = it / 96, chunk = it % 96, n = chunk * 64 + F.lane;
            const float* wm = I.w_mod + (size_t)layer * 1024 * 6144 + n;
            float acc[9];
#pragma unroll
            for (int r = 0; r < 9; ++r) acc[r] = 0.f;
            const int kb = F.wave * 128;
#pragma unroll 4
            for (int k = 0; k < 128; ++k) { const float wv = wm[(size_t)(kb + k) * 6144];
#pragma unroll
                for (int r = 0; r < 9; ++r) acc[r] += sv[r * 1024 + kb + k] * wv; }
#pragma unroll
            for (int r = 0; r < 9; ++r) red[(F.wave * 9 + r) * 64 + F.lane] = acc[r];
            __syncthreads();
            for (int idx = F.tid; idx < 9 * 64; idx += NWAVES * 64) { const int r = idx >> 6, l = idx & 63; float s = 0.f;
#pragma unroll
                for (int w = 0; w < 8; ++w) s += red[(w * 9 + r) * 64 + l];
                const int nn = chunk * 64 + l;
                ((float*)(F.ws + WS_MOD))[((size_t)layer * 9 + r) * 6144 + nn] = s + I.b_mod[layer * 6144 + nn]; }
            __syncthreads();
        }
        if (F.bid == 0) { const int pos = F.tid >> 3, f = F.tid & 7; const float inv = powf(10000.f, -(float)f / 8.f); const float ang = (float)pos * inv;
            ((f32x2*)(F.ws + WS_ROPE))[F.tid] = (f32x2){cosf(ang), sinf(ang)}; }
        __syncthreads();
        LAS f32x2* tab = (LAS f32x2*)(F.lds);
        for (int m = F.tid; m < 4096; m += NWAVES * 64) { float s, c; sincospif((float)m * (1.f / 2048.f), &s, &c); tab[m] = (f32x2){c, s}; }
        __syncthreads();
        bf16* DF = (bf16*)(F.ws + WS_DFT);
        for (int q = F.bid * (NWAVES * 64) + F.tid; q < 4096 * 1024; q += F.G * NWAVES * 64) {
            const int np = q >> 10, kk0 = (q & 1023) * 8, type = kk0 >= 4096, n = kk0 & 4095; float v[8];
#pragma unroll
            for (int e = 0; e < 8; ++e) { const f32x2 t = tab[(np * (n + e)) & 4095]; v[e] = (type ? -t.y : t.x) * (1.f / 512.f); }
            u32x4 o; o.x = pk2(v[0], v[1]); o.y = pk2(v[2], v[3]); o.z = pk2(v[4], v[5]); o.w = pk2(v[6], v[7]);
            *(GAS u32x4*)(DF + (size_t)np * 8192 + kk0) = o;
        }
        bf16* DC = (bf16*)(F.ws + WS_DFTC);
        for (int q = F.bid * (NWAVES * 64) + F.tid; q < 256 * 64; q += F.G * NWAVES * 64) {
            const int np = q >> 6, kk0 = (q & 63) * 8, type = kk0 >= 256, n = kk0 & 255; float v[8];
#pragma unroll
            for (int e = 0; e < 8; ++e) { const f32x2 t = tab[((np * (n + e)) & 255) * 16]; v[e] = (type ? -t.y : t.x) * (1.f / 128.f); }
            u32x4 o; o.x = pk2(v[0], v[1]); o.y = pk2(v[2], v[3]); o.z = pk2(v[4], v[5]); o.w = pk2(v[6], v[7]);
            *(GAS u32x4*)(DC + (size_t)np * 512 + kk0) = o;
        }
        __syncthreads();
    }
    {
        LAS float* scr = (LAS float*)(F.lds + F.wave * 16384);
        const int gw = F.bid * NWAVES + F.wave, NGW = F.G * NWAVES;
        const float* a_w_in = I.a_w_in + (size_t)j * 1024 * 672;
        WJob J0{a_w_in, a_w_in, 672, 1024, 416, nullptr, (bf16*)(W + WO_WIN_E), 1024, 512, 0};
        WJob J2{I.a_w_ukv + (size_t)j * 128 * 1536, nullptr, 1536, 128, 1536, I.a_g_ckv + j * 128, (bf16*)(W + WO_WUKV), 256, 1536, 1};
        WJob J3{I.a_w_uq + (size_t)j * 256 * 1152, nullptr, 1152, 256, 1152, I.a_g_cq + j * 256, (bf16*)(W + WO_WUQ), 256, 1152, 0};
        WJob J4{I.a_w_out + (size_t)j * 1024 * 1024, nullptr, 1024, 1024, 1024, nullptr, (bf16*)(W + WO_WOUT_E), 1024, 1024, 0};
        WJob J5{I.f_w_gate + (size_t)j * 1024 * DFF, I.f_w_up + (size_t)j * 1024 * DFF, DFF, 1024, DFF, nullptr, (bf16*)(W + WO_WGU_E), 1024, 2 * DFF, 2};
        WJob J6{I.f_w_down + (size_t)j * DFF * 1024, nullptr, 1024, DFF, 1024, nullptr, (bf16*)(W + WO_WDN_E), DFF, 1024, 0};
        WJob J7{I.c_w_in + (size_t)j * 1024 * 3072, nullptr, 3072, 1024, 3072, nullptr, (bf16*)(W + WO_WIN_O), 1024, 3072, 3};
        WJob J8{I.c_w_out + (size_t)j * 1024 * 1024, nullptr, 1024, 1024, 1024, nullptr, (bf16*)(W + WO_WOUT_O), 1024, 1024, 0};
        constexpr int IT_GU = (1024 / 64) * (2 * DFFE / 32), IT_DN = (DFFE / 64) * (1024 / 32);
        const int fixed = 16 * 16 + 4 * 48 + 4 * 36 + 16 * 32 + 16 * 176 + 44 * 32 + 16 * 96 + 16 * 32;
        const int total = fixed + NEXP * (IT_GU + IT_DN);
        for (int it = gw; it < total; it += NGW) {
            int r = it;
            if (wjob_run(J0, r, scr, F.lane)) continue;
            if (wjob_run(J2, r, scr, F.lane)) continue;
            if (wjob_run(J3, r, scr, F.lane)) continue;
            if (wjob_run(J4, r, scr, F.lane)) continue;
            if (wjob_run(J5, r, scr, F.lane)) continue;
            if (wjob_run(J6, r, scr, F.lane)) continue;
            if (wjob_run(J7, r, scr, F.lane)) continue;
            if (wjob_run(J8, r, scr, F.lane)) continue;
            if (r < NEXP * IT_GU) { const int e = r / IT_GU, rr = r % IT_GU; const size_t eo = ((size_t)j * NEXP + e) * 1024 * DFFE;
                wconv_item(I.m_w_gate + eo, I.m_w_up + eo, DFFE, 1024, DFFE, nullptr, (bf16*)(W + WO_WGU_M) + (size_t)e * 2 * DFFE * 1024, 1024, 2, rr / (2 * DFFE / 32), rr % (2 * DFFE / 32), scr, F.lane); continue; }
            r -= NEXP * IT_GU;
            { const int e = r / IT_DN, rr = r % IT_DN; const size_t eo = ((size_t)j * NEXP + e) * DFFE * 1024;
                wconv_item(I.m_w_down + eo, nullptr, 1024, DFFE, 1024, nullptr, (bf16*)(W + WO_WDN_M) + (size_t)e * 1024 * DFFE, DFFE, 0, rr / 32, rr % 32, scr, F.lane); }
        }
        __syncthreads();
        LAS f32x2* t64 = (LAS f32x2*)(F.lds);
        if (F.tid < 64) { float s, c; sincospif((float)F.tid * (1.f / 32.f), &s, &c); t64[F.tid] = (f32x2){c, s}; }
        __syncthreads();
        bf16* WE = (bf16*)(W + WO_WIN_E);
        for (int it = gw; it < 1024 * 4; it += NGW) {
            const int k = it >> 2, g = it & 3;
            const float f = a_w_in[(size_t)k * 672 + 416 + 64 * g + F.lane];
            float ac = 0.f, as = 0.f;
#pragma unroll 8
            for (int c = 0; c < 64; ++c) { const float fc = __shfl(f, c); const f32x2 t = t64[(c * F.lane) & 63]; ac += fc * t.x; as += fc * t.y; }
            WE[(size_t)(512 + g * 64 + F.lane) * 1024 + k] = (bf16)f2bf(ac);
            WE[(size_t)(768 + g * 64 + F.lane) * 1024 + k] = (bf16)f2bf(as);
        }
        __syncthreads();
    }
}

__device__ __forceinline__ void moe_panels_to_lds(Frame& F, int pair) {
    volatile LAS int* MOE = (volatile LAS int*)(F.lds + MOE_LDS_OFF);
    if (F.tid == 0) { int p = 0;
        for (int e = 0; e < NEXP; ++e) { const int c = (int)__hip_atomic_load(F.ctl + CW_MOECNT + 64 * pair + e, RLX_AGENT); MOE[e] = p; MOE[16 + e] = c; p += (c + 255) >> 8; }
        MOE[8] = p; }
    __syncthreads();
}
struct NormArgs { int layer, which, from_inputs, combine_pair, router_pair, final_only; };
__device__ __forceinline__ void norm_phase(Frame& F, const NormArgs a) {
    const CAS Inputs& I = *F.in;
    volatile LAS int* MOE = (volatile LAS int*)(F.lds + MOE_LDS_OFF);
    LAS float* wr = (LAS float*)(F.lds);
    volatile LAS int* lcnt = (volatile LAS int*)(F.lds + 32768);
    volatile LAS int* stash = (volatile LAS int*)(F.lds + 32768 + 256);
    if (a.combine_pair >= 0) moe_panels_to_lds(F, a.combine_pair);
    if (a.router_pair >= 0) {
        const float* wsrc = I.m_w_router + (size_t)a.router_pair * 1024 * NEXP;
        for (int idx = F.tid; idx < 1024 * NEXP; idx += NWAVES * 64) wr[idx] = wsrc[idx];
        if (F.tid < 16) lcnt[F.tid] = 0;
        __syncthreads();
    }
    const int* te = (const int*)(F.ws + WS_ROUTE); const int* tr = te + 2 * NTOK; const float* tg = (const float*)(tr + 2 * NTOK);
    const bf16* Y = (const bf16*)(F.ws + WS_Y);
    bf16* XN = (bf16*)(F.ws + WS_ACT);
    const int nrows = a.final_only ? NLAT : NTOK;
    const int nk = (nrows - F.bid + F.G - 1) / F.G;
    for (int k = F.wave; k < nk; k += NWAVES) {
        const int row = F.bid + F.G * k;
        const int b9 = row_b9(row);
        float* hp = hrow(F, row);
        const float* src = a.from_inputs ? (row < NLAT ? I.x + (size_t)row * DM : I.ctx + (size_t)(row - NLAT) * DM) : hp;
        f32x4 v[4];
#pragma unroll
        for (int j = 0; j < 4; ++j) v[j] = ((const f32x4*)src)[F.lane + 64 * j];
        if (a.combine_pair >= 0) {
            const int e1 = te[2 * row], e2 = te[2 * row + 1], r1 = tr[2 * row], r2 = tr[2 * row + 1];
            const float g1 = tg[2 * row], g2 = tg[2 * row + 1];
            const size_t s1 = (size_t)MOE[e1] * 256 + r1, s2 = (size_t)MOE[e2] * 256 + r2;
            const float* gm = modp(F, 2 * a.combine_pair + 1, b9, 5);
#pragma unroll
            for (int j = 0; j < 4; ++j) {
                const u32x2 y1 = *(const u32x2*)(Y + s1 * 1024 + 256 * j + 4 * F.lane), y2 = *(const u32x2*)(Y + s2 * 1024 + 256 * j + 4 * F.lane);
                const f32x4 gg = ((const f32x4*)gm)[F.lane + 64 * j];
                v[j].x += gg.x * (g1 * bflo(y1.x) + g2 * bflo(y2.x)); v[j].y += gg.y * (g1 * bfhi(y1.x) + g2 * bfhi(y2.x));
                v[j].z += gg.z * (g1 * bflo(y1.y) + g2 * bflo(y2.y)); v[j].w += gg.w * (g1 * bfhi(y1.y) + g2 * bfhi(y2.y));
            }
        }
        if (a.from_inputs || a.combine_pair >= 0) {
#pragma unroll
            for (int j = 0; j < 4; ++j) ((f32x4*)hp)[F.lane + 64 * j] = v[j];
        }
        if (a.final_only) continue;
        float ss = 0.f;
#pragma unroll
        for (int j = 0; j < 4; ++j) ss += (v[j].x * v[j].x + v[j].y * v[j].y) + (v[j].z * v[j].z + v[j].w * v[j].w);
        const float rstd = 1.0f / sqrtf(wave_sum(ss) * (1.f / DM) + EPS);
        const float* gp = I.norm_g + ((size_t)a.layer * 2 + a.which) * DM;
        const float* shp = modp(F, a.layer, b9, a.which ? 3 : 0);
        const float* scp = modp(F, a.layer, b9, a.which ? 4 : 1);
        f32x4 xn[4];
#pragma unroll
        for (int j = 0; j < 4; ++j) { const f32x4 g = ((const f32x4*)gp)[F.lane + 64 * j], sh = ((const f32x4*)shp)[F.lane + 64 * j], sc = ((const f32x4*)scp)[F.lane + 64 * j];
            xn[j] = v[j] * rstd * g * (sc + 1.0f) + sh; }
        u32x2* o8 = (u32x2*)(XN + (size_t)row * DM) + F.lane;
#pragma unroll
        for (int j = 0; j < 4; ++j) o8[64 * j] = (u32x2){pk2(xn[j].x, xn[j].y), pk2(xn[j].z, xn[j].w)};
        if (a.router_pair >= 0) {
            float lg[NEXP];
#pragma unroll
            for (int e = 0; e < NEXP; ++e) lg[e] = 0.f;
#pragma unroll
            for (int j = 0; j < 4; ++j)
#pragma unroll
                for (int q = 0; q < 4; ++q) { const float xv = xn[j][q]; const LAS f32x4* w4 = (const LAS f32x4*)(wr + (256 * j + 4 * F.lane + q) * NEXP); const f32x4 wa = w4[0], wb = w4[1];
                    lg[0] += xv * wa.x; lg[1] += xv * wa.y; lg[2] += xv * wa.z; lg[3] += xv * wa.w; lg[4] += xv * wb.x; lg[5] += xv * wb.y; lg[6] += xv * wb.z; lg[7] += xv * wb.w; }
#pragma unroll
            for (int e = 0; e < NEXP; ++e) lg[e] = wave_sum(lg[e]);
            int i1 = 0; float v1 = lg[0];
#pragma unroll
            for (int e = 1; e < NEXP; ++e) if (lg[e] > v1) { v1 = lg[e]; i1 = e; }
            int i2 = -1; float v2 = -3.0e38f;
#pragma unroll
            for (int e = 0; e < NEXP; ++e) if (e != i1 && lg[e] > v2) { v2 = lg[e]; i2 = e; }
            const float ga = 1.f / (1.f + __expf(v2 - v1)), gb = 1.f - ga;
            if (F.lane == 0) {
                const int l1 = __hip_atomic_fetch_add((LAS int*)(lcnt + i1), 1, __ATOMIC_RELAXED, __HIP_MEMORY_SCOPE_WORKGROUP);
                const int l2 = __hip_atomic_fetch_add((LAS int*)(lcnt + i2), 1, __ATOMIC_RELAXED, __HIP_MEMORY_SCOPE_WORKGROUP);
                stash[4 * k + 0] = i1; stash[4 * k + 1] = l1; stash[4 * k + 2] = i2; stash[4 * k + 3] = l2;
                float* tgw = (float*)(F.ws + WS_ROUTE) + 4 * NTOK; tgw[2 * row] = ga; tgw[2 * row + 1] = gb;
            }
        }
    }
    if (a.router_pair >= 0) {
        __syncthreads();
        if (F.tid < NEXP) lcnt[8 + F.tid] = (int)__hip_atomic_fetch_add(F.ctl + CW_MOECNT + 64 * a.router_pair + F.tid, (unsigned)lcnt[F.tid], RLX_AGENT);
        __syncthreads();
        int* tew = (int*)(F.ws + WS_ROUTE); int* trw = tew + 2 * NTOK; int* list = (int*)(F.ws + WS_LIST);
        for (int k = F.tid; k < nk; k += NWAVES * 64) {
            const int row = F.bid + F.G * k;
            const int i1 = stash[4 * k + 0], l1 = stash[4 * k + 1], i2 = stash[4 * k + 2], l2 = stash[4 * k + 3];
            const int r1 = lcnt[8 + i1] + l1, r2 = lcnt[8 + i2] + l2;
            tew[2 * row] = i1; tew[2 * row + 1] = i2; trw[2 * row] = r1; trw[2 * row + 1] = r2;
            list[(size_t)i1 * NTOK + r1] = row; list[(size_t)i2 * NTOK + r2] = row;
        }
    }
    __syncthreads();
}

struct SchedStatic {
    static constexpr bool GATHER = false;
    const bf16* A; int lda; const bf16* Bt; int K, nM, nN, G, c;
    __device__ __forceinline__ bool next(int i, pg8::Unit& u) const { return pg8::static_next(i, G, c, nM, nN, u); }
    __device__ __forceinline__ unsigned a_row(const pg8::Unit& u, int r) const { return (unsigned)(u.pm * 256 + r); }
    __device__ __forceinline__ const char* b_base(const pg8::Unit& u) const { return (const char*)Bt + (size_t)u.pn * 256 * K * 2; }
};
struct SchedOne {
    static constexpr bool GATHER = false;
    const bf16* A; int lda; const bf16* Bt; int K, pm, pn, have;
    __device__ __forceinline__ bool next(int i, pg8::Unit& u) const { if (i != 0 || !have) return false; u.pm = pm; u.pn = pn; return true; }
    __device__ __forceinline__ unsigned a_row(const pg8::Unit& u, int r) const { return (unsigned)(u.pm * 256 + r); }
    __device__ __forceinline__ const char* b_base(const pg8::Unit& u) const { return (const char*)Bt + (size_t)u.pn * 256 * K * 2; }
};
template <bool G_> struct SchedMoe {
    static constexpr bool GATHER = G_;
    const bf16* A; int lda; const bf16* Bt; size_t bstride; int K, nN, G, c; const int* list; volatile LAS int* MOE;
    __device__ __forceinline__ bool next(int i, pg8::Unit& u) const { const long L = (long)i * G + c; const int nP = MOE[8]; if (L >= (long)nP * nN) return false; u.pm = (int)(L / nN); u.pn = (int)(L % nN); return true; }
    __device__ __forceinline__ int expert(int pm) const { int e = 0;
#pragma unroll
        for (int k = 1; k < NEXP; ++k) e += (pm >= MOE[k]) ? 1 : 0;
        return e; }
    __device__ __forceinline__ unsigned a_row(const pg8::Unit& u, int r) const {
        if (!G_) return (unsigned)(u.pm * 256 + r);
        const int e = expert(u.pm), idx = (u.pm - MOE[e]) * 256 + r;
        return idx < MOE[16 + e] ? (unsigned)list[e * NTOK + idx] : 0u; }
    __device__ __forceinline__ const char* b_base(const pg8::Unit& u) const { return (const char*)Bt + (size_t)expert(u.pm) * bstride + (size_t)u.pn * 256 * K * 2; }
};

__device__ __forceinline__ unsigned cvt_pk_bf16(float lo, float hi) { unsigned r; asm volatile("v_cvt_pk_bf16_f32 %0, %1, %2" : "=v"(r) : "v"(lo), "v"(hi)); return r; }
typedef const f32x4 (&AccRef)[2][2][4][2];
__device__ __forceinline__ int swap12(int g) { return ((g & 1) << 1) | (g >> 1); }

struct EpiBf16 { static constexpr bool PERM = true;
    bf16* O; int ldc, mode;
    __device__ __forceinline__ void operator()(AccRef acc, const pg8::Unit& u, int wr, int wc, int fr, int fq) const {
        const int rbase = mode == 0 ? u.pm * 256 : (mode == 1 ? u.pn * 4096 + u.pm * 256 : NLAT + u.pn * 256 + u.pm * 256);
        const int cbase = mode == 0 ? u.pn * 256 : 768;
        const int row0 = rbase + wr * 64 + fr, col0 = cbase + wc * 32 + 8 * fq;
#pragma unroll
        for (int ai = 0; ai < 2; ++ai)
#pragma unroll
            for (int m = 0; m < 4; ++m) { bf16* rowp = O + (size_t)(row0 + ai * 128 + m * 16) * ldc + col0;
#pragma unroll
                for (int bj = 0; bj < 2; ++bj) { const f32x4 v0 = acc[ai][bj][m][0], v1 = acc[ai][bj][m][1];
                    u32x4 w; w.x = cvt_pk_bf16(v0[0], v0[1]); w.y = cvt_pk_bf16(v0[2], v0[3]); w.z = cvt_pk_bf16(v1[0], v1[1]); w.w = cvt_pk_bf16(v1[2], v1[3]);
                    *(u32x4*)(rowp + bj * 128) = w; } }
    }
};
struct EpiWin { static constexpr bool PERM = true;
    bf16* PX; bf16* GT; bf16* GTC;
    __device__ __forceinline__ void operator()(AccRef acc, const pg8::Unit& u, int wr, int wc, int fr, int fq) const {
        if (u.pn < 2) {
            const int row0 = u.pm * 256 + wr * 64 + fr, col0 = u.pn * 256 + wc * 32 + 8 * fq;
#pragma unroll
            for (int ai = 0; ai < 2; ++ai)
#pragma unroll
                for (int m = 0; m < 4; ++m) { bf16* rowp = PX + (size_t)(row0 + ai * 128 + m * 16) * 512 + col0;
#pragma unroll
                    for (int bj = 0; bj < 2; ++bj) { const f32x4 v0 = acc[ai][bj][m][0], v1 = acc[ai][bj][m][1];
                        u32x4 w; w.x = cvt_pk_bf16(v0[0], v0[1]); w.y = cvt_pk_bf16(v0[2], v0[3]); w.z = cvt_pk_bf16(v1[0], v1[1]); w.w = cvt_pk_bf16(v1[2], v1[3]);
                        *(u32x4*)(rowp + bj * 128) = w; } }
        } else {
            const int type = u.pn - 2; const bool lat = u.pm < 128;
            const int b = lat ? (u.pm >> 4) : (u.pm - 128);
            bf16* base = lat ? GT + (size_t)b * 256 * 8192 + type * 4096 + (u.pm & 15) * 256 : GTC + (size_t)b * 256 * 512 + type * 256;
            const size_t ldt = lat ? 8192 : 512;
#pragma unroll
            for (int ai = 0; ai < 2; ++ai)
#pragma unroll
                for (int m = 0; m < 4; ++m) { const int lr = ai * 128 + wr * 64 + m * 16 + fr;
#pragma unroll
                    for (int bj = 0; bj < 2; ++bj)
#pragma unroll
                        for (int n = 0; n < 2; ++n)
#pragma unroll
                            for (int e = 0; e < 4; ++e) { const int jc = 128 * bj + 32 * wc + 8 * fq + 4 * n + e; base[(size_t)jc * ldt + lr] = (bf16)f2bf(acc[ai][bj][m][n][e]); }
                    if (m == 3) asm volatile("" ::: "memory"); }
        }
    }
};
struct EpiKV { static constexpr bool PERM = false;
    const bf16* PX; bf16* Kb; bf16* Vt; const float* g_k; const f32x2* rope;
    __device__ __forceinline__ void operator()(AccRef acc, const pg8::Unit& u, int wr, int wc, int fr, int fq) const {
        const int head = 2 * u.pn + (wc >> 1), part = wc & 1;
        const bool lat = u.pm < 128;
        const int b = lat ? (u.pm >> 4) : (u.pm - 128);
        const int pos0 = lat ? (u.pm & 15) * 256 : SEQ;
        const size_t bh = (size_t)b * A_HEADS + head;
#pragma unroll
        for (int ai = 0; ai < 2; ++ai)
#pragma unroll
            for (int m = 0; m < 4; ++m) {
                const int lr = ai * 128 + wr * 64 + m * 16 + fr, row = u.pm * 256 + lr, pos = pos0 + lr;
                const bf16* pxr = PX + (size_t)row * 512;
                float ss = 0.f;
#pragma unroll
                for (int q = 0; q < 4; ++q) { const u32x4 w = *(const u32x4*)(pxr + 256 + 32 * fq + 8 * q);
                    ss += bflo(w.x) * bflo(w.x) + bfhi(w.x) * bfhi(w.x) + bflo(w.y) * bflo(w.y) + bfhi(w.y) * bfhi(w.y) + bflo(w.z) * bflo(w.z) + bfhi(w.z) * bfhi(w.z) + bflo(w.w) * bflo(w.w) + bfhi(w.w) * bfhi(w.w); }
                ss += __shfl_xor(ss, 16); ss += __shfl_xor(ss, 32);
                const float rkv = 1.0f / sqrtf(ss * (1.f / 128.f) + EPS);
                if (part == 0) {
                    const u32x4 kw = *(const u32x4*)(pxr + 384 + 8 * fq);
                    float kr[8] = {bflo(kw.x), bfhi(kw.x), bflo(kw.y), bfhi(kw.y), bflo(kw.z), bfhi(kw.z), bflo(kw.w), bfhi(kw.w)};
                    float s2 = 0.f;
#pragma unroll
                    for (int q = 0; q < 8; ++q) s2 += kr[q] * kr[q];
#pragma unroll
                    for (int bj = 0; bj < 2; ++bj)
#pragma unroll
                        for (int n = 0; n < 2; ++n) { const f32x4 x = acc[ai][bj][m][n] * rkv; s2 += (x[0] * x[0] + x[1] * x[1]) + (x[2] * x[2] + x[3] * x[3]); }
                    s2 += __shfl_xor(s2, 16); s2 += __shfl_xor(s2, 32);
                    const float rs = 1.0f / sqrtf(s2 * (1.f / 96.f) + EPS);
                    bf16* kp = Kb + (bh * KPOS + pos) * 96;
#pragma unroll
                    for (int bj = 0; bj < 2; ++bj)
#pragma unroll
                        for (int n = 0; n < 2; ++n) { const int d0 = 32 * bj + 16 * n; const f32x4 g = *(const f32x4*)(g_k + d0 + 4 * fq); const f32x4 x = acc[ai][bj][m][n] * (rkv * rs) * g;
                            *(u32x2*)(kp + d0 + 4 * swap12(fq)) = (u32x2){pk2(x[0], x[1]), pk2(x[2], x[3])}; }
                    float t[8];
                    { const f32x4 ga = *(const f32x4*)(g_k + 64 + 8 * fq), gb = *(const f32x4*)(g_k + 64 + 8 * fq + 4);
                      t[0] = kr[0] * rs * ga[0]; t[1] = kr[1] * rs * ga[1]; t[2] = kr[2] * rs * ga[2]; t[3] = kr[3] * rs * ga[3];
                      t[4] = kr[4] * rs * gb[0]; t[5] = kr[5] * rs * gb[1]; t[6] = kr[6] * rs * gb[2]; t[7] = kr[7] * rs * gb[3]; }
                    if (lat) {
                        const int pidx = (fq < 2) ? (pos >> 6) : (pos & 63);
#pragma unroll
                        for (int q = 0; q < 4; ++q) { const f32x2 cs = rope[pidx * 8 + ((4 * fq + q) & 7)]; const float t0 = t[2 * q], t1 = t[2 * q + 1];
                            t[2 * q] = t0 * cs.x - t1 * cs.y; t[2 * q + 1] = t0 * cs.y + t1 * cs.x; }
                    }
                    bf16* krp = kp + 64 + 16 * (fq >> 1) + 4 * (fq & 1);
                    *(u32x2*)(krp) = (u32x2){pk2(t[0], t[1]), pk2(t[2], t[3])};
                    *(u32x2*)(krp + 8) = (u32x2){pk2(t[4], t[5]), pk2(t[6], t[7])};
                } else {
                    const int pp = (pos & ~15) | (((pos & 4) << 1) | ((pos & 8) >> 1) | (pos & 3));
                    bf16* vp = Vt + bh * 64 * KPOS + pp;
#pragma unroll
                    for (int bj = 0; bj < 2; ++bj)
#pragma unroll
                        for (int n = 0; n < 2; ++n)
#pragma unroll
                            for (int e = 0; e < 4; ++e) vp[(size_t)(32 * bj + 16 * n + 4 * fq + e) * KPOS] = (bf16)f2bf(acc[ai][bj][m][n][e] * rkv);
                }
                if (m & 1) asm volatile("" ::: "memory");
            }
    }
};
struct EpiResid { static constexpr bool PERM = false;
    float* out; float* hc; const float* modl; int gk;
    __device__ __forceinline__ void operator()(AccRef acc, const pg8::Unit& u, int wr, int wc, int fr, int fq) const {
        const bool lat = u.pm < 128; const int b9 = lat ? (u.pm >> 4) : 8;
        float* base = lat ? out + (size_t)u.pm * 256 * DM : hc + (size_t)(u.pm - 128) * 256 * DM;
        const int col0 = u.pn * 256 + wc * 32 + 4 * fq;
        const float* gp = modl + (size_t)b9 * 6144 + gk * 1024 + col0;
        f32x4 gv[2][2];
#pragma unroll
        for (int bj = 0; bj < 2; ++bj)
#pragma unroll
            for (int n = 0; n < 2; ++n) gv[bj][n] = *(const f32x4*)(gp + bj * 128 + n * 16);
#pragma unroll
        for (int ai = 0; ai < 2; ++ai)
#pragma unroll
            for (int m = 0; m < 4; ++m) { float* rowp = base + (size_t)(ai * 128 + wr * 64 + m * 16 + fr) * DM + col0;
#pragma unroll
                for (int bj = 0; bj < 2; ++bj)
#pragma unroll
                    for (int n = 0; n < 2; ++n) { f32x4* p = (f32x4*)(rowp + bj * 128 + n * 16); *p = *p + gv[bj][n] * acc[ai][bj][m][n]; }
                if (m == 3) asm volatile("" ::: "memory"); }
    }
};
struct EpiSwiglu { static constexpr bool PERM = false;
    bf16* HM; int ldh;
    __device__ __forceinline__ void operator()(AccRef acc, const pg8::Unit& u, int wr, int wc, int fr, int fq) const {
        const int row0 = u.pm * 256 + wr * 64 + fr, col0 = u.pn * 128 + wc * 16 + 4 * fq;
#pragma unroll
        for (int ai = 0; ai < 2; ++ai)
#pragma unroll
            for (int m = 0; m < 4; ++m) { bf16* rowp = HM + (size_t)(row0 + ai * 128 + m * 16) * ldh + col0;
#pragma unroll
                for (int bj = 0; bj < 2; ++bj) { const f32x4 g = acc[ai][bj][m][0], up = acc[ai][bj][m][1]; float h[4];
#pragma unroll
                    for (int e = 0; e < 4; ++e) h[e] = g[e] * __builtin_amdgcn_rcpf(1.f + __builtin_amdgcn_exp2f(-g[e] * LOG2E)) * up[e];
                    *(u32x2*)(rowp + bj * 64) = (u32x2){cvt_pk_bf16(h[0], h[1]), cvt_pk_bf16(h[2], h[3])}; } }
    }
};
struct EpiNAin { static constexpr bool PERM = false;
    bf16* QN; bf16* KN; bf16* Vt; const float* g_q; const float* g_k;
    __device__ __forceinline__ void operator()(AccRef acc, const pg8::Unit& u, int wr, int wc, int fr, int fq) const {
        const int sec = u.pn >> 2, head = 4 * (u.pn & 3) + wc;
        const bool lat = u.pm < 128;
        const int b = lat ? (u.pm >> 4) : (u.pm - 128);
        const int pos0 = lat ? (u.pm & 15) * 256 : SEQ;
#pragma unroll
        for (int ai = 0; ai < 2; ++ai)
#pragma unroll
            for (int m = 0; m < 4; ++m) {
                const int lr = ai * 128 + wr * 64 + m * 16 + fr, row = u.pm * 256 + lr;
                if (sec < 2) {
                    float s2 = 0.f;
#pragma unroll
                    for (int bj = 0; bj < 2; ++bj)
#pragma unroll
                        for (int n = 0; n < 2; ++n) { const f32x4 x = acc[ai][bj][m][n]; s2 += (x[0] * x[0] + x[1] * x[1]) + (x[2] * x[2] + x[3] * x[3]); }
                    s2 += __shfl_xor(s2, 16); s2 += __shfl_xor(s2, 32);
                    const float rs = (1.0f / sqrtf(s2 * (1.f / 64.f) + EPS)) * (sec == 0 ? 0.125f * LOG2E : 1.0f);
                    const float* gp = sec == 0 ? g_q : g_k;
                    bf16* op = (sec == 0 ? QN : KN) + (size_t)row * DM + head * 64;
#pragma unroll
                    for (int bj = 0; bj < 2; ++bj)
#pragma unroll
                        for (int n = 0; n < 2; ++n) { const int d0 = 32 * bj + 16 * n + 4 * fq; const f32x4 g = *(const f32x4*)(gp + d0); const f32x4 x = acc[ai][bj][m][n] * rs * g;
                            *(u32x2*)(op + d0) = (u32x2){pk2(x[0], x[1]), pk2(x[2], x[3])}; }
                } else {
                    bf16* vp = Vt + ((size_t)b * C_HEADS + head) * 64 * KPOS + pos0 + lr;
#pragma unroll
                    for (int bj = 0; bj < 2; ++bj)
#pragma unroll
                        for (int n = 0; n < 2; ++n)
#pragma unroll
                            for (int e = 0; e < 4; ++e) vp[(size_t)(32 * bj + 16 * n + 4 * fq + e) * KPOS] = (bf16)f2bf(acc[ai][bj][m][n][e]);
                }
                if (m == 3) asm volatile("" ::: "memory");
            }
    }
};

constexpr int AT_KP = 208, AT_VP = 144;
constexpr int AT_KB = 64 * AT_KP, AT_VB = 64 * AT_VP, AT_BUF = AT_KB + AT_VB;

__device__ __forceinline__ void mla_attn_unit(Frame& F, int pair, int b, int h, int qrow0, bool lat, int key0, int nkt) {
    const int lane = F.lane, l31 = lane & 31, hi = lane >> 5;
    const bf16* PX = (const bf16*)(F.ws + WS_PX);
    const bf16* WUQ = (const bf16*)(F.ws + WS_W + WO_WUQ);
    const bf16* Kg = (const bf16*)(F.ws + WS_K) + ((size_t)(b * A_HEADS + h) * KPOS + key0) * 96;
    const bf16* Vg = (const bf16*)(F.ws + WS_VT) + (size_t)(b * A_HEADS + h) * 64 * KPOS + key0;
    bf16* MIX = (bf16*)(F.ws + WS_ACT);
    const f32x2* rope = (const f32x2*)(F.ws + WS_ROPE);
    const int row = qrow0 + 32 * F.wave + l31;
    const int vdv = F.tid >> 3, vpart = F.tid & 7;
    u32x4 kr0, kr1 = (u32x4){0u, 0u, 0u, 0u}, vr;
    kr0 = *(const u32x4*)((const char*)Kg + (size_t)F.tid * 16);
    if (F.tid < 256) kr1 = *(const u32x4*)((const char*)Kg + (size_t)(512 + F.tid) * 16);
    vr = *(const u32x4*)(Vg + (size_t)vdv * KPOS + vpart * 8);
    bf16x8 qf[3][2];
    {
        bf16x8 bq[16];
        const bf16* pxr = PX + (size_t)row * 512 + 8 * hi;
#pragma unroll
        for (int s = 0; s < 16; ++s) bq[s] = *(const bf16x8*)(pxr + 16 * s);
        float ss = 0.f;
#pragma unroll
        for (int s = 0; s < 16; ++s)
#pragma unroll
            for (int e = 0; e < 8; ++e) { const float x = bf2f((unsigned short)bq[s][e]); ss += x * x; }
        ss += __shfl_xor(ss, 32);
        const float rq = 1.0f / sqrtf(ss * (1.f / 256.f) + EPS);
        f32x16 qt[3];
#pragma unroll
        for (int blk = 0; blk < 3; ++blk) {
            f32x16 acc;
#pragma unroll
            for (int i = 0; i < 16; ++i) acc[i] = 0.f;
            const bf16* wrp = WUQ + (size_t)(h * 96 + 32 * blk + l31) * 256 + 8 * hi;
#pragma unroll
            for (int s = 0; s < 16; ++s) { const bf16x8 a = *(const bf16x8*)(wrp + 16 * s); acc = __builtin_amdgcn_mfma_f32_32x32x16_bf16(a, bq[s], acc, 0, 0, 0); }
            qt[blk] = acc * rq;
        }
        float s2 = 0.f;
#pragma unroll
        for (int blk = 0; blk < 3; ++blk)
#pragma unroll
            for (int i = 0; i < 16; ++i) s2 += qt[blk][i] * qt[blk][i];
        s2 += __shfl_xor(s2, 32);
        const float rs = (1.0f / sqrtf(s2 * (1.f / 96.f) + EPS));
        const float* gq = F.in->a_g_q + pair * 96;
#pragma unroll
        for (int blk = 0; blk < 3; ++blk)
#pragma unroll
            for (int c = 0; c < 4; ++c) { const f32x4 g = *(const f32x4*)(gq + 32 * blk + 8 * c + 4 * hi);
#pragma unroll
                for (int e = 0; e < 4; ++e) qt[blk][4 * c + e] *= rs * g[e]; }
        if (lat) {
            const int t = row & (SEQ - 1);
#pragma unroll
            for (int c = 0; c < 4; ++c) {
                const int pidx = (c < 2) ? (t >> 6) : (t & 63);
#pragma unroll
                for (int q = 0; q < 2; ++q) { const f32x2 cs = rope[pidx * 8 + ((4 * c + 2 * hi + q) & 7)]; const float t0 = qt[2][4 * c + 2 * q], t1 = qt[2][4 * c + 2 * q + 1];
                    qt[2][4 * c + 2 * q] = t0 * cs.x - t1 * cs.y; qt[2][4 * c + 2 * q + 1] = t0 * cs.y + t1 * cs.x; }
            }
        }
        const float sc = 0.10206207261596577f * LOG2E;
#pragma unroll
        for (int blk = 0; blk < 3; ++blk)
#pragma unroll
            for (int s = 0; s < 2; ++s) { u32x4 w;
                w.x = pk2(qt[blk][8 * s + 0] * sc, qt[blk][8 * s + 1] * sc); w.y = pk2(qt[blk][8 * s + 2] * sc, qt[blk][8 * s + 3] * sc);
                w.z = pk2(qt[blk][8 * s + 4] * sc, qt[blk][8 * s + 5] * sc); w.w = pk2(qt[blk][8 * s + 6] * sc, qt[blk][8 * s + 7] * sc);
                qf[blk][s] = __builtin_bit_cast(bf16x8, w); }
    }
    LAS unsigned char* L = F.lds;
    const int kd0 = (F.tid / 12) * AT_KP + (F.tid % 12) * 16, kd1 = ((512 + F.tid) / 12) * AT_KP + ((512 + F.tid) % 12) * 16, vd = AT_KB + vdv * AT_VP + vpart * 16;
    *(LAS u32x4*)(L + kd0) = kr0; if (F.tid < 256) *(LAS u32x4*)(L + kd1) = kr1; *(LAS u32x4*)(L + vd) = vr;
    __syncthreads();
    f32x16 oT[2];
#pragma unroll
    for (int d = 0; d < 2; ++d)
#pragma unroll
        for (int i = 0; i < 16; ++i) oT[d][i] = 0.f;
    float mrun = -3.0e38f, lrun = 0.f;
    const int kro = l31 * AT_KP + hi * 16, vro = AT_KB + l31 * AT_VP + hi * 16;
    for (int t = 0; t < nkt; ++t) {
        const bool more = (t + 1 < nkt);
        if (more) {
            const char* kg = (const char*)Kg + (size_t)(t + 1) * 64 * 192;
            kr0 = *(const u32x4*)(kg + (size_t)F.tid * 16);
            if (F.tid < 256) kr1 = *(const u32x4*)(kg + (size_t)(512 + F.tid) * 16);
            vr = *(const u32x4*)(Vg + (size_t)vdv * KPOS + (t + 1) * 64 + vpart * 8);
        }
        const LAS unsigned char* Lb = L + (t & 1) * AT_BUF;
        f32x16 sT[2];
#pragma unroll
        for (int kb = 0; kb < 2; ++kb) {
            f32x16 acc;
#pragma unroll
            for (int i = 0; i < 16; ++i) acc[i] = 0.f;
#pragma unroll
            for (int blk = 0; blk < 3; ++blk)
#pragma unroll
                for (int s = 0; s < 2; ++s) { const bf16x8 a = *(const LAS bf16x8*)(Lb + kro + kb * 32 * AT_KP + (32 * blk + 16 * s) * 2);
                    acc = __builtin_amdgcn_mfma_f32_32x32x16_bf16(a, qf[blk][s], acc, 0, 0, 0); }
            sT[kb] = acc;
        }
        float mx = sT[0][0];
#pragma unroll
        for (int kb = 0; kb < 2; ++kb)
#pragma unroll
            for (int i = 0; i < 16; ++i) mx = fmaxf(mx, sT[kb][i]);
        mx = fmaxf(mx, __shfl_xor(mx, 32));
        const float mnew = fmaxf(mrun, mx);
        const float alpha = __builtin_amdgcn_exp2f(mrun - mnew);
        mrun = mnew;
        float psum = 0.f;
        bf16x8 pf[2][2];
#pragma unroll
        for (int kb = 0; kb < 2; ++kb) {
            float p[16];
#pragma unroll
            for (int i = 0; i < 16; ++i) { p[i] = __builtin_amdgcn_exp2f(sT[kb][i] - mnew); psum += p[i]; }
#pragma unroll
            for (int s = 0; s < 2; ++s) { u32x4 w; w.x = cvt_pk_bf16(p[8 * s + 0], p[8 * s + 1]); w.y = cvt_pk_bf16(p[8 * s + 2], p[8 * s + 3]); w.z = cvt_pk_bf16(p[8 * s + 4], p[8 * s + 5]); w.w = cvt_pk_bf16(p[8 * s + 6], p[8 * s + 7]);
                pf[kb][s] = __builtin_bit_cast(bf16x8, w); }
        }
        lrun = lrun * alpha + psum;
#pragma unroll
        for (int d = 0; d < 2; ++d) oT[d] = oT[d] * alpha;
#pragma unroll
        for (int d = 0; d < 2; ++d)
#pragma unroll
            for (int kb = 0; kb < 2; ++kb)
#pragma unroll
                for (int s = 0; s < 2; ++s) { const bf16x8 a = *(const LAS bf16x8*)(Lb + vro + d * 32 * AT_VP + (32 * kb + 16 * s) * 2);
                    oT[d] = __builtin_amdgcn_mfma_f32_32x32x16_bf16(a, pf[kb][s], oT[d], 0, 0, 0); }
        if (more) {
            LAS unsigned char* Ln = L + ((t + 1) & 1) * AT_BUF;
            *(LAS u32x4*)(Ln + kd0) = kr0; if (F.tid < 256) *(LAS u32x4*)(Ln + kd1) = kr1; *(LAS u32x4*)(Ln + vd) = vr;
        }
        __syncthreads();
    }
    lrun += __shfl_xor(lrun, 32);
    const float inv = 1.0f / lrun;
    bf16* op = MIX + (size_t)row * DM + h * 64 + 4 * hi;
#pragma unroll
    for (int d = 0; d < 2; ++d)
#pragma unroll
        for (int c = 0; c < 4; ++c) *(u32x2*)(op + 32 * d + 8 * c) = (u32x2){pk2(oT[d][4 * c] * inv, oT[d][4 * c + 1] * inv), pk2(oT[d][4 * c + 2] * inv, oT[d][4 * c + 3] * inv)};
}

__device__ __forceinline__ void mla_attn_phase(Frame& F, int pair) {
    constexpr int NLU = NB * A_HEADS * (SEQ / 256), NCU = NB * A_HEADS;
    for (;;) {
        if (F.tid == 0) F.MISC[0] = __hip_atomic_fetch_add(F.ctl + CW_ATTQ + 64 * pair, 1u, RLX_AGENT);
        __syncthreads();
        const int u = (int)F.MISC[0];
        __syncthreads();
        if (u >= NLU + NCU) break;
        if (u < NLU) { const int qb = u & 15, bh = u >> 4, b = bh / A_HEADS, h = bh % A_HEADS; mla_attn_unit(F, pair, b, h, b * SEQ + qb * 256, true, 0, KPOS / 64); }
        else { const int bh = u - NLU, b = bh / A_HEADS, h = bh % A_HEADS; mla_attn_unit(F, pair, b, h, NLAT + b * CTXL, false, SEQ, CTXL / 64); }
    }
}

__device__ __forceinline__ void na_wave(Frame& F, const LAS float* rpbs, int b, int h, bool lat, int qr, int c0, int qrow0) {
    const int lane = F.lane, l15 = lane & 15, g = lane >> 4;
    const bf16* QN = (const bf16*)(F.ws + WS_QN); const bf16* KN = (const bf16*)(F.ws + WS_KN);
    const bf16* Vt = (const bf16*)(F.ws + WS_VTN) + (size_t)(b * C_HEADS + h) * 64 * KPOS;
    bf16* MIX = (bf16*)(F.ws + WS_ACT);
    const int qrow = qrow0 + l15;
    bf16x8 qf[2];
#pragma unroll
    for (int s = 0; s < 2; ++s) qf[s] = *(const bf16x8*)(QN + (size_t)qrow * DM + h * 64 + 32 * s + 8 * g);
    const int rs = min(max(qr - 4, 0), 56), ks = min(max(c0 - 8, 0), 32);
    f32x4 sc[32];
#pragma unroll
    for (int t = 0; t < 32; ++t) {
        if (t < 16 && !lat) { sc[t] = (f32x4){-1.0e30f, -1.0e30f, -1.0e30f, -1.0e30f}; continue; }
        int krow;
        if (t < 16) krow = b * SEQ + (rs + (t >> 1)) * 64 + ks + 16 * (t & 1) + l15;
        else krow = NLAT + b * CTXL + 16 * (t - 16) + l15;
        const bf16* kp = KN + (size_t)krow * DM + h * 64 + 8 * g;
        f32x4 acc = (f32x4){0.f, 0.f, 0.f, 0.f};
#pragma unroll
        for (int s = 0; s < 2; ++s) { const bf16x8 a = *(const bf16x8*)(kp + 32 * s); acc = __builtin_amdgcn_mfma_f32_16x16x32_bf16(a, qf[s], acc, 0, 0, 0); }
        if (t < 16) {
            const int cq = c0 + l15, cs = min(max(cq - 8, 0), 48), kr = rs + (t >> 1), dr = kr - qr + 7;
#pragma unroll
            for (int e = 0; e < 4; ++e) { const int kc = ks + 16 * (t & 1) + 4 * g + e; const bool ok = (kc >= cs) && (kc < cs + 16); const int dc = kc - cq + 15;
                acc[e] = ok ? acc[e] + rpbs[dr * 31 + min(max(dc, 0), 30)] : -1.0e30f; }
        }
        sc[t] = acc;
    }
    float mx = -3.0e38f;
#pragma unroll
    for (int t = 0; t < 32; ++t)
#pragma unroll
        for (int e = 0; e < 4; ++e) mx = fmaxf(mx, sc[t][e]);
    mx = fmaxf(mx, __shfl_xor(mx, 16)); mx = fmaxf(mx, __shfl_xor(mx, 32));
    float lsum = 0.f;
    bf16x8 pf[16];
#pragma unroll
    for (int u = 0; u < 16; ++u) { float p[8];
#pragma unroll
        for (int e = 0; e < 4; ++e) { p[e] = __builtin_amdgcn_exp2f(sc[2 * u][e] - mx); p[4 + e] = __builtin_amdgcn_exp2f(sc[2 * u + 1][e] - mx); }
#pragma unroll
        for (int e = 0; e < 8; ++e) lsum += p[e];
        u32x4 w; w.x = cvt_pk_bf16(p[0], p[1]); w.y = cvt_pk_bf16(p[2], p[3]); w.z = cvt_pk_bf16(p[4], p[5]); w.w = cvt_pk_bf16(p[6], p[7]);
        pf[u] = __builtin_bit_cast(bf16x8, w); }
    lsum += __shfl_xor(lsum, 16); lsum += __shfl_xor(lsum, 32);
    const float inv = 1.0f / lsum;
    bf16* op = MIX + (size_t)qrow * DM + h * 64 + 4 * g;
#pragma unroll
    for (int dvt = 0; dvt < 4; ++dvt) {
        f32x4 acc = (f32x4){0.f, 0.f, 0.f, 0.f};
        const bf16* vrow = Vt + (size_t)(16 * dvt + l15) * KPOS + 4 * g;
#pragma unroll
        for (int u = 0; u < 16; ++u) {
            if (u < 8 && !lat) continue;
            const int pos = (u < 8) ? (rs + u) * 64 + ks : SEQ + 32 * (u - 8);
            const u32x2 lo = *(const u32x2*)(vrow + pos), hi2 = *(const u32x2*)(vrow + pos + 16);
            const u32x4 w = (u32x4){lo.x, lo.y, hi2.x, hi2.y};
            acc = __builtin_amdgcn_mfma_f32_16x16x32_bf16(__builtin_bit_cast(bf16x8, w), pf[u], acc, 0, 0, 0);
        }
        *(u32x2*)(op + 16 * dvt) = (u32x2){pk2(acc[0] * inv, acc[1] * inv), pk2(acc[2] * inv, acc[3] * inv)};
    }
}
__device__ __forceinline__ void na_phase(Frame& F, int pair) {
    LAS float* rpbs = (LAS float*)(F.lds);
    constexpr int NLU = NB * C_HEADS * 32, NCU = NB * C_HEADS * 2;
    int hcur = -1;
    for (int u = F.bid; u < NLU + NCU; u += F.G) {
        int b, h, r2 = 0, ch = 0; const bool lat = u < NLU;
        if (lat) { h = u / (NB * 32); const int rem = u % (NB * 32); b = rem >> 5; r2 = rem & 31; }
        else { const int v = u - NLU; h = v / (NB * 2); const int rem = v % (NB * 2); b = rem >> 1; ch = rem & 1; }
        if (h != hcur) {
            __syncthreads();
            const float* rp = F.in->c_rpb + ((size_t)pair * C_HEADS + h) * 15 * 31;
            for (int i = F.tid; i < 15 * 31; i += NWAVES * 64) rpbs[i] = rp[i] * LOG2E;
            __syncthreads();
            hcur = h;
        }
        if (lat) { const int qr = 2 * r2 + (F.wave >> 2), c0 = 16 * (F.wave & 3); na_wave(F, rpbs, b, h, true, qr, c0, b * SEQ + qr * 64 + c0); }
        else na_wave(F, rpbs, b, h, false, 0, 0, NLAT + b * CTXL + ch * 128 + 16 * F.wave);
    }
    __syncthreads();
}

constexpr int PH_PER_PAIR = 16, N_PHASES = 2 * PH_PER_PAIR + 1;
struct Args { Inputs in; float* out; unsigned char* ws; int ph_lo, ph_hi; };
static_assert(sizeof(Args) == 27 * 8 + 8 + 8 + 8, "Args has no padding bytes");

__global__ void __launch_bounds__(NWAVES * 64, 2) dit_fwd(Args args) {
    extern __shared__ __attribute__((aligned(16))) unsigned char lds_raw[];
    Frame F;
    F.lds = (LAS unsigned char*)lds_raw;
    F.MISC = (volatile LAS unsigned*)(F.lds + MISC_OFF);
    F.tid = threadIdx.x; F.lane = F.tid & 63; F.wave = __builtin_amdgcn_readfirstlane(F.tid >> 6);
    F.G = gridDim.x; F.bid = blockIdx.x;
    F.ws = args.ws; F.ctl = (gu32*)(args.ws + WS_CTL); F.out = args.out; F.hc = (float*)(args.ws + WS_HC); F.in = (const CAS Inputs*)__builtin_amdgcn_kernarg_segment_ptr();
    for (int u = F.tid; u < (LDS_BYTES - LDSCTL_OFF) / 4; u += NWAVES * 64) ((LAS unsigned*)(F.lds + LDSCTL_OFF))[u] = 0u;
    __syncthreads();
    const int lo = args.ph_lo, hi = args.ph_hi;
    const bool use_bar = (hi - lo) > 1;
    XcdBarrier bar; bar.bar = (unsigned*)(F.ctl + CW_BAR); bar.x = 0; bar.st = nullptr;
    if (use_bar) bar = xcd_barrier_post((unsigned*)(F.ctl + CW_BAR), F.MISC + 8);
#ifndef ONLYP
#define PH_EN(c) true
#else
#define PH_EN(c) ((c) == ONLYP)
#endif
#define INR(k) (lo <= (k) && (k) < hi)
#define FRESH() do { asm volatile("" : "+s"(F.ws), "+s"(F.out), "+s"(F.hc), "+s"(F.ctl), "+s"(F.in)); asm volatile("" : "+v"(F.tid)); F.lane = F.tid & 63; W = F.ws + WS_W; MODB = (const float*)(F.ws + WS_MOD); ACT = (bf16*)(F.ws + WS_ACT); } while (0)
#define IN(k) (PH_EN((k) - P) && INR(k))
#define SEAM(k) do { if (INR(k) && INR((k) + 1)) { asm volatile("" : "+s"(bar.bar), "+s"(bar.x)); xcd_barrier(bar); } } while (0)
    unsigned char* W; const float* MODB; bf16* ACT;
    volatile LAS int* MOE = (volatile LAS int*)(F.lds + MOE_LDS_OFF);
    LAS unsigned char* ring = F.lds + RING_OFF;

    for (int j = 0; j < 2; ++j) {
        const int P = j * PH_PER_PAIR, le = 2 * j, lod = 2 * j + 1;
        if (IN(P + 0)) { FRESH(); prep_phase(F, j); } SEAM(P + 0);
        if (IN(P + 1)) { FRESH(); norm_phase(F, NormArgs{le, 0, j == 0, j > 0 ? j - 1 : -1, -1, 0}); } SEAM(P + 1);
        if (IN(P + 2)) { FRESH();
            SchedStatic S{ACT, 1024, (const bf16*)(W + WO_WIN_E), 1024, NTOK / 256, 4, F.G, F.bid};
            EpiWin E{(bf16*)(F.ws + WS_PX), (bf16*)(F.ws + WS_GT), (bf16*)(F.ws + WS_GTC)};
            pg8::gemm_phase<EpiWin, SchedStatic>(ring, 1024, S, E, F.tid);
        } SEAM(P + 2);
        if (IN(P + 3)) { FRESH();
            SchedStatic S{(const bf16*)(F.ws + WS_PX) + 256, 512, (const bf16*)(W + WO_WUKV), 256, NTOK / 256, 6, F.G, F.bid};
            EpiKV E{(const bf16*)(F.ws + WS_PX), (bf16*)(F.ws + WS_K), (bf16*)(F.ws + WS_VT), F.in->a_g_k + j * 96, (const f32x2*)(F.ws + WS_ROPE)};
            pg8::gemm_phase<EpiKV, SchedStatic>(ring, 256, S, E, F.tid);
        } SEAM(P + 3);
        if (IN(P + 4)) { FRESH();
            {
                const bool latf = F.bid < 128; const int have = F.bid < 136;
                SchedOne S{latf ? (const bf16*)(F.ws + WS_DFT) : (const bf16*)(F.ws + WS_DFTC), latf ? 8192 : 512, latf ? (const bf16*)(F.ws + WS_GT) : (const bf16*)(F.ws + WS_GTC), latf ? 8192 : 512,
                           latf ? (F.bid >> 3) : 0, latf ? (F.bid & 7) : (F.bid - 128), have};
                EpiBf16 E{ACT, 1024, latf ? 1 : 2};
                pg8::gemm_phase<EpiBf16, SchedOne>(ring, S.K, S, E, F.tid);
            }
            __syncthreads();
            mla_attn_phase(F, j);
        } SEAM(P + 4);
        if (IN(P + 5)) { FRESH();
            SchedStatic S{ACT, 1024, (const bf16*)(W + WO_WOUT_E), 1024, NTOK / 256, 4, F.G, F.bid};
            EpiResid E{F.out, F.hc, MODB + (size_t)le * 9 * 6144, 2};
            pg8::gemm_phase<EpiResid, SchedStatic>(ring, 1024, S, E, F.tid);
        } SEAM(P + 5);
        if (IN(P + 6)) { FRESH(); norm_phase(F, NormArgs{le, 1, 0, -1, -1, 0}); } SEAM(P + 6);
        if (IN(P + 7)) { FRESH();
            SchedStatic S{ACT, 1024, (const bf16*)(W + WO_WGU_E), 1024, NTOK / 256, 2 * DFF / 256, F.G, F.bid};
            EpiSwiglu E{(bf16*)(F.ws + WS_HMID), DFF};
            pg8::gemm_phase<EpiSwiglu, SchedStatic>(ring, 1024, S, E, F.tid);
        } SEAM(P + 7);
        if (IN(P + 8)) { FRESH();
            SchedStatic S{(const bf16*)(F.ws + WS_HMID), DFF, (const bf16*)(W + WO_WDN_E), DFF, NTOK / 256, 4, F.G, F.bid};
            EpiResid E{F.out, F.hc, MODB + (size_t)le * 9 * 6144, 5};
            pg8::gemm_phase<EpiResid, SchedStatic>(ring, DFF, S, E, F.tid);
        } SEAM(P + 8);
        if (IN(P + 9)) { FRESH(); norm_phase(F, NormArgs{lod, 0, 0, -1, -1, 0}); } SEAM(P + 9);
        if (IN(P + 10)) { FRESH();
            SchedStatic S{ACT, 1024, (const bf16*)(W + WO_WIN_O), 1024, NTOK / 256, 12, F.G, F.bid};
            EpiNAin E{(bf16*)(F.ws + WS_QN), (bf16*)(F.ws + WS_KN), (bf16*)(F.ws + WS_VTN), F.in->c_g_q + j * 64, F.in->c_g_k + j * 64};
            pg8::gemm_phase<EpiNAin, SchedStatic>(ring, 1024, S, E, F.tid);
        } SEAM(P + 10);
        if (IN(P + 11)) { FRESH(); na_phase(F, j); } SEAM(P + 11);
        if (IN(P + 12)) { FRESH();
            SchedStatic S{ACT, 1024, (const bf16*)(W + WO_WOUT_O), 1024, NTOK / 256, 4, F.G, F.bid};
            EpiResid E{F.out, F.hc, MODB + (size_t)lod * 9 * 6144, 2};
            pg8::gemm_phase<EpiResid, SchedStatic>(ring, 1024, S, E, F.tid);
        } SEAM(P + 12);
        if (IN(P + 13)) { FRESH(); norm_phase(F, NormArgs{lod, 1, 0, -1, j, 0}); } SEAM(P + 13);
        if (IN(P + 14)) { FRESH();
            moe_panels_to_lds(F, j);
            SchedMoe<true> S{ACT, 1024, (const bf16*)(W + WO_WGU_M), (size_t)2 * DFFE * 1024 * 2, 1024, 2 * DFFE / 256, F.G, F.bid, (const int*)(F.ws + WS_LIST), MOE};
            EpiSwiglu E{(bf16*)(F.ws + WS_HMOE), DFFE};
            pg8::gemm_phase<EpiSwiglu, SchedMoe<true>>(ring, 1024, S, E, F.tid);
        } SEAM(P + 14);
        if (IN(P + 15)) { FRESH();
            moe_panels_to_lds(F, j);
            SchedMoe<false> S{(const bf16*)(F.ws + WS_HMOE), DFFE, (const bf16*)(W + WO_WDN_M), (size_t)1024 * DFFE * 2, DFFE, 4, F.G, F.bid, nullptr, MOE};
            EpiBf16 E{(bf16*)(F.ws + WS_Y), 1024, 0};
            pg8::gemm_phase<EpiBf16, SchedMoe<false>>(ring, DFFE, S, E, F.tid);
        } SEAM(P + 15);
    }
    { const int P = 0; if (IN(2 * PH_PER_PAIR)) { FRESH(); norm_phase(F, NormArgs{3, 0, 0, 1, -1, 1}); } }
#undef IN
#undef INR
#undef SEAM
}

#if DBG

#endif

extern "C" void kernel_launch(void* const* d_in, const int* in_sizes, int n_in, void* d_out, int out_size, void* d_ws, size_t ws_size, hipStream_t stream) {
    static int grid = 0;
    if (grid == 0) {
        if (n_in != 27 || in_sizes[0] != NLAT * DM || out_size != NLAT * DM || ws_size < WS_END) {
            fprintf(stderr, "kernel_launch: built for 27 inputs, x/out of %d floats, >= %zu bytes of workspace; got n_in %d, in0 %d, out %d, ws %zu; nothing launched\n", NLAT * DM, (size_t)WS_END, n_in, n_in > 0 ? in_sizes[0] : -1, out_size, ws_size);
            grid = -1; return; }
        int dev = 0, cus = 0, per_cu = 0;
        if (hipGetDevice(&dev) != hipSuccess || hipDeviceGetAttribute(&cus, hipDeviceAttributeMultiprocessorCount, dev) != hipSuccess) { fprintf(stderr, "kernel_launch: device query failed\n"); grid = -1; return; }
        if (hipFuncSetAttribute((const void*)dit_fwd, hipFuncAttributeMaxDynamicSharedMemorySize, LDS_BYTES) != hipSuccess) { fprintf(stderr, "kernel_launch: hipFuncSetAttribute failed\n"); grid = -1; return; }
        if (hipOccupancyMaxActiveBlocksPerMultiprocessor(&per_cu, (const void*)dit_fwd, NWAVES * 64, LDS_BYTES) != hipSuccess || per_cu < 1) { fprintf(stderr, "kernel_launch: occupancy query reports %d workgroups per CU\n", per_cu); }
        (void)hipGetLastError();
        grid = cus;
    }
    if (grid < 0) return;
    if (hipMemsetAsync((char*)d_ws + WS_CTL, 0, CTL_ZERO_BYTES, stream) != hipSuccess) { fprintf(stderr, "kernel_launch: memset failed\n"); return; }
    Args a{};
    const float** ip = (const float**)&a.in;
    for (int i = 0; i < 27; ++i) ip[i] = (const float*)d_in[i];
    a.out = (float*)d_out; a.ws = (unsigned char*)d_ws;
#if DBG
    dbg_launch_all(a, grid, stream);
#else
    a.ph_lo = 0; a.ph_hi = N_PHASES;
    hipLaunchKernelGGL(dit_fwd, dim3(grid), dim3(NWAVES * 64), LDS_BYTES, stream, a);
    const hipError_t le = hipPeekAtLastError();
    if (le != hipSuccess) fprintf(stderr, "kernel_launch: launch failed: %s\n", hipGetErrorName(le));
#endif
}
```

```cpp
#include <hip/hip_runtime.h>
#include <cstdio>
#include <cstdint>

#define LAS __attribute__((address_space(3)))
#define GAS __attribute__((address_space(1)))
typedef unsigned short bf16;
typedef short bf16x8 __attribute__((ext_vector_type(8)));
typedef short bf16x4 __attribute__((ext_vector_type(4)));
typedef float f32x4 __attribute__((ext_vector_type(4)));
typedef float f32x2 __attribute__((ext_vector_type(2)));
typedef float f32x16 __attribute__((ext_vector_type(16)));
typedef unsigned u32x4 __attribute__((ext_vector_type(4)));
typedef unsigned u32x2 __attribute__((ext_vector_type(2)));

#define DBG 0

constexpr int DM = 1024, NB = 8, SEQ = 4096, CTXL = 256;
constexpr int NLAT = NB * SEQ, NCTX = NB * CTXL, NTOK = NLAT + NCTX;
constexpr int KPOS = SEQ + CTXL;
constexpr int A_HEADS = 12, A_QK = 96, A_IN_SRC = 672;
constexpr int C_HEADS = 16;
constexpr int DFF = 2816, NEXP = 8, DFFE = 1408;
constexpr int MOE_SLOTS = 2 * NTOK + NEXP * 256;
constexpr float EPS = 1e-6f;
constexpr float LOG2E = 1.4426950408889634f;

__device__ __forceinline__ unsigned f2bf(float f) { unsigned u = __builtin_bit_cast(unsigned, f); return (u + 0x7fffu + ((u >> 16) & 1u)) >> 16; }
__device__ __forceinline__ unsigned pk2(float lo, float hi) { return f2bf(lo) | (f2bf(hi) << 16); }
__device__ __forceinline__ float bf2f(unsigned short h) { return __builtin_bit_cast(float, (unsigned)h << 16); }
__device__ __forceinline__ float bflo(unsigned w) { return __builtin_bit_cast(float, w << 16); }
__device__ __forceinline__ float bfhi(unsigned w) { return __builtin_bit_cast(float, w & 0xffff0000u); }

namespace pg8 {
typedef unsigned u32x4 __attribute__((ext_vector_type(4)));
#define PG8_LAS __attribute__((address_space(3)))
constexpr int GN_LDS_OFF = 131072;
constexpr int BM = 256, BK = 64, HALF = 128, HTB = HALF * BK * 2  , STAGE_BYTES = 8 * HTB, NXCD = 8, WGM = 8;

__host__ __device__ __forceinline__ int lds_byte(int r, int c) { const int st = (r >> 4) * 2 + (c >> 5), rr = r & 15, cc = c & 31, ob = rr * 64 + cc * 2; return st * 1024 + (ob ^ (((ob >> 9) & 1) << 5)); }
__host__ __device__ __forceinline__ void stage_rc(int b, int& R, int& C) { const int st = b / 1024, sb = b % 1024, swz = sb ^ (((sb >> 9) & 1) << 5); R = (st >> 1) * 16 + swz / 64; C = (st & 1) * 32 + (swz % 64) / 2; }
__host__ __device__ __forceinline__ int perm32(int rho) { const int n = rho >> 4, i = rho & 15; return 8 * (i >> 2) + 4 * n + (i & 3); }

struct Unit { int pm, pn; };

__device__ __forceinline__ bool static_next(int i, int G, int c, int nM, int nN, Unit& u) {
    const int nwg = nM * nN;
    const long L = (long)i * G + c; if (L >= nwg) return false;
    int wgid = (int)L; { const int q = nwg / NXCD, r = nwg % NXCD, xcd = wgid % NXCD, off = wgid / NXCD; wgid = (xcd < r ? xcd * (q + 1) : r * (q + 1) + (xcd - r) * q) + off; }
    const int nig = WGM * nN, gid = wgid / nig, fm = gid * WGM, gsz = (nM - fm) < WGM ? (nM - fm) : WGM;
    u.pm = fm + ((wgid % nig) % gsz); u.pn = (wgid % nig) / gsz; return true;
}

template <class Epi, class Sched, bool ALIGN_EPI = true, bool SP2 = true>
__device__ __forceinline__ void gemm_phase(PG8_LAS unsigned char* lds, const int K, const Sched& S, const Epi& E, const int tid) {
    const int wid = __builtin_amdgcn_readfirstlane(tid >> 6), lane = tid & 63, wr = wid >> 2, wc = wid & 3, fr = lane & 15, fq = lane >> 4;
    const int nt = K / BK;
    unsigned voffB[2], voffA[2];
    const unsigned lda = (unsigned)S.lda;
#pragma unroll
    for (int i = 0; i < 2; ++i) { int R, C; stage_rc(tid * 16 + i * 8192, R, C); const int Rb = Epi::PERM ? ((R & ~31) + perm32(R & 31)) : R;
        voffB[i] = (unsigned)(Rb * K + C) * 2u; voffA[i] = ((unsigned)R * lda + (unsigned)C) * 2u; }
    const char* const Ab = (const char*)S.A;
    const size_t kstep = (size_t)(BK * 2);
    const size_t hstep = (size_t)HALF * K * 2;
    const size_t hstepA = (size_t)HALF * lda * 2;
    const unsigned ldsw = (unsigned)wid * 1024u;
    const int aoff = lds_byte(wr * 64 + fr, fq * 8), boff = lds_byte(wc * 32 + fr, fq * 8);
#define PG8_SA(b, h) (((b) * 2 + (h)) * HTB)
#define PG8_SB(b, h) ((4 + (b) * 2 + (h)) * HTB)
#define PG8_STAGE(bufoff, gbase, voff) do { _Pragma("unroll") for (int _i = 0; _i < 2; ++_i) \
        __builtin_amdgcn_global_load_lds((const unsigned*)((const char*)(gbase) + (voff)[_i]), (PG8_LAS unsigned*)(lds + (bufoff) + ldsw + _i * 8192), 16, 0, 0); } while (0)
#define PG8_LDA(dst, b, h) do { _Pragma("unroll") for (int m = 0; m < 4; ++m) _Pragma("unroll") for (int k = 0; k < 2; ++k) dst[m][k] = *(const PG8_LAS bf16x8*)(lds + PG8_SA(b, h) + aoff + m * 2048 + k * 1024); } while (0)
#define PG8_LDB(dst, b, h) do { _Pragma("unroll") for (int n = 0; n < 2; ++n) _Pragma("unroll") for (int k = 0; k < 2; ++k) dst[n][k] = *(const PG8_LAS bf16x8*)(lds + PG8_SB(b, h) + boff + n * 2048 + k * 1024); } while (0)
#define PG8_MMA(ai, bj, At, Bt) do { __builtin_amdgcn_s_setprio(1); _Pragma("unroll") for (int m = 0; m < 4; ++m) _Pragma("unroll") for (int n = 0; n < 2; ++n) _Pragma("unroll") for (int k = 0; k < 2; ++k) \
        acc[ai][bj][m][n] = __builtin_amdgcn_mfma_f32_16x16x32_bf16(Bt[n][k], At[m][k], acc[ai][bj][m][n], 0, 0, 0); __builtin_amdgcn_s_setprio(0); } while (0)
#define PG8_WAIT_V(n) asm volatile("s_waitcnt vmcnt(" #n ")" ::: "memory")
#define PG8_WAIT_L(n) asm volatile("s_waitcnt lgkmcnt(" #n ")" ::: "memory")
#define PG8_BAR __builtin_amdgcn_s_barrier()
#define PG8_SCHED __builtin_amdgcn_sched_barrier(0)
    Unit cur, nxt; int ui = 0;
    if (!S.next(0, cur)) return;
    f32x4 acc[2][2][4][2];
    bf16x8 At[4][2], B0[2][2], B1[2][2];
    constexpr bool GATHER = Sched::GATHER;
    const char* cA = Ab; const char* nA = Ab;
    unsigned ga0[2] = {0u, 0u}, ga1[2] = {0u, 0u};
    PG8_LAS u32x4* const gnslot = (PG8_LAS u32x4*)(lds + GN_LDS_OFF) + tid;
    if constexpr (GATHER) {
#pragma unroll
        for (int i = 0; i < 2; ++i) { int R, C; stage_rc(tid * 16 + i * 8192, R, C); ga0[i] = (S.a_row(cur, R) * lda + (unsigned)C) * 2u; ga1[i] = (S.a_row(cur, HALF + R) * lda + (unsigned)C) * 2u; }
    } else { cA = Ab + (size_t)S.a_row(cur, 0) * lda * 2; }
    const char* cB = S.b_base(cur);
#define PG8_STAGE_A(bufoff, h, uptr, kb, g0, g1) do { if constexpr (GATHER) { if (h) PG8_STAGE(bufoff, Ab + (kb), g1); else PG8_STAGE(bufoff, Ab + (kb), g0); } \
        else { PG8_STAGE(bufoff, (uptr) + (h) * hstepA + (kb), voffA); } } while (0)
    static_assert(SP2, "only the SP2 loop is carried here");
    PG8_STAGE(PG8_SB(0, 0), cB, voffB); PG8_STAGE(PG8_SB(0, 1), cB + hstep, voffB); PG8_STAGE_A(PG8_SA(0, 0), 0, cA, 0, ga0, ga1); PG8_STAGE_A(PG8_SA(0, 1), 1, cA, 0, ga0, ga1);
    if (wr == 1) PG8_BAR;
    PG8_WAIT_V(2); PG8_BAR;
    PG8_STAGE(PG8_SB(1, 0), cB + kstep, voffB); PG8_STAGE_A(PG8_SA(1, 0), 0, cA, kstep, ga0, ga1); PG8_STAGE(PG8_SB(1, 1), cB + hstep + kstep, voffB);
    PG8_WAIT_V(6); PG8_BAR;
    for (;;) {
        const bool has_next = S.next(ui + 1, nxt);
        const char* nB = has_next ? S.b_base(nxt) : cB;
        if constexpr (GATHER) {
            u32x4 gn = (u32x4){ga0[0], ga0[1], ga1[0], ga1[1]};
            if (has_next) { int R0, C0, R1, C1; stage_rc(tid * 16, R0, C0); stage_rc(tid * 16 + 8192, R1, C1);
                gn.x = (S.a_row(nxt, R0) * lda + (unsigned)C0) * 2u; gn.y = (S.a_row(nxt, R1) * lda + (unsigned)C1) * 2u;
                gn.z = (S.a_row(nxt, HALF + R0) * lda + (unsigned)C0) * 2u; gn.w = (S.a_row(nxt, HALF + R1) * lda + (unsigned)C1) * 2u; }
            *gnslot = gn;
        } else { nA = has_next ? Ab + (size_t)S.a_row(nxt, 0) * lda * 2 : cA; }
#pragma unroll
        for (int a = 0; a < 2; ++a)
#pragma unroll
            for (int b = 0; b < 2; ++b)
#pragma unroll
                for (int m = 0; m < 4; ++m)
#pragma unroll
                    for (int n = 0; n < 2; ++n) acc[a][b][m][n] = (f32x4){0.f, 0.f, 0.f, 0.f};
#pragma nounroll
        for (int t = 0; t < nt; t += 2) {
            const bool last = (t == nt - 2);
            const size_t k1 = (size_t)(t + 1) * kstep, k2 = last ? 0 : (size_t)(t + 2) * kstep, k3 = k2 + kstep;
            const char* u2 = last ? nA : cA;
            const char* b2 = last ? nB : cB + (size_t)(t + 2) * kstep; const char* b3 = b2 + kstep;
            unsigned o20[2] = {0u, 0u}, o21[2] = {0u, 0u};
            if constexpr (GATHER) {
                if (last) { const u32x4 gn = *gnslot; o20[0] = gn.x; o20[1] = gn.y; o21[0] = gn.z; o21[1] = gn.w; }
                else { o20[0] = ga0[0]; o20[1] = ga0[1]; o21[0] = ga1[0]; o21[1] = ga1[1]; }
            }
            PG8_LDB(B0, 0, 0); PG8_LDB(B1, 0, 1); PG8_SCHED; PG8_LDA(At, 0, 0); PG8_STAGE_A(PG8_SA(1, 1), 1, cA, k1, ga0, ga1);
            PG8_WAIT_V(8); PG8_WAIT_L(0); PG8_BAR; PG8_MMA(0, 0, At, B0); PG8_MMA(0, 1, At, B1); PG8_BAR; PG8_SCHED;
            PG8_LDA(At, 0, 1); PG8_STAGE(PG8_SB(0, 0), b2, voffB); PG8_STAGE(PG8_SB(0, 1), b2 + hstep, voffB); PG8_STAGE_A(PG8_SA(0, 0), 0, u2, k2, o20, o21);
            PG8_WAIT_V(8); PG8_WAIT_L(0); PG8_BAR; PG8_MMA(1, 0, At, B0); PG8_MMA(1, 1, At, B1); PG8_BAR; PG8_SCHED;
            PG8_LDB(B0, 1, 0); PG8_LDB(B1, 1, 1); PG8_SCHED; PG8_LDA(At, 1, 0); PG8_STAGE_A(PG8_SA(0, 1), 1, u2, k2, o20, o21);
            PG8_WAIT_V(8); PG8_WAIT_L(0); PG8_BAR; PG8_MMA(0, 0, At, B0); PG8_MMA(0, 1, At, B1); PG8_BAR; PG8_SCHED;
            PG8_LDA(At, 1, 1); PG8_STAGE(PG8_SB(1, 0), b3, voffB); PG8_STAGE(PG8_SB(1, 1), b3 + hstep, voffB); PG8_STAGE_A(PG8_SA(1, 0), 0, u2, k3, o20, o21);
            PG8_WAIT_V(8); PG8_WAIT_L(0); PG8_BAR; PG8_MMA(1, 0, At, B0); PG8_MMA(1, 1, At, B1); PG8_BAR; PG8_SCHED;
        }
        if constexpr (ALIGN_EPI) { if (wr == 0) PG8_BAR; }
        { int fr_ = fr, fq_ = fq, wr_ = wr, wc_ = wc; asm volatile("" : "+v"(fr_), "+v"(fq_), "+s"(wr_), "+s"(wc_));
          E(acc, cur, wr_, wc_, fr_, fq_); }
        if (!has_next) break;
        cur = nxt; cB = nB; cA = nA; ++ui;
        if constexpr (GATHER) { const u32x4 gn = *gnslot; ga0[0] = gn.x; ga0[1] = gn.y; ga1[0] = gn.z; ga1[1] = gn.w; }
        if constexpr (ALIGN_EPI) { if (wr == 1) PG8_BAR; }
    }
    PG8_WAIT_V(0);
    if constexpr (!ALIGN_EPI) { if (wr == 0) PG8_BAR; }
    PG8_BAR;
#undef PG8_SA
#undef PG8_SB
#undef PG8_STAGE
#undef PG8_STAGE_A
#undef PG8_LDA
#undef PG8_LDB
#undef PG8_MMA
#undef PG8_WAIT_V
#undef PG8_WAIT_L
#undef PG8_BAR
#undef PG8_SCHED
}
}

constexpr size_t MiB = 1u << 20;
constexpr size_t WS_CTL = 0, CTL_ZERO_BYTES = 1 * MiB;
constexpr size_t WS_MOD = 1 * MiB;
constexpr size_t WS_ROPE = 2 * MiB;
constexpr size_t WS_ROUTE = 3 * MiB;
constexpr size_t WS_LIST = 4 * MiB;
constexpr size_t WS_SNAP = 6 * MiB;
constexpr size_t WS_HC = 8 * MiB;
constexpr size_t WS_W = 16 * MiB;
constexpr size_t WS_DFT = 114 * MiB;
constexpr size_t WS_DFTC = WS_DFT + 64 * MiB;
constexpr size_t WS_SCR = 180 * MiB;
constexpr size_t WS_ACT = WS_SCR;
constexpr size_t WS_PX = WS_SCR + 68 * MiB;
constexpr size_t WS_GT = WS_SCR + 102 * MiB;
constexpr size_t WS_GTC = WS_SCR + 134 * MiB;
constexpr size_t WS_K = WS_SCR + 136 * MiB;
constexpr size_t WS_VT = WS_SCR + 213 * MiB;
constexpr size_t WS_HMID = WS_SCR + 68 * MiB;
constexpr size_t WS_QN = WS_SCR + 68 * MiB;
constexpr size_t WS_KN = WS_SCR + 136 * MiB;
constexpr size_t WS_VTN = WS_SCR + 204 * MiB;
constexpr size_t WS_HMOE = WS_SCR + 68 * MiB;
constexpr size_t WS_Y = WS_SCR + 261 * MiB;
constexpr size_t WS_END = WS_SCR + 401 * MiB;
static_assert((size_t)NTOK * 1024 * 2 <= 68 * MiB && (size_t)NTOK * 512 * 2 <= 34 * MiB && (size_t)NB * A_HEADS * KPOS * 96 * 2 <= 77 * MiB && (size_t)NB * A_HEADS * 64 * KPOS * 2 <= 51 * MiB, "even map");
static_assert((size_t)NTOK * DFF * 2 <= 196 * MiB && (size_t)NB * C_HEADS * 64 * KPOS * 2 <= 68 * MiB + 4 * MiB && (size_t)MOE_SLOTS * DFFE * 2 <= 193 * MiB && (size_t)MOE_SLOTS * 1024 * 2 <= 140 * MiB, "odd map");
constexpr size_t WO_WIN_E = 0, WO_WUKV = 2 * MiB, WO_WUQ = 3 * MiB, WO_WOUT_E = 4 * MiB, WO_WGU_E = 6 * MiB, WO_WDN_E = 17 * MiB;
constexpr size_t WO_WIN_O = 23 * MiB, WO_WOUT_O = 29 * MiB, WO_WGU_M = 31 * MiB, WO_WDN_M = 75 * MiB;
constexpr int CW_BAR = 4096;
constexpr int CW_MOECNT = 8192;
constexpr int CW_ATTQ = 8192 + 256;
constexpr int CW_CHK = 16384;

constexpr int RING_OFF = 0, RING_BYTES = 131072;
constexpr int LDS_BYTES = 163840;
constexpr int LDSCTL_OFF = LDS_BYTES - 1024, MISC_OFF = LDSCTL_OFF + 320;
constexpr int MOE_LDS_OFF = MISC_OFF + 128;
static_assert(MOE_LDS_OFF + 128 <= LDS_BYTES && pg8::GN_LDS_OFF == RING_BYTES && pg8::GN_LDS_OFF + 512 * 16 <= LDSCTL_OFF, "LDS map");
constexpr int NWAVES = 8;

#define CAS __attribute__((address_space(4)))
typedef GAS unsigned gu32;
#define RLX_AGENT __ATOMIC_RELAXED, __HIP_MEMORY_SCOPE_AGENT
#define LDS_WAIT() asm volatile("s_waitcnt lgkmcnt(0)" ::: "memory")
#define VM_WAIT() asm volatile("s_waitcnt vmcnt(0)" ::: "memory")

#define XB_TMO      128
#define XB_XCNT(j)  (256  + 64 * (j))
#define XB_XSUB(j)  (1280 + 64 * (j))
#define XB_XGEN(j)  (2304 + 64 * (j))
#define XB_TOP      3328
#define XB_TOPGEN   3392
#define XCD_BAR_WORDS 3456
#define XB_SPIN_CAP (1u << 18)

__device__ __forceinline__ unsigned xb_ld(unsigned* p)              { return __hip_atomic_load(p, __ATOMIC_RELAXED, __HIP_MEMORY_SCOPE_AGENT); }
__device__ __forceinline__ unsigned xb_add(unsigned* p, unsigned v) { return __hip_atomic_fetch_add(p, v, __ATOMIC_RELAXED, __HIP_MEMORY_SCOPE_AGENT); }
__device__ __forceinline__ unsigned xb_xcc_id() { return (unsigned)__builtin_amdgcn_s_getreg((3 << 11) | 20) & 0xFu; }
#define XB_SPIN(cond, bar) do { unsigned _sp = 0; while (cond) { __builtin_amdgcn_s_sleep(1); \
    if ((++_sp & 255u) == 0u) { if (xb_ld(&(bar)[XB_TMO])) break; if (_sp > XB_SPIN_CAP) { atomicAdd(&(bar)[XB_TMO], 1u); break; } } } } while (0)

struct XcdBarrier {
    unsigned* bar; unsigned x;
    volatile LAS unsigned* st;
};
__device__ __forceinline__ XcdBarrier xcd_barrier_post(unsigned* bar, volatile LAS unsigned* st) {
    XcdBarrier b; b.bar = bar; b.x = xb_xcc_id(); b.st = st;
    if (threadIdx.x == 0) (void)xb_add(&bar[XB_XCNT(b.x)], 1u);
    return b;
}
__device__ __forceinline__ void xcd_barrier_complete(unsigned* bar, unsigned x, unsigned& nloc, unsigned& nx) {
    const unsigned G = gridDim.x * gridDim.y * gridDim.z;
    unsigned sum, cnt, mine, sp = 0u;
    for (;;) {
        sum = 0u; cnt = 0u; mine = 0u;
#pragma unroll
        for (unsigned j = 0; j < 16; ++j) { const unsigned c = xb_ld(&bar[XB_XCNT(j)]); sum += c; cnt += (c > 0u) ? 1u : 0u; mine = (j == x) ? c : mine; }
        if (sum == G) break;
        __builtin_amdgcn_s_sleep(1);
        if ((++sp & 255u) == 0u) { if (xb_ld(&bar[XB_TMO])) break; if (sp > XB_SPIN_CAP) { atomicAdd(&bar[XB_TMO], 1u); break; } }
    }
    nloc = mine > 0u ? mine : 1u; nx = cnt > 0u ? cnt : 1u;
}
__device__ __forceinline__ void xcd_barrier(const XcdBarrier& b) {
    asm volatile("s_waitcnt vmcnt(0)" ::: "memory");
    __syncthreads();
    if (threadIdx.x == 0) {
        unsigned* bar = b.bar;
        __builtin_amdgcn_s_waitcnt(0);
        unsigned nloc = b.st[0], nx = b.st[1];
        if (nloc == 0u) { xcd_barrier_complete(bar, b.x, nloc, nx); b.st[0] = nloc; b.st[1] = nx; }
        const unsigned old = xb_add(&bar[XB_XSUB(b.x)], 1u);
        const unsigned gen = old / nloc;
        if (old + 1u == (gen + 1u) * nloc) {
            __builtin_amdgcn_fence(__ATOMIC_RELEASE, "agent");
            asm volatile("s_waitcnt vmcnt(0)" ::: "memory");
            const unsigned og = xb_add(&bar[XB_TOP], 1u);
            const unsigned tg = og / nx;
            if (og + 1u == (tg + 1u) * nx) xb_add(&bar[XB_TOPGEN], 1u);
            else XB_SPIN(xb_ld(&bar[XB_TOPGEN]) == tg, bar);
            __builtin_amdgcn_fence(__ATOMIC_ACQUIRE, "agent");
            xb_add(&bar[XB_XGEN(b.x)], 1u);
            asm volatile("s_waitcnt vmcnt(0)" ::: "memory");
        } else {
            XB_SPIN(xb_ld(&bar[XB_XGEN(b.x)]) == gen, bar);
            __builtin_amdgcn_fence(__ATOMIC_ACQUIRE, "agent");
            asm volatile("s_waitcnt vmcnt(0)" ::: "memory");
        }
    }
    __syncthreads();
}

struct Inputs {
    const float *x, *c, *ctx, *c_ctx, *w_mod, *b_mod, *norm_g;
    const float *a_w_in, *a_g_cq, *a_g_ckv, *a_w_uq, *a_w_ukv, *a_g_q, *a_g_k, *a_w_out;
    const float *f_w_gate, *f_w_up, *f_w_down;
    const float *c_w_in, *c_g_q, *c_g_k, *c_rpb, *c_w_out;
    const float *m_w_router, *m_w_gate, *m_w_up, *m_w_down;
};
struct Frame {
    LAS unsigned char* lds;
    volatile LAS unsigned* MISC;
    gu32* ctl;
    unsigned char* ws;
    float* out;
    float* hc;
    int tid, lane, wave, G, bid;
    const CAS Inputs* in;
};
__device__ __forceinline__ float* hrow(const Frame& F, int r) { return r < NLAT ? F.out + (size_t)r * DM : F.hc + (size_t)(r - NLAT) * DM; }
__device__ __forceinline__ int row_b9(int r) { return r < NLAT ? (r >> 12) : 8; }
__device__ __forceinline__ const float* modp(const Frame& F, int layer, int b9, int k) { return (const float*)(F.ws + WS_MOD) + ((size_t)layer * 9 + b9) * 6144 + k * 1024; }

__device__ __forceinline__ float wave_sum(float v) {
#pragma unroll
    for (int o = 1; o < 64; o <<= 1) v += __shfl_xor(v, o);
    return v;
}

struct WMap { int which; int col; };
__device__ __forceinline__ WMap wmap(int mode, int n, int nsrc) {
    WMap r; r.which = 0;
    const int pn = n >> 8, ct = n & 255, bj = ct >> 7, wc = (ct >> 5) & 3, w = ct & 31;
    if (mode == 0) { r.col = n < nsrc ? n : -1; }
    else if (mode == 1) { const int head = 2 * pn + (wc >> 1), part = wc & 1; r.col = head * 128 + part * 64 + 32 * bj + w; }
    else if (mode == 2) { const int nn = (ct >> 4) & 1, fq = (ct >> 2) & 3, e = ct & 3; r.which = nn; r.col = pn * 128 + bj * 64 + wc * 16 + fq * 4 + e; }
    else { r.col = (pn * 4 + wc) * 64 + 32 * bj + w; }
    return r;
}
__device__ __forceinline__ void wconv_item(const float* W0, const float* W1, int ld, int Ksrc, int nsrc, const float* kscale, bf16* WT, int Kdst, int mode, int kb, int nb, LAS float* scr, int lane) {
    const int k0 = 64 * kb, n0 = 32 * nb;
    const WMap mp = wmap(mode, n0 + (lane & 31), nsrc);
    const float* W = mp.which ? W1 : W0;
#pragma unroll 8
    for (int i = 0; i < 32; ++i) { const int kk = 2 * i + (lane >> 5), k = k0 + kk; float v = 0.f;
        if (mp.col >= 0 && k < Ksrc) { v = W[(size_t)k * ld + mp.col]; if (kscale) v *= kscale[k]; }
        scr[kk * 33 + (lane & 31)] = v; }
    LDS_WAIT(); asm volatile("" ::: "memory");
    const int c = lane & 7;
#pragma unroll
    for (int j = 0; j < 4; ++j) { const int n = (lane >> 3) + 8 * j; const LAS float* s = scr + (8 * c) * 33 + n;
        u32x4 o; o.x = pk2(s[0 * 33], s[1 * 33]); o.y = pk2(s[2 * 33], s[3 * 33]); o.z = pk2(s[4 * 33], s[5 * 33]); o.w = pk2(s[6 * 33], s[7 * 33]);
        *(GAS u32x4*)(WT + (size_t)(n0 + n) * Kdst + k0 + 8 * c) = o; }
    LDS_WAIT(); asm volatile("" ::: "memory");
}
struct WJob { const float* W0; const float* W1; int ld, Ksrc, nsrc; const float* kscale; bf16* WT; int Kdst, Ndst, mode; };
__device__ __forceinline__ bool wjob_run(const WJob& J, int& r, LAS float* scr, int lane) {
    const int nblk = J.Ndst / 32, items = (J.Kdst / 64) * nblk;
    if (r < items) { wconv_item(J.W0, J.W1, J.ld, J.Ksrc, J.nsrc, J.kscale, J.WT, J.Kdst, J.mode, r / nblk, r % nblk, scr, lane); return true; }
    r -= items; return false;
}

__device__ __forceinline__ void prep_phase(Frame& F, int j) {
    const CAS Inputs& I = *F.in;
    unsigned char* W = F.ws + WS_W;
    if (j == 0) {
        LAS float* sv = (LAS float*)(F.lds);
        LAS float* red = (LAS float*)(F.lds + 40960);
        for (int idx = F.tid; idx < 9 * 1024; idx += NWAVES * 64) { const int r = idx >> 10, k = idx & 1023; const float cv = r < 8 ? I.c[r * 1024 + k] : I.c_ctx[k]; sv[idx] = cv / (1.f + __expf(-cv)); }
        __syncthreads();
        for (int it = F.bid; it < 4 * 96; it += F.G) {
            const int layer = it / 96, chunk = it % 96, n = chunk * 64 + F.lane;
            const float* wm = I.w_mod + (size_t)layer * 1024 * 6144 + n;
            float acc[9];
#pragma unroll
            for (int r = 0; r < 9; ++r) acc[r] = 0.f;
            const int kb = F.wave * 128;
#pragma unroll 4
            for (int k = 0; k < 128; ++k) { const float wv = wm[(size_t)(kb + k) * 6144];
#pragma unroll
                for (int r = 0; r < 9; ++r) acc[r] += sv[r * 1024 + kb + k] * wv; }
#pragma unroll
            for (int r = 0; r < 9; ++r) red[(F.wave * 9 + r) * 64 + F.lane] = acc[r];
            __syncthreads();
            for (int idx = F.tid; idx < 9 * 64; idx += NWAVES * 64) { const int r = idx >> 6, l = idx & 63; float s = 0.f;
#pragma unroll
                for (int w = 0; w < 8; ++w) s += red[(w * 9 + r) * 64 + l];
                const int nn = chunk * 64 + l;
                ((float*)(F.ws + WS_MOD))[((size_t)layer * 9 + r) * 6144 + nn] = s + I.b_mod[layer * 6144 + nn]; }
            __syncthreads();
        }
        if (F.bid == 0) { const int pos = F.tid >> 3, f = F.tid & 7; const float inv = powf(10000.f, -(float)f / 8.f); const float ang = (float)pos * inv;
            ((f32x2*)(F.ws + WS_ROPE))[F.tid] = (f32x2){cosf(ang), sinf(ang)}; }
        __syncthreads();
        LAS f32x2* tab = (LAS f32x2*)(F.lds);
        for (int m = F.tid; m < 4096; m += NWAVES * 64) { float s, c; sincospif((float)m * (1.f / 2048.f), &s, &c); tab[m] = (f32x2){c, s}; }
        __syncthreads();
        bf16* DF = (bf16*)(F.ws + WS_DFT);
        for (int q = F.bid * (NWAVES * 64) + F.tid; q < 4096 * 1024; q += F.G * NWAVES * 64) {
            const int np = q >> 10, kk0 = (q & 1023) * 8, type = kk0 >= 4096, n = kk0 & 4095; float v[8];
#pragma unroll
            for (int e = 0; e < 8; ++e) { const f32x2 t = tab[(np * (n + e)) & 4095]; v[e] = (type ? -t.y : t.x) * (1.f / 512.f); }
            u32x4 o; o.x = pk2(v[0], v[1]); o.y = pk2(v[2], v[3]); o.z = pk2(v[4], v[5]); o.w = pk2(v[6], v[7]);
            *(GAS u32x4*)(DF + (size_t)np * 8192 + kk0) = o;
        }
        bf16* DC = (bf16*)(F.ws + WS_DFTC);
        for (int q = F.bid * (NWAVES * 64) + F.tid; q < 256 * 64; q += F.G * NWAVES * 64) {
            const int np = q >> 6, kk0 = (q & 63) * 8, type = kk0 >= 256, n = kk0 & 255; float v[8];
#pragma unroll
            for (int e = 0; e < 8; ++e) { const f32x2 t = tab[((np * (n + e)) & 255) * 16]; v[e] = (type ? -t.y : t.x) * (1.f / 128.f); }
            u32x4 o; o.x = pk2(v[0], v[1]); o.y = pk2(v[2], v[3]); o.z = pk2(v[4], v[5]); o.w = pk2(v[6], v[7]);
            *(GAS u32x4*)(DC + (size_t)np * 512 + kk0) = o;
        }
        __syncthreads();
    }
    {
        LAS float* scr = (LAS float*)(F.lds + F.wave * 16384);
        const int gw = F.bid * NWAVES + F.wave, NGW = F.G * NWAVES;
        const float* a_w_in = I.a_w_in + (size_t)j * 1024 * 672;
        WJob J0{a_w_in, a_w_in, 672, 1024, 416, nullptr, (bf16*)(W + WO_WIN_E), 1024, 512, 0};
        WJob J2{I.a_w_ukv + (size_t)j * 128 * 1536, nullptr, 1536, 128, 1536, I.a_g_ckv + j * 128, (bf16*)(W + WO_WUKV), 256, 1536, 1};
        WJob J3{I.a_w_uq + (size_t)j * 256 * 1152, nullptr, 1152, 256, 1152, I.a_g_cq + j * 256, (bf16*)(W + WO_WUQ), 256, 1152, 0};
        WJob J4{I.a_w_out + (size_t)j * 1024 * 1024, nullptr, 1024, 1024, 1024, nullptr, (bf16*)(W + WO_WOUT_E), 1024, 1024, 0};
        WJob J5{I.f_w_gate + (size_t)j * 1024 * DFF, I.f_w_up + (size_t)j * 1024 * DFF, DFF, 1024, DFF, nullptr, (bf16*)(W + WO_WGU_E), 1024, 2 * DFF, 2};
        WJob J6{I.f_w_down + (size_t)j * DFF * 1024, nullptr, 1024, DFF, 1024, nullptr, (bf16*)(W + WO_WDN_E), DFF, 1024, 0};
        WJob J7{I.c_w_in + (size_t)j * 1024 * 3072, nullptr, 3072, 1024, 3072, nullptr, (bf16*)(W + WO_WIN_O), 1024, 3072, 3};
        WJob J8{I.c_w_out + (size_t)j * 1024 * 1024, nullptr, 1024, 1024, 1024, nullptr, (bf16*)(W + WO_WOUT_O), 1024, 1024, 0};
        constexpr int IT_GU = (1024 / 64) * (2 * DFFE / 32), IT_DN = (DFFE / 64) * (1024 / 32);
        const int fixed = 16 * 16 + 4 * 48 + 4 * 36 + 16 * 32 + 16 * 176 + 44 * 32 + 16 * 96 + 16 * 32;
        const int total = fixed + NEXP * (IT_GU + IT_DN);
        for (int it = gw; it < total; it += NGW) {
            int r = it;
            if (wjob_run(J0, r, scr, F.lane)) continue;
            if (wjob_run(J2, r, scr, F.lane)) continue;
            if (wjob_run(J3, r, scr, F.lane)) continue;
            if (wjob_run(J4, r, scr, F.lane)) continue;
            if (wjob_run(J5, r, scr, F.lane)) continue;
            if (wjob_run(J6, r, scr, F.lane)) continue;
            if (wjob_run(J7, r, scr, F.lane)) continue;
            if (wjob_run(J8, r, scr, F.lane)) continue;
            if (r < NEXP * IT_GU) { const int e = r / IT_GU, rr = r % IT_GU; const size_t eo = ((size_t)j * NEXP + e) * 1024 * DFFE;
                wconv_item(I.m_w_gate + eo, I.m_w_up + eo, DFFE, 1024, DFFE, nullptr, (bf16*)(W + WO_WGU_M) + (size_t)e * 2 * DFFE * 1024, 1024, 2, rr / (2 * DFFE / 32), rr % (2 * DFFE / 32), scr, F.lane); continue; }
            r -= NEXP * IT_GU;
            { const int e = r / IT_DN, rr = r % IT_DN; const size_t eo = ((size_t)j * NEXP + e) * DFFE * 1024;
                wconv_item(I.m_w_down + eo, nullptr, 1024, DFFE, 1024, nullptr, (bf16*)(W + WO_WDN_M) + (size_t)e * 1024 * DFFE, DFFE, 0, rr / 32, rr % 32, scr, F.lane); }
        }
        __syncthreads();
        LAS f32x2* t64 = (LAS f32x2*)(F.lds);
        if (F.tid < 64) { float s, c; sincospif((float)F.tid * (1.f / 32.f), &s, &c); t64[F.tid] = (f32x2){c, s}; }
        __syncthreads();
        bf16* WE = (bf16*)(W + WO_WIN_E);
        for (int it = gw; it < 1024 * 4; it += NGW) {
            const int k = it >> 2, g = it & 3;
            const float f = a_w_in[(size_t)k * 672 + 416 + 64 * g + F.lane];
            float ac = 0.f, as = 0.f;
#pragma unroll 8
            for (int c = 0; c < 64; ++c) { const float fc = __shfl(f, c); const f32x2 t = t64[(c * F.lane) & 63]; ac += fc * t.x; as += fc * t.y; }
            WE[(size_t)(512 + g * 64 + F.lane) * 1024 + k] = (bf16)f2bf(ac);
            WE[(size_t)(768 + g * 64 + F.lane) * 1024 + k] = (bf16)f2bf(as);
        }
        __syncthreads();
    }
}

__device__ __forceinline__ void moe_panels_to_lds(Frame& F, int pair) {
    volatile LAS int* MOE = (volatile LAS int*)(F.lds + MOE_LDS_OFF);
    if (F.tid == 0) { int p = 0;
        for (int e = 0; e < NEXP; ++e) { const int c = (int)__hip_atomic_load(F.ctl + CW_MOECNT + 64 * pair + e, RLX_AGENT); MOE[e] = p; MOE[16 + e] = c; p += (c + 255) >> 8; }
        MOE[8] = p; }
    __syncthreads();
}
struct NormArgs { int layer, which, from_inputs, combine_pair, router_pair, final_only; };
__device__ __forceinline__ void norm_phase(Frame& F, const NormArgs a) {
    const CAS Inputs& I = *F.in;
    volatile LAS int* MOE = (volatile LAS int*)(F.lds + MOE_LDS_OFF);
    LAS float* wr = (LAS float*)(F.lds);
    volatile LAS int* lcnt = (volatile LAS int*)(F.lds + 32768);
    volatile LAS int* stash = (volatile LAS int*)(F.lds + 32768 + 256);
    if (a.combine_pair >= 0) moe_panels_to_lds(F, a.combine_pair);
    if (a.router_pair >= 0) {
        const float* wsrc = I.m_w_router + (size_t)a.router_pair * 1024 * NEXP;
        for (int idx = F.tid; idx < 1024 * NEXP; idx += NWAVES * 64) wr[idx] = wsrc[idx];
        if (F.tid < 16) lcnt[F.tid] = 0;
        __syncthreads();
    }
    const int* te = (const int*)(F.ws + WS_ROUTE); const int* tr = te + 2 * NTOK; const float* tg = (const float*)(tr + 2 * NTOK);
    const bf16* Y = (const bf16*)(F.ws + WS_Y);
    bf16* XN = (bf16*)(F.ws + WS_ACT);
    const int nrows = a.final_only ? NLAT : NTOK;
    const int nk = (nrows - F.bid + F.G - 1) / F.G;
    for (int k = F.wave; k < nk; k += NWAVES) {
        const int row = F.bid + F.G * k;
        const int b9 = row_b9(row);
        float* hp = hrow(F, row);
        const float* src = a.from_inputs ? (row < NLAT ? I.x + (size_t)row * DM : I.ctx + (size_t)(row - NLAT) * DM) : hp;
        f32x4 v[4];
#pragma unroll
        for (int j = 0; j < 4; ++j) v[j] = ((const f32x4*)src)[F.lane + 64 * j];
        if (a.combine_pair >= 0) {
            const int e1 = te[2 * row], e2 = te[2 * row + 1], r1 = tr[2 * row], r2 = tr[2 * row + 1];
            const float g1 = tg[2 * row], g2 = tg[2 * row + 1];
            const size_t s1 = (size_t)MOE[e1] * 256 + r1, s2 = (size_t)MOE[e2] * 256 + r2;
            const float* gm = modp(F, 2 * a.combine_pair + 1, b9, 5);
#pragma unroll
            for (int j = 0; j < 4; ++j) {
                const u32x2 y1 = *(const u32x2*)(Y + s1 * 1024 + 256 * j + 4 * F.lane), y2 = *(const u32x2*)(Y + s2 * 1024 + 256 * j + 4 * F.lane);
                const f32x4 gg = ((const f32x4*)gm)[F.lane + 64 * j];
                v[j].x += gg.x * (g1 * bflo(y1.x) + g2 * bflo(y2.x)); v[j].y += gg.y * (g1 * bfhi(y1.x) + g2 * bfhi(y2.x));
                v[j].z += gg.z * (g1 * bflo(y1.y) + g2 * bflo(y2.y)); v[j].w += gg.w * (g1 * bfhi(y1.y) + g2 * bfhi(y2.y));
            }
        }
        if (a.from_inputs || a.combine_pair >= 0) {
#pragma unroll
            for (int j = 0; j < 4; ++j) ((f32x4*)hp)[F.lane + 64 * j] = v[j];
        }
        if (a.final_only) continue;
        float ss = 0.f;
#pragma unroll
        for (int j = 0; j < 4; ++j) ss += (v[j].x * v[j].x + v[j].y * v[j].y) + (v[j].z * v[j].z + v[j].w * v[j].w);
        const float rstd = 1.0f / sqrtf(wave_sum(ss) * (1.f / DM) + EPS);
        const float* gp = I.norm_g + ((size_t)a.layer * 2 + a.which) * DM;
        const float* shp = modp(F, a.layer, b9, a.which ? 3 : 0);
        const float* scp = modp(F, a.layer, b9, a.which ? 4 : 1);
        f32x4 xn[4];
#pragma unroll
        for (int j = 0; j < 4; ++j) { const f32x4 g = ((const f32x4*)gp)[F.lane + 64 * j], sh = ((const f32x4*)shp)[F.lane + 64 * j], sc = ((const f32x4*)scp)[F.lane + 64 * j];
            xn[j] = v[j] * rstd * g * (sc + 1.0f) + sh; }
        u32x2* o8 = (u32x2*)(XN + (size_t)row * DM) + F.lane;
#pragma unroll
        for (int j = 0; j < 4; ++j) o8[64 * j] = (u32x2){pk2(xn[j].x, xn[j].y), pk2(xn[j].z, xn[j].w)};
        if (a.router_pair >= 0) {
            float lg[NEXP];
#pragma unroll
            for (int e = 0; e < NEXP; ++e) lg[e] = 0.f;
#pragma unroll
            for (int j = 0; j < 4; ++j)
#pragma unroll
                for (int q = 0; q < 4; ++q) { const float xv = xn[j][q]; const LAS f32x4* w4 = (const LAS f32x4*)(wr + (256 * j + 4 * F.lane + q) * NEXP); const f32x4 wa = w4[0], wb = w4[1];
                    lg[0] += xv * wa.x; lg[1] += xv * wa.y; lg[2] += xv * wa.z; lg[3] += xv * wa.w; lg[4] += xv * wb.x; lg[5] += xv * wb.y; lg[6] += xv * wb.z; lg[7] += xv * wb.w; }
#pragma unroll
            for (int e = 0; e < NEXP; ++e) lg[e] = wave_sum(lg[e]);
            int i1 = 0; float v1 = lg[0];
#pragma unroll
            for (int e = 1; e < NEXP; ++e) if (lg[e] > v1) { v1 = lg[e]; i1 = e; }
            int i2 = -1; float v2 = -3.0e38f;
#pragma unroll
            for (int e = 0; e < NEXP; ++e) if (e != i1 && lg[e] > v2) { v2 = lg[e]; i2 = e; }
            const float ga = 1.f / (1.f + __expf(v2 - v1)), gb = 1.f - ga;
            if (F.lane == 0) {
                const int l1 = __hip_atomic_fetch_add((LAS int*)(lcnt + i1), 1, __ATOMIC_RELAXED, __HIP_MEMORY_SCOPE_WORKGROUP);
                const int l2 = __hip_atomic_fetch_add((LAS int*)(lcnt + i2), 1, __ATOMIC_RELAXED, __HIP_MEMORY_SCOPE_WORKGROUP);
                stash[4 * k + 0] = i1; stash[4 * k + 1] = l1; stash[4 * k + 2] = i2; stash[4 * k + 3] = l2;
                float* tgw = (float*)(F.ws + WS_ROUTE) + 4 * NTOK; tgw[2 * row] = ga; tgw[2 * row + 1] = gb;
            }
        }
    }
    if (a.router_pair >= 0) {
        __syncthreads();
        if (F.tid < NEXP) lcnt[8 + F.tid] = (int)__hip_atomic_fetch_add(F.ctl + CW_MOECNT + 64 * a.router_pair + F.tid, (unsigned)lcnt[F.tid], RLX_AGENT);
        __syncthreads();
        int* tew = (int*)(F.ws + WS_ROUTE); int* trw = tew + 2 * NTOK; int* list = (int*)(F.ws + WS_LIST);
        for (int k = F.tid; k < nk; k += NWAVES * 64) {
            const int row = F.bid + F.G * k;
            const int i1 = stash[4 * k + 0], l1 = stash[4 * k + 1], i2 = stash[4 * k + 2], l2 = stash[4 * k + 3];
            const int r1 = lcnt[8 + i1] + l1, r2 = lcnt[8 + i2] + l2;
            tew[2 * row] = i1; tew[2 * row + 1] = i2; trw[2 * row] = r1; trw[2 * row + 1] = r2;
            list[(size_t)i1 * NTOK + r1] = row; list[(size_t)i2 * NTOK + r2] = row;
        }
    }
    __syncthreads();
}

struct SchedStatic {
    static constexpr bool GATHER = false;
    const bf16* A; int lda; const bf16* Bt; int K, nM, nN, G, c;
    __device__ __forceinline__ bool next(int i, pg8::Unit& u) const { return pg8::static_next(i, G, c, nM, nN, u); }
    __device__ __forceinline__ unsigned a_row(const pg8::Unit& u, int r) const { return (unsigned)(u.pm * 256 + r); }
    __device__ __forceinline__ const char* b_base(const pg8::Unit& u) const { return (const char*)Bt + (size_t)u.pn * 256 * K * 2; }
};
struct SchedOne {
    static constexpr bool GATHER = false;
    const bf16* A; int lda; const bf16* Bt; int K, pm, pn, have;
    __device__ __forceinline__ bool next(int i, pg8::Unit& u) const { if (i != 0 || !have) return false; u.pm = pm; u.pn = pn; return true; }
    __device__ __forceinline__ unsigned a_row(const pg8::Unit& u, int r) const { return (unsigned)(u.pm * 256 + r); }
    __device__ __forceinline__ const char* b_base(const pg8::Unit& u) const { return (const char*)Bt + (size_t)u.pn * 256 * K * 2; }
};
template <bool G_> struct SchedMoe {
    static constexpr bool GATHER = G_;
    const bf16* A; int lda; const bf16* Bt; size_t bstride; int K, nN, G, c; const int* list; volatile LAS int* MOE;
    __device__ __forceinline__ bool next(int i, pg8::Unit& u) const { const long L = (long)i * G + c; const int nP = MOE[8]; if (L >= (long)nP * nN) return false; u.pm = (int)(L / nN); u.pn = (int)(L % nN); return true; }
    __device__ __forceinline__ int expert(int pm) const { int e = 0;
#pragma unroll
        for (int k = 1; k < NEXP; ++k) e += (pm >= MOE[k]) ? 1 : 0;
        return e; }
    __device__ __forceinline__ unsigned a_row(const pg8::Unit& u, int r) const {
        if (!G_) return (unsigned)(u.pm * 256 + r);
        const int e = expert(u.pm), idx = (u.pm - MOE[e]) * 256 + r;
        return idx < MOE[16 + e] ? (unsigned)list[e * NTOK + idx] : 0u; }
    __device__ __forceinline__ const char* b_base(const pg8::Unit& u) const { return (const char*)Bt + (size_t)expert(u.pm) * bstride + (size_t)u.pn * 256 * K * 2; }
};

__device__ __forceinline__ unsigned cvt_pk_bf16(float lo, float hi) { unsigned r; asm volatile("v_cvt_pk_bf16_f32 %0, %1, %2" : "=v"(r) : "v"(lo), "v"(hi)); return r; }
typedef const f32x4 (&AccRef)[2][2][4][2];
__device__ __forceinline__ int swap12(int g) { return ((g & 1) << 1) | (g >> 1); }

struct EpiBf16 { static constexpr bool PERM = true;
    bf16* O; int ldc, mode;
    __device__ __forceinline__ void operator()(AccRef acc, const pg8::Unit& u, int wr, int wc, int fr, int fq) const {
        const int rbase = mode == 0 ? u.pm * 256 : (mode == 1 ? u.pn * 4096 + u.pm * 256 : NLAT + u.pn * 256 + u.pm * 256);
        const int cbase = mode == 0 ? u.pn * 256 : 768;
        const int row0 = rbase + wr * 64 + fr, col0 = cbase + wc * 32 + 8 * fq;
#pragma unroll
        for (int ai = 0; ai < 2; ++ai)
#pragma unroll
            for (int m = 0; m < 4; ++m) { bf16* rowp = O + (size_t)(row0 + ai * 128 + m * 16) * ldc + col0;
#pragma unroll
                for (int bj = 0; bj < 2; ++bj) { const f32x4 v0 = acc[ai][bj][m][0], v1 = acc[ai][bj][m][1];
                    u32x4 w; w.x = cvt_pk_bf16(v0[0], v0[1]); w.y = cvt_pk_bf16(v0[2], v0[3]); w.z = cvt_pk_bf16(v1[0], v1[1]); w.w = cvt_pk_bf16(v1[2], v1[3]);
                    *(u32x4*)(rowp + bj * 128) = w; } }
    }
};
struct EpiWin { static constexpr bool PERM = true;
    bf16* PX; bf16* GT; bf16* GTC;
    __device__ __forceinline__ void operator()(AccRef acc, const pg8::Unit& u, int wr, int wc, int fr, int fq) const {
        if (u.pn < 2) {
            const int row0 = u.pm * 256 + wr * 64 + fr, col0 = u.pn * 256 + wc * 32 + 8 * fq;
#pragma unroll
            for (int ai = 0; ai < 2; ++ai)
#pragma unroll
                for (int m = 0; m < 4; ++m) { bf16* rowp = PX + (size_t)(row0 + ai * 128 + m * 16) * 512 + col0;
#pragma unroll
                    for (int bj = 0; bj < 2; ++bj) { const f32x4 v0 = acc[ai][bj][m][0], v1 = acc[ai][bj][m][1];
                        u32x4 w; w.x = cvt_pk_bf16(v0[0], v0[1]); w.y = cvt_pk_bf16(v0[2], v0[3]); w.z = cvt_pk_bf16(v1[0], v1[1]); w.w = cvt_pk_bf16(v1[2], v1[3]);
                        *(u32x4*)(rowp + bj * 128) = w; } }
        } else {
            const int type = u.pn - 2; const bool lat = u.pm < 128;
            const int b = lat ? (u.pm >> 4) : (u.pm - 128);
            bf16* base = lat ? GT + (size_t)b * 256 * 8192 + type * 4096 + (u.pm & 15) * 256 : GTC + (size_t)b * 256 * 512 + type * 256;
            const size_t ldt = lat ? 8192 : 512;
#pragma unroll
            for (int ai = 0; ai < 2; ++ai)
#pragma unroll
                for (int m = 0; m < 4; ++m) { const int lr = ai * 128 + wr * 64 + m * 16 + fr;
#pragma unroll
                    for (int bj = 0; bj < 2; ++bj)
#pragma unroll
                        for (int n = 0; n < 2; ++n)
#pragma unroll
                            for (int e = 0; e < 4; ++e) { const int jc = 128 * bj + 32 * wc + 8 * fq + 4 * n + e; base[(size_t)jc * ldt + lr] = (bf16)f2bf(acc[ai][bj][m][n][e]); }
                    if (m == 3) asm volatile("" ::: "memory"); }
        }
    }
};
struct EpiKV { static constexpr bool PERM = false;
    const bf16* PX; bf16* Kb; bf16* Vt; const float* g_k; const f32x2* rope;
    __device__ __forceinline__ void operator()(AccRef acc, const pg8::Unit& u, int wr, int wc, int fr, int fq) const {
        const int head = 2 * u.pn + (wc >> 1), part = wc & 1;
        const bool lat = u.pm < 128;
        const int b = lat ? (u.pm >> 4) : (u.pm - 128);
        const int pos0 = lat ? (u.pm & 15) * 256 : SEQ;
        const size_t bh = (size_t)b * A_HEADS + head;
#pragma unroll
        for (int ai = 0; ai < 2; ++ai)
#pragma unroll
            for (int m = 0; m < 4; ++m) {
                const int lr = ai * 128 + wr * 64 + m * 16 + fr, row = u.pm * 256 + lr, pos = pos0 + lr;
                const bf16* pxr = PX + (size_t)row * 512;
                float ss = 0.f;
#pragma unroll
                for (int q = 0; q < 4; ++q) { const u32x4 w = *(const u32x4*)(pxr + 256 + 32 * fq + 8 * q);
                    ss += bflo(w.x) * bflo(w.x) + bfhi(w.x) * bfhi(w.x) + bflo(w.y) * bflo(w.y) + bfhi(w.y) * bfhi(w.y) + bflo(w.z) * bflo(w.z) + bfhi(w.z) * bfhi(w.z) + bflo(w.w) * bflo(w.w) + bfhi(w.w) * bfhi(w.w); }
                ss += __shfl_xor(ss, 16); ss += __shfl_xor(ss, 32);
                const float rkv = 1.0f / sqrtf(ss * (1.f / 128.f) + EPS);
                if (part == 0) {
                    const u32x4 kw = *(const u32x4*)(pxr + 384 + 8 * fq);
                    float kr[8] = {bflo(kw.x), bfhi(kw.x), bflo(kw.y), bfhi(kw.y), bflo(kw.z), bfhi(kw.z), bflo(kw.w), bfhi(kw.w)};
                    float s2 = 0.f;
#pragma unroll
                    for (int q = 0; q < 8; ++q) s2 += kr[q] * kr[q];
#pragma unroll
                    for (int bj = 0; bj < 2; ++bj)
#pragma unroll
                        for (int n = 0; n < 2; ++n) { const f32x4 x = acc[ai][bj][m][n] * rkv; s2 += (x[0] * x[0] + x[1] * x[1]) + (x[2] * x[2] + x[3] * x[3]); }
                    s2 += __shfl_xor(s2, 16); s2 += __shfl_xor(s2, 32);
                    const float rs = 1.0f / sqrtf(s2 * (1.f / 96.f) + EPS);
                    bf16* kp = Kb + (bh * KPOS + pos) * 96;
#pragma unroll
                    for (int bj = 0; bj < 2; ++bj)
#pragma unroll
                        for (int n = 0; n < 2; ++n) { const int d0 = 32 * bj + 16 * n; const f32x4 g = *(const f32x4*)(g_k + d0 + 4 * fq); const f32x4 x = acc[ai][bj][m][n] * (rkv * rs) * g;
                            *(u32x2*)(kp + d0 + 4 * swap12(fq)) = (u32x2){pk2(x[0], x[1]), pk2(x[2], x[3])}; }
                    float t[8];
                    { const f32x4 ga = *(const f32x4*)(g_k + 64 + 8 * fq), gb = *(const f32x4*)(g_k + 64 + 8 * fq + 4);
                      t[0] = kr[0] * rs * ga[0]; t[1] = kr[1] * rs * ga[1]; t[2] = kr[2] * rs * ga[2]; t[3] = kr[3] * rs * ga[3];
                      t[4] = kr[4] * rs * gb[0]; t[5] = kr[5] * rs * gb[1]; t[6] = kr[6] * rs * gb[2]; t[7] = kr[7] * rs * gb[3]; }
                    if (lat) {
                        const int pidx = (fq < 2) ? (pos >> 6) : (pos & 63);
#pragma unroll
                        for (int q = 0; q < 4; ++q) { const f32x2 cs = rope[pidx * 8 + ((4 * fq + q) & 7)]; const float t0 = t[2 * q], t1 = t[2 * q + 1];
                            t[2 * q] = t0 * cs.x - t1 * cs.y; t[2 * q + 1] = t0 * cs.y + t1 * cs.x; }
                    }
                    bf16* krp = kp + 64 + 16 * (fq >> 1) + 4 * (fq & 1);
                    *(u32x2*)(krp) = (u32x2){pk2(t[0], t[1]), pk2(t[2], t[3])};
                    *(u32x2*)(krp + 8) = (u32x2){pk2(t[4], t[5]), pk2(t[6], t[7])};
                } else {
                    const int pp = (pos & ~15) | (((pos & 4) << 1) | ((pos & 8) >> 1) | (pos & 3));
                    bf16* vp = Vt + bh * 64 * KPOS + pp;
#pragma unroll
                    for (int bj = 0; bj < 2; ++bj)
#pragma unroll
                        for (int n = 0; n < 2; ++n)
#pragma unroll
                            for (int e = 0; e < 4; ++e) vp[(size_t)(32 * bj + 16 * n + 4 * fq + e) * KPOS] = (bf16)f2bf(acc[ai][bj][m][n][e] * rkv);
                }
                if (m & 1) asm volatile("" ::: "memory");
            }
    }
};
struct EpiResid { static constexpr bool PERM = false;
    float* out; float* hc; const float* modl; int gk; bool dry;
    __device__ __forceinline__ void operator()(AccRef acc, const pg8::Unit& u, int wr, int wc, int fr, int fq) const {
        const bool lat = u.pm < 128; const int b9 = lat ? (u.pm >> 4) : 8;
        float* base = lat ? out + (size_t)u.pm * 256 * DM : hc + (size_t)(u.pm - 128) * 256 * DM;
        const int col0 = u.pn * 256 + wc * 32 + 4 * fq;
        const float* gp = modl + (size_t)b9 * 6144 + gk * 1024 + col0;
        f32x4 gv[2][2];
#pragma unroll
        for (int bj = 0; bj < 2; ++bj)
#pragma unroll
            for (int n = 0; n < 2; ++n) gv[bj][n] = *(const f32x4*)(gp + bj * 128 + n * 16);
#pragma unroll
        for (int ai = 0; ai < 2; ++ai)
#pragma unroll
            for (int m = 0; m < 4; ++m) { float* rowp = base + (size_t)(ai * 128 + wr * 64 + m * 16 + fr) * DM + col0;
#pragma unroll
                for (int bj = 0; bj < 2; ++bj)
#pragma unroll
                    for (int n = 0; n < 2; ++n) { f32x4* p = (f32x4*)(rowp + bj * 128 + n * 16); const f32x4 r = *p + gv[bj][n] * acc[ai][bj][m][n]; if (!dry) *p = r; }
                if (m == 3) asm volatile("" ::: "memory"); }
    }
};
struct EpiSwiglu { static constexpr bool PERM = false;
    bf16* HM; int ldh;
    __device__ __forceinline__ void operator()(AccRef acc, const pg8::Unit& u, int wr, int wc, int fr, int fq) const {
        const int row0 = u.pm * 256 + wr * 64 + fr, col0 = u.pn * 128 + wc * 16 + 4 * fq;
#pragma unroll
        for (int ai = 0; ai < 2; ++ai)
#pragma unroll
            for (int m = 0; m < 4; ++m) { bf16* rowp = HM + (size_t)(row0 + ai * 128 + m * 16) * ldh + col0;
#pragma unroll
                for (int bj = 0; bj < 2; ++bj) { const f32x4 g = acc[ai][bj][m][0], up = acc[ai][bj][m][1]; float h[4];
#pragma unroll
                    for (int e = 0; e < 4; ++e) h[e] = g[e] * __builtin_amdgcn_rcpf(1.f + __builtin_amdgcn_exp2f(-g[e] * LOG2E)) * up[e];
                    *(u32x2*)(rowp + bj * 64) = (u32x2){cvt_pk_bf16(h[0], h[1]), cvt_pk_bf16(h[2], h[3])}; } }
    }
};
struct EpiNAin { static constexpr bool PERM = false;
    bf16* QN; bf16* KN; bf16* Vt; const float* g_q; const float* g_k;
    __device__ __forceinline__ void operator()(AccRef acc, const pg8::Unit& u, int wr, int wc, int fr, int fq) const {
        const int sec = u.pn >> 2, head = 4 * (u.pn & 3) + wc;
        const bool lat = u.pm < 128;
        const int b = lat ? (u.pm >> 4) : (u.pm - 128);
        const int pos0 = lat ? (u.pm & 15) * 256 : SEQ;
#pragma unroll
        for (int ai = 0; ai < 2; ++ai)
#pragma unroll
            for (int m = 0; m < 4; ++m) {
                const int lr = ai * 128 + wr * 64 + m * 16 + fr, row = u.pm * 256 + lr;
                if (sec < 2) {
                    float s2 = 0.f;
#pragma unroll
                    for (int bj = 0; bj < 2; ++bj)
#pragma unroll
                        for (int n = 0; n < 2; ++n) { const f32x4 x = acc[ai][bj][m][n]; s2 += (x[0] * x[0] + x[1] * x[1]) + (x[2] * x[2] + x[3] * x[3]); }
                    s2 += __shfl_xor(s2, 16); s2 += __shfl_xor(s2, 32);
                    const float rs = (1.0f / sqrtf(s2 * (1.f / 64.f) + EPS)) * (sec == 0 ? 0.125f * LOG2E : 1.0f);
                    const float* gp = sec == 0 ? g_q : g_k;
                    bf16* op = (sec == 0 ? QN : KN) + (size_t)row * DM + head * 64;
#pragma unroll
                    for (int bj = 0; bj < 2; ++bj)
#pragma unroll
                        for (int n = 0; n < 2; ++n) { const int d0 = 32 * bj + 16 * n + 4 * fq; const f32x4 g = *(const f32x4*)(gp + d0); const f32x4 x = acc[ai][bj][m][n] * rs * g;
                            *(u32x2*)(op + d0) = (u32x2){pk2(x[0], x[1]), pk2(x[2], x[3])}; }
                } else {
                    bf16* vp = Vt + ((size_t)b * C_HEADS + head) * 64 * KPOS + pos0 + lr;
#pragma unroll
                    for (int bj = 0; bj < 2; ++bj)
#pragma unroll
                        for (int n = 0; n < 2; ++n)
#pragma unroll
                            for (int e = 0; e < 4; ++e) vp[(size_t)(32 * bj + 16 * n + 4 * fq + e) * KPOS] = (bf16)f2bf(acc[ai][bj][m][n][e]);
                }
                if (m == 3) asm volatile("" ::: "memory");
            }
    }
};

constexpr int AT_KP = 208, AT_VP = 144;
constexpr int AT_KB = 64 * AT_KP, AT_VB = 64 * AT_VP, AT_BUF = AT_KB + AT_VB;

__device__ __forceinline__ void mla_attn_unit(Frame& F, int pair, int b, int h, int qrow0, bool lat, int key0, int nkt) {
    const int lane = F.lane, l31 = lane & 31, hi = lane >> 5;
    const bf16* PX = (const bf16*)(F.ws + WS_PX);
    const bf16* WUQ = (const bf16*)(F.ws + WS_W + WO_WUQ);
    const bf16* Kg = (const bf16*)(F.ws + WS_K) + ((size_t)(b * A_HEADS + h) * KPOS + key0) * 96;
    const bf16* Vg = (const bf16*)(F.ws + WS_VT) + (size_t)(b * A_HEADS + h) * 64 * KPOS + key0;
    bf16* MIX = (bf16*)(F.ws + WS_ACT);
    const f32x2* rope = (const f32x2*)(F.ws + WS_ROPE);
    const int row = qrow0 + 32 * F.wave + l31;
    const int vdv = F.tid >> 3, vpart = F.tid & 7;
    u32x4 kr0, kr1 = (u32x4){0u, 0u, 0u, 0u}, vr;
    kr0 = *(const u32x4*)((const char*)Kg + (size_t)F.tid * 16);
    if (F.tid < 256) kr1 = *(const u32x4*)((const char*)Kg + (size_t)(512 + F.tid) * 16);
    vr = *(const u32x4*)(Vg + (size_t)vdv * KPOS + vpart * 8);
    bf16x8 qf[3][2];
    {
        bf16x8 bq[16];
        const bf16* pxr = PX + (size_t)row * 512 + 8 * hi;
#pragma unroll
        for (int s = 0; s < 16; ++s) bq[s] = *(const bf16x8*)(pxr + 16 * s);
        float ss = 0.f;
#pragma unroll
        for (int s = 0; s < 16; ++s)
#pragma unroll
            for (int e = 0; e < 8; ++e) { const float x = bf2f((unsigned short)bq[s][e]); ss += x * x; }
        ss += __shfl_xor(ss, 32);
        const float rq = 1.0f / sqrtf(ss * (1.f / 256.f) + EPS);
        f32x16 qt[3];
#pragma unroll
        for (int blk = 0; blk < 3; ++blk) {
            f32x16 acc;
#pragma unroll
            for (int i = 0; i < 16; ++i) acc[i] = 0.f;
            const bf16* wrp = WUQ + (size_t)(h * 96 + 32 * blk + l31) * 256 + 8 * hi;
#pragma unroll
            for (int s = 0; s < 16; ++s) { const bf16x8 a = *(const bf16x8*)(wrp + 16 * s); acc = __builtin_amdgcn_mfma_f32_32x32x16_bf16(a, bq[s], acc, 0, 0, 0); }
            qt[blk] = acc * rq;
        }
        float s2 = 0.f;
#pragma unroll
        for (int blk = 0; blk < 3; ++blk)
#pragma unroll
            for (int i = 0; i < 16; ++i) s2 += qt[blk][i] * qt[blk][i];
        s2 += __shfl_xor(s2, 32);
        const float rs = (1.0f / sqrtf(s2 * (1.f / 96.f) + EPS));
        const float* gq = F.in->a_g_q + pair * 96;
#pragma unroll
        for (int blk = 0; blk < 3; ++blk)
#pragma unroll
            for (int c = 0; c < 4; ++c) { const f32x4 g = *(const f32x4*)(gq + 32 * blk + 8 * c + 4 * hi);
#pragma unroll
                for (int e = 0; e < 4; ++e) qt[blk][4 * c + e] *= rs * g[e]; }
        if (lat) {
            const int t = row & (SEQ - 1);
#pragma unroll
            for (int c = 0; c < 4; ++c) {
                const int pidx = (c < 2) ? (t >> 6) : (t & 63);
#pragma unroll
                for (int q = 0; q < 2; ++q) { const f32x2 cs = rope[pidx * 8 + ((4 * c + 2 * hi + q) & 7)]; const float t0 = qt[2][4 * c + 2 * q], t1 = qt[2][4 * c + 2 * q + 1];
                    qt[2][4 * c + 2 * q] = t0 * cs.x - t1 * cs.y; qt[2][4 * c + 2 * q + 1] = t0 * cs.y + t1 * cs.x; }
            }
        }
        const float sc = 0.10206207261596577f * LOG2E;
#pragma unroll
        for (int blk = 0; blk < 3; ++blk)
#pragma unroll
            for (int s = 0; s < 2; ++s) { u32x4 w;
                w.x = pk2(qt[blk][8 * s + 0] * sc, qt[blk][8 * s + 1] * sc); w.y = pk2(qt[blk][8 * s + 2] * sc, qt[blk][8 * s + 3] * sc);
                w.z = pk2(qt[blk][8 * s + 4] * sc, qt[blk][8 * s + 5] * sc); w.w = pk2(qt[blk][8 * s + 6] * sc, qt[blk][8 * s + 7] * sc);
                qf[blk][s] = __builtin_bit_cast(bf16x8, w); }
    }
    LAS unsigned char* L = F.lds;
    const int kd0 = (F.tid / 12) * AT_KP + (F.tid % 12) * 16, kd1 = ((512 + F.tid) / 12) * AT_KP + ((512 + F.tid) % 12) * 16, vd = AT_KB + vdv * AT_VP + vpart * 16;
    *(LAS u32x4*)(L + kd0) = kr0; if (F.tid < 256) *(LAS u32x4*)(L + kd1) = kr1; *(LAS u32x4*)(L + vd) = vr;
    __syncthreads();
    f32x16 oT[2];
#pragma unroll
    for (int d = 0; d < 2; ++d)
#pragma unroll
        for (int i = 0; i < 16; ++i) oT[d][i] = 0.f;
    float mrun = -3.0e38f, lrun = 0.f;
    const int kro = l31 * AT_KP + hi * 16, vro = AT_KB + l31 * AT_VP + hi * 16;
    for (int t = 0; t < nkt; ++t) {
        const bool more = (t + 1 < nkt);
        if (more) {
            const char* kg = (const char*)Kg + (size_t)(t + 1) * 64 * 192;
            kr0 = *(const u32x4*)(kg + (size_t)F.tid * 16);
            if (F.tid < 256) kr1 = *(const u32x4*)(kg + (size_t)(512 + F.tid) * 16);
            vr = *(const u32x4*)(Vg + (size_t)vdv * KPOS + (t + 1) * 64 + vpart * 8);
        }
        const LAS unsigned char* Lb = L + (t & 1) * AT_BUF;
        f32x16 sT[2];
#pragma unroll
        for (int kb = 0; kb < 2; ++kb) {
            f32x16 acc;
#pragma unroll
            for (int i = 0; i < 16; ++i) acc[i] = 0.f;
#pragma unroll
            for (int blk = 0; blk < 3; ++blk)
#pragma unroll
                for (int s = 0; s < 2; ++s) { const bf16x8 a = *(const LAS bf16x8*)(Lb + kro + kb * 32 * AT_KP + (32 * blk + 16 * s) * 2);
                    acc = __builtin_amdgcn_mfma_f32_32x32x16_bf16(a, qf[blk][s], acc, 0, 0, 0); }
            sT[kb] = acc;
        }
        float mx = sT[0][0];
#pragma unroll
        for (int kb = 0; kb < 2; ++kb)
#pragma unroll
            for (int i = 0; i < 16; ++i) mx = fmaxf(mx, sT[kb][i]);
        mx = fmaxf(mx, __shfl_xor(mx, 32));
        const float mnew = fmaxf(mrun, mx);
        const float alpha = __builtin_amdgcn_exp2f(mrun - mnew);
        mrun = mnew;
        float psum = 0.f;
        bf16x8 pf[2][2];
#pragma unroll
        for (int kb = 0; kb < 2; ++kb) {
            float p[16];
#pragma unroll
            for (int i = 0; i < 16; ++i) { p[i] = __builtin_amdgcn_exp2f(sT[kb][i] - mnew); psum += p[i]; }
#pragma unroll
            for (int s = 0; s < 2; ++s) { u32x4 w; w.x = cvt_pk_bf16(p[8 * s + 0], p[8 * s + 1]); w.y = cvt_pk_bf16(p[8 * s + 2], p[8 * s + 3]); w.z = cvt_pk_bf16(p[8 * s + 4], p[8 * s + 5]); w.w = cvt_pk_bf16(p[8 * s + 6], p[8 * s + 7]);
                pf[kb][s] = __builtin_bit_cast(bf16x8, w); }
        }
        lrun = lrun * alpha + psum;
#pragma unroll
        for (int d = 0; d < 2; ++d) oT[d] = oT[d] * alpha;
#pragma unroll
        for (int d = 0; d < 2; ++d)
#pragma unroll
            for (int kb = 0; kb < 2; ++kb)
#pragma unroll
                for (int s = 0; s < 2; ++s) { const bf16x8 a = *(const LAS bf16x8*)(Lb + vro + d * 32 * AT_VP + (32 * kb + 16 * s) * 2);
                    oT[d] = __builtin_amdgcn_mfma_f32_32x32x16_bf16(a, pf[kb][s], oT[d], 0, 0, 0); }
        if (more) {
            LAS unsigned char* Ln = L + ((t + 1) & 1) * AT_BUF;
            *(LAS u32x4*)(Ln + kd0) = kr0; if (F.tid < 256) *(LAS u32x4*)(Ln + kd1) = kr1; *(LAS u32x4*)(Ln + vd) = vr;
        }
        __syncthreads();
    }
    lrun += __shfl_xor(lrun, 32);
    const float inv = 1.0f / lrun;
    bf16* op = MIX + (size_t)row * DM + h * 64 + 4 * hi;
#pragma unroll
    for (int d = 0; d < 2; ++d)
#pragma unroll
        for (int c = 0; c < 4; ++c) *(u32x2*)(op + 32 * d + 8 * c) = (u32x2){pk2(oT[d][4 * c] * inv, oT[d][4 * c + 1] * inv), pk2(oT[d][4 * c + 2] * inv, oT[d][4 * c + 3] * inv)};
}

__device__ __forceinline__ void mla_attn_phase(Frame& F, int pair, int rep) {
    constexpr int NLU = NB * A_HEADS * (SEQ / 256), NCU = NB * A_HEADS;
    for (;;) {
        if (F.tid == 0) F.MISC[0] = __hip_atomic_fetch_add(F.ctl + CW_ATTQ + 64 * pair + 32 * rep, 1u, RLX_AGENT);
        __syncthreads();
        const int u = (int)F.MISC[0];
        __syncthreads();
        if (u >= NLU + NCU) break;
        if (u < NLU) { const int qb = u & 15, bh = u >> 4, b = bh / A_HEADS, h = bh % A_HEADS; mla_attn_unit(F, pair, b, h, b * SEQ + qb * 256, true, 0, KPOS / 64); }
        else { const int bh = u - NLU, b = bh / A_HEADS, h = bh % A_HEADS; mla_attn_unit(F, pair, b, h, NLAT + b * CTXL, false, SEQ, CTXL / 64); }
    }
}

constexpr int NA_KP = 144, NA_CVP = 528, NA_LVP = 1168;
constexpr int NA_CK = 0, NA_CV = 256 * NA_KP, NA_L = NA_CV + 64 * NA_CVP, NA_RPB = NA_L + 576 * NA_KP, NA_END = NA_RPB + 15 * 31 * 4;
static_assert(NA_L == 70656 && 64 * NA_LVP <= 576 * NA_KP && NA_END <= LDSCTL_OFF, "NA LDS map");

struct NaPref { u32x4 r[9]; };
__device__ __forceinline__ void na_load_k(NaPref& p, const bf16* KN, int rowbase, int h, int tid) {
    const char* gb = (const char*)(KN + (size_t)rowbase * DM + h * 64); const unsigned lo = (unsigned)(tid >> 3) * 2048u + (unsigned)(tid & 7) * 16u;
#pragma unroll
    for (int i = 0; i < 9; ++i) p.r[i] = *(const u32x4*)(gb + (size_t)i * 131072 + lo);
}
__device__ __forceinline__ void na_store_k(const NaPref& p, LAS unsigned char* L, int tid) {
    LAS unsigned char* d = L + NA_L + (tid >> 3) * NA_KP + (tid & 7) * 16;
#pragma unroll
    for (int i = 0; i < 9; ++i) *(LAS u32x4*)(d + i * 64 * NA_KP) = p.r[i];
}
__device__ __forceinline__ void na_load_v(NaPref& p, const bf16* Vt, int pos0, int tid) {
    const char* gb = (const char*)(Vt + pos0); const unsigned lo = (unsigned)(tid >> 3) * (unsigned)(KPOS * 2) + (unsigned)(tid & 7) * 16u;
#pragma unroll
    for (int i = 0; i < 9; ++i) p.r[i] = *(const u32x4*)(gb + i * 128 + lo);
}
__device__ __forceinline__ void na_store_v(const NaPref& p, LAS unsigned char* L, int tid) {
    LAS unsigned char* d = L + NA_L + (tid >> 3) * NA_LVP + (tid & 7) * 16;
#pragma unroll
    for (int i = 0; i < 9; ++i) *(LAS u32x4*)(d + i * 128) = p.r[i];
}
__device__ __forceinline__ void na_stage_ctx(Frame& F, int b, int h) {
    const char* kb = (const char*)((const bf16*)(F.ws + WS_KN) + (size_t)(NLAT + b * CTXL) * DM + h * 64);
    const char* vb = (const char*)((const bf16*)(F.ws + WS_VTN) + (size_t)(b * C_HEADS + h) * 64 * KPOS + SEQ);
    const unsigned klo = (unsigned)(F.tid >> 3) * 2048u + (unsigned)(F.tid & 7) * 16u, vlo = (unsigned)(F.tid >> 3) * (unsigned)(KPOS * 2) + (unsigned)(F.tid & 7) * 16u;
    u32x4 a[4], v[4];
#pragma unroll
    for (int i = 0; i < 4; ++i) a[i] = *(const u32x4*)(kb + (size_t)i * 131072 + klo);
#pragma unroll
    for (int i = 0; i < 4; ++i) v[i] = *(const u32x4*)(vb + i * 128 + vlo);
    LAS unsigned char* kd = F.lds + NA_CK + (F.tid >> 3) * NA_KP + (F.tid & 7) * 16;
    LAS unsigned char* vd = F.lds + NA_CV + (F.tid >> 3) * NA_CVP + (F.tid & 7) * 16;
#pragma unroll
    for (int i = 0; i < 4; ++i) *(LAS u32x4*)(kd + i * 64 * NA_KP) = a[i];
#pragma unroll
    for (int i = 0; i < 4; ++i) *(LAS u32x4*)(vd + i * 128) = v[i];
}
__device__ __forceinline__ float na_scores(Frame& F, bf16x8 (&pf)[16], float& f1, bool lat, int qrow, int h, int qr, int c0, int kr0, int rs, int ks) {
    const int lane = F.lane, l15 = lane & 15, g = lane >> 4;
    const bf16* QN = (const bf16*)(F.ws + WS_QN);
    const LAS float* rpbs = (const LAS float*)(F.lds + NA_RPB);
    bf16x8 qf[2];
#pragma unroll
    for (int s = 0; s < 2; ++s) qf[s] = *(const bf16x8*)(QN + (size_t)qrow * DM + h * 64 + 32 * s + 8 * g);
    float m1 = -3.0e38f, l1 = 0.f;
    if (lat) {
        f32x4 sc[16];
        const int cq = c0 + l15, cs = min(max(cq - 8, 0), 48);
#pragma unroll
        for (int t = 0; t < 16; ++t) {
            const LAS unsigned char* kp = F.lds + NA_L + (((rs - kr0) + (t >> 1)) * 64 + ks + 16 * (t & 1) + l15) * NA_KP + g * 16;
            f32x4 acc = (f32x4){0.f, 0.f, 0.f, 0.f};
#pragma unroll
            for (int s = 0; s < 2; ++s) { const bf16x8 a = *(const LAS bf16x8*)(kp + s * 64); acc = __builtin_amdgcn_mfma_f32_16x16x32_bf16(a, qf[s], acc, 0, 0, 0); }
            const int dr = rs + (t >> 1) - qr + 7;
#pragma unroll
            for (int e = 0; e < 4; ++e) { const int kc = ks + 16 * (t & 1) + 4 * g + e; const bool ok = (kc >= cs) && (kc < cs + 16); const int dc = kc - cq + 15;
                acc[e] = ok ? acc[e] + rpbs[dr * 31 + min(max(dc, 0), 30)] : -1.0e30f; }
            sc[t] = acc;
            if ((t & 3) == 3) asm volatile("" ::: "memory");
        }
#pragma unroll
        for (int t = 0; t < 16; ++t)
#pragma unroll
            for (int e = 0; e < 4; ++e) m1 = fmaxf(m1, sc[t][e]);
        m1 = fmaxf(m1, __shfl_xor(m1, 16)); m1 = fmaxf(m1, __shfl_xor(m1, 32));
#pragma unroll
        for (int u = 0; u < 8; ++u) { float p[8];
#pragma unroll
            for (int e = 0; e < 4; ++e) { p[e] = __builtin_amdgcn_exp2f(sc[2 * u][e] - m1); p[4 + e] = __builtin_amdgcn_exp2f(sc[2 * u + 1][e] - m1); }
#pragma unroll
            for (int e = 0; e < 8; ++e) l1 += p[e];
            u32x4 w; w.x = cvt_pk_bf16(p[0], p[1]); w.y = cvt_pk_bf16(p[2], p[3]); w.z = cvt_pk_bf16(p[4], p[5]); w.w = cvt_pk_bf16(p[6], p[7]);
            pf[u] = __builtin_bit_cast(bf16x8, w); }
    } else {
#pragma unroll
        for (int u = 0; u < 8; ++u) pf[u] = (bf16x8){0, 0, 0, 0, 0, 0, 0, 0};
    }
    float m = m1, l2 = 0.f;
    {
        f32x4 sc[16];
#pragma unroll
        for (int t = 0; t < 16; ++t) {
            const LAS unsigned char* kp = F.lds + NA_CK + (16 * t + l15) * NA_KP + g * 16;
            f32x4 acc = (f32x4){0.f, 0.f, 0.f, 0.f};
#pragma unroll
            for (int s = 0; s < 2; ++s) { const bf16x8 a = *(const LAS bf16x8*)(kp + s * 64); acc = __builtin_amdgcn_mfma_f32_16x16x32_bf16(a, qf[s], acc, 0, 0, 0); }
            sc[t] = acc;
            if ((t & 3) == 3) asm volatile("" ::: "memory");
        }
        float m2 = -3.0e38f;
#pragma unroll
        for (int t = 0; t < 16; ++t)
#pragma unroll
            for (int e = 0; e < 4; ++e) m2 = fmaxf(m2, sc[t][e]);
        m2 = fmaxf(m2, __shfl_xor(m2, 16)); m2 = fmaxf(m2, __shfl_xor(m2, 32));
        m = fmaxf(m1, m2);
#pragma unroll
        for (int u = 0; u < 8; ++u) { float p[8];
#pragma unroll
            for (int e = 0; e < 4; ++e) { p[e] = __builtin_amdgcn_exp2f(sc[2 * u][e] - m); p[4 + e] = __builtin_amdgcn_exp2f(sc[2 * u + 1][e] - m); }
#pragma unroll
            for (int e = 0; e < 8; ++e) l2 += p[e];
            u32x4 w; w.x = cvt_pk_bf16(p[0], p[1]); w.y = cvt_pk_bf16(p[2], p[3]); w.z = cvt_pk_bf16(p[4], p[5]); w.w = cvt_pk_bf16(p[6], p[7]);
            pf[8 + u] = __builtin_bit_cast(bf16x8, w); }
    }
    f1 = __builtin_amdgcn_exp2f(m1 - m);
    float lsum = l1 * f1 + l2;
    lsum += __shfl_xor(lsum, 16); lsum += __shfl_xor(lsum, 32);
    return 1.0f / lsum;
}
__device__ __forceinline__ void na_pv(Frame& F, const bf16x8 (&pf)[16], float f1, float inv, bool lat, int qrow, int h, int kr0, int rs, int ks) {
    const int lane = F.lane, l15 = lane & 15, g = lane >> 4;
    bf16* MIX = (bf16*)(F.ws + WS_ACT);
    bf16* op = MIX + (size_t)qrow * DM + h * 64 + 4 * g;
#pragma unroll
    for (int dvt = 0; dvt < 4; ++dvt) {
        f32x4 acc = (f32x4){0.f, 0.f, 0.f, 0.f};
        const int dv = 16 * dvt + l15;
        if (lat) {
#pragma unroll
            for (int u = 0; u < 8; ++u) {
                const LAS unsigned char* vp = F.lds + NA_L + dv * NA_LVP + (((rs - kr0) + u) * 64 + ks + 4 * g) * 2;
                const u32x2 lo = *(const LAS u32x2*)(vp), hi2 = *(const LAS u32x2*)(vp + 32);
                const u32x4 w = (u32x4){lo.x, lo.y, hi2.x, hi2.y};
                acc = __builtin_amdgcn_mfma_f32_16x16x32_bf16(__builtin_bit_cast(bf16x8, w), pf[u], acc, 0, 0, 0);
                if ((u & 3) == 3) asm volatile("" ::: "memory");
            }
            acc = acc * f1;
        }
#pragma unroll
        for (int u = 8; u < 16; ++u) {
            const LAS unsigned char* vp = F.lds + NA_CV + dv * NA_CVP + (32 * (u - 8) + 4 * g) * 2;
            const u32x2 lo = *(const LAS u32x2*)(vp), hi2 = *(const LAS u32x2*)(vp + 32);
            const u32x4 w = (u32x4){lo.x, lo.y, hi2.x, hi2.y};
            acc = __builtin_amdgcn_mfma_f32_16x16x32_bf16(__builtin_bit_cast(bf16x8, w), pf[u], acc, 0, 0, 0);
            if ((u & 3) == 3) asm volatile("" ::: "memory");
        }
        *(u32x2*)(op + 16 * dvt) = (u32x2){pk2(acc[0] * inv, acc[1] * inv), pk2(acc[2] * inv, acc[3] * inv)};
    }
}
__device__ __forceinline__ void na_phase(Frame& F, int pair) {
    const bf16* KN = (const bf16*)(F.ws + WS_KN);
    LAS float* rpbs = (LAS float*)(F.lds + NA_RPB);
    constexpr int NGRP = NB * C_HEADS * 2;
    for (int gi = F.bid; gi < NGRP; gi += F.G) {
        const int h = gi / (NB * 2), rem = gi % (NB * 2), b = rem >> 1, half = rem & 1;
        const bf16* Vt = (const bf16*)(F.ws + WS_VTN) + (size_t)(b * C_HEADS + h) * 64 * KPOS;
        __syncthreads();
        na_stage_ctx(F, b, h);
        { const float* rp = F.in->c_rpb + ((size_t)pair * C_HEADS + h) * 15 * 31; for (int i = F.tid; i < 15 * 31; i += NWAVES * 64) rpbs[i] = rp[i] * LOG2E; }
        NaPref pk, pv;
        { const int r0 = 2 * (16 * half), kr0 = min(max(r0 - 4, 0), 55); na_load_k(pk, KN, b * SEQ + kr0 * 64, h, F.tid); }
        for (int bi = 0; bi < 16; ++bi) {
            const int r0 = 2 * (16 * half + bi), kr0 = min(max(r0 - 4, 0), 55);
            const int qr = r0 + (F.wave >> 2), c0 = 16 * (F.wave & 3), rs = min(max(qr - 4, 0), 56), ks = min(max(c0 - 8, 0), 32);
            const int qrow = b * SEQ + qr * 64 + c0 + (F.lane & 15);
            na_store_k(pk, F.lds, F.tid);
            __syncthreads();
            na_load_v(pv, Vt, kr0 * 64, F.tid);
            bf16x8 pf[16];
            float f1; const float inv = na_scores(F, pf, f1, true, qrow, h, qr, c0, kr0, rs, ks);
            __syncthreads();
            na_store_v(pv, F.lds, F.tid);
            __syncthreads();
            if (bi + 1 < 16) { const int r1 = r0 + 2, kr1 = min(max(r1 - 4, 0), 55); na_load_k(pk, KN, b * SEQ + kr1 * 64, h, F.tid); }
            na_pv(F, pf, f1, inv, true, qrow, h, kr0, rs, ks);
            __syncthreads();
        }
    }
    constexpr int NCU = NB * C_HEADS * 2;
    for (int u = F.bid; u < NCU; u += F.G) {
        const int h = u / (NB * 2), rem = u % (NB * 2), b = rem >> 1, ch = rem & 1;
        __syncthreads();
        na_stage_ctx(F, b, h);
        __syncthreads();
        const int qrow = NLAT + b * CTXL + ch * 128 + 16 * F.wave + (F.lane & 15);
        bf16x8 pf[16];
        float f1; const float inv = na_scores(F, pf, f1, false, qrow, h, 0, 0, 0, 0, 0);
        na_pv(F, pf, f1, inv, false, qrow, h, 0, 0, 0);
    }
    __syncthreads();
}

constexpr int PH_PER_PAIR = 16, N_PHASES = 2 * PH_PER_PAIR + 1;
struct Args { Inputs in; float* out; unsigned char* ws; int ph_lo, ph_hi; };
static_assert(sizeof(Args) == 27 * 8 + 8 + 8 + 8, "Args has no padding bytes");

__global__ void __launch_bounds__(NWAVES * 64, 2) dit_fwd(Args args) {
    extern __shared__ __attribute__((aligned(16))) unsigned char lds_raw[];
    Frame F;
    F.lds = (LAS unsigned char*)lds_raw;
    F.MISC = (volatile LAS unsigned*)(F.lds + MISC_OFF);
    F.tid = threadIdx.x; F.lane = F.tid & 63; F.wave = __builtin_amdgcn_readfirstlane(F.tid >> 6);
    F.G = gridDim.x; F.bid = blockIdx.x;
    F.ws = args.ws; F.ctl = (gu32*)(args.ws + WS_CTL); F.out = args.out; F.hc = (float*)(args.ws + WS_HC); F.in = (const CAS Inputs*)__builtin_amdgcn_kernarg_segment_ptr();
    for (int u = F.tid; u < (LDS_BYTES - LDSCTL_OFF) / 4; u += NWAVES * 64) ((LAS unsigned*)(F.lds + LDSCTL_OFF))[u] = 0u;
    __syncthreads();
    const int lo = args.ph_lo, hi = args.ph_hi;
    const bool use_bar = (hi - lo) > 1;
    XcdBarrier bar; bar.bar = (unsigned*)(F.ctl + CW_BAR); bar.x = 0; bar.st = nullptr;
    if (use_bar) bar = xcd_barrier_post((unsigned*)(F.ctl + CW_BAR), F.MISC + 8);
#ifndef ONLYP
#define PH_EN(c) true
#else
#define PH_EN(c) ((c) == ONLYP)
#endif
#define INR(k) (lo <= (k) && (k) < hi)
#define PROBE_MASK 0
#define NREP(c) (((PROBE_MASK) >> (c)) & 1 ? 2 : 1)
#define FRESH() do { asm volatile("" : "+s"(F.ws), "+s"(F.out), "+s"(F.hc), "+s"(F.ctl), "+s"(F.in), "+s"(F.G), "+s"(F.bid), "+s"(F.wave)); asm volatile("" : "+v"(F.tid)); F.lane = F.tid & 63; W = F.ws + WS_W; MODB = (const float*)(F.ws + WS_MOD); ACT = (bf16*)(F.ws + WS_ACT); } while (0)
#define IN(k) (PH_EN((k) - P) && INR(k))
#define SEAM(k) do { if (INR(k) && INR((k) + 1)) { for (int rb = 0; rb < ((PROBE_MASK >> 20) & 1 ? 2 : 1); ++rb) { asm volatile("" : "+s"(bar.bar), "+s"(bar.x)); xcd_barrier(bar); } } } while (0)
    unsigned char* W; const float* MODB; bf16* ACT;
    volatile LAS int* MOE = (volatile LAS int*)(F.lds + MOE_LDS_OFF);
    LAS unsigned char* ring = F.lds + RING_OFF;

    for (int j = 0; j < 2; ++j) {
        const int P = j * PH_PER_PAIR, le = 2 * j, lod = 2 * j + 1;
        if (IN(P + 0)) { for (int rep = 0; rep < NREP(0); ++rep) { FRESH(); prep_phase(F, j); } } SEAM(P + 0);
        if (IN(P + 1)) { FRESH(); norm_phase(F, NormArgs{le, 0, j == 0, j > 0 ? j - 1 : -1, -1, 0}); } SEAM(P + 1);
        if (IN(P + 2)) { for (int rep = 0; rep < NREP(2); ++rep) { FRESH();
            SchedStatic S{ACT, 1024, (const bf16*)(W + WO_WIN_E), 1024, NTOK / 256, 4, F.G, F.bid};
            EpiWin E{(bf16*)(F.ws + WS_PX), (bf16*)(F.ws + WS_GT), (bf16*)(F.ws + WS_GTC)};
            pg8::gemm_phase<EpiWin, SchedStatic>(ring, 1024, S, E, F.tid);
        } } SEAM(P + 2);
        if (IN(P + 3)) { for (int rep = 0; rep < NREP(3); ++rep) { FRESH();
            SchedStatic S{(const bf16*)(F.ws + WS_PX) + 256, 512, (const bf16*)(W + WO_WUKV), 256, NTOK / 256, 6, F.G, F.bid};
            EpiKV E{(const bf16*)(F.ws + WS_PX), (bf16*)(F.ws + WS_K), (bf16*)(F.ws + WS_VT), F.in->a_g_k + j * 96, (const f32x2*)(F.ws + WS_ROPE)};
            pg8::gemm_phase<EpiKV, SchedStatic>(ring, 256, S, E, F.tid);
        } } SEAM(P + 3);
        if (IN(P + 4)) { for (int rep = 0; rep < NREP(4); ++rep) { FRESH();
            {
                const bool latf = F.bid < 128; const int have = F.bid < 136;
                SchedOne S{latf ? (const bf16*)(F.ws + WS_DFT) : (const bf16*)(F.ws + WS_DFTC), latf ? 8192 : 512, latf ? (const bf16*)(F.ws + WS_GT) : (const bf16*)(F.ws + WS_GTC), latf ? 8192 : 512,
                           latf ? (F.bid >> 3) : 0, latf ? (F.bid & 7) : (F.bid - 128), have};
                EpiBf16 E{ACT, 1024, latf ? 1 : 2};
                pg8::gemm_phase<EpiBf16, SchedOne>(ring, S.K, S, E, F.tid);
            }
            __syncthreads();
            mla_attn_phase(F, j, rep);
        } } SEAM(P + 4);
        if (IN(P + 5)) { for (int rep = 0; rep < NREP(5); ++rep) { FRESH();
            SchedStatic S{ACT, 1024, (const bf16*)(W + WO_WOUT_E), 1024, NTOK / 256, 4, F.G, F.bid};
            EpiResid E{F.out, F.hc, MODB + (size_t)le * 9 * 6144, 2, rep + 1 < NREP(5)};
            pg8::gemm_phase<EpiResid, SchedStatic>(ring, 1024, S, E, F.tid);
        } } SEAM(P + 5);
        if (IN(P + 6)) { for (int rep = 0; rep < NREP(6); ++rep) { FRESH(); norm_phase(F, NormArgs{le, 1, 0, -1, -1, 0}); } } SEAM(P + 6);
        if (IN(P + 7)) { for (int rep = 0; rep < NREP(7); ++rep) { FRESH();
            SchedStatic S{ACT, 1024, (const bf16*)(W + WO_WGU_E), 1024, NTOK / 256, 2 * DFF / 256, F.G, F.bid};
            EpiSwiglu E{(bf16*)(F.ws + WS_HMID), DFF};
            pg8::gemm_phase<EpiSwiglu, SchedStatic>(ring, 1024, S, E, F.tid);
        } } SEAM(P + 7);
        if (IN(P + 8)) { for (int rep = 0; rep < NREP(8); ++rep) { FRESH();
            SchedStatic S{(const bf16*)(F.ws + WS_HMID), DFF, (const bf16*)(W + WO_WDN_E), DFF, NTOK / 256, 4, F.G, F.bid};
            EpiResid E{F.out, F.hc, MODB + (size_t)le * 9 * 6144, 5, rep + 1 < NREP(8)};
            pg8::gemm_phase<EpiResid, SchedStatic>(ring, DFF, S, E, F.tid);
        } } SEAM(P + 8);
        if (IN(P + 9)) { for (int rep = 0; rep < NREP(9); ++rep) { FRESH(); norm_phase(F, NormArgs{lod, 0, 0, -1, -1, 0}); } } SEAM(P + 9);
        if (IN(P + 10)) { for (int rep = 0; rep < NREP(10); ++rep) { FRESH();
            SchedStatic S{ACT, 1024, (const bf16*)(W + WO_WIN_O), 1024, NTOK / 256, 12, F.G, F.bid};
            EpiNAin E{(bf16*)(F.ws + WS_QN), (bf16*)(F.ws + WS_KN), (bf16*)(F.ws + WS_VTN), F.in->c_g_q + j * 64, F.in->c_g_k + j * 64};
            pg8::gemm_phase<EpiNAin, SchedStatic>(ring, 1024, S, E, F.tid);
        } } SEAM(P + 10);
        if (IN(P + 11)) { for (int rep = 0; rep < NREP(11); ++rep) { FRESH(); na_phase(F, j); } } SEAM(P + 11);
        if (IN(P + 12)) { for (int rep = 0; rep < NREP(12); ++rep) { FRESH();
            SchedStatic S{ACT, 1024, (const bf16*)(W + WO_WOUT_O), 1024, NTOK / 256, 4, F.G, F.bid};
            EpiResid E{F.out, F.hc, MODB + (size_t)lod * 9 * 6144, 2, rep + 1 < NREP(12)};
            pg8::gemm_phase<EpiResid, SchedStatic>(ring, 1024, S, E, F.tid);
        } } SEAM(P + 12);
        if (IN(P + 13)) { FRESH(); norm_phase(F, NormArgs{lod, 1, 0, -1, j, 0}); } SEAM(P + 13);
        if (IN(P + 14)) { for (int rep = 0; rep < NREP(14); ++rep) { FRESH();
            moe_panels_to_lds(F, j);
            SchedMoe<true> S{ACT, 1024, (const bf16*)(W + WO_WGU_M), (size_t)2 * DFFE * 1024 * 2, 1024, 2 * DFFE / 256, F.G, F.bid, (const int*)(F.ws + WS_LIST), MOE};
            EpiSwiglu E{(bf16*)(F.ws + WS_HMOE), DFFE};
            pg8::gemm_phase<EpiSwiglu, SchedMoe<true>>(ring, 1024, S, E, F.tid);
        } } SEAM(P + 14);
        if (IN(P + 15)) { for (int rep = 0; rep < NREP(15); ++rep) { FRESH();
            moe_panels_to_lds(F, j);
            SchedMoe<false> S{(const bf16*)(F.ws + WS_HMOE), DFFE, (const bf16*)(W + WO_WDN_M), (size_t)1024 * DFFE * 2, DFFE, 4, F.G, F.bid, nullptr, MOE};
            EpiBf16 E{(bf16*)(F.ws + WS_Y), 1024, 0};
            pg8::gemm_phase<EpiBf16, SchedMoe<false>>(ring, DFFE, S, E, F.tid);
        } } SEAM(P + 15);
    }
    { const int P = 0; if (IN(2 * PH_PER_PAIR)) { FRESH(); norm_phase(F, NormArgs{3, 0, 0, 1, -1, 1}); } }
#undef IN
#undef INR
#undef SEAM
}

#if DBG

#endif

extern "C" void kernel_launch(void* const* d_in, const int* in_sizes, int n_in, void* d_out, int out_size, void* d_ws, size_t ws_size, hipStream_t stream) {
    static int grid = 0;
    if (grid == 0) {
        if (n_in != 27 || in_sizes[0] != NLAT * DM || out_size != NLAT * DM || ws_size < WS_END) {
            fprintf(stderr, "kernel_launch: built for 27 inputs, x/out of %d floats, >= %zu bytes of workspace; got n_in %d, in0 %d, out %d, ws %zu; nothing launched\n", NLAT * DM, (size_t)WS_END, n_in, n_in > 0 ? in_sizes[0] : -1, out_size, ws_size);
            grid = -1; return; }
        int dev = 0, cus = 0, per_cu = 0;
        if (hipGetDevice(&dev) != hipSuccess || hipDeviceGetAttribute(&cus, hipDeviceAttributeMultiprocessorCount, dev) != hipSuccess) { fprintf(stderr, "kernel_launch: device query failed\n"); grid = -1; return; }
        if (hipFuncSetAttribute((const void*)dit_fwd, hipFuncAttributeMaxDynamicSharedMemorySize, LDS_BYTES) != hipSuccess) { fprintf(stderr, "kernel_launch: hipFuncSetAttribute failed\n"); grid = -1; return; }
        if (hipOccupancyMaxActiveBlocksPerMultiprocessor(&per_cu, (const void*)dit_fwd, NWAVES * 64, LDS_BYTES) != hipSuccess || per_cu < 1) { fprintf(stderr, "kernel_launch: occupancy query reports %d workgroups per CU\n", per_cu); }
        (void)hipGetLastError();
        grid = cus;
    }
    if (grid < 0) return;
    if (hipMemsetAsync((char*)d_ws + WS_CTL, 0, CTL_ZERO_BYTES, stream) != hipSuccess) { fprintf(stderr, "kernel_launch: memset failed\n"); return; }
    Args a{};
    const float** ip = (const float**)&a.in;
    for (int i = 0; i < 27; ++i) ip[i] = (const float*)d_in[i];
    a.out = (float*)d_out; a.ws = (unsigned char*)d_ws;
#if DBG
    dbg_launch_all(a, grid, stream);
#else
    a.ph_lo = 0; a.ph_hi = N_PHASES;
    hipLaunchKernelGGL(dit_fwd, dim3(grid), dim3(NWAVES * 64), LDS_BYTES, stream, a);
    const hipError_t le = hipPeekAtLastError();
    if (le != hipSuccess) fprintf(stderr, "kernel_launch: launch failed: %s\n", hipGetErrorName(le));
#endif
}
```

```cpp
#include <hip/hip_runtime.h>
#include <cstdio>
#include <cstdint>

#define LAS __attribute__((address_space(3)))
#define GAS __attribute__((address_space(1)))
typedef unsigned short bf16;
typedef short bf16x8 __attribute__((ext_vector_type(8)));
typedef short bf16x4 __attribute__((ext_vector_type(4)));
typedef float f32x4 __attribute__((ext_vector_type(4)));
typedef float f32x2 __attribute__((ext_vector_type(2)));
typedef float f32x16 __attribute__((ext_vector_type(16)));
typedef unsigned u32x4 __attribute__((ext_vector_type(4)));
typedef unsigned u32x2 __attribute__((ext_vector_type(2)));

#define DBG 0

constexpr int DM = 1024, NB = 8, SEQ = 4096, CTXL = 256;
constexpr int NLAT = NB * SEQ, NCTX = NB * CTXL, NTOK = NLAT + NCTX;
constexpr int KPOS = SEQ + CTXL;
constexpr int A_HEADS = 12, A_QK = 96, A_IN_SRC = 672;
constexpr int C_HEADS = 16;
constexpr int DFF = 2816, NEXP = 8, DFFE = 1408;
constexpr int MOE_SLOTS = 2 * NTOK + NEXP * 256;
constexpr float EPS = 1e-6f;
constexpr float LOG2E = 1.4426950408889634f;

__device__ __forceinline__ unsigned f2bf(float f) { unsigned u = __builtin_bit_cast(unsigned, f); return (u + 0x7fffu + ((u >> 16) & 1u)) >> 16; }
__device__ __forceinline__ unsigned pk2(float lo, float hi) { return f2bf(lo) | (f2bf(hi) << 16); }
__device__ __forceinline__ float bf2f(unsigned short h) { return __builtin_bit_cast(float, (unsigned)h << 16); }
__device__ __forceinline__ float bflo(unsigned w) { return __builtin_bit_cast(float, w << 16); }
__device__ __forceinline__ float bfhi(unsigned w) { return __builtin_bit_cast(float, w & 0xffff0000u); }

namespace pg8 {
typedef unsigned u32x4 __attribute__((ext_vector_type(4)));
#define PG8_LAS __attribute__((address_space(3)))
constexpr int GN_LDS_OFF = 131072;
constexpr int BM = 256, BK = 64, HALF = 128, HTB = HALF * BK * 2  , STAGE_BYTES = 8 * HTB, NXCD = 8, WGM = 8;

__host__ __device__ __forceinline__ int lds_byte(int r, int c) { const int st = (r >> 4) * 2 + (c >> 5), rr = r & 15, cc = c & 31, ob = rr * 64 + cc * 2; return st * 1024 + (ob ^ (((ob >> 9) & 1) << 5)); }
__host__ __device__ __forceinline__ void stage_rc(int b, int& R, int& C) { const int st = b / 1024, sb = b % 1024, swz = sb ^ (((sb >> 9) & 1) << 5); R = (st >> 1) * 16 + swz / 64; C = (st & 1) * 32 + (swz % 64) / 2; }
__host__ __device__ __forceinline__ int perm32(int rho) { const int n = rho >> 4, i = rho & 15; return 8 * (i >> 2) + 4 * n + (i & 3); }

struct Unit { int pm, pn; };

__device__ __forceinline__ bool static_next(int i, int G, int c, int nM, int nN, Unit& u) {
    const int nwg = nM * nN;
    const long L = (long)i * G + c; if (L >= nwg) return false;
    int wgid = (int)L; { const int q = nwg / NXCD, r = nwg % NXCD, xcd = wgid % NXCD, off = wgid / NXCD; wgid = (xcd < r ? xcd * (q + 1) : r * (q + 1) + (xcd - r) * q) + off; }
    const int nig = WGM * nN, gid = wgid / nig, fm = gid * WGM, gsz = (nM - fm) < WGM ? (nM - fm) : WGM;
    u.pm = fm + ((wgid % nig) % gsz); u.pn = (wgid % nig) / gsz; return true;
}

template <class Epi, class Sched, bool ALIGN_EPI = true, bool SP2 = true>
__device__ __forceinline__ void gemm_phase(PG8_LAS unsigned char* lds, const int K, const Sched& S, const Epi& E, const int tid) {
    const int wid = __builtin_amdgcn_readfirstlane(tid >> 6), lane = tid & 63, wr = wid >> 2, wc = wid & 3, fr = lane & 15, fq = lane >> 4;
    const int nt = K / BK;
    unsigned voffB[2], voffA[2];
    const unsigned lda = (unsigned)S.lda;
#pragma unroll
    for (int i = 0; i < 2; ++i) { int R, C; stage_rc(tid * 16 + i * 8192, R, C); const int Rb = Epi::PERM ? ((R & ~31) + perm32(R & 31)) : R;
        voffB[i] = (unsigned)(Rb * K + C) * 2u; voffA[i] = ((unsigned)R * lda + (unsigned)C) * 2u; }
    const char* const Ab = (const char*)S.A;
    const size_t kstep = (size_t)(BK * 2);
    const size_t hstep = (size_t)HALF * K * 2;
    const size_t hstepA = (size_t)HALF * lda * 2;
    const unsigned ldsw = (unsigned)wid * 1024u;
    const int aoff = lds_byte(wr * 64 + fr, fq * 8), boff = lds_byte(wc * 32 + fr, fq * 8);
#define PG8_SA(b, h) (((b) * 2 + (h)) * HTB)
#define PG8_SB(b, h) ((4 + (b) * 2 + (h)) * HTB)
#define PG8_STAGE(bufoff, gbase, voff) do { _Pragma("unroll") for (int _i = 0; _i < 2; ++_i) \
        __builtin_amdgcn_global_load_lds((const unsigned*)((const char*)(gbase) + (voff)[_i]), (PG8_LAS unsigned*)(lds + (bufoff) + ldsw + _i * 8192), 16, 0, 0); } while (0)
#define PG8_LDA(dst, b, h) do { _Pragma("unroll") for (int m = 0; m < 4; ++m) _Pragma("unroll") for (int k = 0; k < 2; ++k) dst[m][k] = *(const PG8_LAS bf16x8*)(lds + PG8_SA(b, h) + aoff + m * 2048 + k * 1024); } while (0)
#define PG8_LDB(dst, b, h) do { _Pragma("unroll") for (int n = 0; n < 2; ++n) _Pragma("unroll") for (int k = 0; k < 2; ++k) dst[n][k] = *(const PG8_LAS bf16x8*)(lds + PG8_SB(b, h) + boff + n * 2048 + k * 1024); } while (0)
#define PG8_MMA(ai, bj, At, Bt) do { __builtin_amdgcn_s_setprio(1); _Pragma("unroll") for (int m = 0; m < 4; ++m) _Pragma("unroll") for (int n = 0; n < 2; ++n) _Pragma("unroll") for (int k = 0; k < 2; ++k) \
        acc[ai][bj][m][n] = __builtin_amdgcn_mfma_f32_16x16x32_bf16(Bt[n][k], At[m][k], acc[ai][bj][m][n], 0, 0, 0); __builtin_amdgcn_s_setprio(0); } while (0)
#define PG8_WAIT_V(n) asm volatile("s_waitcnt vmcnt(" #n ")" ::: "memory")
#define PG8_WAIT_L(n) asm volatile("s_waitcnt lgkmcnt(" #n ")" ::: "memory")
#define PG8_BAR __builtin_amdgcn_s_barrier()
#define PG8_SCHED __builtin_amdgcn_sched_barrier(0)
    Unit cur, nxt; int ui = 0;
    if (!S.next(0, cur)) return;
    f32x4 acc[2][2][4][2];
    bf16x8 At[4][2], B0[2][2], B1[2][2];
    constexpr bool GATHER = Sched::GATHER;
    const char* cA = Ab; const char* nA = Ab;
    unsigned ga0[2] = {0u, 0u}, ga1[2] = {0u, 0u};
    PG8_LAS u32x4* const gnslot = (PG8_LAS u32x4*)(lds + GN_LDS_OFF) + tid;
    if constexpr (GATHER) {
#pragma unroll
        for (int i = 0; i < 2; ++i) { int R, C; stage_rc(tid * 16 + i * 8192, R, C); ga0[i] = (S.a_row(cur, R) * lda + (unsigned)C) * 2u; ga1[i] = (S.a_row(cur, HALF + R) * lda + (unsigned)C) * 2u; }
    } else { cA = Ab + (size_t)S.a_row(cur, 0) * lda * 2; }
    const char* cB = S.b_base(cur);
#define PG8_STAGE_A(bufoff, h, uptr, kb, g0, g1) do { if constexpr (GATHER) { if (h) PG8_STAGE(bufoff, Ab + (kb), g1); else PG8_STAGE(bufoff, Ab + (kb), g0); } \
        else { PG8_STAGE(bufoff, (uptr) + (h) * hstepA + (kb), voffA); } } while (0)
    static_assert(SP2, "only the SP2 loop is carried here");
    PG8_STAGE(PG8_SB(0, 0), cB, voffB); PG8_STAGE(PG8_SB(0, 1), cB + hstep, voffB); PG8_STAGE_A(PG8_SA(0, 0), 0, cA, 0, ga0, ga1); PG8_STAGE_A(PG8_SA(0, 1), 1, cA, 0, ga0, ga1);
    if (wr == 1) PG8_BAR;
    PG8_WAIT_V(2); PG8_BAR;
    PG8_STAGE(PG8_SB(1, 0), cB + kstep, voffB); PG8_STAGE_A(PG8_SA(1, 0), 0, cA, kstep, ga0, ga1); PG8_STAGE(PG8_SB(1, 1), cB + hstep + kstep, voffB);
    PG8_WAIT_V(6); PG8_BAR;
    for (;;) {
        const bool has_next = S.next(ui + 1, nxt);
        const char* nB = has_next ? S.b_base(nxt) : cB;
        if constexpr (GATHER) {
            u32x4 gn = (u32x4){ga0[0], ga0[1], ga1[0], ga1[1]};
            if (has_next) { int R0, C0, R1, C1; stage_rc(tid * 16, R0, C0); stage_rc(tid * 16 + 8192, R1, C1);
                gn.x = (S.a_row(nxt, R0) * lda + (unsigned)C0) * 2u; gn.y = (S.a_row(nxt, R1) * lda + (unsigned)C1) * 2u;
                gn.z = (S.a_row(nxt, HALF + R0) * lda + (unsigned)C0) * 2u; gn.w = (S.a_row(nxt, HALF + R1) * lda + (unsigned)C1) * 2u; }
            *gnslot = gn;
        } else { nA = has_next ? Ab + (size_t)S.a_row(nxt, 0) * lda * 2 : cA; }
#pragma unroll
        for (int a = 0; a < 2; ++a)
#pragma unroll
            for (int b = 0; b < 2; ++b)
#pragma unroll
                for (int m = 0; m < 4; ++m)
#pragma unroll
                    for (int n = 0; n < 2; ++n) acc[a][b][m][n] = (f32x4){0.f, 0.f, 0.f, 0.f};
#pragma nounroll
        for (int t = 0; t < nt; t += 2) {
            const bool last = (t == nt - 2);
            const size_t k1 = (size_t)(t + 1) * kstep, k2 = last ? 0 : (size_t)(t + 2) * kstep, k3 = k2 + kstep;
            const char* u2 = last ? nA : cA;
            const char* b2 = last ? nB : cB + (size_t)(t + 2) * kstep; const char* b3 = b2 + kstep;
            unsigned o20[2] = {0u, 0u}, o21[2] = {0u, 0u};
            if constexpr (GATHER) {
                if (last) { const u32x4 gn = *gnslot; o20[0] = gn.x; o20[1] = gn.y; o21[0] = gn.z; o21[1] = gn.w; }
                else { o20[0] = ga0[0]; o20[1] = ga0[1]; o21[0] = ga1[0]; o21[1] = ga1[1]; }
            }
            PG8_LDB(B0, 0, 0); PG8_LDB(B1, 0, 1); PG8_SCHED; PG8_LDA(At, 0, 0); PG8_STAGE_A(PG8_SA(1, 1), 1, cA, k1, ga0, ga1);
            PG8_WAIT_V(8); PG8_WAIT_L(0); PG8_BAR; PG8_MMA(0, 0, At, B0); PG8_MMA(0, 1, At, B1); PG8_BAR; PG8_SCHED;
            PG8_LDA(At, 0, 1); PG8_STAGE(PG8_SB(0, 0), b2, voffB); PG8_STAGE(PG8_SB(0, 1), b2 + hstep, voffB); PG8_STAGE_A(PG8_SA(0, 0), 0, u2, k2, o20, o21);
            PG8_WAIT_V(8); PG8_WAIT_L(0); PG8_BAR; PG8_MMA(1, 0, At, B0); PG8_MMA(1, 1, At, B1); PG8_BAR; PG8_SCHED;
            PG8_LDB(B0, 1, 0); PG8_LDB(B1, 1, 1); PG8_SCHED; PG8_LDA(At, 1, 0); PG8_STAGE_A(PG8_SA(0, 1), 1, u2, k2, o20, o21);
            PG8_WAIT_V(8); PG8_WAIT_L(0); PG8_BAR; PG8_MMA(0, 0, At, B0); PG8_MMA(0, 1, At, B1); PG8_BAR; PG8_SCHED;
            PG8_LDA(At, 1, 1); PG8_STAGE(PG8_SB(1, 0), b3, voffB); PG8_STAGE(PG8_SB(1, 1), b3 + hstep, voffB); PG8_STAGE_A(PG8_SA(1, 0), 0, u2, k3, o20, o21);
            PG8_WAIT_V(8); PG8_WAIT_L(0); PG8_BAR; PG8_MMA(1, 0, At, B0); PG8_MMA(1, 1, At, B1); PG8_BAR; PG8_SCHED;
        }
        if constexpr (ALIGN_EPI) { if (wr == 0) PG8_BAR; }
        { int fr_ = fr, fq_ = fq, wr_ = wr, wc_ = wc; asm volatile("" : "+v"(fr_), "+v"(fq_), "+s"(wr_), "+s"(wc_));
          E(acc, cur, wr_, wc_, fr_, fq_); }
        if (!has_next) break;
        cur = nxt; cB = nB; cA = nA; ++ui;
        if constexpr (GATHER) { const u32x4 gn = *gnslot; ga0[0] = gn.x; ga0[1] = gn.y; ga1[0] = gn.z; ga1[1] = gn.w; }
        if constexpr (ALIGN_EPI) { if (wr == 1) PG8_BAR; }
    }
    PG8_WAIT_V(0);
    if constexpr (!ALIGN_EPI) { if (wr == 0) PG8_BAR; }
    PG8_BAR;
#undef PG8_SA
#undef PG8_SB
#undef PG8_STAGE
#undef PG8_STAGE_A
#undef PG8_LDA
#undef PG8_LDB
#undef PG8_MMA
#undef PG8_WAIT_V
#undef PG8_WAIT_L
#undef PG8_BAR
#undef PG8_SCHED
}
}

constexpr size_t MiB = 1u << 20;
constexpr size_t WS_CTL = 0, CTL_ZERO_BYTES = 1 * MiB;
constexpr size_t WS_MOD = 1 * MiB;
constexpr size_t WS_ROPE = 2 * MiB;
constexpr size_t WS_ROUTE = 3 * MiB;
constexpr size_t WS_LIST = 4 * MiB;
constexpr size_t WS_SNAP = 6 * MiB;
constexpr size_t WS_HC = 8 * MiB;
constexpr size_t WS_W = 16 * MiB;
constexpr size_t WS_DFT = 114 * MiB;
constexpr size_t WS_DFTC = WS_DFT + 64 * MiB;
constexpr size_t WS_SCR = 180 * MiB;
constexpr size_t WS_ACT = WS_SCR;
constexpr size_t WS_PX = WS_SCR + 68 * MiB;
constexpr size_t WS_GT = WS_SCR + 102 * MiB;
constexpr size_t WS_GTC = WS_SCR + 134 * MiB;
constexpr size_t WS_K = WS_SCR + 136 * MiB;
constexpr size_t WS_VT = WS_SCR + 213 * MiB;
constexpr size_t WS_HMID = WS_SCR + 68 * MiB;
constexpr size_t WS_QN = WS_SCR + 68 * MiB;
constexpr size_t WS_KN = WS_SCR + 136 * MiB;
constexpr size_t WS_VTN = WS_SCR + 204 * MiB;
constexpr size_t WS_HMOE = WS_SCR + 68 * MiB;
constexpr size_t WS_Y = WS_SCR + 261 * MiB;
constexpr size_t WS_END = WS_SCR + 401 * MiB;
static_assert((size_t)NTOK * 1024 * 2 <= 68 * MiB && (size_t)NTOK * 512 * 2 <= 34 * MiB && (size_t)NB * A_HEADS * KPOS * 96 * 2 <= 77 * MiB && (size_t)NB * A_HEADS * 64 * KPOS * 2 <= 51 * MiB, "even map");
static_assert((size_t)NTOK * DFF * 2 <= 196 * MiB && (size_t)NB * C_HEADS * 64 * KPOS * 2 <= 68 * MiB + 4 * MiB && (size_t)MOE_SLOTS * DFFE * 2 <= 193 * MiB && (size_t)MOE_SLOTS * 1024 * 2 <= 140 * MiB, "odd map");
constexpr size_t WO_WIN_E = 0, WO_WUKV = 2 * MiB, WO_WUQ = 3 * MiB, WO_WOUT_E = 4 * MiB, WO_WGU_E = 6 * MiB, WO_WDN_E = 17 * MiB;
constexpr size_t WO_WIN_O = 23 * MiB, WO_WOUT_O = 29 * MiB, WO_WGU_M = 31 * MiB, WO_WDN_M = 75 * MiB;
constexpr int CW_BAR = 4096;
constexpr int CW_MOECNT = 8192;
constexpr int CW_ATTQ = 8192 + 256;
constexpr int CW_CHK = 16384;

constexpr int RING_OFF = 0, RING_BYTES = 131072;
constexpr int LDS_BYTES = 163840;
constexpr int LDSCTL_OFF = LDS_BYTES - 1024, MISC_OFF = LDSCTL_OFF + 320;
constexpr int MOE_LDS_OFF = MISC_OFF + 128;
static_assert(MOE_LDS_OFF + 128 <= LDS_BYTES && pg8::GN_LDS_OFF == RING_BYTES && pg8::GN_LDS_OFF + 512 * 16 <= LDSCTL_OFF, "LDS map");
constexpr int NWAVES = 8;

#define CAS __attribute__((address_space(4)))
typedef GAS unsigned gu32;
#define RLX_AGENT __ATOMIC_RELAXED, __HIP_MEMORY_SCOPE_AGENT
#define LDS_WAIT() asm volatile("s_waitcnt lgkmcnt(0)" ::: "memory")
#define VM_WAIT() asm volatile("s_waitcnt vmcnt(0)" ::: "memory")

#define XB_TMO      128
#define XB_XCNT(j)  (256  + 64 * (j))
#define XB_XSUB(j)  (1280 + 64 * (j))
#define XB_XGEN(j)  (2304 + 64 * (j))
#define XB_TOP      3328
#define XB_TOPGEN   3392
#define XCD_BAR_WORDS 3456
#define XB_SPIN_CAP (1u << 18)

__device__ __forceinline__ unsigned xb_ld(GAS unsigned* p)              { return __hip_atomic_load(p, __ATOMIC_RELAXED, __HIP_MEMORY_SCOPE_AGENT); }
__device__ __forceinline__ unsigned xb_add(GAS unsigned* p, unsigned v) { return __hip_atomic_fetch_add(p, v, __ATOMIC_RELAXED, __HIP_MEMORY_SCOPE_AGENT); }
__device__ __forceinline__ unsigned xb_xcc_id() { return (unsigned)__builtin_amdgcn_s_getreg((3 << 11) | 20) & 0xFu; }
#define XB_SPIN(cond, bar) do { unsigned _sp = 0; while (cond) { __builtin_amdgcn_s_sleep(1); \
    if ((++_sp & 255u) == 0u) { if (xb_ld(&(bar)[XB_TMO])) break; if (_sp > XB_SPIN_CAP) { (void)xb_add(&(bar)[XB_TMO], 1u); break; } } } } while (0)

struct XcdBarrier {
    GAS unsigned* bar; unsigned x;
    volatile LAS unsigned* st;
};
__device__ __forceinline__ XcdBarrier xcd_barrier_post(GAS unsigned* bar, volatile LAS unsigned* st) {
    XcdBarrier b; b.bar = bar; b.x = xb_xcc_id(); b.st = st;
    if (threadIdx.x == 0) (void)xb_add(&bar[XB_XCNT(b.x)], 1u);
    return b;
}
__device__ __forceinline__ void xcd_barrier_complete(GAS unsigned* bar, unsigned x, unsigned& nloc, unsigned& nx) {
    const unsigned G = gridDim.x * gridDim.y * gridDim.z;
    unsigned sum, cnt, mine, sp = 0u;
    for (;;) {
        sum = 0u; cnt = 0u; mine = 0u;
#pragma unroll
        for (unsigned j = 0; j < 16; ++j) { const unsigned c = xb_ld(&bar[XB_XCNT(j)]); sum += c; cnt += (c > 0u) ? 1u : 0u; mine = (j == x) ? c : mine; }
        if (sum == G) break;
        __builtin_amdgcn_s_sleep(1);
        if ((++sp & 255u) == 0u) { if (xb_ld(&bar[XB_TMO])) break; if (sp > XB_SPIN_CAP) { (void)xb_add(&bar[XB_TMO], 1u); break; } }
    }
    nloc = mine > 0u ? mine : 1u; nx = cnt > 0u ? cnt : 1u;
}
__device__ __forceinline__ void xcd_barrier(const XcdBarrier& b) {
    asm volatile("s_waitcnt vmcnt(0)" ::: "memory");
    __syncthreads();
    if (threadIdx.x == 0) {
        GAS unsigned* bar = b.bar;
        __builtin_amdgcn_s_waitcnt(0);
        unsigned nloc = b.st[0], nx = b.st[1];
        if (nloc == 0u) { xcd_barrier_complete(bar, b.x, nloc, nx); b.st[0] = nloc; b.st[1] = nx; }
        const unsigned old = xb_add(&bar[XB_XSUB(b.x)], 1u);
        const unsigned gen = old / nloc;
        if (old + 1u == (gen + 1u) * nloc) {
            __builtin_amdgcn_fence(__ATOMIC_RELEASE, "agent");
            asm volatile("s_waitcnt vmcnt(0)" ::: "memory");
            const unsigned og = xb_add(&bar[XB_TOP], 1u);
            const unsigned tg = og / nx;
            if (og + 1u == (tg + 1u) * nx) xb_add(&bar[XB_TOPGEN], 1u);
            else XB_SPIN(xb_ld(&bar[XB_TOPGEN]) == tg, bar);
            __builtin_amdgcn_fence(__ATOMIC_ACQUIRE, "agent");
            xb_add(&bar[XB_XGEN(b.x)], 1u);
            asm volatile("s_waitcnt vmcnt(0)" ::: "memory");
        } else {
            XB_SPIN(xb_ld(&bar[XB_XGEN(b.x)]) == gen, bar);
            __builtin_amdgcn_fence(__ATOMIC_ACQUIRE, "agent");
            asm volatile("s_waitcnt vmcnt(0)" ::: "memory");
        }
    }
    __syncthreads();
}

struct Inputs {
    const float *x, *c, *ctx, *c_ctx, *w_mod, *b_mod, *norm_g;
    const float *a_w_in, *a_g_cq, *a_g_ckv, *a_w_uq, *a_w_ukv, *a_g_q, *a_g_k, *a_w_out;
    const float *f_w_gate, *f_w_up, *f_w_down;
    const float *c_w_in, *c_g_q, *c_g_k, *c_rpb, *c_w_out;
    const float *m_w_router, *m_w_gate, *m_w_up, *m_w_down;
};
template <class T> __device__ __forceinline__ T* G(T* p) { GAS T* g = (GAS T*)p; asm volatile("" : "+s"(g)); return (T*)g; }
struct Frame {
    LAS unsigned char* lds;
    volatile LAS unsigned* MISC;
    gu32* ctl;
    GAS unsigned char* ws_;
    GAS float* out_;
    GAS float* hc_;
    __device__ __forceinline__ unsigned char* WS() const { return (unsigned char*)ws_; }
    __device__ __forceinline__ float* OUT() const { return (float*)out_; }
    __device__ __forceinline__ float* HC() const { return (float*)hc_; }
    int tid, lane, wave, G, bid;
    const CAS Inputs* in;
};
__device__ __forceinline__ float* hrow(const Frame& F, int r) { return r < NLAT ? F.OUT() + (size_t)r * DM : F.HC() + (size_t)(r - NLAT) * DM; }
__device__ __forceinline__ int row_b9(int r) { return r < NLAT ? (r >> 12) : 8; }
__device__ __forceinline__ const float* modp(const Frame& F, int layer, int b9, int k) { return (const float*)(F.WS() + WS_MOD) + ((size_t)layer * 9 + b9) * 6144 + k * 1024; }

__device__ __forceinline__ float wave_sum(float v) {
#pragma unroll
    for (int o = 1; o < 64; o <<= 1) v += __shfl_xor(v, o);
    return v;
}

struct WMap { int which; int col; };
__device__ __forceinline__ WMap wmap(int mode, int n, int nsrc) {
    WMap r; r.which = 0;
    const int pn = n >> 8, ct = n & 255, bj = ct >> 7, wc = (ct >> 5) & 3, w = ct & 31;
    if (mode == 0) { r.col = n < nsrc ? n : -1; }
    else if (mode == 1) { const int head = 2 * pn + (wc >> 1), part = wc & 1; r.col = head * 128 + part * 64 + 32 * bj + w; }
    else if (mode == 2) { const int nn = (ct >> 4) & 1, fq = (ct >> 2) & 3, e = ct & 3; r.which = nn; r.col = pn * 128 + bj * 64 + wc * 16 + fq * 4 + e; }
    else { r.col = (pn * 4 + wc) * 64 + 32 * bj + w; }
    return r;
}
__device__ __forceinline__ void wconv_item(const float* W0, const float* W1, int ld, int Ksrc, int nsrc, const float* kscale, bf16* WT, int Kdst, int mode, int kb, int nb, LAS float* scr, int lane) {
    const int k0 = 64 * kb, n0 = 64 * nb, n4 = (lane & 15) * 4;
    const WMap mp = wmap(mode, n0 + n4, nsrc);
    const float* W = mp.which ? W1 : W0;
#pragma unroll 4
    for (int i = 0; i < 16; ++i) { const int kk = (lane >> 4) + 4 * i, k = k0 + kk; f32x4 v = (f32x4){0.f, 0.f, 0.f, 0.f};
        if (mp.col >= 0 && k < Ksrc) { v = *(const f32x4*)(W + (size_t)k * ld + mp.col); if (kscale) v = v * kscale[k]; }
        LAS float* d = scr + kk * 65 + n4; d[0] = v.x; d[1] = v.y; d[2] = v.z; d[3] = v.w; }
    LDS_WAIT(); asm volatile("" ::: "memory");
#pragma unroll
    for (int c = 0; c < 8; ++c) { const LAS float* s = scr + (8 * c) * 65 + lane;
        u32x4 o; o.x = pk2(s[0 * 65], s[1 * 65]); o.y = pk2(s[2 * 65], s[3 * 65]); o.z = pk2(s[4 * 65], s[5 * 65]); o.w = pk2(s[6 * 65], s[7 * 65]);
        *(GAS u32x4*)(WT + (size_t)(n0 + lane) * Kdst + k0 + 8 * c) = o; }
    LDS_WAIT(); asm volatile("" ::: "memory");
}
struct WJob { const float* W0; const float* W1; int ld, Ksrc, nsrc; const float* kscale; bf16* WT; int Kdst, Ndst, mode; };
__device__ __forceinline__ bool wjob_run(const WJob& J, int& r, LAS float* scr, int lane) {
    const int nblk = J.Ndst / 64, items = (J.Kdst / 64) * nblk;
    if (r < items) { wconv_item(J.W0, J.W1, J.ld, J.Ksrc, J.nsrc, J.kscale, J.WT, J.Kdst, J.mode, r / nblk, r % nblk, scr, lane); return true; }
    r -= items; return false;
}

__device__ __forceinline__ void prep_phase(Frame& F, int j) {
    const CAS Inputs& I = *F.in;
    unsigned char* W = F.WS() + WS_W;
    if (j == 0) {
        LAS float* sv = (LAS float*)(F.lds);
        LAS float* red = (LAS float*)(F.lds + 40960);
        for (int idx = F.tid; idx < 9 * 1024; idx += NWAVES * 64) { const int r = idx >> 10, k = idx & 1023; const float cv = r < 8 ? G(I.c)[r * 1024 + k] : G(I.c_ctx)[k]; sv[idx] = cv / (1.f + __expf(-cv)); }
        __syncthreads();
        for (int it = F.bid; it < 4 * 96; it += F.G) {
            const int layer = it / 96, chunk = it % 96, n = chunk * 64 + F.lane;
            const float* wm = G(I.w_mod) + (size_t)layer * 1024 * 6144 + n;
            float acc[9];
#pragma unroll
            for (int r = 0; r < 9; ++r) acc[r] = 0.f;
            const int kb = F.wave * 128;
#pragma unroll 4
            for (int k = 0; k < 128; ++k) { const float wv = wm[(size_t)(kb + k) * 6144];
#pragma unroll
                for (int r = 0; r < 9; ++r) acc[r] += sv[r * 1024 + kb + k] * wv; }
#pragma unroll
            for (int r = 0; r < 9; ++r) red[(F.wave * 9 + r) * 64 + F.lane] = acc[r];
            __syncthreads();
            for (int idx = F.tid; idx < 9 * 64; idx += NWAVES * 64) { const int r = idx >> 6, l = idx & 63; float s = 0.f;
#pragma unroll
                for (int w = 0; w < 8; ++w) s += red[(w * 9 + r) * 64 + l];
                const int nn = chunk * 64 + l;
                ((float*)(F.WS() + WS_MOD))[((size_t)layer * 9 + r) * 6144 + nn] = s + G(I.b_mod)[layer * 6144 + nn]; }
            __syncthreads();
        }
        if (F.bid == 0) { const int pos = F.tid >> 3, f = F.tid & 7; const float inv = powf(10000.f, -(float)f / 8.f); const float ang = (float)pos * inv;
            ((f32x2*)(F.WS() + WS_ROPE))[F.tid] = (f32x2){cosf(ang), sinf(ang)}; }
        __syncthreads();
        LAS f32x2* tab = (LAS f32x2*)(F.lds);
        for (int m = F.tid; m < 4096; m += NWAVES * 64) { float s, c; sincospif((float)m * (1.f / 2048.f), &s, &c); tab[m] = (f32x2){c, s}; }
        __syncthreads();
        bf16* DF = (bf16*)(F.WS() + WS_DFT);
        for (int q = F.bid * (NWAVES * 64) + F.tid; q < 4096 * 1024; q += F.G * NWAVES * 64) {
            const int np = q >> 10, kk0 = (q & 1023) * 8, type = kk0 >= 4096, n = kk0 & 4095; float v[8];
#pragma unroll
            for (int e = 0; e < 8; ++e) { const f32x2 t = tab[(np * (n + e)) & 4095]; v[e] = (type ? -t.y : t.x) * (1.f / 512.f); }
            u32x4 o; o.x = pk2(v[0], v[1]); o.y = pk2(v[2], v[3]); o.z = pk2(v[4], v[5]); o.w = pk2(v[6], v[7]);
            *(GAS u32x4*)(DF + (size_t)np * 8192 + kk0) = o;
        }
        bf16* DC = (bf16*)(F.WS() + WS_DFTC);
        for (int q = F.bid * (NWAVES * 64) + F.tid; q < 256 * 64; q += F.G * NWAVES * 64) {
            const int np = q >> 6, kk0 = (q & 63) * 8, type = kk0 >= 256, n = kk0 & 255; float v[8];
#pragma unroll
            for (int e = 0; e < 8; ++e) { const f32x2 t = tab[((np * (n + e)) & 255) * 16]; v[e] = (type ? -t.y : t.x) * (1.f / 128.f); }
            u32x4 o; o.x = pk2(v[0], v[1]); o.y = pk2(v[2], v[3]); o.z = pk2(v[4], v[5]); o.w = pk2(v[6], v[7]);
            *(GAS u32x4*)(DC + (size_t)np * 512 + kk0) = o;
        }
        __syncthreads();
    }
    {
        LAS float* scr = (LAS float*)(F.lds + F.wave * 16896);
        const int gw = F.bid * NWAVES + F.wave, NGW = F.G * NWAVES;
        const float* a_w_in = G(I.a_w_in) + (size_t)j * 1024 * 672;
        WJob J0{a_w_in, a_w_in, 672, 1024, 416, nullptr, (bf16*)(W + WO_WIN_E), 1024, 512, 0};
        WJob J2{G(I.a_w_ukv) + (size_t)j * 128 * 1536, nullptr, 1536, 128, 1536, G(I.a_g_ckv) + j * 128, (bf16*)(W + WO_WUKV), 256, 1536, 1};
        WJob J3{G(I.a_w_uq) + (size_t)j * 256 * 1152, nullptr, 1152, 256, 1152, G(I.a_g_cq) + j * 256, (bf16*)(W + WO_WUQ), 256, 1152, 0};
        WJob J4{G(I.a_w_out) + (size_t)j * 1024 * 1024, nullptr, 1024, 1024, 1024, nullptr, (bf16*)(W + WO_WOUT_E), 1024, 1024, 0};
        WJob J5{G(I.f_w_gate) + (size_t)j * 1024 * DFF, G(I.f_w_up) + (size_t)j * 1024 * DFF, DFF, 1024, DFF, nullptr, (bf16*)(W + WO_WGU_E), 1024, 2 * DFF, 2};
        WJob J6{G(I.f_w_down) + (size_t)j * DFF * 1024, nullptr, 1024, DFF, 1024, nullptr, (bf16*)(W + WO_WDN_E), DFF, 1024, 0};
        WJob J7{G(I.c_w_in) + (size_t)j * 1024 * 3072, nullptr, 3072, 1024, 3072, nullptr, (bf16*)(W + WO_WIN_O), 1024, 3072, 3};
        WJob J8{G(I.c_w_out) + (size_t)j * 1024 * 1024, nullptr, 1024, 1024, 1024, nullptr, (bf16*)(W + WO_WOUT_O), 1024, 1024, 0};
        constexpr int IT_GU = (1024 / 64) * (2 * DFFE / 64), IT_DN = (DFFE / 64) * (1024 / 64);
        const int fixed = 16 * 8 + 4 * 24 + 4 * 18 + 16 * 16 + 16 * 88 + 44 * 16 + 16 * 48 + 16 * 16;
        const int total = fixed + NEXP * (IT_GU + IT_DN);
        for (int it = gw; it < total; it += NGW) {
            int r = it;
            if (wjob_run(J0, r, scr, F.lane)) continue;
            if (wjob_run(J2, r, scr, F.lane)) continue;
            if (wjob_run(J3, r, scr, F.lane)) continue;
            if (wjob_run(J4, r, scr, F.lane)) continue;
            if (wjob_run(J5, r, scr, F.lane)) continue;
            if (wjob_run(J6, r, scr, F.lane)) continue;
            if (wjob_run(J7, r, scr, F.lane)) continue;
            if (wjob_run(J8, r, scr, F.lane)) continue;
            if (r < NEXP * IT_GU) { const int e = r / IT_GU, rr = r % IT_GU; const size_t eo = ((size_t)j * NEXP + e) * 1024 * DFFE;
                wconv_item(G(I.m_w_gate) + eo, G(I.m_w_up) + eo, DFFE, 1024, DFFE, nullptr, (bf16*)(W + WO_WGU_M) + (size_t)e * 2 * DFFE * 1024, 1024, 2, rr / (2 * DFFE / 64), rr % (2 * DFFE / 64), scr, F.lane); continue; }
            r -= NEXP * IT_GU;
            { const int e = r / IT_DN, rr = r % IT_DN; const size_t eo = ((size_t)j * NEXP + e) * DFFE * 1024;
                wconv_item(G(I.m_w_down) + eo, nullptr, 1024, DFFE, 1024, nullptr, (bf16*)(W + WO_WDN_M) + (size_t)e * 1024 * DFFE, DFFE, 0, rr / 16, rr % 16, scr, F.lane); }
        }
        __syncthreads();
        LAS f32x2* t64 = (LAS f32x2*)(F.lds);
        if (F.tid < 64) { float s, c; sincospif((float)F.tid * (1.f / 32.f), &s, &c); t64[F.tid] = (f32x2){c, s}; }
        __syncthreads();
        bf16* WE = (bf16*)(W + WO_WIN_E);
        for (int it = gw; it < 1024 * 4; it += NGW) {
            const int k = it >> 2, g = it & 3;
            const float f = a_w_in[(size_t)k * 672 + 416 + 64 * g + F.lane];
            float ac = 0.f, as = 0.f;
#pragma unroll 8
            for (int c = 0; c < 64; ++c) { const float fc = __shfl(f, c); const f32x2 t = t64[(c * F.lane) & 63]; ac += fc * t.x; as += fc * t.y; }
            WE[(size_t)(512 + g * 64 + F.lane) * 1024 + k] = (bf16)f2bf(ac);
            WE[(size_t)(768 + g * 64 + F.lane) * 1024 + k] = (bf16)f2bf(as);
        }
        __syncthreads();
    }
}

__device__ __forceinline__ void moe_panels_to_lds(Frame& F, int pair) {
    volatile LAS int* MOE = (volatile LAS int*)(F.lds + MOE_LDS_OFF);
    if (F.tid == 0) { int p = 0;
        for (int e = 0; e < NEXP; ++e) { const int c = (int)__hip_atomic_load(F.ctl + CW_MOECNT + 64 * pair + e, RLX_AGENT); MOE[e] = p; MOE[16 + e] = c; p += (c + 255) >> 8; }
        MOE[8] = p; }
    __syncthreads();
}
struct NormArgs { int layer, which, from_inputs, combine_pair, router_pair, final_only; };
__device__ __forceinline__ void norm_phase(Frame& F, const NormArgs a) {
    const CAS Inputs& I = *F.in;
    volatile LAS int* MOE = (volatile LAS int*)(F.lds + MOE_LDS_OFF);
    LAS float* wr = (LAS float*)(F.lds);
    volatile LAS int* lcnt = (volatile LAS int*)(F.lds + 32768);
    volatile LAS int* stash = (volatile LAS int*)(F.lds + 32768 + 256);
    if (a.combine_pair >= 0) moe_panels_to_lds(F, a.combine_pair);
    if (a.router_pair >= 0) {
        const float* wsrc = G(I.m_w_router) + (size_t)a.router_pair * 1024 * NEXP;
        for (int idx = F.tid; idx < 1024 * NEXP; idx += NWAVES * 64) wr[idx] = wsrc[idx];
        if (F.tid < 16) lcnt[F.tid] = 0;
        __syncthreads();
    }
    const int* te = (const int*)(F.WS() + WS_ROUTE); const int* tr = te + 2 * NTOK; const float* tg = (const float*)(tr + 2 * NTOK);
    const bf16* Y = (const bf16*)(F.WS() + WS_Y);
    bf16* XN = (bf16*)(F.WS() + WS_ACT);
    const int nrows = a.final_only ? NLAT : NTOK;
    const int nk = (nrows - F.bid + F.G - 1) / F.G;
    for (int k = F.wave; k < nk; k += NWAVES) {
        const int row = F.bid + F.G * k;
        const int b9 = row_b9(row);
        float* hp = hrow(F, row);
        const float* src = a.from_inputs ? (row < NLAT ? G(I.x) + (size_t)row * DM : G(I.ctx) + (size_t)(row - NLAT) * DM) : hp;
        f32x4 v[4];
#pragma unroll
        for (int j = 0; j < 4; ++j) v[j] = ((const f32x4*)src)[F.lane + 64 * j];
        if (a.combine_pair >= 0) {
            const int e1 = te[2 * row], e2 = te[2 * row + 1], r1 = tr[2 * row], r2 = tr[2 * row + 1];
            const float g1 = tg[2 * row], g2 = tg[2 * row + 1];
            const size_t s1 = (size_t)MOE[e1] * 256 + r1, s2 = (size_t)MOE[e2] * 256 + r2;
            const float* gm = modp(F, 2 * a.combine_pair + 1, b9, 5);
#pragma unroll
            for (int j = 0; j < 4; ++j) {
                const u32x2 y1 = *(const u32x2*)(Y + s1 * 1024 + 256 * j + 4 * F.lane), y2 = *(const u32x2*)(Y + s2 * 1024 + 256 * j + 4 * F.lane);
                const f32x4 gg = ((const f32x4*)gm)[F.lane + 64 * j];
                v[j].x += gg.x * (g1 * bflo(y1.x) + g2 * bflo(y2.x)); v[j].y += gg.y * (g1 * bfhi(y1.x) + g2 * bfhi(y2.x));
                v[j].z += gg.z * (g1 * bflo(y1.y) + g2 * bflo(y2.y)); v[j].w += gg.w * (g1 * bfhi(y1.y) + g2 * bfhi(y2.y));
            }
        }
        if (a.from_inputs || a.combine_pair >= 0) {
#pragma unroll
            for (int j = 0; j < 4; ++j) ((f32x4*)hp)[F.lane + 64 * j] = v[j];
        }
        if (a.final_only) continue;
        float ss = 0.f;
#pragma unroll
        for (int j = 0; j < 4; ++j) ss += (v[j].x * v[j].x + v[j].y * v[j].y) + (v[j].z * v[j].z + v[j].w * v[j].w);
        const float rstd = 1.0f / sqrtf(wave_sum(ss) * (1.f / DM) + EPS);
        const float* gp = G(I.norm_g) + ((size_t)a.layer * 2 + a.which) * DM;
        const float* shp = modp(F, a.layer, b9, a.which ? 3 : 0);
        const float* scp = modp(F, a.layer, b9, a.which ? 4 : 1);
        f32x4 xn[4];
#pragma unroll
        for (int j = 0; j < 4; ++j) { const f32x4 g = ((const f32x4*)gp)[F.lane + 64 * j], sh = ((const f32x4*)shp)[F.lane + 64 * j], sc = ((const f32x4*)scp)[F.lane + 64 * j];
            xn[j] = v[j] * rstd * g * (sc + 1.0f) + sh; }
        u32x2* o8 = (u32x2*)(XN + (size_t)row * DM) + F.lane;
#pragma unroll
        for (int j = 0; j < 4; ++j) o8[64 * j] = (u32x2){pk2(xn[j].x, xn[j].y), pk2(xn[j].z, xn[j].w)};
        if (a.router_pair >= 0) {
            float lg[NEXP];
#pragma unroll
            for (int e = 0; e < NEXP; ++e) lg[e] = 0.f;
#pragma unroll
            for (int j = 0; j < 4; ++j)
#pragma unroll
                for (int q = 0; q < 4; ++q) { const float xv = xn[j][q]; const LAS f32x4* w4 = (const LAS f32x4*)(wr + (256 * j + 4 * F.lane + q) * NEXP); const f32x4 wa = w4[0], wb = w4[1];
                    lg[0] += xv * wa.x; lg[1] += xv * wa.y; lg[2] += xv * wa.z; lg[3] += xv * wa.w; lg[4] += xv * wb.x; lg[5] += xv * wb.y; lg[6] += xv * wb.z; lg[7] += xv * wb.w; }
#pragma unroll
            for (int e = 0; e < NEXP; ++e) lg[e] = wave_sum(lg[e]);
            int i1 = 0; float v1 = lg[0];
#pragma unroll
            for (int e = 1; e < NEXP; ++e) if (lg[e] > v1) { v1 = lg[e]; i1 = e; }
            int i2 = -1; float v2 = -3.0e38f;
#pragma unroll
            for (int e = 0; e < NEXP; ++e) if (e != i1 && lg[e] > v2) { v2 = lg[e]; i2 = e; }
            const float ga = 1.f / (1.f + __expf(v2 - v1)), gb = 1.f - ga;
            if (F.lane == 0) {
                const int l1 = __hip_atomic_fetch_add((LAS int*)(lcnt + i1), 1, __ATOMIC_RELAXED, __HIP_MEMORY_SCOPE_WORKGROUP);
                const int l2 = __hip_atomic_fetch_add((LAS int*)(lcnt + i2), 1, __ATOMIC_RELAXED, __HIP_MEMORY_SCOPE_WORKGROUP);
                stash[4 * k + 0] = i1; stash[4 * k + 1] = l1; stash[4 * k + 2] = i2; stash[4 * k + 3] = l2;
                float* tgw = (float*)(F.WS() + WS_ROUTE) + 4 * NTOK; tgw[2 * row] = ga; tgw[2 * row + 1] = gb;
            }
        }
    }
    if (a.router_pair >= 0) {
        __syncthreads();
        if (F.tid < NEXP) lcnt[8 + F.tid] = (int)__hip_atomic_fetch_add(F.ctl + CW_MOECNT + 64 * a.router_pair + F.tid, (unsigned)lcnt[F.tid], RLX_AGENT);
        __syncthreads();
        int* tew = (int*)(F.WS() + WS_ROUTE); int* trw = tew + 2 * NTOK; int* list = (int*)(F.WS() + WS_LIST);
        for (int k = F.tid; k < nk; k += NWAVES * 64) {
            const int row = F.bid + F.G * k;
            const int i1 = stash[4 * k + 0], l1 = stash[4 * k + 1], i2 = stash[4 * k + 2], l2 = stash[4 * k + 3];
            const int r1 = lcnt[8 + i1] + l1, r2 = lcnt[8 + i2] + l2;
            tew[2 * row] = i1; tew[2 * row + 1] = i2; trw[2 * row] = r1; trw[2 * row + 1] = r2;
            list[(size_t)i1 * NTOK + r1] = row; list[(size_t)i2 * NTOK + r2] = row;
        }
    }
    __syncthreads();
}

struct SchedStatic {
    static constexpr bool GATHER = false;
    const bf16* A; int lda; const bf16* Bt; int K, nM, nN, G, c;
    __device__ __forceinline__ bool next(int i, pg8::Unit& u) const { return pg8::static_next(i, G, c, nM, nN, u); }
    __device__ __forceinline__ unsigned a_row(const pg8::Unit& u, int r) const { return (unsigned)(u.pm * 256 + r); }
    __device__ __forceinline__ const char* b_base(const pg8::Unit& u) const { return (const char*)Bt + (size_t)u.pn * 256 * K * 2; }
};
struct SchedOne {
    static constexpr bool GATHER = false;
    const bf16* A; int lda; const bf16* Bt; int K, pm, pn, have;
    __device__ __forceinline__ bool next(int i, pg8::Unit& u) const { if (i != 0 || !have) return false; u.pm = pm; u.pn = pn; return true; }
    __device__ __forceinline__ unsigned a_row(const pg8::Unit& u, int r) const { return (unsigned)(u.pm * 256 + r); }
    __device__ __forceinline__ const char* b_base(const pg8::Unit& u) const { return (const char*)Bt + (size_t)u.pn * 256 * K * 2; }
};
template <bool G_> struct SchedMoe {
    static constexpr bool GATHER = G_;
    const bf16* A; int lda; const bf16* Bt; size_t bstride; int K, nN, G, c; const int* list; volatile LAS int* MOE;
    __device__ __forceinline__ bool next(int i, pg8::Unit& u) const { const long L = (long)i * G + c; const int nP = MOE[8]; if (L >= (long)nP * nN) return false; u.pm = (int)(L / nN); u.pn = (int)(L % nN); return true; }
    __device__ __forceinline__ int expert(int pm) const { int e = 0;
#pragma unroll
        for (int k = 1; k < NEXP; ++k) e += (pm >= MOE[k]) ? 1 : 0;
        return e; }
    __device__ __forceinline__ unsigned a_row(const pg8::Unit& u, int r) const {
        if (!G_) return (unsigned)(u.pm * 256 + r);
        const int e = expert(u.pm), idx = (u.pm - MOE[e]) * 256 + r;
        return idx < MOE[16 + e] ? (unsigned)list[e * NTOK + idx] : 0u; }
    __device__ __forceinline__ const char* b_base(const pg8::Unit& u) const { return (const char*)Bt + (size_t)expert(u.pm) * bstride + (size_t)u.pn * 256 * K * 2; }
};

__device__ __forceinline__ unsigned cvt_pk_bf16(float lo, float hi) { unsigned r; asm volatile("v_cvt_pk_bf16_f32 %0, %1, %2" : "=v"(r) : "v"(lo), "v"(hi)); return r; }
typedef const f32x4 (&AccRef)[2][2][4][2];
__device__ __forceinline__ int swap12(int g) { return ((g & 1) << 1) | (g >> 1); }

struct EpiBf16 { static constexpr bool PERM = true;
    bf16* O; int ldc, mode;
    __device__ __forceinline__ void operator()(AccRef acc, const pg8::Unit& u, int wr, int wc, int fr, int fq) const {
        const int rbase = mode == 0 ? u.pm * 256 : (mode == 1 ? u.pn * 4096 + u.pm * 256 : NLAT + u.pn * 256 + u.pm * 256);
        const int cbase = mode == 0 ? u.pn * 256 : 768;
        const int row0 = rbase + wr * 64 + fr, col0 = cbase + wc * 32 + 8 * fq;
#pragma unroll
        for (int ai = 0; ai < 2; ++ai)
#pragma unroll
            for (int m = 0; m < 4; ++m) { bf16* rowp = O + (size_t)(row0 + ai * 128 + m * 16) * ldc + col0;
#pragma unroll
                for (int bj = 0; bj < 2; ++bj) { const f32x4 v0 = acc[ai][bj][m][0], v1 = acc[ai][bj][m][1];
                    u32x4 w; w.x = cvt_pk_bf16(v0[0], v0[1]); w.y = cvt_pk_bf16(v0[2], v0[3]); w.z = cvt_pk_bf16(v1[0], v1[1]); w.w = cvt_pk_bf16(v1[2], v1[3]);
                    *(u32x4*)(rowp + bj * 128) = w; } }
    }
};
struct EpiWin { static constexpr bool PERM = true;
    bf16* PX; bf16* GT; bf16* GTC;
    __device__ __forceinline__ void operator()(AccRef acc, const pg8::Unit& u, int wr, int wc, int fr, int fq) const {
        if (u.pn < 2) {
            const int row0 = u.pm * 256 + wr * 64 + fr, col0 = u.pn * 256 + wc * 32 + 8 * fq;
#pragma unroll
            for (int ai = 0; ai < 2; ++ai)
#pragma unroll
                for (int m = 0; m < 4; ++m) { bf16* rowp = PX + (size_t)(row0 + ai * 128 + m * 16) * 512 + col0;
#pragma unroll
                    for (int bj = 0; bj < 2; ++bj) { const f32x4 v0 = acc[ai][bj][m][0], v1 = acc[ai][bj][m][1];
                        u32x4 w; w.x = cvt_pk_bf16(v0[0], v0[1]); w.y = cvt_pk_bf16(v0[2], v0[3]); w.z = cvt_pk_bf16(v1[0], v1[1]); w.w = cvt_pk_bf16(v1[2], v1[3]);
                        *(u32x4*)(rowp + bj * 128) = w; } }
        } else {
            const int type = u.pn - 2; const bool lat = u.pm < 128;
            const int b = lat ? (u.pm >> 4) : (u.pm - 128);
            bf16* base = lat ? GT + (size_t)b * 256 * 8192 + type * 4096 + (u.pm & 15) * 256 : GTC + (size_t)b * 256 * 512 + type * 256;
            const size_t ldt = lat ? 8192 : 512;
#pragma unroll
            for (int ai = 0; ai < 2; ++ai)
#pragma unroll
                for (int m = 0; m < 4; ++m) { const int lr = ai * 128 + wr * 64 + m * 16 + fr;
#pragma unroll
                    for (int bj = 0; bj < 2; ++bj)
#pragma unroll
                        for (int n = 0; n < 2; ++n)
#pragma unroll
                            for (int e = 0; e < 4; ++e) { const int jc = 128 * bj + 32 * wc + 8 * fq + 4 * n + e; base[(size_t)jc * ldt + lr] = (bf16)f2bf(acc[ai][bj][m][n][e]); }
                    if (m == 3) asm volatile("" ::: "memory"); }
        }
    }
};
struct EpiKV { static constexpr bool PERM = false;
    const bf16* PX; bf16* Kb; bf16* Vt; const float* g_k; const f32x2* rope;
    __device__ __forceinline__ void operator()(AccRef acc, const pg8::Unit& u, int wr, int wc, int fr, int fq) const {
        const int head = 2 * u.pn + (wc >> 1), part = wc & 1;
        const bool lat = u.pm < 128;
        const int b = lat ? (u.pm >> 4) : (u.pm - 128);
        const int pos0 = lat ? (u.pm & 15) * 256 : SEQ;
        const size_t bh = (size_t)b * A_HEADS + head;
#pragma unroll
        for (int ai = 0; ai < 2; ++ai)
#pragma unroll
            for (int m = 0; m < 4; ++m) {
                const int lr = ai * 128 + wr * 64 + m * 16 + fr, row = u.pm * 256 + lr, pos = pos0 + lr;
                const bf16* pxr = PX + (size_t)row * 512;
                float ss = 0.f;
#pragma unroll
                for (int q = 0; q < 4; ++q) { const u32x4 w = *(const u32x4*)(pxr + 256 + 32 * fq + 8 * q);
                    ss += bflo(w.x) * bflo(w.x) + bfhi(w.x) * bfhi(w.x) + bflo(w.y) * bflo(w.y) + bfhi(w.y) * bfhi(w.y) + bflo(w.z) * bflo(w.z) + bfhi(w.z) * bfhi(w.z) + bflo(w.w) * bflo(w.w) + bfhi(w.w) * bfhi(w.w); }
                ss += __shfl_xor(ss, 16); ss += __shfl_xor(ss, 32);
                const float rkv = 1.0f / sqrtf(ss * (1.f / 128.f) + EPS);
                if (part == 0) {
                    const u32x4 kw = *(const u32x4*)(pxr + 384 + 8 * fq);
                    float kr[8] = {bflo(kw.x), bfhi(kw.x), bflo(kw.y), bfhi(kw.y), bflo(kw.z), bfhi(kw.z), bflo(kw.w), bfhi(kw.w)};
                    float s2 = 0.f;
#pragma unroll
                    for (int q = 0; q < 8; ++q) s2 += kr[q] * kr[q];
#pragma unroll
                    for (int bj = 0; bj < 2; ++bj)
#pragma unroll
                        for (int n = 0; n < 2; ++n) { const f32x4 x = acc[ai][bj][m][n] * rkv; s2 += (x[0] * x[0] + x[1] * x[1]) + (x[2] * x[2] + x[3] * x[3]); }
                    s2 += __shfl_xor(s2, 16); s2 += __shfl_xor(s2, 32);
                    const float rs = 1.0f / sqrtf(s2 * (1.f / 96.f) + EPS);
                    bf16* kp = Kb + (bh * KPOS + pos) * 96;
#pragma unroll
                    for (int bj = 0; bj < 2; ++bj)
#pragma unroll
                        for (int n = 0; n < 2; ++n) { const int d0 = 32 * bj + 16 * n; const f32x4 g = *(const f32x4*)(g_k + d0 + 4 * fq); const f32x4 x = acc[ai][bj][m][n] * (rkv * rs) * g;
                            *(u32x2*)(kp + d0 + 4 * swap12(fq)) = (u32x2){pk2(x[0], x[1]), pk2(x[2], x[3])}; }
                    float t[8];
                    { const f32x4 ga = *(const f32x4*)(g_k + 64 + 8 * fq), gb = *(const f32x4*)(g_k + 64 + 8 * fq + 4);
                      t[0] = kr[0] * rs * ga[0]; t[1] = kr[1] * rs * ga[1]; t[2] = kr[2] * rs * ga[2]; t[3] = kr[3] * rs * ga[3];
                      t[4] = kr[4] * rs * gb[0]; t[5] = kr[5] * rs * gb[1]; t[6] = kr[6] * rs * gb[2]; t[7] = kr[7] * rs * gb[3]; }
                    if (lat) {
                        const int pidx = (fq < 2) ? (pos >> 6) : (pos & 63);
#pragma unroll
                        for (int q = 0; q < 4; ++q) { const f32x2 cs = rope[pidx * 8 + ((4 * fq + q) & 7)]; const float t0 = t[2 * q], t1 = t[2 * q + 1];
                            t[2 * q] = t0 * cs.x - t1 * cs.y; t[2 * q + 1] = t0 * cs.y + t1 * cs.x; }
                    }
                    bf16* krp = kp + 64 + 16 * (fq >> 1) + 4 * (fq & 1);
                    *(u32x2*)(krp) = (u32x2){pk2(t[0], t[1]), pk2(t[2], t[3])};
                    *(u32x2*)(krp + 8) = (u32x2){pk2(t[4], t[5]), pk2(t[6], t[7])};
                } else {
                    const int pp = (pos & ~15) | (((pos & 4) << 1) | ((pos & 8) >> 1) | (pos & 3));
                    bf16* vp = Vt + bh * 64 * KPOS + pp;
#pragma unroll
                    for (int bj = 0; bj < 2; ++bj)
#pragma unroll
                        for (int n = 0; n < 2; ++n)
#pragma unroll
                            for (int e = 0; e < 4; ++e) vp[(size_t)(32 * bj + 16 * n + 4 * fq + e) * KPOS] = (bf16)f2bf(acc[ai][bj][m][n][e] * rkv);
                }
                if (m & 1) asm volatile("" ::: "memory");
            }
    }
};
struct EpiResid { static constexpr bool PERM = false;
    float* out; float* hc; const float* modl; int gk; bool dry;
    __device__ __forceinline__ void operator()(AccRef acc, const pg8::Unit& u, int wr, int wc, int fr, int fq) const {
        const bool lat = u.pm < 128; const int b9 = lat ? (u.pm >> 4) : 8;
        float* base = lat ? out + (size_t)u.pm * 256 * DM : hc + (size_t)(u.pm - 128) * 256 * DM;
        const int col0 = u.pn * 256 + wc * 32 + 4 * fq;
        const float* gp = modl + (size_t)b9 * 6144 + gk * 1024 + col0;
        f32x4 gv[2][2];
#pragma unroll
        for (int bj = 0; bj < 2; ++bj)
#pragma unroll
            for (int n = 0; n < 2; ++n) gv[bj][n] = *(const f32x4*)(gp + bj * 128 + n * 16);
#pragma unroll
        for (int ai = 0; ai < 2; ++ai)
#pragma unroll
            for (int m = 0; m < 4; ++m) { float* rowp = base + (size_t)(ai * 128 + wr * 64 + m * 16 + fr) * DM + col0;
#pragma unroll
                for (int bj = 0; bj < 2; ++bj)
#pragma unroll
                    for (int n = 0; n < 2; ++n) { f32x4* p = (f32x4*)(rowp + bj * 128 + n * 16); const f32x4 r = *p + gv[bj][n] * acc[ai][bj][m][n]; if (!dry) *p = r; }
                if (m == 3) asm volatile("" ::: "memory"); }
    }
};
struct EpiSwiglu { static constexpr bool PERM = false;
    bf16* HM; int ldh;
    __device__ __forceinline__ void operator()(AccRef acc, const pg8::Unit& u, int wr, int wc, int fr, int fq) const {
        const int row0 = u.pm * 256 + wr * 64 + fr, col0 = u.pn * 128 + wc * 16 + 4 * fq;
#pragma unroll
        for (int ai = 0; ai < 2; ++ai)
#pragma unroll
            for (int m = 0; m < 4; ++m) { bf16* rowp = HM + (size_t)(row0 + ai * 128 + m * 16) * ldh + col0;
#pragma unroll
                for (int bj = 0; bj < 2; ++bj) { const f32x4 g = acc[ai][bj][m][0], up = acc[ai][bj][m][1]; float h[4];
#pragma unroll
                    for (int e = 0; e < 4; ++e) h[e] = g[e] * __builtin_amdgcn_rcpf(1.f + __builtin_amdgcn_exp2f(-g[e] * LOG2E)) * up[e];
                    *(u32x2*)(rowp + bj * 64) = (u32x2){cvt_pk_bf16(h[0], h[1]), cvt_pk_bf16(h[2], h[3])}; } }
    }
};
struct EpiNAin { static constexpr bool PERM = false;
    bf16* QN; bf16* KN; bf16* Vt; const float* g_q; const float* g_k;
    __device__ __forceinline__ void operator()(AccRef acc, const pg8::Unit& u, int wr, int wc, int fr, int fq) const {
        const int sec = u.pn >> 2, head = 4 * (u.pn & 3) + wc;
        const bool lat = u.pm < 128;
        const int b = lat ? (u.pm >> 4) : (u.pm - 128);
        const int pos0 = lat ? (u.pm & 15) * 256 : SEQ;
#pragma unroll
        for (int ai = 0; ai < 2; ++ai)
#pragma unroll
            for (int m = 0; m < 4; ++m) {
                const int lr = ai * 128 + wr * 64 + m * 16 + fr, row = u.pm * 256 + lr;
                if (sec < 2) {
                    float s2 = 0.f;
#pragma unroll
                    for (int bj = 0; bj < 2; ++bj)
#pragma unroll
                        for (int n = 0; n < 2; ++n) { const f32x4 x = acc[ai][bj][m][n]; s2 += (x[0] * x[0] + x[1] * x[1]) + (x[2] * x[2] + x[3] * x[3]); }
                    s2 += __shfl_xor(s2, 16); s2 += __shfl_xor(s2, 32);
                    const float rs = (1.0f / sqrtf(s2 * (1.f / 64.f) + EPS)) * (sec == 0 ? 0.125f * LOG2E : 1.0f);
                    const float* gp = sec == 0 ? g_q : g_k;
                    bf16* op = (sec == 0 ? QN : KN) + (size_t)row * DM + head * 64;
#pragma unroll
                    for (int bj = 0; bj < 2; ++bj)
#pragma unroll
                        for (int n = 0; n < 2; ++n) { const int d0 = 32 * bj + 16 * n + 4 * fq; const f32x4 g = *(const f32x4*)(gp + d0); const f32x4 x = acc[ai][bj][m][n] * rs * g;
                            *(u32x2*)(op + d0) = (u32x2){pk2(x[0], x[1]), pk2(x[2], x[3])}; }
                } else {
                    bf16* vp = Vt + ((size_t)b * C_HEADS + head) * 64 * KPOS + pos0 + lr;
#pragma unroll
                    for (int bj = 0; bj < 2; ++bj)
#pragma unroll
                        for (int n = 0; n < 2; ++n)
#pragma unroll
                            for (int e = 0; e < 4; ++e) vp[(size_t)(32 * bj + 16 * n + 4 * fq + e) * KPOS] = (bf16)f2bf(acc[ai][bj][m][n][e]);
                }
                if (m == 3) asm volatile("" ::: "memory");
            }
    }
};

constexpr int AT_KP = 208, AT_VP = 144;
constexpr int AT_KB = 64 * AT_KP, AT_VB = 64 * AT_VP, AT_BUF = AT_KB + AT_VB;

__device__ __forceinline__ void mla_attn_unit(Frame& F, int pair, int b, int h, int qrow0, bool lat, int key0, int nkt) {
    const int lane = F.lane, l31 = lane & 31, hi = lane >> 5;
    const bf16* PX = (const bf16*)(F.WS() + WS_PX);
    const bf16* WUQ = (const bf16*)(F.WS() + WS_W + WO_WUQ);
    const bf16* Kg = (const bf16*)(F.WS() + WS_K) + ((size_t)(b * A_HEADS + h) * KPOS + key0) * 96;
    const bf16* Vg = (const bf16*)(F.WS() + WS_VT) + (size_t)(b * A_HEADS + h) * 64 * KPOS + key0;
    bf16* MIX = (bf16*)(F.WS() + WS_ACT);
    const f32x2* rope = (const f32x2*)(F.WS() + WS_ROPE);
    const int row = qrow0 + 32 * F.wave + l31;
    const int vdv = F.tid >> 3, vpart = F.tid & 7;
    u32x4 kr0, kr1 = (u32x4){0u, 0u, 0u, 0u}, vr;
    kr0 = *(const u32x4*)((const char*)Kg + (size_t)F.tid * 16);
    if (F.tid < 256) kr1 = *(const u32x4*)((const char*)Kg + (size_t)(512 + F.tid) * 16);
    vr = *(const u32x4*)(Vg + (size_t)vdv * KPOS + vpart * 8);
    bf16x8 qf[3][2];
    {
        bf16x8 bq[16];
        const bf16* pxr = PX + (size_t)row * 512 + 8 * hi;
#pragma unroll
        for (int s = 0; s < 16; ++s) bq[s] = *(const bf16x8*)(pxr + 16 * s);
        float ss = 0.f;
#pragma unroll
        for (int s = 0; s < 16; ++s)
#pragma unroll
            for (int e = 0; e < 8; ++e) { const float x = bf2f((unsigned short)bq[s][e]); ss += x * x; }
        ss += __shfl_xor(ss, 32);
        const float rq = 1.0f / sqrtf(ss * (1.f / 256.f) + EPS);
        f32x16 qt[3];
#pragma unroll
        for (int blk = 0; blk < 3; ++blk) {
            f32x16 acc;
#pragma unroll
            for (int i = 0; i < 16; ++i) acc[i] = 0.f;
            const bf16* wrp = WUQ + (size_t)(h * 96 + 32 * blk + l31) * 256 + 8 * hi;
#pragma unroll
            for (int s = 0; s < 16; ++s) { const bf16x8 a = *(const bf16x8*)(wrp + 16 * s); acc = __builtin_amdgcn_mfma_f32_32x32x16_bf16(a, bq[s], acc, 0, 0, 0); }
            qt[blk] = acc * rq;
        }
        float s2 = 0.f;
#pragma unroll
        for (int blk = 0; blk < 3; ++blk)
#pragma unroll
            for (int i = 0; i < 16; ++i) s2 += qt[blk][i] * qt[blk][i];
        s2 += __shfl_xor(s2, 32);
        const float rs = (1.0f / sqrtf(s2 * (1.f / 96.f) + EPS));
        const float* gq = G(F.in->a_g_q) + pair * 96;
#pragma unroll
        for (int blk = 0; blk < 3; ++blk)
#pragma unroll
            for (int c = 0; c < 4; ++c) { const f32x4 g = *(const f32x4*)(gq + 32 * blk + 8 * c + 4 * hi);
#pragma unroll
                for (int e = 0; e < 4; ++e) qt[blk][4 * c + e] *= rs * g[e]; }
        if (lat) {
            const int t = row & (SEQ - 1);
#pragma unroll
            for (int c = 0; c < 4; ++c) {
                const int pidx = (c < 2) ? (t >> 6) : (t & 63);
#pragma unroll
                for (int q = 0; q < 2; ++q) { const f32x2 cs = rope[pidx * 8 + ((4 * c + 2 * hi + q) & 7)]; const float t0 = qt[2][4 * c + 2 * q], t1 = qt[2][4 * c + 2 * q + 1];
                    qt[2][4 * c + 2 * q] = t0 * cs.x - t1 * cs.y; qt[2][4 * c + 2 * q + 1] = t0 * cs.y + t1 * cs.x; }
            }
        }
        const float sc = 0.10206207261596577f * LOG2E;
#pragma unroll
        for (int blk = 0; blk < 3; ++blk)
#pragma unroll
            for (int s = 0; s < 2; ++s) { u32x4 w;
                w.x = pk2(qt[blk][8 * s + 0] * sc, qt[blk][8 * s + 1] * sc); w.y = pk2(qt[blk][8 * s + 2] * sc, qt[blk][8 * s + 3] * sc);
                w.z = pk2(qt[blk][8 * s + 4] * sc, qt[blk][8 * s + 5] * sc); w.w = pk2(qt[blk][8 * s + 6] * sc, qt[blk][8 * s + 7] * sc);
                qf[blk][s] = __builtin_bit_cast(bf16x8, w); }
    }
    LAS unsigned char* L = F.lds;
    const int kd0 = (F.tid / 12) * AT_KP + (F.tid % 12) * 16, kd1 = ((512 + F.tid) / 12) * AT_KP + ((512 + F.tid) % 12) * 16, vd = AT_KB + vdv * AT_VP + vpart * 16;
    *(LAS u32x4*)(L + kd0) = kr0; if (F.tid < 256) *(LAS u32x4*)(L + kd1) = kr1; *(LAS u32x4*)(L + vd) = vr;
    __syncthreads();
    f32x16 oT[2];
#pragma unroll
    for (int d = 0; d < 2; ++d)
#pragma unroll
        for (int i = 0; i < 16; ++i) oT[d][i] = 0.f;
    float mrun = -3.0e38f, lrun = 0.f;
    const int kro = l31 * AT_KP + hi * 16, vro = AT_KB + l31 * AT_VP + hi * 16;
    for (int t = 0; t < nkt; ++t) {
        const bool more = (t + 1 < nkt);
        if (more) {
            const char* kg = (const char*)Kg + (size_t)(t + 1) * 64 * 192;
            kr0 = *(const u32x4*)(kg + (size_t)F.tid * 16);
            if (F.tid < 256) kr1 = *(const u32x4*)(kg + (size_t)(512 + F.tid) * 16);
            vr = *(const u32x4*)(Vg + (size_t)vdv * KPOS + (t + 1) * 64 + vpart * 8);
        }
        const LAS unsigned char* Lb = L + (t & 1) * AT_BUF;
        f32x16 sT[2];
#pragma unroll
        for (int kb = 0; kb < 2; ++kb) {
            f32x16 acc;
#pragma unroll
            for (int i = 0; i < 16; ++i) acc[i] = 0.f;
#pragma unroll
            for (int blk = 0; blk < 3; ++blk)
#pragma unroll
                for (int s = 0; s < 2; ++s) { const bf16x8 a = *(const LAS bf16x8*)(Lb + kro + kb * 32 * AT_KP + (32 * blk + 16 * s) * 2);
                    acc = __builtin_amdgcn_mfma_f32_32x32x16_bf16(a, qf[blk][s], acc, 0, 0, 0); }
            sT[kb] = acc;
        }
        float mx = sT[0][0];
#pragma unroll
        for (int kb = 0; kb < 2; ++kb)
#pragma unroll
            for (int i = 0; i < 16; ++i) mx = fmaxf(mx, sT[kb][i]);
        mx = fmaxf(mx, __shfl_xor(mx, 32));
        const float mnew = fmaxf(mrun, mx);
        const float alpha = __builtin_amdgcn_exp2f(mrun - mnew);
        mrun = mnew;
        float psum = 0.f;
        bf16x8 pf[2][2];
#pragma unroll
        for (int kb = 0; kb < 2; ++kb) {
            float p[16];
#pragma unroll
            for (int i = 0; i < 16; ++i) { p[i] = __builtin_amdgcn_exp2f(sT[kb][i] - mnew); psum += p[i]; }
#pragma unroll
            for (int s = 0; s < 2; ++s) { u32x4 w; w.x = cvt_pk_bf16(p[8 * s + 0], p[8 * s + 1]); w.y = cvt_pk_bf16(p[8 * s + 2], p[8 * s + 3]); w.z = cvt_pk_bf16(p[8 * s + 4], p[8 * s + 5]); w.w = cvt_pk_bf16(p[8 * s + 6], p[8 * s + 7]);
                pf[kb][s] = __builtin_bit_cast(bf16x8, w); }
        }
        lrun = lrun * alpha + psum;
#pragma unroll
        for (int d = 0; d < 2; ++d) oT[d] = oT[d] * alpha;
#pragma unroll
        for (int d = 0; d < 2; ++d)
#pragma unroll
            for (int kb = 0; kb < 2; ++kb)
#pragma unroll
                for (int s = 0; s < 2; ++s) { const bf16x8 a = *(const LAS bf16x8*)(Lb + vro + d * 32 * AT_VP + (32 * kb + 16 * s) * 2);
                    oT[d] = __builtin_amdgcn_mfma_f32_32x32x16_bf16(a, pf[kb][s], oT[d], 0, 0, 0); }
        if (more) {
            LAS unsigned char* Ln = L + ((t + 1) & 1) * AT_BUF;
            *(LAS u32x4*)(Ln + kd0) = kr0; if (F.tid < 256) *(LAS u32x4*)(Ln + kd1) = kr1; *(LAS u32x4*)(Ln + vd) = vr;
        }
        __syncthreads();
    }
    lrun += __shfl_xor(lrun, 32);
    const float inv = 1.0f / lrun;
    bf16* op = MIX + (size_t)row * DM + h * 64 + 4 * hi;
#pragma unroll
    for (int d = 0; d < 2; ++d)
#pragma unroll
        for (int c = 0; c < 4; ++c) *(u32x2*)(op + 32 * d + 8 * c) = (u32x2){pk2(oT[d][4 * c] * inv, oT[d][4 * c + 1] * inv), pk2(oT[d][4 * c + 2] * inv, oT[d][4 * c + 3] * inv)};
}

__device__ __forceinline__ void mla_attn_phase(Frame& F, int pair, int rep) {
    constexpr int NLU = NB * A_HEADS * (SEQ / 256), NCU = NB * A_HEADS;
    for (;;) {
        if (F.tid == 0) F.MISC[0] = __hip_atomic_fetch_add(F.ctl + CW_ATTQ + 64 * pair + 32 * rep, 1u, RLX_AGENT);
        __syncthreads();
        const int u = (int)F.MISC[0];
        __syncthreads();
        if (u >= NLU + NCU) break;
        if (u < NLU) { const int qb = u & 15, bh = u >> 4, b = bh / A_HEADS, h = bh % A_HEADS; mla_attn_unit(F, pair, b, h, b * SEQ + qb * 256, true, 0, KPOS / 64); }
        else { const int bh = u - NLU, b = bh / A_HEADS, h = bh % A_HEADS; mla_attn_unit(F, pair, b, h, NLAT + b * CTXL, false, SEQ, CTXL / 64); }
    }
}

constexpr int NA_KP = 144, NA_CVP = 528, NA_LVP = 1168;
constexpr int NA_CK = 0, NA_CV = 256 * NA_KP, NA_L = NA_CV + 64 * NA_CVP, NA_RPB = NA_L + 576 * NA_KP, NA_END = NA_RPB + 15 * 31 * 4;
static_assert(NA_L == 70656 && 64 * NA_LVP <= 576 * NA_KP && NA_END <= LDSCTL_OFF, "NA LDS map");

struct NaPref { u32x4 r[9]; };
__device__ __forceinline__ void na_load_k(NaPref& p, const bf16* KN, int rowbase, int h, int tid) {
    const char* gb = (const char*)(KN + (size_t)rowbase * DM + h * 64); const unsigned lo = (unsigned)(tid >> 3) * 2048u + (unsigned)(tid & 7) * 16u;
#pragma unroll
    for (int i = 0; i < 9; ++i) p.r[i] = *(const u32x4*)(gb + (size_t)i * 131072 + lo);
}
__device__ __forceinline__ void na_store_k(const NaPref& p, LAS unsigned char* L, int tid) {
    LAS unsigned char* d = L + NA_L + (tid >> 3) * NA_KP + (tid & 7) * 16;
#pragma unroll
    for (int i = 0; i < 9; ++i) *(LAS u32x4*)(d + i * 64 * NA_KP) = p.r[i];
}
__device__ __forceinline__ void na_load_v(NaPref& p, const bf16* Vt, int pos0, int tid) {
    const char* gb = (const char*)(Vt + pos0); const unsigned lo = (unsigned)(tid >> 3) * (unsigned)(KPOS * 2) + (unsigned)(tid & 7) * 16u;
#pragma unroll
    for (int i = 0; i < 9; ++i) p.r[i] = *(const u32x4*)(gb + i * 128 + lo);
}
__device__ __forceinline__ void na_store_v(const NaPref& p, LAS unsigned char* L, int tid) {
    LAS unsigned char* d = L + NA_L + (tid >> 3) * NA_LVP + (tid & 7) * 16;
#pragma unroll
    for (int i = 0; i < 9; ++i) *(LAS u32x4*)(d + i * 128) = p.r[i];
}
__device__ __forceinline__ void na_stage_ctx(Frame& F, int b, int h) {
    const char* kb = (const char*)((const bf16*)(F.WS() + WS_KN) + (size_t)(NLAT + b * CTXL) * DM + h * 64);
    const char* vb = (const char*)((const bf16*)(F.WS() + WS_VTN) + (size_t)(b * C_HEADS + h) * 64 * KPOS + SEQ);
    const unsigned klo = (unsigned)(F.tid >> 3) * 2048u + (unsigned)(F.tid & 7) * 16u, vlo = (unsigned)(F.tid >> 3) * (unsigned)(KPOS * 2) + (unsigned)(F.tid & 7) * 16u;
    u32x4 a[4], v[4];
#pragma unroll
    for (int i = 0; i < 4; ++i) a[i] = *(const u32x4*)(kb + (size_t)i * 131072 + klo);
#pragma unroll
    for (int i = 0; i < 4; ++i) v[i] = *(const u32x4*)(vb + i * 128 + vlo);
    LAS unsigned char* kd = F.lds + NA_CK + (F.tid >> 3) * NA_KP + (F.tid & 7) * 16;
    LAS unsigned char* vd = F.lds + NA_CV + (F.tid >> 3) * NA_CVP + (F.tid & 7) * 16;
#pragma unroll
    for (int i = 0; i < 4; ++i) *(LAS u32x4*)(kd + i * 64 * NA_KP) = a[i];
#pragma unroll
    for (int i = 0; i < 4; ++i) *(LAS u32x4*)(vd + i * 128) = v[i];
}
__device__ __forceinline__ float na_scores(Frame& F, bf16x8 (&pf)[16], float& f1, const bf16x8 (&qf)[2], const int (&dco)[8], const bool (&okm)[8], bool lat, int qr, int c0, int kr0, int rs, int ks) {
    const int lane = F.lane, l15 = lane & 15, g = lane >> 4;
    const LAS float* rpbs = (const LAS float*)(F.lds + NA_RPB);
    float m1 = -3.0e38f, l1 = 0.f;
    if (lat) {
        f32x4 sc[16];
#pragma unroll
        for (int t = 0; t < 16; ++t) {
            const LAS unsigned char* kp = F.lds + NA_L + (((rs - kr0) + (t >> 1)) * 64 + ks + 16 * (t & 1) + l15) * NA_KP + g * 16;
            f32x4 acc = (f32x4){0.f, 0.f, 0.f, 0.f};
#pragma unroll
            for (int s = 0; s < 2; ++s) { const bf16x8 a = *(const LAS bf16x8*)(kp + s * 64); acc = __builtin_amdgcn_mfma_f32_16x16x32_bf16(a, qf[s], acc, 0, 0, 0); }
            const LAS float* brow = rpbs + (rs + (t >> 1) - qr + 7) * 31;
#pragma unroll
            for (int e = 0; e < 4; ++e) { const float bias = brow[dco[4 * (t & 1) + e]]; acc[e] = okm[4 * (t & 1) + e] ? acc[e] + bias : -1.0e30f; }
            sc[t] = acc;
            if ((t & 3) == 3) asm volatile("" ::: "memory");
        }
#pragma unroll
        for (int t = 0; t < 16; ++t)
#pragma unroll
            for (int e = 0; e < 4; ++e) m1 = fmaxf(m1, sc[t][e]);
        m1 = fmaxf(m1, __shfl_xor(m1, 16)); m1 = fmaxf(m1, __shfl_xor(m1, 32));
#pragma unroll
        for (int u = 0; u < 8; ++u) { float p[8];
#pragma unroll
            for (int e = 0; e < 4; ++e) { p[e] = __builtin_amdgcn_exp2f(sc[2 * u][e] - m1); p[4 + e] = __builtin_amdgcn_exp2f(sc[2 * u + 1][e] - m1); }
#pragma unroll
            for (int e = 0; e < 8; ++e) l1 += p[e];
            u32x4 w; w.x = cvt_pk_bf16(p[0], p[1]); w.y = cvt_pk_bf16(p[2], p[3]); w.z = cvt_pk_bf16(p[4], p[5]); w.w = cvt_pk_bf16(p[6], p[7]);
            pf[u] = __builtin_bit_cast(bf16x8, w); }
    } else {
#pragma unroll
        for (int u = 0; u < 8; ++u) pf[u] = (bf16x8){0, 0, 0, 0, 0, 0, 0, 0};
    }
    float m = m1, l2 = 0.f;
    {
        f32x4 sc[16];
#pragma unroll
        for (int t = 0; t < 16; ++t) {
            const LAS unsigned char* kp = F.lds + NA_CK + (16 * t + l15) * NA_KP + g * 16;
            f32x4 acc = (f32x4){0.f, 0.f, 0.f, 0.f};
#pragma unroll
            for (int s = 0; s < 2; ++s) { const bf16x8 a = *(const LAS bf16x8*)(kp + s * 64); acc = __builtin_amdgcn_mfma_f32_16x16x32_bf16(a, qf[s], acc, 0, 0, 0); }
            sc[t] = acc;
            if ((t & 3) == 3) asm volatile("" ::: "memory");
        }
        float m2 = -3.0e38f;
#pragma unroll
        for (int t = 0; t < 16; ++t)
#pragma unroll
            for (int e = 0; e < 4; ++e) m2 = fmaxf(m2, sc[t][e]);
        m2 = fmaxf(m2, __shfl_xor(m2, 16)); m2 = fmaxf(m2, __shfl_xor(m2, 32));
        m = fmaxf(m1, m2);
#pragma unroll
        for (int u = 0; u < 8; ++u) { float p[8];
#pragma unroll
            for (int e = 0; e < 4; ++e) { p[e] = __builtin_amdgcn_exp2f(sc[2 * u][e] - m); p[4 + e] = __builtin_amdgcn_exp2f(sc[2 * u + 1][e] - m); }
#pragma unroll
            for (int e = 0; e < 8; ++e) l2 += p[e];
            u32x4 w; w.x = cvt_pk_bf16(p[0], p[1]); w.y = cvt_pk_bf16(p[2], p[3]); w.z = cvt_pk_bf16(p[4], p[5]); w.w = cvt_pk_bf16(p[6], p[7]);
            pf[8 + u] = __builtin_bit_cast(bf16x8, w); }
    }
    f1 = __builtin_amdgcn_exp2f(m1 - m);
    float lsum = l1 * f1 + l2;
    lsum += __shfl_xor(lsum, 16); lsum += __shfl_xor(lsum, 32);
    return 1.0f / lsum;
}
__device__ __forceinline__ void na_pv(Frame& F, const bf16x8 (&pf)[16], float f1, float inv, bool lat, int qrow, int h, int kr0, int rs, int ks) {
    const int lane = F.lane, l15 = lane & 15, g = lane >> 4;
    bf16* MIX = (bf16*)(F.WS() + WS_ACT);
    bf16* op = MIX + (size_t)qrow * DM + h * 64 + 4 * g;
#pragma unroll
    for (int dvt = 0; dvt < 4; ++dvt) {
        f32x4 acc = (f32x4){0.f, 0.f, 0.f, 0.f};
        const int dv = 16 * dvt + l15;
        if (lat) {
#pragma unroll
            for (int u = 0; u < 8; ++u) {
                const LAS unsigned char* vp = F.lds + NA_L + dv * NA_LVP + (((rs - kr0) + u) * 64 + ks + 4 * g) * 2;
                const u32x2 lo = *(const LAS u32x2*)(vp), hi2 = *(const LAS u32x2*)(vp + 32);
                const u32x4 w = (u32x4){lo.x, lo.y, hi2.x, hi2.y};
                acc = __builtin_amdgcn_mfma_f32_16x16x32_bf16(__builtin_bit_cast(bf16x8, w), pf[u], acc, 0, 0, 0);
                if ((u & 3) == 3) asm volatile("" ::: "memory");
            }
            acc = acc * f1;
        }
#pragma unroll
        for (int u = 8; u < 16; ++u) {
            const LAS unsigned char* vp = F.lds + NA_CV + dv * NA_CVP + (32 * (u - 8) + 4 * g) * 2;
            const u32x2 lo = *(const LAS u32x2*)(vp), hi2 = *(const LAS u32x2*)(vp + 32);
            const u32x4 w = (u32x4){lo.x, lo.y, hi2.x, hi2.y};
            acc = __builtin_amdgcn_mfma_f32_16x16x32_bf16(__builtin_bit_cast(bf16x8, w), pf[u], acc, 0, 0, 0);
            if ((u & 3) == 3) asm volatile("" ::: "memory");
        }
        *(u32x2*)(op + 16 * dvt) = (u32x2){pk2(acc[0] * inv, acc[1] * inv), pk2(acc[2] * inv, acc[3] * inv)};
    }
}
__device__ __forceinline__ void na_phase(Frame& F, int pair) {
    const bf16* KN = (const bf16*)(F.WS() + WS_KN);
    LAS float* rpbs = (LAS float*)(F.lds + NA_RPB);
    constexpr int NGRP = NB * C_HEADS * 2;
    for (int gi = F.bid; gi < NGRP; gi += F.G) {
        const int h = gi / (NB * 2), rem = gi % (NB * 2), b = rem >> 1, half = rem & 1;
        const bf16* Vt = (const bf16*)(F.WS() + WS_VTN) + (size_t)(b * C_HEADS + h) * 64 * KPOS;
        __syncthreads();
        na_stage_ctx(F, b, h);
        { const float* rp = G(F.in->c_rpb) + ((size_t)pair * C_HEADS + h) * 15 * 31; for (int i = F.tid; i < 15 * 31; i += NWAVES * 64) rpbs[i] = rp[i] * LOG2E; }
        NaPref pk, pv;
        int dco[8]; bool okm[8];
        { const int c0 = 16 * (F.wave & 3), ks = min(max(c0 - 8, 0), 32), cq = c0 + (F.lane & 15), cs = min(max(cq - 8, 0), 48);
#pragma unroll
          for (int k = 0; k < 8; ++k) { const int kc = ks + 16 * (k >> 2) + 4 * (F.lane >> 4) + (k & 3); okm[k] = (kc >= cs) && (kc < cs + 16); dco[k] = min(max(kc - cq + 15, 0), 30); } }
        { const int r0 = 2 * (16 * half), kr0 = min(max(r0 - 4, 0), 55); na_load_k(pk, KN, b * SEQ + kr0 * 64, h, F.tid); }
        for (int bi = 0; bi < 16; ++bi) {
            const int r0 = 2 * (16 * half + bi), kr0 = min(max(r0 - 4, 0), 55);
            const int qr = r0 + (F.wave >> 2), c0 = 16 * (F.wave & 3), rs = min(max(qr - 4, 0), 56), ks = min(max(c0 - 8, 0), 32);
            const int qrow = b * SEQ + qr * 64 + c0 + (F.lane & 15);
            bf16x8 qf[2];
#pragma unroll
            for (int s = 0; s < 2; ++s) qf[s] = *(const bf16x8*)((const bf16*)(F.WS() + WS_QN) + (size_t)qrow * DM + h * 64 + 32 * s + 8 * (F.lane >> 4));
            na_store_k(pk, F.lds, F.tid);
            __syncthreads();
            na_load_v(pv, Vt, kr0 * 64, F.tid);
            bf16x8 pf[16];
            float f1; const float inv = na_scores(F, pf, f1, qf, dco, okm, true, qr, c0, kr0, rs, ks);
            __syncthreads();
            na_store_v(pv, F.lds, F.tid);
            __syncthreads();
            if (bi + 1 < 16) { const int r1 = r0 + 2, kr1 = min(max(r1 - 4, 0), 55); na_load_k(pk, KN, b * SEQ + kr1 * 64, h, F.tid); }
            na_pv(F, pf, f1, inv, true, qrow, h, kr0, rs, ks);
            __syncthreads();
        }
    }
    constexpr int NCU = NB * C_HEADS * 2;
    for (int u = F.bid; u < NCU; u += F.G) {
        const int h = u / (NB * 2), rem = u % (NB * 2), b = rem >> 1, ch = rem & 1;
        __syncthreads();
        na_stage_ctx(F, b, h);
        __syncthreads();
        const int qrow = NLAT + b * CTXL + ch * 128 + 16 * F.wave + (F.lane & 15);
        bf16x8 pf[16]; bf16x8 qf[2];
#pragma unroll
        for (int s = 0; s < 2; ++s) qf[s] = *(const bf16x8*)((const bf16*)(F.WS() + WS_QN) + (size_t)qrow * DM + h * 64 + 32 * s + 8 * (F.lane >> 4));
        const int dco0[8] = {0, 0, 0, 0, 0, 0, 0, 0}; const bool okm0[8] = {false, false, false, false, false, false, false, false};
        float f1; const float inv = na_scores(F, pf, f1, qf, dco0, okm0, false, 0, 0, 0, 0, 0);
        na_pv(F, pf, f1, inv, false, qrow, h, 0, 0, 0);
    }
    __syncthreads();
}

constexpr int PH_PER_PAIR = 16, N_PHASES = 2 * PH_PER_PAIR + 1;
struct Args { Inputs in; float* out; unsigned char* ws; int ph_lo, ph_hi; };
static_assert(sizeof(Args) == 27 * 8 + 8 + 8 + 8, "Args has no padding bytes");

__global__ void __launch_bounds__(NWAVES * 64, 2) dit_fwd(Args args) {
    extern __shared__ __attribute__((aligned(16))) unsigned char lds_raw[];
    Frame F;
    F.lds = (LAS unsigned char*)lds_raw;
    F.MISC = (volatile LAS unsigned*)(F.lds + MISC_OFF);
    F.tid = threadIdx.x; F.lane = F.tid & 63; F.wave = __builtin_amdgcn_readfirstlane(F.tid >> 6);
    F.G = gridDim.x; F.bid = blockIdx.x;
    F.ws_ = (GAS unsigned char*)args.ws; F.ctl = (gu32*)(args.ws + WS_CTL); F.out_ = (GAS float*)args.out; F.hc_ = (GAS float*)(args.ws + WS_HC); F.in = (const CAS Inputs*)__builtin_amdgcn_kernarg_segment_ptr();
    for (int u = F.tid; u < (LDS_BYTES - LDSCTL_OFF) / 4; u += NWAVES * 64) ((LAS unsigned*)(F.lds + LDSCTL_OFF))[u] = 0u;
    __syncthreads();
    const int lo = args.ph_lo, hi = args.ph_hi;
    const bool use_bar = (hi - lo) > 1;
    XcdBarrier bar; bar.bar = (GAS unsigned*)(F.ctl + CW_BAR); bar.x = 0; bar.st = nullptr;
    if (use_bar) bar = xcd_barrier_post((GAS unsigned*)(F.ctl + CW_BAR), F.MISC + 8);
#ifndef ONLYP
#define PH_EN(c) true
#else
#define PH_EN(c) ((c) == ONLYP)
#endif
#define INR(k) (lo <= (k) && (k) < hi)
#define PROBE_MASK 0
#define NREP(c) (((PROBE_MASK) >> (c)) & 1 ? 2 : 1)
#define FRESH() do { asm volatile("" : "+s"(F.ws_), "+s"(F.out_), "+s"(F.hc_), "+s"(F.ctl), "+s"(F.in), "+s"(F.G), "+s"(F.bid), "+s"(F.wave)); asm volatile("" : "+v"(F.tid)); F.lane = F.tid & 63; W = F.WS() + WS_W; MODB = (const float*)(F.WS() + WS_MOD); ACT = (bf16*)(F.WS() + WS_ACT); } while (0)
#define IN(k) (PH_EN((k) - P) && INR(k))
#define SEAM(k) do { if (INR(k) && INR((k) + 1)) { for (int rb = 0; rb < ((PROBE_MASK >> 20) & 1 ? 2 : 1); ++rb) { asm volatile("" : "+s"(bar.bar), "+s"(bar.x)); xcd_barrier(bar); } } } while (0)
    unsigned char* W; const float* MODB; bf16* ACT;
    volatile LAS int* MOE = (volatile LAS int*)(F.lds + MOE_LDS_OFF);
    LAS unsigned char* ring = F.lds + RING_OFF;

    for (int j = 0; j < 2; ++j) {
        const int P = j * PH_PER_PAIR, le = 2 * j, lod = 2 * j + 1;
        if (IN(P + 0)) { for (int rep = 0; rep < NREP(0); ++rep) { FRESH(); prep_phase(F, j); } } SEAM(P + 0);
        if (IN(P + 1)) { FRESH(); norm_phase(F, NormArgs{le, 0, j == 0, j > 0 ? j - 1 : -1, -1, 0}); } SEAM(P + 1);
        if (IN(P + 2)) { for (int rep = 0; rep < NREP(2); ++rep) { FRESH();
            SchedStatic S{ACT, 1024, (const bf16*)(W + WO_WIN_E), 1024, NTOK / 256, 4, F.G, F.bid};
            EpiWin E{(bf16*)(F.WS() + WS_PX), (bf16*)(F.WS() + WS_GT), (bf16*)(F.WS() + WS_GTC)};
            pg8::gemm_phase<EpiWin, SchedStatic>(ring, 1024, S, E, F.tid);
        } } SEAM(P + 2);
        if (IN(P + 3)) { for (int rep = 0; rep < NREP(3); ++rep) { FRESH();
            SchedStatic S{(const bf16*)(F.WS() + WS_PX) + 256, 512, (const bf16*)(W + WO_WUKV), 256, NTOK / 256, 6, F.G, F.bid};
            EpiKV E{(const bf16*)(F.WS() + WS_PX), (bf16*)(F.WS() + WS_K), (bf16*)(F.WS() + WS_VT), G(F.in->a_g_k) + j * 96, (const f32x2*)(F.WS() + WS_ROPE)};
            pg8::gemm_phase<EpiKV, SchedStatic>(ring, 256, S, E, F.tid);
        } } SEAM(P + 3);
        if (IN(P + 4)) { for (int rep = 0; rep < NREP(4); ++rep) { FRESH();
            {
                const bool latf = F.bid < 128; const int have = F.bid < 136;
                SchedOne S{latf ? (const bf16*)(F.WS() + WS_DFT) : (const bf16*)(F.WS() + WS_DFTC), latf ? 8192 : 512, latf ? (const bf16*)(F.WS() + WS_GT) : (const bf16*)(F.WS() + WS_GTC), latf ? 8192 : 512,
                           latf ? (F.bid >> 3) : 0, latf ? (F.bid & 7) : (F.bid - 128), have};
                EpiBf16 E{ACT, 1024, latf ? 1 : 2};
                pg8::gemm_phase<EpiBf16, SchedOne>(ring, S.K, S, E, F.tid);
            }
            __syncthreads();
            mla_attn_phase(F, j, rep);
        } } SEAM(P + 4);
        if (IN(P + 5)) { for (int rep = 0; rep < NREP(5); ++rep) { FRESH();
            SchedStatic S{ACT, 1024, (const bf16*)(W + WO_WOUT_E), 1024, NTOK / 256, 4, F.G, F.bid};
            EpiResid E{F.OUT(), F.HC(), MODB + (size_t)le * 9 * 6144, 2, rep + 1 < NREP(5)};
            pg8::gemm_phase<EpiResid, SchedStatic>(ring, 1024, S, E, F.tid);
        } } SEAM(P + 5);
        if (IN(P + 6)) { for (int rep = 0; rep < NREP(6); ++rep) { FRESH(); norm_phase(F, NormArgs{le, 1, 0, -1, -1, 0}); } } SEAM(P + 6);
        if (IN(P + 7)) { for (int rep = 0; rep < NREP(7); ++rep) { FRESH();
            SchedStatic S{ACT, 1024, (const bf16*)(W + WO_WGU_E), 1024, NTOK / 256, 2 * DFF / 256, F.G, F.bid};
            EpiSwiglu E{(bf16*)(F.WS() + WS_HMID), DFF};
            pg8::gemm_phase<EpiSwiglu, SchedStatic>(ring, 1024, S, E, F.tid);
        } } SEAM(P + 7);
        if (IN(P + 8)) { for (int rep = 0; rep < NREP(8); ++rep) { FRESH();
            SchedStatic S{(const bf16*)(F.WS() + WS_HMID), DFF, (const bf16*)(W + WO_WDN_E), DFF, NTOK / 256, 4, F.G, F.bid};
            EpiResid E{F.OUT(), F.HC(), MODB + (size_t)le * 9 * 6144, 5, rep + 1 < NREP(8)};
            pg8::gemm_phase<EpiResid, SchedStatic>(ring, DFF, S, E, F.tid);
        } } SEAM(P + 8);
        if (IN(P + 9)) { for (int rep = 0; rep < NREP(9); ++rep) { FRESH(); norm_phase(F, NormArgs{lod, 0, 0, -1, -1, 0}); } } SEAM(P + 9);
        if (IN(P + 10)) { for (int rep = 0; rep < NREP(10); ++rep) { FRESH();
            SchedStatic S{ACT, 1024, (const bf16*)(W + WO_WIN_O), 1024, NTOK / 256, 12, F.G, F.bid};
            EpiNAin E{(bf16*)(F.WS() + WS_QN), (bf16*)(F.WS() + WS_KN), (bf16*)(F.WS() + WS_VTN), G(F.in->c_g_q) + j * 64, G(F.in->c_g_k) + j * 64};
            pg8::gemm_phase<EpiNAin, SchedStatic>(ring, 1024, S, E, F.tid);
        } } SEAM(P + 10);
        if (IN(P + 11)) { for (int rep = 0; rep < NREP(11); ++rep) { FRESH(); na_phase(F, j); } } SEAM(P + 11);
        if (IN(P + 12)) { for (int rep = 0; rep < NREP(12); ++rep) { FRESH();
            SchedStatic S{ACT, 1024, (const bf16*)(W + WO_WOUT_O), 1024, NTOK / 256, 4, F.G, F.bid};
            EpiResid E{F.OUT(), F.HC(), MODB + (size_t)lod * 9 * 6144, 2, rep + 1 < NREP(12)};
            pg8::gemm_phase<EpiResid, SchedStatic>(ring, 1024, S, E, F.tid);
        } } SEAM(P + 12);
        if (IN(P + 13)) { FRESH(); norm_phase(F, NormArgs{lod, 1, 0, -1, j, 0}); } SEAM(P + 13);
        if (IN(P + 14)) { for (int rep = 0; rep < NREP(14); ++rep) { FRESH();
            moe_panels_to_lds(F, j);
            SchedMoe<true> S{ACT, 1024, (const bf16*)(W + WO_WGU_M), (size_t)2 * DFFE * 1024 * 2, 1024, 2 * DFFE / 256, F.G, F.bid, (const int*)(F.WS() + WS_LIST), MOE};
            EpiSwiglu E{(bf16*)(F.WS() + WS_HMOE), DFFE};
            pg8::gemm_phase<EpiSwiglu, SchedMoe<true>>(ring, 1024, S, E, F.tid);
        } } SEAM(P + 14);
        if (IN(P + 15)) { for (int rep = 0; rep < NREP(15); ++rep) { FRESH();
            moe_panels_to_lds(F, j);
            SchedMoe<false> S{(const bf16*)(F.WS() + WS_HMOE), DFFE, (const bf16*)(W + WO_WDN_M), (size_t)1024 * DFFE * 2, DFFE, 4, F.G, F.bid, nullptr, MOE};
            EpiBf16 E{(bf16*)(F.WS() + WS_Y), 1024, 0};
            pg8::gemm_phase<EpiBf16, SchedMoe<false>>(ring, DFFE, S, E, F.tid);
        } } SEAM(P + 15);
    }
    { const int P = 0; if (IN(2 * PH_PER_PAIR)) { FRESH(); norm_phase(F, NormArgs{3, 0, 0, 1, -1, 1}); } }
#undef IN
#undef INR
#undef SEAM
}

#if DBG

#endif

extern "C" void kernel_launch(void* const* d_in, const int* in_sizes, int n_in, void* d_out, int out_size, void* d_ws, size_t ws_size, hipStream_t stream) {
    static int grid = 0;
    if (grid == 0) {
        if (n_in != 27 || in_sizes[0] != NLAT * DM || out_size != NLAT * DM || ws_size < WS_END) {
            fprintf(stderr, "kernel_launch: built for 27 inputs, x/out of %d floats, >= %zu bytes of workspace; got n_in %d, in0 %d, out %d, ws %zu; nothing launched\n", NLAT * DM, (size_t)WS_END, n_in, n_in > 0 ? in_sizes[0] : -1, out_size, ws_size);
            grid = -1; return; }
        int dev = 0, cus = 0, per_cu = 0;
        if (hipGetDevice(&dev) != hipSuccess || hipDeviceGetAttribute(&cus, hipDeviceAttributeMultiprocessorCount, dev) != hipSuccess) { fprintf(stderr, "kernel_launch: device query failed\n"); grid = -1; return; }
        if (hipFuncSetAttribute((const void*)dit_fwd, hipFuncAttributeMaxDynamicSharedMemorySize, LDS_BYTES) != hipSuccess) { fprintf(stderr, "kernel_launch: hipFuncSetAttribute failed\n"); grid = -1; return; }
        if (hipOccupancyMaxActiveBlocksPerMultiprocessor(&per_cu, (const void*)dit_fwd, NWAVES * 64, LDS_BYTES) != hipSuccess || per_cu < 1) { fprintf(stderr, "kernel_launch: occupancy query reports %d workgroups per CU\n", per_cu); }
        (void)hipGetLastError();
        grid = cus;
    }
    if (grid < 0) return;
    if (hipMemsetAsync((char*)d_ws + WS_CTL, 0, CTL_ZERO_BYTES, stream) != hipSuccess) { fprintf(stderr, "kernel_launch: memset failed\n"); return; }
    Args a{};
    const float** ip = (const float**)(void*)&a.in;
    for (int i = 0; i < 27; ++i) ip[i] = (const float*)d_in[i];
    a.out = (float*)d_out; a.ws = (unsigned char*)d_ws;
#if DBG
    dbg_launch_all(a, grid, stream);
#else
    a.ph_lo = 0; a.ph_hi = N_PHASES;
    hipLaunchKernelGGL(dit_fwd, dim3(grid), dim3(NWAVES * 64), LDS_BYTES, stream, a);
    const hipError_t le = hipPeekAtLastError();
    if (le != hipSuccess) fprintf(stderr, "kernel_launch: launch failed: %s\n", hipGetErrorName(le));
#endif
}
```

```cpp
#include <hip/hip_runtime.h>
#include <cstdio>
#include <cstdint>

#define LAS __attribute__((address_space(3)))
#define GAS __attribute__((address_space(1)))
typedef unsigned short bf16;
typedef short bf16x8 __attribute__((ext_vector_type(8)));
typedef short bf16x4 __attribute__((ext_vector_type(4)));
typedef float f32x4 __attribute__((ext_vector_type(4)));
typedef float f32x2 __attribute__((ext_vector_type(2)));
typedef float f32x16 __attribute__((ext_vector_type(16)));
typedef unsigned u32x4 __attribute__((ext_vector_type(4)));
typedef unsigned u32x2 __attribute__((ext_vector_type(2)));

#define DBG 0

constexpr int DM = 1024, NB = 8, SEQ = 4096, CTXL = 256;
constexpr int NLAT = NB * SEQ, NCTX = NB * CTXL, NTOK = NLAT + NCTX;
constexpr int KPOS = SEQ + CTXL;
constexpr int A_HEADS = 12, A_QK = 96, A_IN_SRC = 672;
constexpr int C_HEADS = 16;
constexpr int DFF = 2816, NEXP = 8, DFFE = 1408;
constexpr int MOE_SLOTS = 2 * NTOK + NEXP * 256;
constexpr float EPS = 1e-6f;
constexpr float LOG2E = 1.4426950408889634f;

__device__ __forceinline__ unsigned f2bf(float f) { unsigned u = __builtin_bit_cast(unsigned, f); return (u + 0x7fffu + ((u >> 16) & 1u)) >> 16; }
__device__ __forceinline__ unsigned pk2(float lo, float hi) { return f2bf(lo) | (f2bf(hi) << 16); }
__device__ __forceinline__ float bf2f(unsigned short h) { return __builtin_bit_cast(float, (unsigned)h << 16); }
__device__ __forceinline__ float bflo(unsigned w) { return __builtin_bit_cast(float, w << 16); }
__device__ __forceinline__ float bfhi(unsigned w) { return __builtin_bit_cast(float, w & 0xffff0000u); }

namespace pg8 {
typedef unsigned u32x4 __attribute__((ext_vector_type(4)));
#define PG8_LAS __attribute__((address_space(3)))
constexpr int GN_LDS_OFF = 131072;
constexpr int BM = 256, BK = 64, HALF = 128, HTB = HALF * BK * 2  , STAGE_BYTES = 8 * HTB, NXCD = 8, WGM = 8;

__host__ __device__ __forceinline__ int lds_byte(int r, int c) { const int st = (r >> 4) * 2 + (c >> 5), rr = r & 15, cc = c & 31, ob = rr * 64 + cc * 2; return st * 1024 + (ob ^ (((ob >> 9) & 1) << 5)); }
__host__ __device__ __forceinline__ void stage_rc(int b, int& R, int& C) { const int st = b / 1024, sb = b % 1024, swz = sb ^ (((sb >> 9) & 1) << 5); R = (st >> 1) * 16 + swz / 64; C = (st & 1) * 32 + (swz % 64) / 2; }
__host__ __device__ __forceinline__ int perm32(int rho) { const int n = rho >> 4, i = rho & 15; return 8 * (i >> 2) + 4 * n + (i & 3); }

struct Unit { int pm, pn; };

__device__ __forceinline__ bool static_next(int i, int G, int c, int nM, int nN, Unit& u) {
    const int nwg = nM * nN;
    const long L = (long)i * G + c; if (L >= nwg) return false;
    int wgid = (int)L; { const int q = nwg / NXCD, r = nwg % NXCD, xcd = wgid % NXCD, off = wgid / NXCD; wgid = (xcd < r ? xcd * (q + 1) : r * (q + 1) + (xcd - r) * q) + off; }
    const int nig = WGM * nN, gid = wgid / nig, fm = gid * WGM, gsz = (nM - fm) < WGM ? (nM - fm) : WGM;
    u.pm = fm + ((wgid % nig) % gsz); u.pn = (wgid % nig) / gsz; return true;
}

template <class Epi, class Sched, bool ALIGN_EPI = true, bool SP2 = true>
__device__ __forceinline__ void gemm_phase(PG8_LAS unsigned char* lds, const int K, const Sched& S, const Epi& E, const int tid) {
    const int wid = __builtin_amdgcn_readfirstlane(tid >> 6), lane = tid & 63, wr = wid >> 2, wc = wid & 3, fr = lane & 15, fq = lane >> 4;
    const int nt = K / BK;
    unsigned voffB[2], voffA[2];
    const unsigned lda = (unsigned)S.lda;
#pragma unroll
    for (int i = 0; i < 2; ++i) { int R, C; stage_rc(tid * 16 + i * 8192, R, C); const int Rb = Epi::PERM ? ((R & ~31) + perm32(R & 31)) : R;
        voffB[i] = (unsigned)(Rb * K + C) * 2u; voffA[i] = ((unsigned)R * lda + (unsigned)C) * 2u; }
    const char* const Ab = (const char*)S.A;
    const size_t kstep = (size_t)(BK * 2);
    const size_t hstep = (size_t)HALF * K * 2;
    const size_t hstepA = (size_t)HALF * lda * 2;
    const unsigned ldsw = (unsigned)wid * 1024u;
    const int aoff = lds_byte(wr * 64 + fr, fq * 8), boff = lds_byte(wc * 32 + fr, fq * 8);
#define PG8_SA(b, h) (((b) * 2 + (h)) * HTB)
#define PG8_SB(b, h) ((4 + (b) * 2 + (h)) * HTB)
#define PG8_STAGE(bufoff, gbase, voff) do { _Pragma("unroll") for (int _i = 0; _i < 2; ++_i) \
        __builtin_amdgcn_global_load_lds((const unsigned*)((const char*)(gbase) + (voff)[_i]), (PG8_LAS unsigned*)(lds + (bufoff) + ldsw + _i * 8192), 16, 0, 0); } while (0)
#define PG8_LDA(dst, b, h) do { _Pragma("unroll") for (int m = 0; m < 4; ++m) _Pragma("unroll") for (int k = 0; k < 2; ++k) dst[m][k] = *(const PG8_LAS bf16x8*)(lds + PG8_SA(b, h) + aoff + m * 2048 + k * 1024); } while (0)
#define PG8_LDB(dst, b, h) do { _Pragma("unroll") for (int n = 0; n < 2; ++n) _Pragma("unroll") for (int k = 0; k < 2; ++k) dst[n][k] = *(const PG8_LAS bf16x8*)(lds + PG8_SB(b, h) + boff + n * 2048 + k * 1024); } while (0)
#define PG8_MMA(ai, bj, At, Bt) do { __builtin_amdgcn_s_setprio(1); _Pragma("unroll") for (int m = 0; m < 4; ++m) _Pragma("unroll") for (int n = 0; n < 2; ++n) _Pragma("unroll") for (int k = 0; k < 2; ++k) \
        acc[ai][bj][m][n] = __builtin_amdgcn_mfma_f32_16x16x32_bf16(Bt[n][k], At[m][k], acc[ai][bj][m][n], 0, 0, 0); __builtin_amdgcn_s_setprio(0); } while (0)
#define PG8_WAIT_V(n) asm volatile("s_waitcnt vmcnt(" #n ")" ::: "memory")
#define PG8_WAIT_L(n) asm volatile("s_waitcnt lgkmcnt(" #n ")" ::: "memory")
#define PG8_BAR __builtin_amdgcn_s_barrier()
#define PG8_SCHED __builtin_amdgcn_sched_barrier(0)
    Unit cur, nxt; int ui = 0;
    if (!S.next(0, cur)) return;
    f32x4 acc[2][2][4][2];
    bf16x8 At[4][2], B0[2][2], B1[2][2];
    constexpr bool GATHER = Sched::GATHER;
    const char* cA = Ab; const char* nA = Ab;
    unsigned ga0[2] = {0u, 0u}, ga1[2] = {0u, 0u};
    PG8_LAS u32x4* const gnslot = (PG8_LAS u32x4*)(lds + GN_LDS_OFF) + tid;
    if constexpr (GATHER) {
#pragma unroll
        for (int i = 0; i < 2; ++i) { int R, C; stage_rc(tid * 16 + i * 8192, R, C); ga0[i] = (S.a_row(cur, R) * lda + (unsigned)C) * 2u; ga1[i] = (S.a_row(cur, HALF + R) * lda + (unsigned)C) * 2u; }
    } else { cA = Ab + (size_t)S.a_row(cur, 0) * lda * 2; }
    const char* cB = S.b_base(cur);
#define PG8_STAGE_A(bufoff, h, uptr, kb, g0, g1) do { if constexpr (GATHER) { if (h) PG8_STAGE(bufoff, Ab + (kb), g1); else PG8_STAGE(bufoff, Ab + (kb), g0); } \
        else { PG8_STAGE(bufoff, (uptr) + (h) * hstepA + (kb), voffA); } } while (0)
    static_assert(SP2, "only the SP2 loop is carried here");
    PG8_STAGE(PG8_SB(0, 0), cB, voffB); PG8_STAGE(PG8_SB(0, 1), cB + hstep, voffB); PG8_STAGE_A(PG8_SA(0, 0), 0, cA, 0, ga0, ga1); PG8_STAGE_A(PG8_SA(0, 1), 1, cA, 0, ga0, ga1);
    if (wr == 1) PG8_BAR;
    PG8_WAIT_V(2); PG8_BAR;
    PG8_STAGE(PG8_SB(1, 0), cB + kstep, voffB); PG8_STAGE_A(PG8_SA(1, 0), 0, cA, kstep, ga0, ga1); PG8_STAGE(PG8_SB(1, 1), cB + hstep + kstep, voffB);
    PG8_WAIT_V(6); PG8_BAR;
    for (;;) {
        const bool has_next = S.next(ui + 1, nxt);
        const char* nB = has_next ? S.b_base(nxt) : cB;
        if constexpr (GATHER) {
            u32x4 gn = (u32x4){ga0[0], ga0[1], ga1[0], ga1[1]};
            if (has_next) { int R0, C0, R1, C1; stage_rc(tid * 16, R0, C0); stage_rc(tid * 16 + 8192, R1, C1);
                gn.x = (S.a_row(nxt, R0) * lda + (unsigned)C0) * 2u; gn.y = (S.a_row(nxt, R1) * lda + (unsigned)C1) * 2u;
                gn.z = (S.a_row(nxt, HALF + R0) * lda + (unsigned)C0) * 2u; gn.w = (S.a_row(nxt, HALF + R1) * lda + (unsigned)C1) * 2u; }
            *gnslot = gn;
        } else { nA = has_next ? Ab + (size_t)S.a_row(nxt, 0) * lda * 2 : cA; }
#pragma unroll
        for (int a = 0; a < 2; ++a)
#pragma unroll
            for (int b = 0; b < 2; ++b)
#pragma unroll
                for (int m = 0; m < 4; ++m)
#pragma unroll
                    for (int n = 0; n < 2; ++n) acc[a][b][m][n] = (f32x4){0.f, 0.f, 0.f, 0.f};
#pragma nounroll
        for (int t = 0; t < nt; t += 2) {
            const bool last = (t == nt - 2);
            const size_t k1 = (size_t)(t + 1) * kstep, k2 = last ? 0 : (size_t)(t + 2) * kstep, k3 = k2 + kstep;
            const char* u2 = last ? nA : cA;
            const char* b2 = last ? nB : cB + (size_t)(t + 2) * kstep; const char* b3 = b2 + kstep;
            unsigned o20[2] = {0u, 0u}, o21[2] = {0u, 0u};
            if constexpr (GATHER) {
                if (last) { const u32x4 gn = *gnslot; o20[0] = gn.x; o20[1] = gn.y; o21[0] = gn.z; o21[1] = gn.w; }
                else { o20[0] = ga0[0]; o20[1] = ga0[1]; o21[0] = ga1[0]; o21[1] = ga1[1]; }
            }
            PG8_LDB(B0, 0, 0); PG8_LDB(B1, 0, 1); PG8_SCHED; PG8_LDA(At, 0, 0); PG8_STAGE_A(PG8_SA(1, 1), 1, cA, k1, ga0, ga1);
            PG8_WAIT_V(8); PG8_WAIT_L(0); PG8_BAR; PG8_MMA(0, 0, At, B0); PG8_MMA(0, 1, At, B1); PG8_BAR; PG8_SCHED;
            PG8_LDA(At, 0, 1); PG8_STAGE(PG8_SB(0, 0), b2, voffB); PG8_STAGE(PG8_SB(0, 1), b2 + hstep, voffB); PG8_STAGE_A(PG8_SA(0, 0), 0, u2, k2, o20, o21);
            PG8_WAIT_V(8); PG8_WAIT_L(0); PG8_BAR; PG8_MMA(1, 0, At, B0); PG8_MMA(1, 1, At, B1); PG8_BAR; PG8_SCHED;
            PG8_LDB(B0, 1, 0); PG8_LDB(B1, 1, 1); PG8_SCHED; PG8_LDA(At, 1, 0); PG8_STAGE_A(PG8_SA(0, 1), 1, u2, k2, o20, o21);
            PG8_WAIT_V(8); PG8_WAIT_L(0); PG8_BAR; PG8_MMA(0, 0, At, B0); PG8_MMA(0, 1, At, B1); PG8_BAR; PG8_SCHED;
            PG8_LDA(At, 1, 1); PG8_STAGE(PG8_SB(1, 0), b3, voffB); PG8_STAGE(PG8_SB(1, 1), b3 + hstep, voffB); PG8_STAGE_A(PG8_SA(1, 0), 0, u2, k3, o20, o21);
            PG8_WAIT_V(8); PG8_WAIT_L(0); PG8_BAR; PG8_MMA(1, 0, At, B0); PG8_MMA(1, 1, At, B1); PG8_BAR; PG8_SCHED;
        }
        if constexpr (ALIGN_EPI) { if (wr == 0) PG8_BAR; }
        { int fr_ = fr, fq_ = fq, wr_ = wr, wc_ = wc; asm volatile("" : "+v"(fr_), "+v"(fq_), "+s"(wr_), "+s"(wc_));
          E(acc, cur, wr_, wc_, fr_, fq_); }
        if (!has_next) break;
        cur = nxt; cB = nB; cA = nA; ++ui;
        if constexpr (GATHER) { const u32x4 gn = *gnslot; ga0[0] = gn.x; ga0[1] = gn.y; ga1[0] = gn.z; ga1[1] = gn.w; }
        if constexpr (ALIGN_EPI) { if (wr == 1) PG8_BAR; }
    }
    PG8_WAIT_V(0);
    if constexpr (!ALIGN_EPI) { if (wr == 0) PG8_BAR; }
    PG8_BAR;
#undef PG8_SA
#undef PG8_SB
#undef PG8_STAGE
#undef PG8_STAGE_A
#undef PG8_LDA
#undef PG8_LDB
#undef PG8_MMA
#undef PG8_WAIT_V
#undef PG8_WAIT_L
#undef PG8_BAR
#undef PG8_SCHED
}
}

constexpr size_t MiB = 1u << 20;
constexpr size_t WS_CTL = 0, CTL_ZERO_BYTES = 1 * MiB;
constexpr size_t WS_MOD = 1 * MiB;
constexpr size_t WS_ROPE = 2 * MiB;
constexpr size_t WS_ROUTE = 3 * MiB;
constexpr size_t WS_LIST = 4 * MiB;
constexpr size_t WS_SNAP = 6 * MiB;
constexpr size_t WS_HC = 8 * MiB;
constexpr size_t WS_W = 16 * MiB;
constexpr size_t WS_DFT = 114 * MiB;
constexpr size_t WS_DFTC = WS_DFT + 64 * MiB;
constexpr size_t WS_SCR = 180 * MiB;
constexpr size_t WS_ACT = WS_SCR;
constexpr size_t WS_PX = WS_SCR + 68 * MiB;
constexpr size_t WS_GT = WS_SCR + 102 * MiB;
constexpr size_t WS_GTC = WS_SCR + 134 * MiB;
constexpr size_t WS_K = WS_SCR + 136 * MiB;
constexpr size_t WS_VT = WS_SCR + 213 * MiB;
constexpr size_t WS_HMID = WS_SCR + 68 * MiB;
constexpr size_t WS_QN = WS_SCR + 68 * MiB;
constexpr size_t WS_KN = WS_SCR + 136 * MiB;
constexpr size_t WS_VTN = WS_SCR + 204 * MiB;
constexpr size_t WS_HMOE = WS_SCR + 68 * MiB;
constexpr size_t WS_Y = WS_SCR + 261 * MiB;
constexpr size_t WS_END = WS_SCR + 401 * MiB;
static_assert((size_t)NTOK * 1024 * 2 <= 68 * MiB && (size_t)NTOK * 512 * 2 <= 34 * MiB && (size_t)NB * A_HEADS * KPOS * 96 * 2 <= 77 * MiB && (size_t)NB * A_HEADS * 64 * KPOS * 2 <= 51 * MiB, "even map");
static_assert((size_t)NTOK * DFF * 2 <= 196 * MiB && (size_t)NB * C_HEADS * 64 * KPOS * 2 <= 68 * MiB + 4 * MiB && (size_t)MOE_SLOTS * DFFE * 2 <= 193 * MiB && (size_t)MOE_SLOTS * 1024 * 2 <= 140 * MiB, "odd map");
constexpr size_t WO_WIN_E = 0, WO_WUKV = 2 * MiB, WO_WUQ = 3 * MiB, WO_WOUT_E = 4 * MiB, WO_WGU_E = 6 * MiB, WO_WDN_E = 17 * MiB;
constexpr size_t WO_WIN_O = 23 * MiB, WO_WOUT_O = 29 * MiB, WO_WGU_M = 31 * MiB, WO_WDN_M = 75 * MiB;
constexpr int CW_BAR = 4096;
constexpr int CW_MOECNT = 8192;
constexpr int CW_ATTQ = 8192 + 256;
constexpr int CW_CHK = 16384;

constexpr int RING_OFF = 0, RING_BYTES = 131072;
constexpr int LDS_BYTES = 163840;
constexpr int LDSCTL_OFF = LDS_BYTES - 1024, MISC_OFF = LDSCTL_OFF + 320;
constexpr int MOE_LDS_OFF = MISC_OFF + 128;
static_assert(MOE_LDS_OFF + 128 <= LDS_BYTES && pg8::GN_LDS_OFF == RING_BYTES && pg8::GN_LDS_OFF + 512 * 16 <= LDSCTL_OFF, "LDS map");
constexpr int NWAVES = 8;

#define CAS __attribute__((address_space(4)))
typedef GAS unsigned gu32;
#define RLX_AGENT __ATOMIC_RELAXED, __HIP_MEMORY_SCOPE_AGENT
#define LDS_WAIT() asm volatile("s_waitcnt lgkmcnt(0)" ::: "memory")
#define VM_WAIT() asm volatile("s_waitcnt vmcnt(0)" ::: "memory")

#define XB_TMO      128
#define XB_XCNT(j)  (256  + 64 * (j))
#define XB_XSUB(j)  (1280 + 64 * (j))
#define XB_XGEN(j)  (2304 + 64 * (j))
#define XB_TOP      3328
#define XB_TOPGEN   3392
#define XCD_BAR_WORDS 3456
#define XB_SPIN_CAP (1u << 18)

__device__ __forceinline__ unsigned xb_ld(GAS unsigned* p)              { return __hip_atomic_load(p, __ATOMIC_RELAXED, __HIP_MEMORY_SCOPE_AGENT); }
__device__ __forceinline__ unsigned xb_add(GAS unsigned* p, unsigned v) { return __hip_atomic_fetch_add(p, v, __ATOMIC_RELAXED, __HIP_MEMORY_SCOPE_AGENT); }
__device__ __forceinline__ unsigned xb_xcc_id() { return (unsigned)__builtin_amdgcn_s_getreg((3 << 11) | 20) & 0xFu; }
#define XB_SPIN(cond, bar) do { unsigned _sp = 0; while (cond) { __builtin_amdgcn_s_sleep(1); \
    if ((++_sp & 255u) == 0u) { if (xb_ld(&(bar)[XB_TMO])) break; if (_sp > XB_SPIN_CAP) { (void)xb_add(&(bar)[XB_TMO], 1u); break; } } } } while (0)

struct XcdBarrier {
    GAS unsigned* bar; unsigned x;
    volatile LAS unsigned* st;
};
__device__ __forceinline__ XcdBarrier xcd_barrier_post(GAS unsigned* bar, volatile LAS unsigned* st) {
    XcdBarrier b; b.bar = bar; b.x = xb_xcc_id(); b.st = st;
    if (threadIdx.x == 0) (void)xb_add(&bar[XB_XCNT(b.x)], 1u);
    return b;
}
__device__ __forceinline__ void xcd_barrier_complete(GAS unsigned* bar, unsigned x, unsigned& nloc, unsigned& nx) {
    const unsigned G = gridDim.x * gridDim.y * gridDim.z;
    unsigned sum, cnt, mine, sp = 0u;
    for (;;) {
        sum = 0u; cnt = 0u; mine = 0u;
#pragma unroll
        for (unsigned j = 0; j < 16; ++j) { const unsigned c = xb_ld(&bar[XB_XCNT(j)]); sum += c; cnt += (c > 0u) ? 1u : 0u; mine = (j == x) ? c : mine; }
        if (sum == G) break;
        __builtin_amdgcn_s_sleep(1);
        if ((++sp & 255u) == 0u) { if (xb_ld(&bar[XB_TMO])) break; if (sp > XB_SPIN_CAP) { (void)xb_add(&bar[XB_TMO], 1u); break; } }
    }
    nloc = mine > 0u ? mine : 1u; nx = cnt > 0u ? cnt : 1u;
}
__device__ __forceinline__ void xcd_barrier(const XcdBarrier& b) {
    asm volatile("s_waitcnt vmcnt(0)" ::: "memory");
    __syncthreads();
    if (threadIdx.x == 0) {
        GAS unsigned* bar = b.bar;
        __builtin_amdgcn_s_waitcnt(0);
        unsigned nloc = b.st[0], nx = b.st[1];
        if (nloc == 0u) { xcd_barrier_complete(bar, b.x, nloc, nx); b.st[0] = nloc; b.st[1] = nx; }
        const unsigned old = xb_add(&bar[XB_XSUB(b.x)], 1u);
        const unsigned gen = old / nloc;
        if (old + 1u == (gen + 1u) * nloc) {
            __builtin_amdgcn_fence(__ATOMIC_RELEASE, "agent");
            asm volatile("s_waitcnt vmcnt(0)" ::: "memory");
            const unsigned og = xb_add(&bar[XB_TOP], 1u);
            const unsigned tg = og / nx;
            if (og + 1u == (tg + 1u) * nx) xb_add(&bar[XB_TOPGEN], 1u);
            else XB_SPIN(xb_ld(&bar[XB_TOPGEN]) == tg, bar);
            __builtin_amdgcn_fence(__ATOMIC_ACQUIRE, "agent");
            xb_add(&bar[XB_XGEN(b.x)], 1u);
            asm volatile("s_waitcnt vmcnt(0)" ::: "memory");
        } else {
            XB_SPIN(xb_ld(&bar[XB_XGEN(b.x)]) == gen, bar);
            __builtin_amdgcn_fence(__ATOMIC_ACQUIRE, "agent");
            asm volatile("s_waitcnt vmcnt(0)" ::: "memory");
        }
    }
    __syncthreads();
}

struct Inputs {
    const float *x, *c, *ctx, *c_ctx, *w_mod, *b_mod, *norm_g;
    const float *a_w_in, *a_g_cq, *a_g_ckv, *a_w_uq, *a_w_ukv, *a_g_q, *a_g_k, *a_w_out;
    const float *f_w_gate, *f_w_up, *f_w_down;
    const float *c_w_in, *c_g_q, *c_g_k, *c_rpb, *c_w_out;
    const float *m_w_router, *m_w_gate, *m_w_up, *m_w_down;
};
template <class T> __device__ __forceinline__ T* G(T* p) { GAS T* g = (GAS T*)p; asm volatile("" : "+s"(g)); return (T*)g; }
struct Frame {
    LAS unsigned char* lds;
    volatile LAS unsigned* MISC;
    gu32* ctl;
    GAS unsigned char* ws_;
    GAS float* out_;
    GAS float* hc_;
    __device__ __forceinline__ unsigned char* WS() const { return (unsigned char*)ws_; }
    __device__ __forceinline__ float* OUT() const { return (float*)out_; }
    __device__ __forceinline__ float* HC() const { return (float*)hc_; }
    int tid, lane, wave, G, bid;
    const CAS Inputs* in;
};
__device__ __forceinline__ float* hrow(const Frame& F, int r) { return r < NLAT ? F.OUT() + (size_t)r * DM : F.HC() + (size_t)(r - NLAT) * DM; }
__device__ __forceinline__ int row_b9(int r) { return r < NLAT ? (r >> 12) : 8; }
__device__ __forceinline__ const float* modp(const Frame& F, int layer, int b9, int k) { return (const float*)(F.WS() + WS_MOD) + ((size_t)layer * 9 + b9) * 6144 + k * 1024; }

__device__ __forceinline__ float wave_sum(float v) {
#pragma unroll
    for (int o = 1; o < 64; o <<= 1) v += __shfl_xor(v, o);
    return v;
}

struct WMap { int which; int col; };
__device__ __forceinline__ WMap wmap(int mode, int n, int nsrc) {
    WMap r; r.which = 0;
    const int pn = n >> 8, ct = n & 255, bj = ct >> 7, wc = (ct >> 5) & 3, w = ct & 31;
    if (mode == 0) { r.col = n < nsrc ? n : -1; }
    else if (mode == 1) { const int head = 2 * pn + (wc >> 1), part = wc & 1; r.col = head * 128 + part * 64 + 32 * bj + w; }
    else if (mode == 2) { const int nn = (ct >> 4) & 1, fq = (ct >> 2) & 3, e = ct & 3; r.which = nn; r.col = pn * 128 + bj * 64 + wc * 16 + fq * 4 + e; }
    else { r.col = (pn * 4 + wc) * 64 + 32 * bj + w; }
    return r;
}
__device__ __forceinline__ void wconv_item(const float* W0, const float* W1, int ld, int Ksrc, int nsrc, const float* kscale, bf16* WT, int Kdst, int mode, int kb, int nb, LAS float* scr, int lane) {
    const int k0 = 64 * kb, n0 = 64 * nb, n4 = (lane & 15) * 4;
    const WMap mp = wmap(mode, n0 + n4, nsrc);
    const float* W = mp.which ? W1 : W0;
#pragma unroll 4
    for (int i = 0; i < 16; ++i) { const int kk = (lane >> 4) + 4 * i, k = k0 + kk; f32x4 v = (f32x4){0.f, 0.f, 0.f, 0.f};
        if (mp.col >= 0 && k < Ksrc) { v = *(const f32x4*)(W + (size_t)k * ld + mp.col); if (kscale) v = v * kscale[k]; }
        LAS float* d = scr + kk * 65 + n4; d[0] = v.x; d[1] = v.y; d[2] = v.z; d[3] = v.w; }
    LDS_WAIT(); asm volatile("" ::: "memory");
#pragma unroll
    for (int c = 0; c < 8; ++c) { const LAS float* s = scr + (8 * c) * 65 + lane;
        u32x4 o; o.x = pk2(s[0 * 65], s[1 * 65]); o.y = pk2(s[2 * 65], s[3 * 65]); o.z = pk2(s[4 * 65], s[5 * 65]); o.w = pk2(s[6 * 65], s[7 * 65]);
        *(GAS u32x4*)(WT + (size_t)(n0 + lane) * Kdst + k0 + 8 * c) = o; }
    LDS_WAIT(); asm volatile("" ::: "memory");
}
struct WJob { const float* W0; const float* W1; int ld, Ksrc, nsrc; const float* kscale; bf16* WT; int Kdst, Ndst, mode; };
__device__ __forceinline__ bool wjob_run(const WJob& J, int& r, LAS float* scr, int lane) {
    const int nblk = J.Ndst / 64, items = (J.Kdst / 64) * nblk;
    if (r < items) { wconv_item(J.W0, J.W1, J.ld, J.Ksrc, J.nsrc, J.kscale, J.WT, J.Kdst, J.mode, r / nblk, r % nblk, scr, lane); return true; }
    r -= items; return false;
}

__device__ __forceinline__ void prep_phase(Frame& F, int j) {
    const CAS Inputs& I = *F.in;
    unsigned char* W = F.WS() + WS_W;
    if (j == 0) {
        LAS float* sv = (LAS float*)(F.lds);
        LAS float* red = (LAS float*)(F.lds + 40960);
        for (int idx = F.tid; idx < 9 * 1024; idx += NWAVES * 64) { const int r = idx >> 10, k = idx & 1023; const float cv = r < 8 ? G(I.c)[r * 1024 + k] : G(I.c_ctx)[k]; sv[idx] = cv / (1.f + __expf(-cv)); }
        __syncthreads();
        for (int it = F.bid; it < 4 * 96; it += F.G) {
            const int layer = it / 96, chunk = it % 96, n = chunk * 64 + F.lane;
            const float* wm = G(I.w_mod) + (size_t)layer * 1024 * 6144 + n;
            float acc[9];
#pragma unroll
            for (int r = 0; r < 9; ++r) acc[r] = 0.f;
            const int kb = F.wave * 128;
#pragma unroll 4
            for (int k = 0; k < 128; ++k) { const float wv = wm[(size_t)(kb + k) * 6144];
#pragma unroll
                for (int r = 0; r < 9; ++r) acc[r] += sv[r * 1024 + kb + k] * wv; }
#pragma unroll
            for (int r = 0; r < 9; ++r) red[(F.wave * 9 + r) * 64 + F.lane] = acc[r];
            __syncthreads();
            for (int idx = F.tid; idx < 9 * 64; idx += NWAVES * 64) { const int r = idx >> 6, l = idx & 63; float s = 0.f;
#pragma unroll
                for (int w = 0; w < 8; ++w) s += red[(w * 9 + r) * 64 + l];
                const int nn = chunk * 64 + l;
                ((float*)(F.WS() + WS_MOD))[((size_t)layer * 9 + r) * 6144 + nn] = s + G(I.b_mod)[layer * 6144 + nn]; }
            __syncthreads();
        }
        if (F.bid == 0) { const int pos = F.tid >> 3, f = F.tid & 7; const float inv = powf(10000.f, -(float)f / 8.f); const float ang = (float)pos * inv;
            ((f32x2*)(F.WS() + WS_ROPE))[F.tid] = (f32x2){cosf(ang), sinf(ang)}; }
        __syncthreads();
        LAS f32x2* tab = (LAS f32x2*)(F.lds);
        for (int m = F.tid; m < 4096; m += NWAVES * 64) { float s, c; sincospif((float)m * (1.f / 2048.f), &s, &c); tab[m] = (f32x2){c, s}; }
        __syncthreads();
        bf16* DF = (bf16*)(F.WS() + WS_DFT);
        for (int q = F.bid * (NWAVES * 64) + F.tid; q < 4096 * 1024; q += F.G * NWAVES * 64) {
            const int np = q >> 10, kk0 = (q & 1023) * 8, type = kk0 >= 4096, n = kk0 & 4095; float v[8];
#pragma unroll
            for (int e = 0; e < 8; ++e) { const f32x2 t = tab[(np * (n + e)) & 4095]; v[e] = (type ? -t.y : t.x) * (1.f / 512.f); }
            u32x4 o; o.x = pk2(v[0], v[1]); o.y = pk2(v[2], v[3]); o.z = pk2(v[4], v[5]); o.w = pk2(v[6], v[7]);
            *(GAS u32x4*)(DF + (size_t)np * 8192 + kk0) = o;
        }
        bf16* DC = (bf16*)(F.WS() + WS_DFTC);
        for (int q = F.bid * (NWAVES * 64) + F.tid; q < 256 * 64; q += F.G * NWAVES * 64) {
            const int np = q >> 6, kk0 = (q & 63) * 8, type = kk0 >= 256, n = kk0 & 255; float v[8];
#pragma unroll
            for (int e = 0; e < 8; ++e) { const f32x2 t = tab[((np * (n + e)) & 255) * 16]; v[e] = (type ? -t.y : t.x) * (1.f / 128.f); }
            u32x4 o; o.x = pk2(v[0], v[1]); o.y = pk2(v[2], v[3]); o.z = pk2(v[4], v[5]); o.w = pk2(v[6], v[7]);
            *(GAS u32x4*)(DC + (size_t)np * 512 + kk0) = o;
        }
        __syncthreads();
    }
    {
        LAS float* scr = (LAS float*)(F.lds + F.wave * 16896);
        const int gw = F.bid * NWAVES + F.wave, NGW = F.G * NWAVES;
        const float* a_w_in = G(I.a_w_in) + (size_t)j * 1024 * 672;
        WJob J0{a_w_in, a_w_in, 672, 1024, 416, nullptr, (bf16*)(W + WO_WIN_E), 1024, 512, 0};
        WJob J2{G(I.a_w_ukv) + (size_t)j * 128 * 1536, nullptr, 1536, 128, 1536, G(I.a_g_ckv) + j * 128, (bf16*)(W + WO_WUKV), 256, 1536, 1};
        WJob J3{G(I.a_w_uq) + (size_t)j * 256 * 1152, nullptr, 1152, 256, 1152, G(I.a_g_cq) + j * 256, (bf16*)(W + WO_WUQ), 256, 1152, 0};
        WJob J4{G(I.a_w_out) + (size_t)j * 1024 * 1024, nullptr, 1024, 1024, 1024, nullptr, (bf16*)(W + WO_WOUT_E), 1024, 1024, 0};
        WJob J5{G(I.f_w_gate) + (size_t)j * 1024 * DFF, G(I.f_w_up) + (size_t)j * 1024 * DFF, DFF, 1024, DFF, nullptr, (bf16*)(W + WO_WGU_E), 1024, 2 * DFF, 2};
        WJob J6{G(I.f_w_down) + (size_t)j * DFF * 1024, nullptr, 1024, DFF, 1024, nullptr, (bf16*)(W + WO_WDN_E), DFF, 1024, 0};
        WJob J7{G(I.c_w_in) + (size_t)j * 1024 * 3072, nullptr, 3072, 1024, 3072, nullptr, (bf16*)(W + WO_WIN_O), 1024, 3072, 3};
        WJob J8{G(I.c_w_out) + (size_t)j * 1024 * 1024, nullptr, 1024, 1024, 1024, nullptr, (bf16*)(W + WO_WOUT_O), 1024, 1024, 0};
        constexpr int IT_GU = (1024 / 64) * (2 * DFFE / 64), IT_DN = (DFFE / 64) * (1024 / 64);
        const int fixed = 16 * 8 + 4 * 24 + 4 * 18 + 16 * 16 + 16 * 88 + 44 * 16 + 16 * 48 + 16 * 16;
        const int total = fixed + NEXP * (IT_GU + IT_DN);
        for (int it = gw; it < total; it += NGW) {
            int r = it;
            if (wjob_run(J0, r, scr, F.lane)) continue;
            if (wjob_run(J2, r, scr, F.lane)) continue;
            if (wjob_run(J3, r, scr, F.lane)) continue;
            if (wjob_run(J4, r, scr, F.lane)) continue;
            if (wjob_run(J5, r, scr, F.lane)) continue;
            if (wjob_run(J6, r, scr, F.lane)) continue;
            if (wjob_run(J7, r, scr, F.lane)) continue;
            if (wjob_run(J8, r, scr, F.lane)) continue;
            if (r < NEXP * IT_GU) { const int e = r / IT_GU, rr = r % IT_GU; const size_t eo = ((size_t)j * NEXP + e) * 1024 * DFFE;
                wconv_item(G(I.m_w_gate) + eo, G(I.m_w_up) + eo, DFFE, 1024, DFFE, nullptr, (bf16*)(W + WO_WGU_M) + (size_t)e * 2 * DFFE * 1024, 1024, 2, rr / (2 * DFFE / 64), rr % (2 * DFFE / 64), scr, F.lane); continue; }
            r -= NEXP * IT_GU;
            { const int e = r / IT_DN, rr = r % IT_DN; const size_t eo = ((size_t)j * NEXP + e) * DFFE * 1024;
                wconv_item(G(I.m_w_down) + eo, nullptr, 1024, DFFE, 1024, nullptr, (bf16*)(W + WO_WDN_M) + (size_t)e * 1024 * DFFE, DFFE, 0, rr / 16, rr % 16, scr, F.lane); }
        }
        __syncthreads();
        LAS f32x2* t64 = (LAS f32x2*)(F.lds);
        if (F.tid < 64) { float s, c; sincospif((float)F.tid * (1.f / 32.f), &s, &c); t64[F.tid] = (f32x2){c, s}; }
        __syncthreads();
        bf16* WE = (bf16*)(W + WO_WIN_E);
        for (int it = gw; it < 1024 * 4; it += NGW) {
            const int k = it >> 2, g = it & 3;
            const float f = a_w_in[(size_t)k * 672 + 416 + 64 * g + F.lane];
            float ac = 0.f, as = 0.f;
#pragma unroll 8
            for (int c = 0; c < 64; ++c) { const float fc = __shfl(f, c); const f32x2 t = t64[(c * F.lane) & 63]; ac += fc * t.x; as += fc * t.y; }
            WE[(size_t)(512 + g * 64 + F.lane) * 1024 + k] = (bf16)f2bf(ac);
            WE[(size_t)(768 + g * 64 + F.lane) * 1024 + k] = (bf16)f2bf(as);
        }
        __syncthreads();
    }
}

__device__ __forceinline__ void moe_panels_to_lds(Frame& F, int pair) {
    volatile LAS int* MOE = (volatile LAS int*)(F.lds + MOE_LDS_OFF);
    if (F.tid == 0) { int p = 0;
        for (int e = 0; e < NEXP; ++e) { const int c = (int)__hip_atomic_load(F.ctl + CW_MOECNT + 64 * pair + e, RLX_AGENT); MOE[e] = p; MOE[16 + e] = c; p += (c + 255) >> 8; }
        MOE[8] = p; }
    __syncthreads();
}
struct NormArgs { int layer, which, from_inputs, combine_pair, router_pair, final_only; };
__device__ __forceinline__ void norm_phase(Frame& F, const NormArgs a) {
    const CAS Inputs& I = *F.in;
    volatile LAS int* MOE = (volatile LAS int*)(F.lds + MOE_LDS_OFF);
    LAS float* wr = (LAS float*)(F.lds);
    volatile LAS int* lcnt = (volatile LAS int*)(F.lds + 32768);
    volatile LAS int* stash = (volatile LAS int*)(F.lds + 32768 + 256);
    if (a.combine_pair >= 0) moe_panels_to_lds(F, a.combine_pair);
    if (a.router_pair >= 0) {
        const float* wsrc = G(I.m_w_router) + (size_t)a.router_pair * 1024 * NEXP;
        for (int idx = F.tid; idx < 1024 * NEXP; idx += NWAVES * 64) wr[idx] = wsrc[idx];
        if (F.tid < 16) lcnt[F.tid] = 0;
        __syncthreads();
    }
    const int* te = (const int*)(F.WS() + WS_ROUTE); const int* tr = te + 2 * NTOK; const float* tg = (const float*)(tr + 2 * NTOK);
    const bf16* Y = (const bf16*)(F.WS() + WS_Y);
    bf16* XN = (bf16*)(F.WS() + WS_ACT);
    const int nrows = a.final_only ? NLAT : NTOK;
    const int nk = (nrows - F.bid + F.G - 1) / F.G;
    for (int k = F.wave; k < nk; k += NWAVES) {
        const int row = F.bid + F.G * k;
        const int b9 = row_b9(row);
        float* hp = hrow(F, row);
        const float* src = a.from_inputs ? (row < NLAT ? G(I.x) + (size_t)row * DM : G(I.ctx) + (size_t)(row - NLAT) * DM) : hp;
        f32x4 v[4];
#pragma unroll
        for (int j = 0; j < 4; ++j) v[j] = ((const f32x4*)src)[F.lane + 64 * j];
        if (a.combine_pair >= 0) {
            const int e1 = te[2 * row], e2 = te[2 * row + 1], r1 = tr[2 * row], r2 = tr[2 * row + 1];
            const float g1 = tg[2 * row], g2 = tg[2 * row + 1];
            const size_t s1 = (size_t)MOE[e1] * 256 + r1, s2 = (size_t)MOE[e2] * 256 + r2;
            const float* gm = modp(F, 2 * a.combine_pair + 1, b9, 5);
#pragma unroll
            for (int j = 0; j < 4; ++j) {
                const u32x2 y1 = *(const u32x2*)(Y + s1 * 1024 + 256 * j + 4 * F.lane), y2 = *(const u32x2*)(Y + s2 * 1024 + 256 * j + 4 * F.lane);
                const f32x4 gg = ((const f32x4*)gm)[F.lane + 64 * j];
                v[j].x += gg.x * (g1 * bflo(y1.x) + g2 * bflo(y2.x)); v[j].y += gg.y * (g1 * bfhi(y1.x) + g2 * bfhi(y2.x));
                v[j].z += gg.z * (g1 * bflo(y1.y) + g2 * bflo(y2.y)); v[j].w += gg.w * (g1 * bfhi(y1.y) + g2 * bfhi(y2.y));
            }
        }
        if (a.from_inputs || a.combine_pair >= 0) {
#pragma unroll
            for (int j = 0; j < 4; ++j) ((f32x4*)hp)[F.lane + 64 * j] = v[j];
        }
        if (a.final_only) continue;
        float ss = 0.f;
#pragma unroll
        for (int j = 0; j < 4; ++j) ss += (v[j].x * v[j].x + v[j].y * v[j].y) + (v[j].z * v[j].z + v[j].w * v[j].w);
        const float rstd = 1.0f / sqrtf(wave_sum(ss) * (1.f / DM) + EPS);
        const float* gp = G(I.norm_g) + ((size_t)a.layer * 2 + a.which) * DM;
        const float* shp = modp(F, a.layer, b9, a.which ? 3 : 0);
        const float* scp = modp(F, a.layer, b9, a.which ? 4 : 1);
        f32x4 xn[4];
#pragma unroll
        for (int j = 0; j < 4; ++j) { const f32x4 g = ((const f32x4*)gp)[F.lane + 64 * j], sh = ((const f32x4*)shp)[F.lane + 64 * j], sc = ((const f32x4*)scp)[F.lane + 64 * j];
            xn[j] = v[j] * rstd * g * (sc + 1.0f) + sh; }
        u32x2* o8 = (u32x2*)(XN + (size_t)row * DM) + F.lane;
#pragma unroll
        for (int j = 0; j < 4; ++j) o8[64 * j] = (u32x2){pk2(xn[j].x, xn[j].y), pk2(xn[j].z, xn[j].w)};
        if (a.router_pair >= 0) {
            float lg[NEXP];
#pragma unroll
            for (int e = 0; e < NEXP; ++e) lg[e] = 0.f;
#pragma unroll
            for (int j = 0; j < 4; ++j)
#pragma unroll
                for (int q = 0; q < 4; ++q) { const float xv = xn[j][q]; const LAS f32x4* w4 = (const LAS f32x4*)(wr + (256 * j + 4 * F.lane + q) * NEXP); const f32x4 wa = w4[0], wb = w4[1];
                    lg[0] += xv * wa.x; lg[1] += xv * wa.y; lg[2] += xv * wa.z; lg[3] += xv * wa.w; lg[4] += xv * wb.x; lg[5] += xv * wb.y; lg[6] += xv * wb.z; lg[7] += xv * wb.w; }
#pragma unroll
            for (int e = 0; e < NEXP; ++e) lg[e] = wave_sum(lg[e]);
            int i1 = 0; float v1 = lg[0];
#pragma unroll
            for (int e = 1; e < NEXP; ++e) if (lg[e] > v1) { v1 = lg[e]; i1 = e; }
            int i2 = -1; float v2 = -3.0e38f;
#pragma unroll
            for (int e = 0; e < NEXP; ++e) if (e != i1 && lg[e] > v2) { v2 = lg[e]; i2 = e; }
            const float ga = 1.f / (1.f + __expf(v2 - v1)), gb = 1.f - ga;
            if (F.lane == 0) {
                const int l1 = __hip_atomic_fetch_add((LAS int*)(lcnt + i1), 1, __ATOMIC_RELAXED, __HIP_MEMORY_SCOPE_WORKGROUP);
                const int l2 = __hip_atomic_fetch_add((LAS int*)(lcnt + i2), 1, __ATOMIC_RELAXED, __HIP_MEMORY_SCOPE_WORKGROUP);
                stash[4 * k + 0] = i1; stash[4 * k + 1] = l1; stash[4 * k + 2] = i2; stash[4 * k + 3] = l2;
                float* tgw = (float*)(F.WS() + WS_ROUTE) + 4 * NTOK; tgw[2 * row] = ga; tgw[2 * row + 1] = gb;
            }
        }
    }
    if (a.router_pair >= 0) {
        __syncthreads();
        if (F.tid < NEXP) lcnt[8 + F.tid] = (int)__hip_atomic_fetch_add(F.ctl + CW_MOECNT + 64 * a.router_pair + F.tid, (unsigned)lcnt[F.tid], RLX_AGENT);
        __syncthreads();
        int* tew = (int*)(F.WS() + WS_ROUTE); int* trw = tew + 2 * NTOK; int* list = (int*)(F.WS() + WS_LIST);
        for (int k = F.tid; k < nk; k += NWAVES * 64) {
            const int row = F.bid + F.G * k;
            const int i1 = stash[4 * k + 0], l1 = stash[4 * k + 1], i2 = stash[4 * k + 2], l2 = stash[4 * k + 3];
            const int r1 = lcnt[8 + i1] + l1, r2 = lcnt[8 + i2] + l2;
            tew[2 * row] = i1; tew[2 * row + 1] = i2; trw[2 * row] = r1; trw[2 * row + 1] = r2;
            list[(size_t)i1 * NTOK + r1] = row; list[(size_t)i2 * NTOK + r2] = row;
        }
    }
    __syncthreads();
}

struct SchedStatic {
    static constexpr bool GATHER = false;
    const bf16* A; int lda; const bf16* Bt; int K, nM, nN, G, c;
    __device__ __forceinline__ bool next(int i, pg8::Unit& u) const { return pg8::static_next(i, G, c, nM, nN, u); }
    __device__ __forceinline__ unsigned a_row(const pg8::Unit& u, int r) const { return (unsigned)(u.pm * 256 + r); }
    __device__ __forceinline__ const char* b_base(const pg8::Unit& u) const { return (const char*)Bt + (size_t)u.pn * 256 * K * 2; }
};
struct SchedOne {
    static constexpr bool GATHER = false;
    const bf16* A; int lda; const bf16* Bt; int K, pm, pn, have;
    __device__ __forceinline__ bool next(int i, pg8::Unit& u) const { if (i != 0 || !have) return false; u.pm = pm; u.pn = pn; return true; }
    __device__ __forceinline__ unsigned a_row(const pg8::Unit& u, int r) const { return (unsigned)(u.pm * 256 + r); }
    __device__ __forceinline__ const char* b_base(const pg8::Unit& u) const { return (const char*)Bt + (size_t)u.pn * 256 * K * 2; }
};
template <bool G_> struct SchedMoe {
    static constexpr bool GATHER = G_;
    const bf16* A; int lda; const bf16* Bt; size_t bstride; int K, nN, G, c; const int* list; volatile LAS int* MOE;
    __device__ __forceinline__ bool next(int i, pg8::Unit& u) const { const long L = (long)i * G + c; const int nP = MOE[8]; if (L >= (long)nP * nN) return false; u.pm = (int)(L / nN); u.pn = (int)(L % nN); return true; }
    __device__ __forceinline__ int expert(int pm) const { int e = 0;
#pragma unroll
        for (int k = 1; k < NEXP; ++k) e += (pm >= MOE[k]) ? 1 : 0;
        return e; }
    __device__ __forceinline__ unsigned a_row(const pg8::Unit& u, int r) const {
        if (!G_) return (unsigned)(u.pm * 256 + r);
        const int e = expert(u.pm), idx = (u.pm - MOE[e]) * 256 + r;
        return idx < MOE[16 + e] ? (unsigned)list[e * NTOK + idx] : 0u; }
    __device__ __forceinline__ const char* b_base(const pg8::Unit& u) const { return (const char*)Bt + (size_t)expert(u.pm) * bstride + (size_t)u.pn * 256 * K * 2; }
};

__device__ __forceinline__ unsigned cvt_pk_bf16(float lo, float hi) { unsigned r; asm volatile("v_cvt_pk_bf16_f32 %0, %1, %2" : "=v"(r) : "v"(lo), "v"(hi)); return r; }
typedef const f32x4 (&AccRef)[2][2][4][2];
__device__ __forceinline__ int swap12(int g) { return ((g & 1) << 1) | (g >> 1); }

__device__ __forceinline__ f32x4 tr4(const f32x4 a, int lane) {
    const bool o1 = lane & 1, o2 = lane & 2;
    const float t0 = __shfl_xor(o1 ? a[0] : a[1], 1), t1 = __shfl_xor(o1 ? a[2] : a[3], 1);
    const f32x4 b = o1 ? (f32x4){t0, a[1], t1, a[3]} : (f32x4){a[0], t0, a[2], t1};
    const float u0 = __shfl_xor(o2 ? b[0] : b[2], 2), u1 = __shfl_xor(o2 ? b[1] : b[3], 2);
    return o2 ? (f32x4){u0, u1, b[2], b[3]} : (f32x4){b[0], b[1], u0, u1};
}
struct EpiBf16 { static constexpr bool PERM = true;
    bf16* O; int ldc, mode;
    __device__ __forceinline__ void operator()(AccRef acc, const pg8::Unit& u, int wr, int wc, int fr, int fq) const {
        const int rbase = mode == 0 ? u.pm * 256 : (mode == 1 ? u.pn * 4096 + u.pm * 256 : NLAT + u.pn * 256 + u.pm * 256);
        const int cbase = mode == 0 ? u.pn * 256 : 768;
        const int row0 = rbase + wr * 64 + fr, col0 = cbase + wc * 32 + 8 * fq;
#pragma unroll
        for (int ai = 0; ai < 2; ++ai)
#pragma unroll
            for (int m = 0; m < 4; ++m) { bf16* rowp = O + (size_t)(row0 + ai * 128 + m * 16) * ldc + col0;
#pragma unroll
                for (int bj = 0; bj < 2; ++bj) { const f32x4 v0 = acc[ai][bj][m][0], v1 = acc[ai][bj][m][1];
                    u32x4 w; w.x = cvt_pk_bf16(v0[0], v0[1]); w.y = cvt_pk_bf16(v0[2], v0[3]); w.z = cvt_pk_bf16(v1[0], v1[1]); w.w = cvt_pk_bf16(v1[2], v1[3]);
                    *(u32x4*)(rowp + bj * 128) = w; } }
    }
};
struct EpiWin { static constexpr bool PERM = true;
    bf16* PX; bf16* GT; bf16* GTC;
    __device__ __forceinline__ void operator()(AccRef acc, const pg8::Unit& u, int wr, int wc, int fr, int fq) const {
        if (u.pn < 2) {
            const int row0 = u.pm * 256 + wr * 64 + fr, col0 = u.pn * 256 + wc * 32 + 8 * fq;
#pragma unroll
            for (int ai = 0; ai < 2; ++ai)
#pragma unroll
                for (int m = 0; m < 4; ++m) { bf16* rowp = PX + (size_t)(row0 + ai * 128 + m * 16) * 512 + col0;
#pragma unroll
                    for (int bj = 0; bj < 2; ++bj) { const f32x4 v0 = acc[ai][bj][m][0], v1 = acc[ai][bj][m][1];
                        u32x4 w; w.x = cvt_pk_bf16(v0[0], v0[1]); w.y = cvt_pk_bf16(v0[2], v0[3]); w.z = cvt_pk_bf16(v1[0], v1[1]); w.w = cvt_pk_bf16(v1[2], v1[3]);
                        *(u32x4*)(rowp + bj * 128) = w; } }
        } else {
            const int type = u.pn - 2; const bool lat = u.pm < 128;
            const int b = lat ? (u.pm >> 4) : (u.pm - 128);
            bf16* base = lat ? GT + (size_t)b * 256 * 8192 + type * 4096 + (u.pm & 15) * 256 : GTC + (size_t)b * 256 * 512 + type * 256;
            const size_t ldt = lat ? 8192 : 512;
#pragma unroll
            for (int ai = 0; ai < 2; ++ai)
#pragma unroll
                for (int m = 0; m < 4; ++m) { const int lr4 = ai * 128 + wr * 64 + m * 16 + (fr & 12);
#pragma unroll
                    for (int bj = 0; bj < 2; ++bj)
#pragma unroll
                        for (int n = 0; n < 2; ++n) { const f32x4 t = tr4(acc[ai][bj][m][n], fr); const int jc = 128 * bj + 32 * wc + 8 * fq + 4 * n + (fr & 3);
                            *(u32x2*)(base + (size_t)jc * ldt + lr4) = (u32x2){pk2(t[0], t[1]), pk2(t[2], t[3])}; }
                    if (m == 3) asm volatile("" ::: "memory"); }
        }
    }
};
struct EpiKV { static constexpr bool PERM = false;
    const bf16* PX; bf16* Kb; bf16* Vt; const float* g_k; const f32x2* rope;
    __device__ __forceinline__ void operator()(AccRef acc, const pg8::Unit& u, int wr, int wc, int fr, int fq) const {
        const int head = 2 * u.pn + (wc >> 1), part = wc & 1;
        const bool lat = u.pm < 128;
        const int b = lat ? (u.pm >> 4) : (u.pm - 128);
        const int pos0 = lat ? (u.pm & 15) * 256 : SEQ;
        const size_t bh = (size_t)b * A_HEADS + head;
#pragma unroll
        for (int ai = 0; ai < 2; ++ai)
#pragma unroll
            for (int m = 0; m < 4; ++m) {
                const int lr = ai * 128 + wr * 64 + m * 16 + fr, row = u.pm * 256 + lr, pos = pos0 + lr;
                const bf16* pxr = PX + (size_t)row * 512;
                float ss = 0.f;
#pragma unroll
                for (int q = 0; q < 4; ++q) { const u32x4 w = *(const u32x4*)(pxr + 256 + 32 * fq + 8 * q);
                    ss += bflo(w.x) * bflo(w.x) + bfhi(w.x) * bfhi(w.x) + bflo(w.y) * bflo(w.y) + bfhi(w.y) * bfhi(w.y) + bflo(w.z) * bflo(w.z) + bfhi(w.z) * bfhi(w.z) + bflo(w.w) * bflo(w.w) + bfhi(w.w) * bfhi(w.w); }
                ss += __shfl_xor(ss, 16); ss += __shfl_xor(ss, 32);
                const float rkv = 1.0f / sqrtf(ss * (1.f / 128.f) + EPS);
                if (part == 0) {
                    const u32x4 kw = *(const u32x4*)(pxr + 384 + 8 * fq);
                    float kr[8] = {bflo(kw.x), bfhi(kw.x), bflo(kw.y), bfhi(kw.y), bflo(kw.z), bfhi(kw.z), bflo(kw.w), bfhi(kw.w)};
                    float s2 = 0.f;
#pragma unroll
                    for (int q = 0; q < 8; ++q) s2 += kr[q] * kr[q];
#pragma unroll
                    for (int bj = 0; bj < 2; ++bj)
#pragma unroll
                        for (int n = 0; n < 2; ++n) { const f32x4 x = acc[ai][bj][m][n] * rkv; s2 += (x[0] * x[0] + x[1] * x[1]) + (x[2] * x[2] + x[3] * x[3]); }
                    s2 += __shfl_xor(s2, 16); s2 += __shfl_xor(s2, 32);
                    const float rs = 1.0f / sqrtf(s2 * (1.f / 96.f) + EPS);
                    bf16* kp = Kb + (bh * KPOS + pos) * 96;
#pragma unroll
                    for (int bj = 0; bj < 2; ++bj)
#pragma unroll
                        for (int n = 0; n < 2; ++n) { const int d0 = 32 * bj + 16 * n; const f32x4 g = *(const f32x4*)(g_k + d0 + 4 * fq); const f32x4 x = acc[ai][bj][m][n] * (rkv * rs) * g;
                            *(u32x2*)(kp + d0 + 4 * swap12(fq)) = (u32x2){pk2(x[0], x[1]), pk2(x[2], x[3])}; }
                    float t[8];
                    { const f32x4 ga = *(const f32x4*)(g_k + 64 + 8 * fq), gb = *(const f32x4*)(g_k + 64 + 8 * fq + 4);
                      t[0] = kr[0] * rs * ga[0]; t[1] = kr[1] * rs * ga[1]; t[2] = kr[2] * rs * ga[2]; t[3] = kr[3] * rs * ga[3];
                      t[4] = kr[4] * rs * gb[0]; t[5] = kr[5] * rs * gb[1]; t[6] = kr[6] * rs * gb[2]; t[7] = kr[7] * rs * gb[3]; }
                    if (lat) {
                        const int pidx = (fq < 2) ? (pos >> 6) : (pos & 63);
#pragma unroll
                        for (int q = 0; q < 4; ++q) { const f32x2 cs = rope[pidx * 8 + ((4 * fq + q) & 7)]; const float t0 = t[2 * q], t1 = t[2 * q + 1];
                            t[2 * q] = t0 * cs.x - t1 * cs.y; t[2 * q + 1] = t0 * cs.y + t1 * cs.x; }
                    }
                    bf16* krp = kp + 64 + 16 * (fq >> 1) + 4 * (fq & 1);
                    *(u32x2*)(krp) = (u32x2){pk2(t[0], t[1]), pk2(t[2], t[3])};
                    *(u32x2*)(krp + 8) = (u32x2){pk2(t[4], t[5]), pk2(t[6], t[7])};
                } else {
                    const int p4 = pos & ~3, pp = (p4 & ~15) | (((p4 & 4) << 1) | ((p4 & 8) >> 1));
                    bf16* vp = Vt + bh * 64 * KPOS + pp;
#pragma unroll
                    for (int bj = 0; bj < 2; ++bj)
#pragma unroll
                        for (int n = 0; n < 2; ++n) { const f32x4 t = tr4(acc[ai][bj][m][n] * rkv, fr);
                            *(u32x2*)(vp + (size_t)(32 * bj + 16 * n + 4 * fq + (fr & 3)) * KPOS) = (u32x2){pk2(t[0], t[1]), pk2(t[2], t[3])}; }
                }
                if (m & 1) asm volatile("" ::: "memory");
            }
    }
};
struct EpiResid { static constexpr bool PERM = false;
    float* out; float* hc; const float* modl; int gk; bool dry;
    __device__ __forceinline__ void operator()(AccRef acc, const pg8::Unit& u, int wr, int wc, int fr, int fq) const {
        const bool lat = u.pm < 128; const int b9 = lat ? (u.pm >> 4) : 8;
        float* base = lat ? out + (size_t)u.pm * 256 * DM : hc + (size_t)(u.pm - 128) * 256 * DM;
        const int col0 = u.pn * 256 + wc * 32 + 4 * fq;
        const float* gp = modl + (size_t)b9 * 6144 + gk * 1024 + col0;
        f32x4 gv[2][2];
#pragma unroll
        for (int bj = 0; bj < 2; ++bj)
#pragma unroll
            for (int n = 0; n < 2; ++n) gv[bj][n] = *(const f32x4*)(gp + bj * 128 + n * 16);
#pragma unroll
        for (int ai = 0; ai < 2; ++ai)
#pragma unroll
            for (int m = 0; m < 4; ++m) { float* rowp = base + (size_t)(ai * 128 + wr * 64 + m * 16 + fr) * DM + col0;
#pragma unroll
                for (int bj = 0; bj < 2; ++bj)
#pragma unroll
                    for (int n = 0; n < 2; ++n) { f32x4* p = (f32x4*)(rowp + bj * 128 + n * 16); const f32x4 r = *p + gv[bj][n] * acc[ai][bj][m][n]; if (!dry) *p = r; }
                if (m == 3) asm volatile("" ::: "memory"); }
    }
};
struct EpiSwiglu { static constexpr bool PERM = false;
    bf16* HM; int ldh;
    __device__ __forceinline__ void operator()(AccRef acc, const pg8::Unit& u, int wr, int wc, int fr, int fq) const {
        const int row0 = u.pm * 256 + wr * 64 + fr, col0 = u.pn * 128 + wc * 16 + 4 * fq;
#pragma unroll
        for (int ai = 0; ai < 2; ++ai)
#pragma unroll
            for (int m = 0; m < 4; ++m) { bf16* rowp = HM + (size_t)(row0 + ai * 128 + m * 16) * ldh + col0;
#pragma unroll
                for (int bj = 0; bj < 2; ++bj) { const f32x4 g = acc[ai][bj][m][0], up = acc[ai][bj][m][1]; float h[4];
#pragma unroll
                    for (int e = 0; e < 4; ++e) h[e] = g[e] * __builtin_amdgcn_rcpf(1.f + __builtin_amdgcn_exp2f(-g[e] * LOG2E)) * up[e];
                    *(u32x2*)(rowp + bj * 64) = (u32x2){cvt_pk_bf16(h[0], h[1]), cvt_pk_bf16(h[2], h[3])}; } }
    }
};
struct EpiNAin { static constexpr bool PERM = false;
    bf16* QN; bf16* KN; bf16* Vt; const float* g_q; const float* g_k;
    __device__ __forceinline__ void operator()(AccRef acc, const pg8::Unit& u, int wr, int wc, int fr, int fq) const {
        const int sec = u.pn >> 2, head = 4 * (u.pn & 3) + wc;
        const bool lat = u.pm < 128;
        const int b = lat ? (u.pm >> 4) : (u.pm - 128);
        const int pos0 = lat ? (u.pm & 15) * 256 : SEQ;
#pragma unroll
        for (int ai = 0; ai < 2; ++ai)
#pragma unroll
            for (int m = 0; m < 4; ++m) {
                const int lr = ai * 128 + wr * 64 + m * 16 + fr, row = u.pm * 256 + lr;
                if (sec < 2) {
                    float s2 = 0.f;
#pragma unroll
                    for (int bj = 0; bj < 2; ++bj)
#pragma unroll
                        for (int n = 0; n < 2; ++n) { const f32x4 x = acc[ai][bj][m][n]; s2 += (x[0] * x[0] + x[1] * x[1]) + (x[2] * x[2] + x[3] * x[3]); }
                    s2 += __shfl_xor(s2, 16); s2 += __shfl_xor(s2, 32);
                    const float rs = (1.0f / sqrtf(s2 * (1.f / 64.f) + EPS)) * (sec == 0 ? 0.125f * LOG2E : 1.0f);
                    const float* gp = sec == 0 ? g_q : g_k;
                    bf16* op = (sec == 0 ? QN : KN) + (size_t)row * DM + head * 64;
#pragma unroll
                    for (int bj = 0; bj < 2; ++bj)
#pragma unroll
                        for (int n = 0; n < 2; ++n) { const int d0 = 32 * bj + 16 * n + 4 * fq; const f32x4 g = *(const f32x4*)(gp + d0); const f32x4 x = acc[ai][bj][m][n] * rs * g;
                            *(u32x2*)(op + d0) = (u32x2){pk2(x[0], x[1]), pk2(x[2], x[3])}; }
                } else {
                    bf16* vp = Vt + ((size_t)b * C_HEADS + head) * 64 * KPOS + pos0 + (lr & ~3);
#pragma unroll
                    for (int bj = 0; bj < 2; ++bj)
#pragma unroll
                        for (int n = 0; n < 2; ++n) { const f32x4 t = tr4(acc[ai][bj][m][n], fr);
                            *(u32x2*)(vp + (size_t)(32 * bj + 16 * n + 4 * fq + (fr & 3)) * KPOS) = (u32x2){pk2(t[0], t[1]), pk2(t[2], t[3])}; }
                }
                if (m == 3) asm volatile("" ::: "memory");
            }
    }
};

constexpr int AT_KP = 208, AT_VP = 144;
constexpr int AT_KB = 64 * AT_KP, AT_VB = 64 * AT_VP, AT_BUF = AT_KB + AT_VB;

__device__ __forceinline__ void mla_attn_unit(Frame& F, int pair, int b, int h, int qrow0, bool lat, int key0, int nkt) {
    const int lane = F.lane, l31 = lane & 31, hi = lane >> 5;
    const bf16* PX = (const bf16*)(F.WS() + WS_PX);
    const bf16* WUQ = (const bf16*)(F.WS() + WS_W + WO_WUQ);
    const bf16* Kg = (const bf16*)(F.WS() + WS_K) + ((size_t)(b * A_HEADS + h) * KPOS + key0) * 96;
    const bf16* Vg = (const bf16*)(F.WS() + WS_VT) + (size_t)(b * A_HEADS + h) * 64 * KPOS + key0;
    bf16* MIX = (bf16*)(F.WS() + WS_ACT);
    const f32x2* rope = (const f32x2*)(F.WS() + WS_ROPE);
    const int row = qrow0 + 32 * F.wave + l31;
    const int vdv = F.tid >> 3, vpart = F.tid & 7;
    u32x4 kr0, kr1 = (u32x4){0u, 0u, 0u, 0u}, vr;
    kr0 = *(const u32x4*)((const char*)Kg + (size_t)F.tid * 16);
    if (F.tid < 256) kr1 = *(const u32x4*)((const char*)Kg + (size_t)(512 + F.tid) * 16);
    vr = *(const u32x4*)(Vg + (size_t)vdv * KPOS + vpart * 8);
    bf16x8 qf[3][2];
    {
        bf16x8 bq[16];
        const bf16* pxr = PX + (size_t)row * 512 + 8 * hi;
#pragma unroll
        for (int s = 0; s < 16; ++s) bq[s] = *(const bf16x8*)(pxr + 16 * s);
        float ss = 0.f;
#pragma unroll
        for (int s = 0; s < 16; ++s)
#pragma unroll
            for (int e = 0; e < 8; ++e) { const float x = bf2f((unsigned short)bq[s][e]); ss += x * x; }
        ss += __shfl_xor(ss, 32);
        const float rq = 1.0f / sqrtf(ss * (1.f / 256.f) + EPS);
        f32x16 qt[3];
#pragma unroll
        for (int blk = 0; blk < 3; ++blk) {
            f32x16 acc;
#pragma unroll
            for (int i = 0; i < 16; ++i) acc[i] = 0.f;
            const bf16* wrp = WUQ + (size_t)(h * 96 + 32 * blk + l31) * 256 + 8 * hi;
#pragma unroll
            for (int s = 0; s < 16; ++s) { const bf16x8 a = *(const bf16x8*)(wrp + 16 * s); acc = __builtin_amdgcn_mfma_f32_32x32x16_bf16(a, bq[s], acc, 0, 0, 0); }
            qt[blk] = acc * rq;
        }
        float s2 = 0.f;
#pragma unroll
        for (int blk = 0; blk < 3; ++blk)
#pragma unroll
            for (int i = 0; i < 16; ++i) s2 += qt[blk][i] * qt[blk][i];
        s2 += __shfl_xor(s2, 32);
        const float rs = (1.0f / sqrtf(s2 * (1.f / 96.f) + EPS));
        const float* gq = G(F.in->a_g_q) + pair * 96;
#pragma unroll
        for (int blk = 0; blk < 3; ++blk)
#pragma unroll
            for (int c = 0; c < 4; ++c) { const f32x4 g = *(const f32x4*)(gq + 32 * blk + 8 * c + 4 * hi);
#pragma unroll
                for (int e = 0; e < 4; ++e) qt[blk][4 * c + e] *= rs * g[e]; }
        if (lat) {
            const int t = row & (SEQ - 1);
#pragma unroll
            for (int c = 0; c < 4; ++c) {
                const int pidx = (c < 2) ? (t >> 6) : (t & 63);
#pragma unroll
                for (int q = 0; q < 2; ++q) { const f32x2 cs = rope[pidx * 8 + ((4 * c + 2 * hi + q) & 7)]; const float t0 = qt[2][4 * c + 2 * q], t1 = qt[2][4 * c + 2 * q + 1];
                    qt[2][4 * c + 2 * q] = t0 * cs.x - t1 * cs.y; qt[2][4 * c + 2 * q + 1] = t0 * cs.y + t1 * cs.x; }
            }
        }
        const float sc = 0.10206207261596577f * LOG2E;
#pragma unroll
        for (int blk = 0; blk < 3; ++blk)
#pragma unroll
            for (int s = 0; s < 2; ++s) { u32x4 w;
                w.x = pk2(qt[blk][8 * s + 0] * sc, qt[blk][8 * s + 1] * sc); w.y = pk2(qt[blk][8 * s + 2] * sc, qt[blk][8 * s + 3] * sc);
                w.z = pk2(qt[blk][8 * s + 4] * sc, qt[blk][8 * s + 5] * sc); w.w = pk2(qt[blk][8 * s + 6] * sc, qt[blk][8 * s + 7] * sc);
                qf[blk][s] = __builtin_bit_cast(bf16x8, w); }
    }
    LAS unsigned char* L = F.lds;
    const int kd0 = (F.tid / 12) * AT_KP + (F.tid % 12) * 16, kd1 = ((512 + F.tid) / 12) * AT_KP + ((512 + F.tid) % 12) * 16, vd = AT_KB + vdv * AT_VP + vpart * 16;
    *(LAS u32x4*)(L + kd0) = kr0; if (F.tid < 256) *(LAS u32x4*)(L + kd1) = kr1; *(LAS u32x4*)(L + vd) = vr;
    __syncthreads();
    f32x16 oT[2];
#pragma unroll
    for (int d = 0; d < 2; ++d)
#pragma unroll
        for (int i = 0; i < 16; ++i) oT[d][i] = 0.f;
    float mrun = -3.0e38f, lrun = 0.f;
    const int kro = l31 * AT_KP + hi * 16, vro = AT_KB + l31 * AT_VP + hi * 16;
    for (int t = 0; t < nkt; ++t) {
        const bool more = (t + 1 < nkt);
        if (more) {
            const char* kg = (const char*)Kg + (size_t)(t + 1) * 64 * 192;
            kr0 = *(const u32x4*)(kg + (size_t)F.tid * 16);
            if (F.tid < 256) kr1 = *(const u32x4*)(kg + (size_t)(512 + F.tid) * 16);
            vr = *(const u32x4*)(Vg + (size_t)vdv * KPOS + (t + 1) * 64 + vpart * 8);
        }
        const LAS unsigned char* Lb = L + (t & 1) * AT_BUF;
        f32x16 sT[2];
#pragma unroll
        for (int kb = 0; kb < 2; ++kb) {
            f32x16 acc;
#pragma unroll
            for (int i = 0; i < 16; ++i) acc[i] = 0.f;
#pragma unroll
            for (int blk = 0; blk < 3; ++blk)
#pragma unroll
                for (int s = 0; s < 2; ++s) { const bf16x8 a = *(const LAS bf16x8*)(Lb + kro + kb * 32 * AT_KP + (32 * blk + 16 * s) * 2);
                    acc = __builtin_amdgcn_mfma_f32_32x32x16_bf16(a, qf[blk][s], acc, 0, 0, 0); }
            sT[kb] = acc;
        }
        float mx = sT[0][0];
#pragma unroll
        for (int kb = 0; kb < 2; ++kb)
#pragma unroll
            for (int i = 0; i < 16; ++i) mx = fmaxf(mx, sT[kb][i]);
        mx = fmaxf(mx, __shfl_xor(mx, 32));
        const float mnew = fmaxf(mrun, mx);
        const float alpha = __builtin_amdgcn_exp2f(mrun - mnew);
        mrun = mnew;
        float psum = 0.f;
        bf16x8 pf[2][2];
#pragma unroll
        for (int kb = 0; kb < 2; ++kb) {
            float p[16];
#pragma unroll
            for (int i = 0; i < 16; ++i) { p[i] = __builtin_amdgcn_exp2f(sT[kb][i] - mnew); psum += p[i]; }
#pragma unroll
            for (int s = 0; s < 2; ++s) { u32x4 w; w.x = cvt_pk_bf16(p[8 * s + 0], p[8 * s + 1]); w.y = cvt_pk_bf16(p[8 * s + 2], p[8 * s + 3]); w.z = cvt_pk_bf16(p[8 * s + 4], p[8 * s + 5]); w.w = cvt_pk_bf16(p[8 * s + 6], p[8 * s + 7]);
                pf[kb][s] = __builtin_bit_cast(bf16x8, w); }
        }
        lrun = lrun * alpha + psum;
#pragma unroll
        for (int d = 0; d < 2; ++d) oT[d] = oT[d] * alpha;
#pragma unroll
        for (int d = 0; d < 2; ++d)
#pragma unroll
            for (int kb = 0; kb < 2; ++kb)
#pragma unroll
                for (int s = 0; s < 2; ++s) { const bf16x8 a = *(const LAS bf16x8*)(Lb + vro + d * 32 * AT_VP + (32 * kb + 16 * s) * 2);
                    oT[d] = __builtin_amdgcn_mfma_f32_32x32x16_bf16(a, pf[kb][s], oT[d], 0, 0, 0); }
        if (more) {
            LAS unsigned char* Ln = L + ((t + 1) & 1) * AT_BUF;
            *(LAS u32x4*)(Ln + kd0) = kr0; if (F.tid < 256) *(LAS u32x4*)(Ln + kd1) = kr1; *(LAS u32x4*)(Ln + vd) = vr;
        }
        __syncthreads();
    }
    lrun += __shfl_xor(lrun, 32);
    const float inv = 1.0f / lrun;
    bf16* op = MIX + (size_t)row * DM + h * 64 + 4 * hi;
#pragma unroll
    for (int d = 0; d < 2; ++d)
#pragma unroll
        for (int c = 0; c < 4; ++c) *(u32x2*)(op + 32 * d + 8 * c) = (u32x2){pk2(oT[d][4 * c] * inv, oT[d][4 * c + 1] * inv), pk2(oT[d][4 * c + 2] * inv, oT[d][4 * c + 3] * inv)};
}

__device__ __forceinline__ void mla_attn_phase(Frame& F, int pair, int rep) {
    constexpr int NLU = NB * A_HEADS * (SEQ / 256), NCU = NB * A_HEADS;
    for (;;) {
        if (F.tid == 0) F.MISC[0] = __hip_atomic_fetch_add(F.ctl + CW_ATTQ + 64 * pair + 32 * rep, 1u, RLX_AGENT);
        __syncthreads();
        const int u = (int)F.MISC[0];
        __syncthreads();
        if (u >= NLU + NCU) break;
        if (u < NLU) { const int qb = u & 15, bh = u >> 4, b = bh / A_HEADS, h = bh % A_HEADS; mla_attn_unit(F, pair, b, h, b * SEQ + qb * 256, true, 0, KPOS / 64); }
        else { const int bh = u - NLU, b = bh / A_HEADS, h = bh % A_HEADS; mla_attn_unit(F, pair, b, h, NLAT + b * CTXL, false, SEQ, CTXL / 64); }
    }
}

constexpr int NA_KP = 144, NA_CVP = 528, NA_LVP = 1168;
constexpr int NA_CK = 0, NA_CV = 256 * NA_KP, NA_L = NA_CV + 64 * NA_CVP, NA_RPB = NA_L + 576 * NA_KP, NA_END = NA_RPB + 15 * 31 * 4;
static_assert(NA_L == 70656 && 64 * NA_LVP <= 576 * NA_KP && NA_END <= LDSCTL_OFF, "NA LDS map");

struct NaPref { u32x4 r[9]; };
__device__ __forceinline__ void na_load_k(NaPref& p, const bf16* KN, int rowbase, int h, int tid) {
    const char* gb = (const char*)(KN + (size_t)rowbase * DM + h * 64); const unsigned lo = (unsigned)(tid >> 3) * 2048u + (unsigned)(tid & 7) * 16u;
#pragma unroll
    for (int i = 0; i < 9; ++i) p.r[i] = *(const u32x4*)(gb + (size_t)i * 131072 + lo);
}
__device__ __forceinline__ void na_store_k(const NaPref& p, LAS unsigned char* L, int tid) {
    LAS unsigned char* d = L + NA_L + (tid >> 3) * NA_KP + (tid & 7) * 16;
#pragma unroll
    for (int i = 0; i < 9; ++i) *(LAS u32x4*)(d + i * 64 * NA_KP) = p.r[i];
}
__device__ __forceinline__ void na_load_v(NaPref& p, const bf16* Vt, int pos0, int tid) {
    const char* gb = (const char*)(Vt + pos0); const unsigned lo = (unsigned)(tid >> 3) * (unsigned)(KPOS * 2) + (unsigned)(tid & 7) * 16u;
#pragma unroll
    for (int i = 0; i < 9; ++i) p.r[i] = *(const u32x4*)(gb + i * 128 + lo);
}
__device__ __forceinline__ void na_store_v(const NaPref& p, LAS unsigned char* L, int tid) {
    LAS unsigned char* d = L + NA_L + (tid >> 3) * NA_LVP + (tid & 7) * 16;
#pragma unroll
    for (int i = 0; i < 9; ++i) *(LAS u32x4*)(d + i * 128) = p.r[i];
}
__device__ __forceinline__ void na_stage_ctx(Frame& F, int b, int h) {
    const char* kb = (const char*)((const bf16*)(F.WS() + WS_KN) + (size_t)(NLAT + b * CTXL) * DM + h * 64);
    const char* vb = (const char*)((const bf16*)(F.WS() + WS_VTN) + (size_t)(b * C_HEADS + h) * 64 * KPOS + SEQ);
    const unsigned klo = (unsigned)(F.tid >> 3) * 2048u + (unsigned)(F.tid & 7) * 16u, vlo = (unsigned)(F.tid >> 3) * (unsigned)(KPOS * 2) + (unsigned)(F.tid & 7) * 16u;
    u32x4 a[4], v[4];
#pragma unroll
    for (int i = 0; i < 4; ++i) a[i] = *(const u32x4*)(kb + (size_t)i * 131072 + klo);
#pragma unroll
    for (int i = 0; i < 4; ++i) v[i] = *(const u32x4*)(vb + i * 128 + vlo);
    LAS unsigned char* kd = F.lds + NA_CK + (F.tid >> 3) * NA_KP + (F.tid & 7) * 16;
    LAS unsigned char* vd = F.lds + NA_CV + (F.tid >> 3) * NA_CVP + (F.tid & 7) * 16;
#pragma unroll
    for (int i = 0; i < 4; ++i) *(LAS u32x4*)(kd + i * 64 * NA_KP) = a[i];
#pragma unroll
    for (int i = 0; i < 4; ++i) *(LAS u32x4*)(vd + i * 128) = v[i];
}
__device__ __forceinline__ float na_scores(Frame& F, bf16x8 (&pf)[16], float& f1, const bf16x8 (&qf)[2], const int (&dco)[8], const bool (&okm)[8], bool lat, int qr, int c0, int kr0, int rs, int ks) {
    const int lane = F.lane, l15 = lane & 15, g = lane >> 4;
    const LAS float* rpbs = (const LAS float*)(F.lds + NA_RPB);
    float m1 = -3.0e38f, l1 = 0.f;
    if (lat) {
        f32x4 sc[16];
#pragma unroll
        for (int t = 0; t < 16; ++t) {
            const LAS unsigned char* kp = F.lds + NA_L + (((rs - kr0) + (t >> 1)) * 64 + ks + 16 * (t & 1) + l15) * NA_KP + g * 16;
            f32x4 acc = (f32x4){0.f, 0.f, 0.f, 0.f};
#pragma unroll
            for (int s = 0; s < 2; ++s) { const bf16x8 a = *(const LAS bf16x8*)(kp + s * 64); acc = __builtin_amdgcn_mfma_f32_16x16x32_bf16(a, qf[s], acc, 0, 0, 0); }
            const LAS float* brow = rpbs + (rs + (t >> 1) - qr + 7) * 31;
#pragma unroll
            for (int e = 0; e < 4; ++e) { const float bias = brow[dco[4 * (t & 1) + e]]; acc[e] = okm[4 * (t & 1) + e] ? acc[e] + bias : -1.0e30f; }
            sc[t] = acc;
            if ((t & 3) == 3) asm volatile("" ::: "memory");
        }
#pragma unroll
        for (int t = 0; t < 16; ++t)
#pragma unroll
            for (int e = 0; e < 4; ++e) m1 = fmaxf(m1, sc[t][e]);
        m1 = fmaxf(m1, __shfl_xor(m1, 16)); m1 = fmaxf(m1, __shfl_xor(m1, 32));
#pragma unroll
        for (int u = 0; u < 8; ++u) { float p[8];
#pragma unroll
            for (int e = 0; e < 4; ++e) { p[e] = __builtin_amdgcn_exp2f(sc[2 * u][e] - m1); p[4 + e] = __builtin_amdgcn_exp2f(sc[2 * u + 1][e] - m1); }
#pragma unroll
            for (int e = 0; e < 8; ++e) l1 += p[e];
            u32x4 w; w.x = cvt_pk_bf16(p[0], p[1]); w.y = cvt_pk_bf16(p[2], p[3]); w.z = cvt_pk_bf16(p[4], p[5]); w.w = cvt_pk_bf16(p[6], p[7]);
            pf[u] = __builtin_bit_cast(bf16x8, w); }
    } else {
#pragma unroll
        for (int u = 0; u < 8; ++u) pf[u] = (bf16x8){0, 0, 0, 0, 0, 0, 0, 0};
    }
    float m = m1, l2 = 0.f;
    {
        f32x4 sc[16];
#pragma unroll
        for (int t = 0; t < 16; ++t) {
            const LAS unsigned char* kp = F.lds + NA_CK + (16 * t + l15) * NA_KP + g * 16;
            f32x4 acc = (f32x4){0.f, 0.f, 0.f, 0.f};
#pragma unroll
            for (int s = 0; s < 2; ++s) { const bf16x8 a = *(const LAS bf16x8*)(kp + s * 64); acc = __builtin_amdgcn_mfma_f32_16x16x32_bf16(a, qf[s], acc, 0, 0, 0); }
            sc[t] = acc;
            if ((t & 3) == 3) asm volatile("" ::: "memory");
        }
        float m2 = -3.0e38f;
#pragma unroll
        for (int t = 0; t < 16; ++t)
#pragma unroll
            for (int e = 0; e < 4; ++e) m2 = fmaxf(m2, sc[t][e]);
        m2 = fmaxf(m2, __shfl_xor(m2, 16)); m2 = fmaxf(m2, __shfl_xor(m2, 32));
        m = fmaxf(m1, m2);
#pragma unroll
        for (int u = 0; u < 8; ++u) { float p[8];
#pragma unroll
            for (int e = 0; e < 4; ++e) { p[e] = __builtin_amdgcn_exp2f(sc[2 * u][e] - m); p[4 + e] = __builtin_amdgcn_exp2f(sc[2 * u + 1][e] - m); }
#pragma unroll
            for (int e = 0; e < 8; ++e) l2 += p[e];
            u32x4 w; w.x = cvt_pk_bf16(p[0], p[1]); w.y = cvt_pk_bf16(p[2], p[3]); w.z = cvt_pk_bf16(p[4], p[5]); w.w = cvt_pk_bf16(p[6], p[7]);
            pf[8 + u] = __builtin_bit_cast(bf16x8, w); }
    }
    f1 = __builtin_amdgcn_exp2f(m1 - m);
    float lsum = l1 * f1 + l2;
    lsum += __shfl_xor(lsum, 16); lsum += __shfl_xor(lsum, 32);
    return 1.0f / lsum;
}
__device__ __forceinline__ void na_pv(Frame& F, const bf16x8 (&pf)[16], float f1, float inv, bool lat, int qrow, int h, int kr0, int rs, int ks) {
    const int lane = F.lane, l15 = lane & 15, g = lane >> 4;
    bf16* MIX = (bf16*)(F.WS() + WS_ACT);
    bf16* op = MIX + (size_t)qrow * DM + h * 64 + 4 * g;
#pragma unroll
    for (int dvt = 0; dvt < 4; ++dvt) {
        f32x4 acc = (f32x4){0.f, 0.f, 0.f, 0.f};
        const int dv = 16 * dvt + l15;
        if (lat) {
#pragma unroll
            for (int u = 0; u < 8; ++u) {
                const LAS unsigned char* vp = F.lds + NA_L + dv * NA_LVP + (((rs - kr0) + u) * 64 + ks + 4 * g) * 2;
                const u32x2 lo = *(const LAS u32x2*)(vp), hi2 = *(const LAS u32x2*)(vp + 32);
                const u32x4 w = (u32x4){lo.x, lo.y, hi2.x, hi2.y};
                acc = __builtin_amdgcn_mfma_f32_16x16x32_bf16(__builtin_bit_cast(bf16x8, w), pf[u], acc, 0, 0, 0);
                if ((u & 3) == 3) asm volatile("" ::: "memory");
            }
            acc = acc * f1;
        }
#pragma unroll
        for (int u = 8; u < 16; ++u) {
            const LAS unsigned char* vp = F.lds + NA_CV + dv * NA_CVP + (32 * (u - 8) + 4 * g) * 2;
            const u32x2 lo = *(const LAS u32x2*)(vp), hi2 = *(const LAS u32x2*)(vp + 32);
            const u32x4 w = (u32x4){lo.x, lo.y, hi2.x, hi2.y};
            acc = __builtin_amdgcn_mfma_f32_16x16x32_bf16(__builtin_bit_cast(bf16x8, w), pf[u], acc, 0, 0, 0);
            if ((u & 3) == 3) asm volatile("" ::: "memory");
        }
        *(u32x2*)(op + 16 * dvt) = (u32x2){pk2(acc[0] * inv, acc[1] * inv), pk2(acc[2] * inv, acc[3] * inv)};
    }
}
__device__ __forceinline__ void na_phase(Frame& F, int pair) {
    const bf16* KN = (const bf16*)(F.WS() + WS_KN);
    LAS float* rpbs = (LAS float*)(F.lds + NA_RPB);
    constexpr int NGRP = NB * C_HEADS * 2;
    for (int gi = F.bid; gi < NGRP; gi += F.G) {
        const int h = gi / (NB * 2), rem = gi % (NB * 2), b = rem >> 1, half = rem & 1;
        const bf16* Vt = (const bf16*)(F.WS() + WS_VTN) + (size_t)(b * C_HEADS + h) * 64 * KPOS;
        __syncthreads();
        na_stage_ctx(F, b, h);
        { const float* rp = G(F.in->c_rpb) + ((size_t)pair * C_HEADS + h) * 15 * 31; for (int i = F.tid; i < 15 * 31; i += NWAVES * 64) rpbs[i] = rp[i] * LOG2E; }
        NaPref pk, pv;
        int dco[8]; bool okm[8];
        { const int c0 = 16 * (F.wave & 3), ks = min(max(c0 - 8, 0), 32), cq = c0 + (F.lane & 15), cs = min(max(cq - 8, 0), 48);
#pragma unroll
          for (int k = 0; k < 8; ++k) { const int kc = ks + 16 * (k >> 2) + 4 * (F.lane >> 4) + (k & 3); okm[k] = (kc >= cs) && (kc < cs + 16); dco[k] = min(max(kc - cq + 15, 0), 30); } }
        { const int r0 = 2 * (16 * half), kr0 = min(max(r0 - 4, 0), 55); na_load_k(pk, KN, b * SEQ + kr0 * 64, h, F.tid); }
        for (int bi = 0; bi < 16; ++bi) {
            const int r0 = 2 * (16 * half + bi), kr0 = min(max(r0 - 4, 0), 55);
            const int qr = r0 + (F.wave >> 2), c0 = 16 * (F.wave & 3), rs = min(max(qr - 4, 0), 56), ks = min(max(c0 - 8, 0), 32);
            const int qrow = b * SEQ + qr * 64 + c0 + (F.lane & 15);
            bf16x8 qf[2];
#pragma unroll
            for (int s = 0; s < 2; ++s) qf[s] = *(const bf16x8*)((const bf16*)(F.WS() + WS_QN) + (size_t)qrow * DM + h * 64 + 32 * s + 8 * (F.lane >> 4));
            na_store_k(pk, F.lds, F.tid);
            __syncthreads();
            na_load_v(pv, Vt, kr0 * 64, F.tid);
            bf16x8 pf[16];
            float f1; const float inv = na_scores(F, pf, f1, qf, dco, okm, true, qr, c0, kr0, rs, ks);
            __syncthreads();
            na_store_v(pv, F.lds, F.tid);
            __syncthreads();
            if (bi + 1 < 16) { const int r1 = r0 + 2, kr1 = min(max(r1 - 4, 0), 55); na_load_k(pk, KN, b * SEQ + kr1 * 64, h, F.tid); }
            na_pv(F, pf, f1, inv, true, qrow, h, kr0, rs, ks);
            __syncthreads();
        }
    }
    constexpr int NCU = NB * C_HEADS * 2;
    for (int u = F.bid; u < NCU; u += F.G) {
        const int h = u / (NB * 2), rem = u % (NB * 2), b = rem >> 1, ch = rem & 1;
        __syncthreads();
        na_stage_ctx(F, b, h);
        __syncthreads();
        const int qrow = NLAT + b * CTXL + ch * 128 + 16 * F.wave + (F.lane & 15);
        bf16x8 pf[16]; bf16x8 qf[2];
#pragma unroll
        for (int s = 0; s < 2; ++s) qf[s] = *(const bf16x8*)((const bf16*)(F.WS() + WS_QN) + (size_t)qrow * DM + h * 64 + 32 * s + 8 * (F.lane >> 4));
        const int dco0[8] = {0, 0, 0, 0, 0, 0, 0, 0}; const bool okm0[8] = {false, false, false, false, false, false, false, false};
        float f1; const float inv = na_scores(F, pf, f1, qf, dco0, okm0, false, 0, 0, 0, 0, 0);
        na_pv(F, pf, f1, inv, false, qrow, h, 0, 0, 0);
    }
    __syncthreads();
}

constexpr int PH_PER_PAIR = 16, N_PHASES = 2 * PH_PER_PAIR + 1;
struct Args { Inputs in; float* out; unsigned char* ws; int ph_lo, ph_hi; };
static_assert(sizeof(Args) == 27 * 8 + 8 + 8 + 8, "Args has no padding bytes");

__global__ void __launch_bounds__(NWAVES * 64, 2) dit_fwd(Args args) {
    extern __shared__ __attribute__((aligned(16))) unsigned char lds_raw[];
    Frame F;
    F.lds = (LAS unsigned char*)lds_raw;
    F.MISC = (volatile LAS unsigned*)(F.lds + MISC_OFF);
    F.tid = threadIdx.x; F.lane = F.tid & 63; F.wave = __builtin_amdgcn_readfirstlane(F.tid >> 6);
    F.G = gridDim.x; F.bid = blockIdx.x;
    F.ws_ = (GAS unsigned char*)args.ws; F.ctl = (gu32*)(args.ws + WS_CTL); F.out_ = (GAS float*)args.out; F.hc_ = (GAS float*)(args.ws + WS_HC); F.in = (const CAS Inputs*)__builtin_amdgcn_kernarg_segment_ptr();
    for (int u = F.tid; u < (LDS_BYTES - LDSCTL_OFF) / 4; u += NWAVES * 64) ((LAS unsigned*)(F.lds + LDSCTL_OFF))[u] = 0u;
    __syncthreads();
    const int lo = args.ph_lo, hi = args.ph_hi;
    const bool use_bar = (hi - lo) > 1;
    XcdBarrier bar; bar.bar = (GAS unsigned*)(F.ctl + CW_BAR); bar.x = 0; bar.st = nullptr;
    if (use_bar) bar = xcd_barrier_post((GAS unsigned*)(F.ctl + CW_BAR), F.MISC + 8);
#ifndef ONLYP
#define PH_EN(c) true
#else
#define PH_EN(c) ((c) == ONLYP)
#endif
#define INR(k) (lo <= (k) && (k) < hi)
#define PROBE_MASK 0
#define NREP(c) (((PROBE_MASK) >> (c)) & 1 ? 2 : 1)
#define FRESH() do { asm volatile("" : "+s"(F.ws_), "+s"(F.out_), "+s"(F.hc_), "+s"(F.ctl), "+s"(F.in), "+s"(F.G), "+s"(F.bid), "+s"(F.wave)); asm volatile("" : "+v"(F.tid)); F.lane = F.tid & 63; W = F.WS() + WS_W; MODB = (const float*)(F.WS() + WS_MOD); ACT = (bf16*)(F.WS() + WS_ACT); } while (0)
#define IN(k) (PH_EN((k) - P) && INR(k))
#define SEAM(k) do { if (INR(k) && INR((k) + 1)) { for (int rb = 0; rb < ((PROBE_MASK >> 20) & 1 ? 2 : 1); ++rb) { asm volatile("" : "+s"(bar.bar), "+s"(bar.x)); xcd_barrier(bar); } } } while (0)
    unsigned char* W; const float* MODB; bf16* ACT;
    volatile LAS int* MOE = (volatile LAS int*)(F.lds + MOE_LDS_OFF);
    LAS unsigned char* ring = F.lds + RING_OFF;

    for (int j = 0; j < 2; ++j) {
        const int P = j * PH_PER_PAIR, le = 2 * j, lod = 2 * j + 1;
        if (IN(P + 0)) { for (int rep = 0; rep < NREP(0); ++rep) { FRESH(); prep_phase(F, j); } } SEAM(P + 0);
        if (IN(P + 1)) { FRESH(); norm_phase(F, NormArgs{le, 0, j == 0, j > 0 ? j - 1 : -1, -1, 0}); } SEAM(P + 1);
        if (IN(P + 2)) { for (int rep = 0; rep < NREP(2); ++rep) { FRESH();
            SchedStatic S{ACT, 1024, (const bf16*)(W + WO_WIN_E), 1024, NTOK / 256, 4, F.G, F.bid};
            EpiWin E{(bf16*)(F.WS() + WS_PX), (bf16*)(F.WS() + WS_GT), (bf16*)(F.WS() + WS_GTC)};
            pg8::gemm_phase<EpiWin, SchedStatic>(ring, 1024, S, E, F.tid);
        } } SEAM(P + 2);
        if (IN(P + 3)) { for (int rep = 0; rep < NREP(3); ++rep) { FRESH();
            SchedStatic S{(const bf16*)(F.WS() + WS_PX) + 256, 512, (const bf16*)(W + WO_WUKV), 256, NTOK / 256, 6, F.G, F.bid};
            EpiKV E{(const bf16*)(F.WS() + WS_PX), (bf16*)(F.WS() + WS_K), (bf16*)(F.WS() + WS_VT), G(F.in->a_g_k) + j * 96, (const f32x2*)(F.WS() + WS_ROPE)};
            pg8::gemm_phase<EpiKV, SchedStatic>(ring, 256, S, E, F.tid);
        } } SEAM(P + 3);
        if (IN(P + 4)) { for (int rep = 0; rep < NREP(4); ++rep) { FRESH();
            {
                const bool latf = F.bid < 128; const int have = F.bid < 136;
                SchedOne S{latf ? (const bf16*)(F.WS() + WS_DFT) : (const bf16*)(F.WS() + WS_DFTC), latf ? 8192 : 512, latf ? (const bf16*)(F.WS() + WS_GT) : (const bf16*)(F.WS() + WS_GTC), latf ? 8192 : 512,
                           latf ? (F.bid >> 3) : 0, latf ? (F.bid & 7) : (F.bid - 128), have};
                EpiBf16 E{ACT, 1024, latf ? 1 : 2};
                pg8::gemm_phase<EpiBf16, SchedOne>(ring, S.K, S, E, F.tid);
            }
            __syncthreads();
            mla_attn_phase(F, j, rep);
        } } SEAM(P + 4);
        if (IN(P + 5)) { for (int rep = 0; rep < NREP(5); ++rep) { FRESH();
            SchedStatic S{ACT, 1024, (const bf16*)(W + WO_WOUT_E), 1024, NTOK / 256, 4, F.G, F.bid};
            EpiResid E{F.OUT(), F.HC(), MODB + (size_t)le * 9 * 6144, 2, rep + 1 < NREP(5)};
            pg8::gemm_phase<EpiResid, SchedStatic>(ring, 1024, S, E, F.tid);
        } } SEAM(P + 5);
        if (IN(P + 6)) { for (int rep = 0; rep < NREP(6); ++rep) { FRESH(); norm_phase(F, NormArgs{le, 1, 0, -1, -1, 0}); } } SEAM(P + 6);
        if (IN(P + 7)) { for (int rep = 0; rep < NREP(7); ++rep) { FRESH();
            SchedStatic S{ACT, 1024, (const bf16*)(W + WO_WGU_E), 1024, NTOK / 256, 2 * DFF / 256, F.G, F.bid};
            EpiSwiglu E{(bf16*)(F.WS() + WS_HMID), DFF};
            pg8::gemm_phase<EpiSwiglu, SchedStatic>(ring, 1024, S, E, F.tid);
        } } SEAM(P + 7);
        if (IN(P + 8)) { for (int rep = 0; rep < NREP(8); ++rep) { FRESH();
            SchedStatic S{(const bf16*)(F.WS() + WS_HMID), DFF, (const bf16*)(W + WO_WDN_E), DFF, NTOK / 256, 4, F.G, F.bid};
            EpiResid E{F.OUT(), F.HC(), MODB + (size_t)le * 9 * 6144, 5, rep + 1 < NREP(8)};
            pg8::gemm_phase<EpiResid, SchedStatic>(ring, DFF, S, E, F.tid);
        } } SEAM(P + 8);
        if (IN(P + 9)) { for (int rep = 0; rep < NREP(9); ++rep) { FRESH(); norm_phase(F, NormArgs{lod, 0, 0, -1, -1, 0}); } } SEAM(P + 9);
        if (IN(P + 10)) { for (int rep = 0; rep < NREP(10); ++rep) { FRESH();
            SchedStatic S{ACT, 1024, (const bf16*)(W + WO_WIN_O), 1024, NTOK / 256, 12, F.G, F.bid};
            EpiNAin E{(bf16*)(F.WS() + WS_QN), (bf16*)(F.WS() + WS_KN), (bf16*)(F.WS() + WS_VTN), G(F.in->c_g_q) + j * 64, G(F.in->c_g_k) + j * 64};
            pg8::gemm_phase<EpiNAin, SchedStatic>(ring, 1024, S, E, F.tid);
        } } SEAM(P + 10);
        if (IN(P + 11)) { for (int rep = 0; rep < NREP(11); ++rep) { FRESH(); na_phase(F, j); } } SEAM(P + 11);
        if (IN(P + 12)) { for (int rep = 0; rep < NREP(12); ++rep) { FRESH();
            SchedStatic S{ACT, 1024, (const bf16*)(W + WO_WOUT_O), 1024, NTOK / 256, 4, F.G, F.bid};
            EpiResid E{F.OUT(), F.HC(), MODB + (size_t)lod * 9 * 6144, 2, rep + 1 < NREP(12)};
            pg8::gemm_phase<EpiResid, SchedStatic>(ring, 1024, S, E, F.tid);
        } } SEAM(P + 12);
        if (IN(P + 13)) { FRESH(); norm_phase(F, NormArgs{lod, 1, 0, -1, j, 0}); } SEAM(P + 13);
        if (IN(P + 14)) { for (int rep = 0; rep < NREP(14); ++rep) { FRESH();
            moe_panels_to_lds(F, j);
            SchedMoe<true> S{ACT, 1024, (const bf16*)(W + WO_WGU_M), (size_t)2 * DFFE * 1024 * 2, 1024, 2 * DFFE / 256, F.G, F.bid, (const int*)(F.WS() + WS_LIST), MOE};
            EpiSwiglu E{(bf16*)(F.WS() + WS_HMOE), DFFE};
            pg8::gemm_phase<EpiSwiglu, SchedMoe<true>>(ring, 1024, S, E, F.tid);
        } } SEAM(P + 14);
        if (IN(P + 15)) { for (int rep = 0; rep < NREP(15); ++rep) { FRESH();
            moe_panels_to_lds(F, j);
            SchedMoe<false> S{(const bf16*)(F.WS() + WS_HMOE), DFFE, (const bf16*)(W + WO_WDN_M), (size_t)1024 * DFFE * 2, DFFE, 4, F.G, F.bid, nullptr, MOE};
            EpiBf16 E{(bf16*)(F.WS() + WS_Y), 1024, 0};
            pg8::gemm_phase<EpiBf16, SchedMoe<false>>(ring, DFFE, S, E, F.tid);
        } } SEAM(P + 15);
    }
    { const int P = 0; if (IN(2 * PH_PER_PAIR)) { FRESH(); norm_phase(F, NormArgs{3, 0, 0, 1, -1, 1}); } }
#undef IN
#undef INR
#undef SEAM
}

#if DBG

#endif

extern "C" void kernel_launch(void* const* d_in, const int* in_sizes, int n_in, void* d_out, int out_size, void* d_ws, size_t ws_size, hipStream_t stream) {
    static int grid = 0;
    if (grid == 0) {
        if (n_in != 27 || in_sizes[0] != NLAT * DM || out_size != NLAT * DM || ws_size < WS_END) {
            fprintf(stderr, "kernel_launch: built for 27 inputs, x/out of %d floats, >= %zu bytes of workspace; got n_in %d, in0 %d, out %d, ws %zu; nothing launched\n", NLAT * DM, (size_t)WS_END, n_in, n_in > 0 ? in_sizes[0] : -1, out_size, ws_size);
            grid = -1; return; }
        int dev = 0, cus = 0, per_cu = 0;
        if (hipGetDevice(&dev) != hipSuccess || hipDeviceGetAttribute(&cus, hipDeviceAttributeMultiprocessorCount, dev) != hipSuccess) { fprintf(stderr, "kernel_launch: device query failed\n"); grid = -1; return; }
        if (hipFuncSetAttribute((const void*)dit_fwd, hipFuncAttributeMaxDynamicSharedMemorySize, LDS_BYTES) != hipSuccess) { fprintf(stderr, "kernel_launch: hipFuncSetAttribute failed\n"); grid = -1; return; }
        if (hipOccupancyMaxActiveBlocksPerMultiprocessor(&per_cu, (const void*)dit_fwd, NWAVES * 64, LDS_BYTES) != hipSuccess || per_cu < 1) { fprintf(stderr, "kernel_launch: occupancy query reports %d workgroups per CU\n", per_cu); }
        (void)hipGetLastError();
        grid = cus;
    }
    if (grid < 0) return;
    if (hipMemsetAsync((char*)d_ws + WS_CTL, 0, CTL_ZERO_BYTES, stream) != hipSuccess) { fprintf(stderr, "kernel_launch: memset failed\n"); return; }
    Args a{};
    const float** ip = (const float**)(void*)&a.in;
    for (int i = 0; i < 27; ++i) ip[i] = (const float*)d_in[i];
    a.out = (float*)d_out; a.ws = (unsigned char*)d_ws;
#if DBG
    dbg_launch_all(a, grid, stream);
#else
    a.ph_lo = 0; a.ph_hi = N_PHASES;
    hipLaunchKernelGGL(dit_fwd, dim3(grid), dim3(NWAVES * 64), LDS_BYTES, stream, a);
    const hipError_t le = hipPeekAtLastError();
    if (le != hipSuccess) fprintf(stderr, "kernel_launch: launch failed: %s\n", hipGetErrorName(le));
#endif
}
```

```cpp
#include <hip/hip_runtime.h>
#include <cstdio>
#include <cstdint>

#define LAS __attribute__((address_space(3)))
#define GAS __attribute__((address_space(1)))
typedef unsigned short bf16;
typedef short bf16x8 __attribute__((ext_vector_type(8)));
typedef short bf16x4 __attribute__((ext_vector_type(4)));
typedef float f32x4 __attribute__((ext_vector_type(4)));
typedef float f32x2 __attribute__((ext_vector_type(2)));
typedef float f32x16 __attribute__((ext_vector_type(16)));
typedef unsigned u32x4 __attribute__((ext_vector_type(4)));
typedef unsigned u32x2 __attribute__((ext_vector_type(2)));

#define DBG 0

constexpr int DM = 1024, NB = 8, SEQ = 4096, CTXL = 256;
constexpr int NLAT = NB * SEQ, NCTX = NB * CTXL, NTOK = NLAT + NCTX;
constexpr int KPOS = SEQ + CTXL;
constexpr int A_HEADS = 12, A_QK = 96, A_IN_SRC = 672;
constexpr int C_HEADS = 16;
constexpr int DFF = 2816, NEXP = 8, DFFE = 1408;
constexpr int MOE_SLOTS = 2 * NTOK + NEXP * 256;
constexpr float EPS = 1e-6f;
constexpr float LOG2E = 1.4426950408889634f;

__device__ __forceinline__ unsigned f2bf(float f) { unsigned u = __builtin_bit_cast(unsigned, f); return (u + 0x7fffu + ((u >> 16) & 1u)) >> 16; }
__device__ __forceinline__ unsigned pk2(float lo, float hi) { return f2bf(lo) | (f2bf(hi) << 16); }
__device__ __forceinline__ float bf2f(unsigned short h) { return __builtin_bit_cast(float, (unsigned)h << 16); }
__device__ __forceinline__ float bflo(unsigned w) { return __builtin_bit_cast(float, w << 16); }
__device__ __forceinline__ float bfhi(unsigned w) { return __builtin_bit_cast(float, w & 0xffff0000u); }

namespace pg8 {
typedef unsigned u32x4 __attribute__((ext_vector_type(4)));
#define PG8_LAS __attribute__((address_space(3)))
constexpr int GN_LDS_OFF = 131072;
constexpr int BM = 256, BK = 64, HALF = 128, HTB = HALF * BK * 2  , STAGE_BYTES = 8 * HTB, NXCD = 8, WGM = 8;

__host__ __device__ __forceinline__ int lds_byte(int r, int c) { const int st = (r >> 4) * 2 + (c >> 5), rr = r & 15, cc = c & 31, ob = rr * 64 + cc * 2; return st * 1024 + (ob ^ (((ob >> 9) & 1) << 5)); }
__host__ __device__ __forceinline__ void stage_rc(int b, int& R, int& C) { const int st = b / 1024, sb = b % 1024, swz = sb ^ (((sb >> 9) & 1) << 5); R = (st >> 1) * 16 + swz / 64; C = (st & 1) * 32 + (swz % 64) / 2; }
__host__ __device__ __forceinline__ int perm32(int rho) { const int n = rho >> 4, i = rho & 15; return 8 * (i >> 2) + 4 * n + (i & 3); }

struct Unit { int pm, pn, kq; };

__device__ __forceinline__ bool static_next(int i, int G, int c, int nM, int nN, Unit& u) {
    const int nwg = nM * nN;
    const long L = (long)i * G + c; if (L >= nwg) return false;
    int wgid = (int)L; { const int q = nwg / NXCD, r = nwg % NXCD, xcd = wgid % NXCD, off = wgid / NXCD; wgid = (xcd < r ? xcd * (q + 1) : r * (q + 1) + (xcd - r) * q) + off; }
    const int nig = WGM * nN, gid = wgid / nig, fm = gid * WGM, gsz = (nM - fm) < WGM ? (nM - fm) : WGM;
    u.pm = fm + ((wgid % nig) % gsz); u.pn = (wgid % nig) / gsz; u.kq = -1; return true;
}

template <class Epi, class Sched, bool ALIGN_EPI = true, bool SP2 = true>
__device__ __forceinline__ void gemm_phase(PG8_LAS unsigned char* lds, const int K, const Sched& S, const Epi& E, const int tid) {
    const int wid = __builtin_amdgcn_readfirstlane(tid >> 6), lane = tid & 63, wr = wid >> 2, wc = wid & 3, fr = lane & 15, fq = lane >> 4;
    unsigned voffB[2], voffA[2];
    const unsigned lda = (unsigned)S.lda;
#pragma unroll
    for (int i = 0; i < 2; ++i) { int R, C; stage_rc(tid * 16 + i * 8192, R, C); const int Rb = Epi::PERM ? ((R & ~31) + perm32(R & 31)) : R;
        voffB[i] = (unsigned)(Rb * K + C) * 2u; voffA[i] = ((unsigned)R * lda + (unsigned)C) * 2u; }
    const char* const Ab = (const char*)S.A;
    const size_t kstep = (size_t)(BK * 2);
    const size_t hstep = (size_t)HALF * K * 2;
    const size_t hstepA = (size_t)HALF * lda * 2;
    const unsigned ldsw = (unsigned)wid * 1024u;
    const int aoff = lds_byte(wr * 64 + fr, fq * 8), boff = lds_byte(wc * 32 + fr, fq * 8);
#define PG8_SA(b, h) (((b) * 2 + (h)) * HTB)
#define PG8_SB(b, h) ((4 + (b) * 2 + (h)) * HTB)
#define PG8_STAGE(bufoff, gbase, voff) do { _Pragma("unroll") for (int _i = 0; _i < 2; ++_i) \
        __builtin_amdgcn_global_load_lds((const unsigned*)((const char*)(gbase) + (voff)[_i]), (PG8_LAS unsigned*)(lds + (bufoff) + ldsw + _i * 8192), 16, 0, 0); } while (0)
#define PG8_LDA(dst, b, h) do { _Pragma("unroll") for (int m = 0; m < 4; ++m) _Pragma("unroll") for (int k = 0; k < 2; ++k) dst[m][k] = *(const PG8_LAS bf16x8*)(lds + PG8_SA(b, h) + aoff + m * 2048 + k * 1024); } while (0)
#define PG8_LDB(dst, b, h) do { _Pragma("unroll") for (int n = 0; n < 2; ++n) _Pragma("unroll") for (int k = 0; k < 2; ++k) dst[n][k] = *(const PG8_LAS bf16x8*)(lds + PG8_SB(b, h) + boff + n * 2048 + k * 1024); } while (0)
#define PG8_MMA(ai, bj, At, Bt) do { __builtin_amdgcn_s_setprio(1); _Pragma("unroll") for (int m = 0; m < 4; ++m) _Pragma("unroll") for (int n = 0; n < 2; ++n) _Pragma("unroll") for (int k = 0; k < 2; ++k) \
        acc[ai][bj][m][n] = __builtin_amdgcn_mfma_f32_16x16x32_bf16(Bt[n][k], At[m][k], acc[ai][bj][m][n], 0, 0, 0); __builtin_amdgcn_s_setprio(0); } while (0)
#define PG8_WAIT_V(n) asm volatile("s_waitcnt vmcnt(" #n ")" ::: "memory")
#define PG8_WAIT_L(n) asm volatile("s_waitcnt lgkmcnt(" #n ")" ::: "memory")
#define PG8_BAR __builtin_amdgcn_s_barrier()
#define PG8_SCHED __builtin_amdgcn_sched_barrier(0)
    Unit cur, nxt; int ui = 0;
    if (!S.next(0, cur)) return;
    f32x4 acc[2][2][4][2];
    bf16x8 At[4][2], B0[2][2], B1[2][2];
    constexpr bool GATHER = Sched::GATHER;
    const char* cA = Ab; const char* nA = Ab;
    unsigned ga0[2] = {0u, 0u}, ga1[2] = {0u, 0u};
    PG8_LAS u32x4* const gnslot = (PG8_LAS u32x4*)(lds + GN_LDS_OFF) + tid;
    if constexpr (GATHER) {
#pragma unroll
        for (int i = 0; i < 2; ++i) { int R, C; stage_rc(tid * 16 + i * 8192, R, C); ga0[i] = (S.a_row(cur, R) * lda + (unsigned)C) * 2u; ga1[i] = (S.a_row(cur, HALF + R) * lda + (unsigned)C) * 2u; }
    } else { cA = Ab + (size_t)S.a_row(cur, 0) * lda * 2 + (size_t)S.k0(cur) * (BK * 2); }
    const char* cB = S.b_base(cur) + (size_t)S.k0(cur) * (BK * 2);
    int nt = S.nt(cur), ntn = nt;
#define PG8_STAGE_A(bufoff, h, uptr, kb, g0, g1) do { if constexpr (GATHER) { if (h) PG8_STAGE(bufoff, Ab + (kb), g1); else PG8_STAGE(bufoff, Ab + (kb), g0); } \
        else { PG8_STAGE(bufoff, (uptr) + (h) * hstepA + (kb), voffA); } } while (0)
    static_assert(SP2, "only the SP2 loop is carried here");
    PG8_STAGE(PG8_SB(0, 0), cB, voffB); PG8_STAGE(PG8_SB(0, 1), cB + hstep, voffB); PG8_STAGE_A(PG8_SA(0, 0), 0, cA, 0, ga0, ga1); PG8_STAGE_A(PG8_SA(0, 1), 1, cA, 0, ga0, ga1);
    if (wr == 1) PG8_BAR;
    PG8_WAIT_V(2); PG8_BAR;
    PG8_STAGE(PG8_SB(1, 0), cB + kstep, voffB); PG8_STAGE_A(PG8_SA(1, 0), 0, cA, kstep, ga0, ga1); PG8_STAGE(PG8_SB(1, 1), cB + hstep + kstep, voffB);
    PG8_WAIT_V(6); PG8_BAR;
    for (;;) {
        const bool has_next = S.next(ui + 1, nxt);
        const char* nB = has_next ? S.b_base(nxt) + (size_t)S.k0(nxt) * (BK * 2) : cB;
        ntn = has_next ? S.nt(nxt) : nt;
        if constexpr (GATHER) {
            u32x4 gn = (u32x4){ga0[0], ga0[1], ga1[0], ga1[1]};
            if (has_next) { int R0, C0, R1, C1; stage_rc(tid * 16, R0, C0); stage_rc(tid * 16 + 8192, R1, C1);
                gn.x = (S.a_row(nxt, R0) * lda + (unsigned)C0) * 2u; gn.y = (S.a_row(nxt, R1) * lda + (unsigned)C1) * 2u;
                gn.z = (S.a_row(nxt, HALF + R0) * lda + (unsigned)C0) * 2u; gn.w = (S.a_row(nxt, HALF + R1) * lda + (unsigned)C1) * 2u; }
            *gnslot = gn;
        } else { nA = has_next ? Ab + (size_t)S.a_row(nxt, 0) * lda * 2 + (size_t)S.k0(nxt) * (BK * 2) : cA; }
#pragma unroll
        for (int a = 0; a < 2; ++a)
#pragma unroll
            for (int b = 0; b < 2; ++b)
#pragma unroll
                for (int m = 0; m < 4; ++m)
#pragma unroll
                    for (int n = 0; n < 2; ++n) acc[a][b][m][n] = (f32x4){0.f, 0.f, 0.f, 0.f};
#pragma nounroll
        for (int t = 0; t < nt; t += 2) {
            const bool last = (t == nt - 2);
            const size_t k1 = (size_t)(t + 1) * kstep, k2 = last ? 0 : (size_t)(t + 2) * kstep, k3 = k2 + kstep;
            const char* u2 = last ? nA : cA;
            const char* b2 = last ? nB : cB + (size_t)(t + 2) * kstep; const char* b3 = b2 + kstep;
            unsigned o20[2] = {0u, 0u}, o21[2] = {0u, 0u};
            if constexpr (GATHER) {
                if (last) { const u32x4 gn = *gnslot; o20[0] = gn.x; o20[1] = gn.y; o21[0] = gn.z; o21[1] = gn.w; }
                else { o20[0] = ga0[0]; o20[1] = ga0[1]; o21[0] = ga1[0]; o21[1] = ga1[1]; }
            }
            PG8_LDB(B0, 0, 0); PG8_LDB(B1, 0, 1); PG8_SCHED; PG8_LDA(At, 0, 0); PG8_STAGE_A(PG8_SA(1, 1), 1, cA, k1, ga0, ga1);
            PG8_WAIT_V(8); PG8_WAIT_L(0); PG8_BAR; PG8_MMA(0, 0, At, B0); PG8_MMA(0, 1, At, B1); PG8_BAR; PG8_SCHED;
            PG8_LDA(At, 0, 1); PG8_STAGE(PG8_SB(0, 0), b2, voffB); PG8_STAGE(PG8_SB(0, 1), b2 + hstep, voffB); PG8_STAGE_A(PG8_SA(0, 0), 0, u2, k2, o20, o21);
            PG8_WAIT_V(8); PG8_WAIT_L(0); PG8_BAR; PG8_MMA(1, 0, At, B0); PG8_MMA(1, 1, At, B1); PG8_BAR; PG8_SCHED;
            PG8_LDB(B0, 1, 0); PG8_LDB(B1, 1, 1); PG8_SCHED; PG8_LDA(At, 1, 0); PG8_STAGE_A(PG8_SA(0, 1), 1, u2, k2, o20, o21);
            PG8_WAIT_V(8); PG8_WAIT_L(0); PG8_BAR; PG8_MMA(0, 0, At, B0); PG8_MMA(0, 1, At, B1); PG8_BAR; PG8_SCHED;
            PG8_LDA(At, 1, 1); PG8_STAGE(PG8_SB(1, 0), b3, voffB); PG8_STAGE(PG8_SB(1, 1), b3 + hstep, voffB); PG8_STAGE_A(PG8_SA(1, 0), 0, u2, k3, o20, o21);
            PG8_WAIT_V(8); PG8_WAIT_L(0); PG8_BAR; PG8_MMA(1, 0, At, B0); PG8_MMA(1, 1, At, B1); PG8_BAR; PG8_SCHED;
        }
        if constexpr (ALIGN_EPI) { if (wr == 0) PG8_BAR; }
        { int fr_ = fr, fq_ = fq, wr_ = wr, wc_ = wc; asm volatile("" : "+v"(fr_), "+v"(fq_), "+s"(wr_), "+s"(wc_));
          E(acc, cur, wr_, wc_, fr_, fq_); }
        if (!has_next) break;
        cur = nxt; cB = nB; cA = nA; nt = ntn; ++ui;
        if constexpr (GATHER) { const u32x4 gn = *gnslot; ga0[0] = gn.x; ga0[1] = gn.y; ga1[0] = gn.z; ga1[1] = gn.w; }
        if constexpr (ALIGN_EPI) { if (wr == 1) PG8_BAR; }
    }
    PG8_WAIT_V(0);
    if constexpr (!ALIGN_EPI) { if (wr == 0) PG8_BAR; }
    PG8_BAR;
#undef PG8_SA
#undef PG8_SB
#undef PG8_STAGE
#undef PG8_STAGE_A
#undef PG8_LDA
#undef PG8_LDB
#undef PG8_MMA
#undef PG8_WAIT_V
#undef PG8_WAIT_L
#undef PG8_BAR
#undef PG8_SCHED
}
}

constexpr size_t MiB = 1u << 20;
constexpr size_t WS_CTL = 0, CTL_ZERO_BYTES = 1 * MiB;
constexpr size_t WS_MOD = 1 * MiB;
constexpr size_t WS_ROPE = 2 * MiB;
constexpr size_t WS_ROUTE = 3 * MiB;
constexpr size_t WS_LIST = 4 * MiB;
constexpr size_t WS_SNAP = 6 * MiB;
constexpr size_t WS_HC = 8 * MiB;
constexpr size_t WS_W = 16 * MiB;
constexpr size_t WS_DFT = 114 * MiB;
constexpr size_t WS_DFTC = WS_DFT + 64 * MiB;
constexpr size_t WS_SCR = 180 * MiB;
constexpr size_t WS_ACT = WS_SCR;
constexpr size_t WS_PX = WS_SCR + 68 * MiB;
constexpr size_t WS_GT = WS_SCR + 102 * MiB;
constexpr size_t WS_GTC = WS_SCR + 134 * MiB;
constexpr size_t WS_K = WS_SCR + 136 * MiB;
constexpr size_t WS_VT = WS_SCR + 213 * MiB;
constexpr size_t WS_HMID = WS_SCR + 68 * MiB;
constexpr size_t WS_QN = WS_SCR + 68 * MiB;
constexpr size_t WS_KN = WS_SCR + 136 * MiB;
constexpr size_t WS_VTN = WS_SCR + 204 * MiB;
constexpr size_t WS_HMOE = WS_SCR + 68 * MiB;
constexpr size_t WS_Y = WS_SCR + 261 * MiB;
constexpr size_t WS_PART = WS_SCR + 272 * MiB;
constexpr size_t WS_END = WS_SCR + 401 * MiB;
static_assert((size_t)NTOK * 1024 * 2 <= 68 * MiB && (size_t)NTOK * 512 * 2 <= 34 * MiB && (size_t)NB * A_HEADS * KPOS * 96 * 2 <= 77 * MiB && (size_t)NB * A_HEADS * 64 * KPOS * 2 <= 51 * MiB, "even map");
static_assert((size_t)NTOK * DFF * 2 <= 196 * MiB && (size_t)NB * C_HEADS * 64 * KPOS * 2 <= 68 * MiB + 4 * MiB && (size_t)MOE_SLOTS * DFFE * 2 <= 193 * MiB && (size_t)MOE_SLOTS * 1024 * 2 <= 140 * MiB, "odd map");
constexpr size_t WO_WIN_E = 0, WO_WUKV = 2 * MiB, WO_WUQ = 3 * MiB, WO_WOUT_E = 4 * MiB, WO_WGU_E = 6 * MiB, WO_WDN_E = 17 * MiB;
constexpr size_t WO_WIN_O = 23 * MiB, WO_WOUT_O = 29 * MiB, WO_WGU_M = 31 * MiB, WO_WDN_M = 75 * MiB;
constexpr int CW_BAR = 4096;
constexpr int CW_MOECNT = 8192;
constexpr int CW_ATTQ = 8192 + 256;
constexpr int CW_CHK = 16384;

constexpr int RING_OFF = 0, RING_BYTES = 131072;
constexpr int LDS_BYTES = 163840;
constexpr int LDSCTL_OFF = LDS_BYTES - 1024, MISC_OFF = LDSCTL_OFF + 320;
constexpr int MOE_LDS_OFF = MISC_OFF + 128;
static_assert(MOE_LDS_OFF + 128 <= LDS_BYTES && pg8::GN_LDS_OFF == RING_BYTES && pg8::GN_LDS_OFF + 512 * 16 <= LDSCTL_OFF, "LDS map");
constexpr int NWAVES = 8;

#define CAS __attribute__((address_space(4)))
typedef GAS unsigned gu32;
#define RLX_AGENT __ATOMIC_RELAXED, __HIP_MEMORY_SCOPE_AGENT
#define LDS_WAIT() asm volatile("s_waitcnt lgkmcnt(0)" ::: "memory")
#define VM_WAIT() asm volatile("s_waitcnt vmcnt(0)" ::: "memory")

#define XB_TMO      128
#define XB_XCNT(j)  (256  + 64 * (j))
#define XB_XSUB(j)  (1280 + 64 * (j))
#define XB_XGEN(j)  (2304 + 64 * (j))
#define XB_TOP      3328
#define XB_TOPGEN   3392
#define XCD_BAR_WORDS 3456
#define XB_SPIN_CAP (1u << 18)

__device__ __forceinline__ unsigned xb_ld(GAS unsigned* p)              { return __hip_atomic_load(p, __ATOMIC_RELAXED, __HIP_MEMORY_SCOPE_AGENT); }
__device__ __forceinline__ unsigned xb_add(GAS unsigned* p, unsigned v) { return __hip_atomic_fetch_add(p, v, __ATOMIC_RELAXED, __HIP_MEMORY_SCOPE_AGENT); }
__device__ __forceinline__ unsigned xb_xcc_id() { return (unsigned)__builtin_amdgcn_s_getreg((3 << 11) | 20) & 0xFu; }
#define XB_SPIN(cond, bar) do { unsigned _sp = 0; while (cond) { __builtin_amdgcn_s_sleep(1); \
    if ((++_sp & 255u) == 0u) { if (xb_ld(&(bar)[XB_TMO])) break; if (_sp > XB_SPIN_CAP) { (void)xb_add(&(bar)[XB_TMO], 1u); break; } } } } while (0)

struct XcdBarrier {
    GAS unsigned* bar; unsigned x;
    volatile LAS unsigned* st;
};
__device__ __forceinline__ XcdBarrier xcd_barrier_post(GAS unsigned* bar, volatile LAS unsigned* st) {
    XcdBarrier b; b.bar = bar; b.x = xb_xcc_id(); b.st = st;
    if (threadIdx.x == 0) (void)xb_add(&bar[XB_XCNT(b.x)], 1u);
    return b;
}
__device__ __forceinline__ void xcd_barrier_complete(GAS unsigned* bar, unsigned x, unsigned& nloc, unsigned& nx) {
    const unsigned G = gridDim.x * gridDim.y * gridDim.z;
    unsigned sum, cnt, mine, sp = 0u;
    for (;;) {
        sum = 0u; cnt = 0u; mine = 0u;
#pragma unroll
        for (unsigned j = 0; j < 16; ++j) { const unsigned c = xb_ld(&bar[XB_XCNT(j)]); sum += c; cnt += (c > 0u) ? 1u : 0u; mine = (j == x) ? c : mine; }
        if (sum == G) break;
        __builtin_amdgcn_s_sleep(1);
        if ((++sp & 255u) == 0u) { if (xb_ld(&bar[XB_TMO])) break; if (sp > XB_SPIN_CAP) { (void)xb_add(&bar[XB_TMO], 1u); break; } }
    }
    nloc = mine > 0u ? mine : 1u; nx = cnt > 0u ? cnt : 1u;
}
__device__ __forceinline__ void xcd_barrier(const XcdBarrier& b) {
    asm volatile("s_waitcnt vmcnt(0)" ::: "memory");
    __syncthreads();
    if (threadIdx.x == 0) {
        GAS unsigned* bar = b.bar;
        __builtin_amdgcn_s_waitcnt(0);
        unsigned nloc = b.st[0], nx = b.st[1];
        if (nloc == 0u) { xcd_barrier_complete(bar, b.x, nloc, nx); b.st[0] = nloc; b.st[1] = nx; }
        const unsigned old = xb_add(&bar[XB_XSUB(b.x)], 1u);
        const unsigned gen = old / nloc;
        if (old + 1u == (gen + 1u) * nloc) {
            __builtin_amdgcn_fence(__ATOMIC_RELEASE, "agent");
            asm volatile("s_waitcnt vmcnt(0)" ::: "memory");
            const unsigned og = xb_add(&bar[XB_TOP], 1u);
            const unsigned tg = og / nx;
            if (og + 1u == (tg + 1u) * nx) xb_add(&bar[XB_TOPGEN], 1u);
            else XB_SPIN(xb_ld(&bar[XB_TOPGEN]) == tg, bar);
            __builtin_amdgcn_fence(__ATOMIC_ACQUIRE, "agent");
            xb_add(&bar[XB_XGEN(b.x)], 1u);
            asm volatile("s_waitcnt vmcnt(0)" ::: "memory");
        } else {
            XB_SPIN(xb_ld(&bar[XB_XGEN(b.x)]) == gen, bar);
            __builtin_amdgcn_fence(__ATOMIC_ACQUIRE, "agent");
            asm volatile("s_waitcnt vmcnt(0)" ::: "memory");
        }
    }
    __syncthreads();
}

struct Inputs {
    const float *x, *c, *ctx, *c_ctx, *w_mod, *b_mod, *norm_g;
    const float *a_w_in, *a_g_cq, *a_g_ckv, *a_w_uq, *a_w_ukv, *a_g_q, *a_g_k, *a_w_out;
    const float *f_w_gate, *f_w_up, *f_w_down;
    const float *c_w_in, *c_g_q, *c_g_k, *c_rpb, *c_w_out;
    const float *m_w_router, *m_w_gate, *m_w_up, *m_w_down;
};
template <class T> __device__ __forceinline__ T* G(T* p) { GAS T* g = (GAS T*)p; asm volatile("" : "+s"(g)); return (T*)g; }
struct Frame {
    LAS unsigned char* lds;
    volatile LAS unsigned* MISC;
    gu32* ctl;
    GAS unsigned char* ws_;
    GAS float* out_;
    GAS float* hc_;
    __device__ __forceinline__ unsigned char* WS() const { return (unsigned char*)ws_; }
    __device__ __forceinline__ float* OUT() const { return (float*)out_; }
    __device__ __forceinline__ float* HC() const { return (float*)hc_; }
    int tid, lane, wave, G, bid;
    const CAS Inputs* in;
};
__device__ __forceinline__ float* hrow(const Frame& F, int r) { return r < NLAT ? F.OUT() + (size_t)r * DM : F.HC() + (size_t)(r - NLAT) * DM; }
__device__ __forceinline__ int row_b9(int r) { return r < NLAT ? (r >> 12) : 8; }
__device__ __forceinline__ const float* modp(const Frame& F, int layer, int b9, int k) { return (const float*)(F.WS() + WS_MOD) + ((size_t)layer * 9 + b9) * 6144 + k * 1024; }

__device__ __forceinline__ float wave_sum(float v) {
#pragma unroll
    for (int o = 1; o < 64; o <<= 1) v += __shfl_xor(v, o);
    return v;
}

struct WMap { int which; int col; };
__device__ __forceinline__ WMap wmap(int mode, int n, int nsrc) {
    WMap r; r.which = 0;
    const int pn = n >> 8, ct = n & 255, bj = ct >> 7, wc = (ct >> 5) & 3, w = ct & 31;
    if (mode == 0) { r.col = n < nsrc ? n : -1; }
    else if (mode == 1) { const int head = 2 * pn + (wc >> 1), part = wc & 1; r.col = head * 128 + part * 64 + 32 * bj + w; }
    else if (mode == 2) { const int nn = (ct >> 4) & 1, fq = (ct >> 2) & 3, e = ct & 3; r.which = nn; r.col = pn * 128 + bj * 64 + wc * 16 + fq * 4 + e; }
    else { r.col = (pn * 4 + wc) * 64 + 32 * bj + w; }
    return r;
}
__device__ __forceinline__ void wconv_item(const float* W0, const float* W1, int ld, int Ksrc, int nsrc, const float* kscale, bf16* WT, int Kdst, int mode, int kb, int nb, LAS float* scr, int lane) {
    const int k0 = 64 * kb, n0 = 64 * nb, n4 = (lane & 15) * 4;
    const WMap mp = wmap(mode, n0 + n4, nsrc);
    const float* W = mp.which ? W1 : W0;
#pragma unroll 4
    for (int i = 0; i < 16; ++i) { const int kk = (lane >> 4) + 4 * i, k = k0 + kk; f32x4 v = (f32x4){0.f, 0.f, 0.f, 0.f};
        if (mp.col >= 0 && k < Ksrc) { v = *(const f32x4*)(W + (size_t)k * ld + mp.col); if (kscale) v = v * kscale[k]; }
        LAS float* d = scr + kk * 65 + n4; d[0] = v.x; d[1] = v.y; d[2] = v.z; d[3] = v.w; }
    LDS_WAIT(); asm volatile("" ::: "memory");
#pragma unroll
    for (int c = 0; c < 8; ++c) { const LAS float* s = scr + (8 * c) * 65 + lane;
        u32x4 o; o.x = pk2(s[0 * 65], s[1 * 65]); o.y = pk2(s[2 * 65], s[3 * 65]); o.z = pk2(s[4 * 65], s[5 * 65]); o.w = pk2(s[6 * 65], s[7 * 65]);
        *(GAS u32x4*)(WT + (size_t)(n0 + lane) * Kdst + k0 + 8 * c) = o; }
    LDS_WAIT(); asm volatile("" ::: "memory");
}
struct WJob { const float* W0; const float* W1; int ld, Ksrc, nsrc; const float* kscale; bf16* WT; int Kdst, Ndst, mode; };
__device__ __forceinline__ bool wjob_run(const WJob& J, int& r, LAS float* scr, int lane) {
    const int nblk = J.Ndst / 64, items = (J.Kdst / 64) * nblk;
    if (r < items) { wconv_item(J.W0, J.W1, J.ld, J.Ksrc, J.nsrc, J.kscale, J.WT, J.Kdst, J.mode, r / nblk, r % nblk, scr, lane); return true; }
    r -= items; return false;
}

__device__ __forceinline__ void prep_phase(Frame& F, int j) {
    const CAS Inputs& I = *F.in;
    unsigned char* W = F.WS() + WS_W;
    if (j == 0) {
        LAS float* sv = (LAS float*)(F.lds);
        LAS float* red = (LAS float*)(F.lds + 40960);
        for (int idx = F.tid; idx < 9 * 1024; idx += NWAVES * 64) { const int r = idx >> 10, k = idx & 1023; const float cv = r < 8 ? G(I.c)[r * 1024 + k] : G(I.c_ctx)[k]; sv[idx] = cv / (1.f + __expf(-cv)); }
        __syncthreads();
        for (int it = F.bid; it < 4 * 96; it += F.G) {
            const int layer = it / 96, chunk = it % 96, n = chunk * 64 + F.lane;
            const float* wm = G(I.w_mod) + (size_t)layer * 1024 * 6144 + n;
            float acc[9];
#pragma unroll
            for (int r = 0; r < 9; ++r) acc[r] = 0.f;
            const int kb = F.wave * 128;
#pragma unroll 4
            for (int k = 0; k < 128; ++k) { const float wv = wm[(size_t)(kb + k) * 6144];
#pragma unroll
                for (int r = 0; r < 9; ++r) acc[r] += sv[r * 1024 + kb + k] * wv; }
#pragma unroll
            for (int r = 0; r < 9; ++r) red[(F.wave * 9 + r) * 64 + F.lane] = acc[r];
            __syncthreads();
            for (int idx = F.tid; idx < 9 * 64; idx += NWAVES * 64) { const int r = idx >> 6, l = idx & 63; float s = 0.f;
#pragma unroll
                for (int w = 0; w < 8; ++w) s += red[(w * 9 + r) * 64 + l];
                const int nn = chunk * 64 + l;
                ((float*)(F.WS() + WS_MOD))[((size_t)layer * 9 + r) * 6144 + nn] = s + G(I.b_mod)[layer * 6144 + nn]; }
            __syncthreads();
        }
        if (F.bid == 0) { const int pos = F.tid >> 3, f = F.tid & 7; const float inv = powf(10000.f, -(float)f / 8.f); const float ang = (float)pos * inv;
            ((f32x2*)(F.WS() + WS_ROPE))[F.tid] = (f32x2){cosf(ang), sinf(ang)}; }
        __syncthreads();
        LAS f32x2* tab = (LAS f32x2*)(F.lds);
        for (int m = F.tid; m < 4096; m += NWAVES * 64) { float s, c; sincospif((float)m * (1.f / 2048.f), &s, &c); tab[m] = (f32x2){c, s}; }
        __syncthreads();
        bf16* DF = (bf16*)(F.WS() + WS_DFT);
        for (int q = F.bid * (NWAVES * 64) + F.tid; q < 4096 * 1024; q += F.G * NWAVES * 64) {
            const int np = q >> 10, kk0 = (q & 1023) * 8, type = kk0 >= 4096, n = kk0 & 4095; float v[8];
#pragma unroll
            for (int e = 0; e < 8; ++e) { const f32x2 t = tab[(np * (n + e)) & 4095]; v[e] = (type ? -t.y : t.x) * (1.f / 512.f); }
            u32x4 o; o.x = pk2(v[0], v[1]); o.y = pk2(v[2], v[3]); o.z = pk2(v[4], v[5]); o.w = pk2(v[6], v[7]);
            *(GAS u32x4*)(DF + (size_t)np * 8192 + kk0) = o;
        }
        bf16* DC = (bf16*)(F.WS() + WS_DFTC);
        for (int q = F.bid * (NWAVES * 64) + F.tid; q < 256 * 64; q += F.G * NWAVES * 64) {
            const int np = q >> 6, kk0 = (q & 63) * 8, type = kk0 >= 256, n = kk0 & 255; float v[8];
#pragma unroll
            for (int e = 0; e < 8; ++e) { const f32x2 t = tab[((np * (n + e)) & 255) * 16]; v[e] = (type ? -t.y : t.x) * (1.f / 128.f); }
            u32x4 o; o.x = pk2(v[0], v[1]); o.y = pk2(v[2], v[3]); o.z = pk2(v[4], v[5]); o.w = pk2(v[6], v[7]);
            *(GAS u32x4*)(DC + (size_t)np * 512 + kk0) = o;
        }
        __syncthreads();
    }
    {
        LAS float* scr = (LAS float*)(F.lds + F.wave * 16896);
        const int gw = F.bid * NWAVES + F.wave, NGW = F.G * NWAVES;
        const float* a_w_in = G(I.a_w_in) + (size_t)j * 1024 * 672;
        WJob J0{a_w_in, a_w_in, 672, 1024, 416, nullptr, (bf16*)(W + WO_WIN_E), 1024, 512, 0};
        WJob J2{G(I.a_w_ukv) + (size_t)j * 128 * 1536, nullptr, 1536, 128, 1536, G(I.a_g_ckv) + j * 128, (bf16*)(W + WO_WUKV), 256, 1536, 1};
        WJob J3{G(I.a_w_uq) + (size_t)j * 256 * 1152, nullptr, 1152, 256, 1152, G(I.a_g_cq) + j * 256, (bf16*)(W + WO_WUQ), 256, 1152, 0};
        WJob J4{G(I.a_w_out) + (size_t)j * 1024 * 1024, nullptr, 1024, 1024, 1024, nullptr, (bf16*)(W + WO_WOUT_E), 1024, 1024, 0};
        WJob J5{G(I.f_w_gate) + (size_t)j * 1024 * DFF, G(I.f_w_up) + (size_t)j * 1024 * DFF, DFF, 1024, DFF, nullptr, (bf16*)(W + WO_WGU_E), 1024, 2 * DFF, 2};
        WJob J6{G(I.f_w_down) + (size_t)j * DFF * 1024, nullptr, 1024, DFF, 1024, nullptr, (bf16*)(W + WO_WDN_E), DFF, 1024, 0};
        WJob J7{G(I.c_w_in) + (size_t)j * 1024 * 3072, nullptr, 3072, 1024, 3072, nullptr, (bf16*)(W + WO_WIN_O), 1024, 3072, 3};
        WJob J8{G(I.c_w_out) + (size_t)j * 1024 * 1024, nullptr, 1024, 1024, 1024, nullptr, (bf16*)(W + WO_WOUT_O), 1024, 1024, 0};
        constexpr int IT_GU = (1024 / 64) * (2 * DFFE / 64), IT_DN = (DFFE / 64) * (1024 / 64);
        const int fixed = 16 * 8 + 4 * 24 + 4 * 18 + 16 * 16 + 16 * 88 + 44 * 16 + 16 * 48 + 16 * 16;
        const int total = fixed + NEXP * (IT_GU + IT_DN);
        for (int it = gw; it < total; it += NGW) {
            int r = it;
            if (wjob_run(J0, r, scr, F.lane)) continue;
            if (wjob_run(J2, r, scr, F.lane)) continue;
            if (wjob_run(J3, r, scr, F.lane)) continue;
            if (wjob_run(J4, r, scr, F.lane)) continue;
            if (wjob_run(J5, r, scr, F.lane)) continue;
            if (wjob_run(J6, r, scr, F.lane)) continue;
            if (wjob_run(J7, r, scr, F.lane)) continue;
            if (wjob_run(J8, r, scr, F.lane)) continue;
            if (r < NEXP * IT_GU) { const int e = r / IT_GU, rr = r % IT_GU; const size_t eo = ((size_t)j * NEXP + e) * 1024 * DFFE;
                wconv_item(G(I.m_w_gate) + eo, G(I.m_w_up) + eo, DFFE, 1024, DFFE, nullptr, (bf16*)(W + WO_WGU_M) + (size_t)e * 2 * DFFE * 1024, 1024, 2, rr / (2 * DFFE / 64), rr % (2 * DFFE / 64), scr, F.lane); continue; }
            r -= NEXP * IT_GU;
            { const int e = r / IT_DN, rr = r % IT_DN; const size_t eo = ((size_t)j * NEXP + e) * DFFE * 1024;
                wconv_item(G(I.m_w_down) + eo, nullptr, 1024, DFFE, 1024, nullptr, (bf16*)(W + WO_WDN_M) + (size_t)e * 1024 * DFFE, DFFE, 0, rr / 16, rr % 16, scr, F.lane); }
        }
        __syncthreads();
        LAS f32x2* t64 = (LAS f32x2*)(F.lds);
        if (F.tid < 64) { float s, c; sincospif((float)F.tid * (1.f / 32.f), &s, &c); t64[F.tid] = (f32x2){c, s}; }
        __syncthreads();
        bf16* WE = (bf16*)(W + WO_WIN_E);
        for (int it = gw; it < 1024 * 4; it += NGW) {
            const int k = it >> 2, g = it & 3;
            const float f = a_w_in[(size_t)k * 672 + 416 + 64 * g + F.lane];
            float ac = 0.f, as = 0.f;
#pragma unroll 8
            for (int c = 0; c < 64; ++c) { const float fc = __shfl(f, c); const f32x2 t = t64[(c * F.lane) & 63]; ac += fc * t.x; as += fc * t.y; }
            WE[(size_t)(512 + g * 64 + F.lane) * 1024 + k] = (bf16)f2bf(ac);
            WE[(size_t)(768 + g * 64 + F.lane) * 1024 + k] = (bf16)f2bf(as);
        }
        __syncthreads();
    }
}

__device__ __forceinline__ void moe_panels_to_lds(Frame& F, int pair) {
    volatile LAS int* MOE = (volatile LAS int*)(F.lds + MOE_LDS_OFF);
    if (F.tid == 0) { int p = 0;
        for (int e = 0; e < NEXP; ++e) { const int c = (int)__hip_atomic_load(F.ctl + CW_MOECNT + 64 * pair + e, RLX_AGENT); MOE[e] = p; MOE[16 + e] = c; p += (c + 255) >> 8; }
        MOE[8] = p; }
    __syncthreads();
}
struct NormArgs { int layer, which, from_inputs, combine_pair, router_pair, lat_only, add_part; };
__device__ __forceinline__ void norm_phase(Frame& F, const NormArgs a) {
    const CAS Inputs& I = *F.in;
    volatile LAS int* MOE = (volatile LAS int*)(F.lds + MOE_LDS_OFF);
    LAS float* wr = (LAS float*)(F.lds);
    volatile LAS int* lcnt = (volatile LAS int*)(F.lds + 32768);
    volatile LAS int* stash = (volatile LAS int*)(F.lds + 32768 + 256);
    if (a.combine_pair >= 0) moe_panels_to_lds(F, a.combine_pair);
    if (a.router_pair >= 0) {
        const float* wsrc = G(I.m_w_router) + (size_t)a.router_pair * 1024 * NEXP;
        for (int idx = F.tid; idx < 1024 * NEXP; idx += NWAVES * 64) wr[idx] = wsrc[idx];
        if (F.tid < 16) lcnt[F.tid] = 0;
        __syncthreads();
    }
    const int* te = (const int*)(F.WS() + WS_ROUTE); const int* tr = te + 2 * NTOK; const float* tg = (const float*)(tr + 2 * NTOK);
    const bf16* Y = (const bf16*)(F.WS() + WS_Y);
    bf16* XN = (bf16*)(F.WS() + WS_ACT);
    const int nrows = a.lat_only ? NLAT : NTOK;
    const bool final_only = a.lat_only && a.router_pair < 0;
    const int nk = (nrows - F.bid + F.G - 1) / F.G;
    for (int k = F.wave; k < nk; k += NWAVES) {
        const int row = F.bid + F.G * k;
        const int b9 = row_b9(row);
        float* hp = hrow(F, row);
        const float* src = a.from_inputs ? (row < NLAT ? G(I.x) + (size_t)row * DM : G(I.ctx) + (size_t)(row - NLAT) * DM) : hp;
        f32x4 v[4];
#pragma unroll
        for (int j = 0; j < 4; ++j) v[j] = ((const f32x4*)src)[F.lane + 64 * j];
        if (a.combine_pair >= 0) {
            const int e1 = te[2 * row], e2 = te[2 * row + 1], r1 = tr[2 * row], r2 = tr[2 * row + 1];
            const float g1 = tg[2 * row], g2 = tg[2 * row + 1];
            const size_t s1 = (size_t)MOE[e1] * 256 + r1, s2 = (size_t)MOE[e2] * 256 + r2;
            const float* gm = modp(F, 2 * a.combine_pair + 1, b9, 5);
#pragma unroll
            for (int j = 0; j < 4; ++j) {
                const u32x2 y1 = *(const u32x2*)(Y + s1 * 1024 + 256 * j + 4 * F.lane), y2 = *(const u32x2*)(Y + s2 * 1024 + 256 * j + 4 * F.lane);
                const f32x4 gg = ((const f32x4*)gm)[F.lane + 64 * j];
                v[j].x += gg.x * (g1 * bflo(y1.x) + g2 * bflo(y2.x)); v[j].y += gg.y * (g1 * bfhi(y1.x) + g2 * bfhi(y2.x));
                v[j].z += gg.z * (g1 * bflo(y1.y) + g2 * bflo(y2.y)); v[j].w += gg.w * (g1 * bfhi(y1.y) + g2 * bfhi(y2.y));
            }
        }
        const bool parts = a.add_part && row >= NLAT;
        if (parts) {
            const float* pp = (const float*)(F.WS() + WS_PART) + (size_t)(row - NLAT) * DM;
#pragma unroll
            for (int q = 0; q < 4; ++q)
#pragma unroll
                for (int j = 0; j < 4; ++j) v[j] = v[j] + ((const f32x4*)(pp + (size_t)q * NCTX * DM))[F.lane + 64 * j];
        }
        if (a.from_inputs || a.combine_pair >= 0 || parts) {
#pragma unroll
            for (int j = 0; j < 4; ++j) ((f32x4*)hp)[F.lane + 64 * j] = v[j];
        }
        if (final_only) continue;
        float ss = 0.f;
#pragma unroll
        for (int j = 0; j < 4; ++j) ss += (v[j].x * v[j].x + v[j].y * v[j].y) + (v[j].z * v[j].z + v[j].w * v[j].w);
        const float rstd = 1.0f / sqrtf(wave_sum(ss) * (1.f / DM) + EPS);
        const float* gp = G(I.norm_g) + ((size_t)a.layer * 2 + a.which) * DM;
        const float* shp = modp(F, a.layer, b9, a.which ? 3 : 0);
        const float* scp = modp(F, a.layer, b9, a.which ? 4 : 1);
        f32x4 xn[4];
#pragma unroll
        for (int j = 0; j < 4; ++j) { const f32x4 g = ((const f32x4*)gp)[F.lane + 64 * j], sh = ((const f32x4*)shp)[F.lane + 64 * j], sc = ((const f32x4*)scp)[F.lane + 64 * j];
            xn[j] = v[j] * rstd * g * (sc + 1.0f) + sh; }
        u32x2* o8 = (u32x2*)(XN + (size_t)row * DM) + F.lane;
#pragma unroll
        for (int j = 0; j < 4; ++j) o8[64 * j] = (u32x2){pk2(xn[j].x, xn[j].y), pk2(xn[j].z, xn[j].w)};
        if (a.router_pair >= 0) {
            float lg[NEXP];
#pragma unroll
            for (int e = 0; e < NEXP; ++e) lg[e] = 0.f;
#pragma unroll
            for (int j = 0; j < 4; ++j)
#pragma unroll
                for (int q = 0; q < 4; ++q) { const float xv = xn[j][q]; const LAS f32x4* w4 = (const LAS f32x4*)(wr + (256 * j + 4 * F.lane + q) * NEXP); const f32x4 wa = w4[0], wb = w4[1];
                    lg[0] += xv * wa.x; lg[1] += xv * wa.y; lg[2] += xv * wa.z; lg[3] += xv * wa.w; lg[4] += xv * wb.x; lg[5] += xv * wb.y; lg[6] += xv * wb.z; lg[7] += xv * wb.w; }
#pragma unroll
            for (int e = 0; e < NEXP; ++e) lg[e] = wave_sum(lg[e]);
            int i1 = 0; float v1 = lg[0];
#pragma unroll
            for (int e = 1; e < NEXP; ++e) if (lg[e] > v1) { v1 = lg[e]; i1 = e; }
            int i2 = -1; float v2 = -3.0e38f;
#pragma unroll
            for (int e = 0; e < NEXP; ++e) if (e != i1 && lg[e] > v2) { v2 = lg[e]; i2 = e; }
            const float ga = 1.f / (1.f + __expf(v2 - v1)), gb = 1.f - ga;
            if (F.lane == 0) {
                const int l1 = __hip_atomic_fetch_add((LAS int*)(lcnt + i1), 1, __ATOMIC_RELAXED, __HIP_MEMORY_SCOPE_WORKGROUP);
                const int l2 = __hip_atomic_fetch_add((LAS int*)(lcnt + i2), 1, __ATOMIC_RELAXED, __HIP_MEMORY_SCOPE_WORKGROUP);
                stash[4 * k + 0] = i1; stash[4 * k + 1] = l1; stash[4 * k + 2] = i2; stash[4 * k + 3] = l2;
                float* tgw = (float*)(F.WS() + WS_ROUTE) + 4 * NTOK; tgw[2 * row] = ga; tgw[2 * row + 1] = gb;
            }
        }
    }
    if (a.router_pair >= 0) {
        __syncthreads();
        if (F.tid < NEXP) lcnt[8 + F.tid] = (int)__hip_atomic_fetch_add(F.ctl + CW_MOECNT + 64 * a.router_pair + F.tid, (unsigned)lcnt[F.tid], RLX_AGENT);
        __syncthreads();
        int* tew = (int*)(F.WS() + WS_ROUTE); int* trw = tew + 2 * NTOK; int* list = (int*)(F.WS() + WS_LIST);
        for (int k = F.tid; k < nk; k += NWAVES * 64) {
            const int row = F.bid + F.G * k;
            const int i1 = stash[4 * k + 0], l1 = stash[4 * k + 1], i2 = stash[4 * k + 2], l2 = stash[4 * k + 3];
            const int r1 = lcnt[8 + i1] + l1, r2 = lcnt[8 + i2] + l2;
            tew[2 * row] = i1; tew[2 * row + 1] = i2; trw[2 * row] = r1; trw[2 * row + 1] = r2;
            list[(size_t)i1 * NTOK + r1] = row; list[(size_t)i2 * NTOK + r2] = row;
        }
    }
    __syncthreads();
}

struct SchedStatic {
    static constexpr bool GATHER = false;
    const bf16* A; int lda; const bf16* Bt; int K, nM, nN, G, c;
    __device__ __forceinline__ bool next(int i, pg8::Unit& u) const { return pg8::static_next(i, G, c, nM, nN, u); }
    __device__ __forceinline__ int k0(const pg8::Unit&) const { return 0; }
    __device__ __forceinline__ int nt(const pg8::Unit&) const { return K / 64; }
    __device__ __forceinline__ unsigned a_row(const pg8::Unit& u, int r) const { return (unsigned)(u.pm * 256 + r); }
    __device__ __forceinline__ const char* b_base(const pg8::Unit& u) const { return (const char*)Bt + (size_t)u.pn * 256 * K * 2; }
};
struct SchedResid {
    static constexpr bool GATHER = false;
    const bf16* A; int lda; const bf16* Bt; int K, nctx, G, c;
    __device__ __forceinline__ bool next(int i, pg8::Unit& u) const {
        const int L = i * G + c;
        if (L < 512) return pg8::static_next(i, G, c, 128, 4, u);
        const int r = L - 512; if (r >= nctx * 16) return false;
        u.kq = r & 3; u.pn = (r >> 2) & 3; u.pm = 128 + (r >> 4); return true; }
    __device__ __forceinline__ int nt(const pg8::Unit& u) const { const int n = K / 64; if (u.kq < 0) return n; const int q = (n / 4) & ~1, rem = n - 4 * q; return q + ((u.kq * 2 < rem) ? 2 : 0); }
    __device__ __forceinline__ int k0(const pg8::Unit& u) const { if (u.kq <= 0) return 0; const int n = K / 64, q = (n / 4) & ~1, rem = n - 4 * q; int s = 0; for (int k = 0; k < u.kq; ++k) s += q + ((k * 2 < rem) ? 2 : 0); return s; }
    __device__ __forceinline__ unsigned a_row(const pg8::Unit& u, int r) const { return (unsigned)(u.pm * 256 + r); }
    __device__ __forceinline__ const char* b_base(const pg8::Unit& u) const { return (const char*)Bt + (size_t)u.pn * 256 * K * 2; }
};
struct SchedOne {
    static constexpr bool GATHER = false;
    const bf16* A; int lda; const bf16* Bt; int K, pm, pn, have;
    __device__ __forceinline__ bool next(int i, pg8::Unit& u) const { if (i != 0 || !have) return false; u.pm = pm; u.pn = pn; u.kq = -1; return true; }
    __device__ __forceinline__ int k0(const pg8::Unit&) const { return 0; }
    __device__ __forceinline__ int nt(const pg8::Unit&) const { return K / 64; }
    __device__ __forceinline__ unsigned a_row(const pg8::Unit& u, int r) const { return (unsigned)(u.pm * 256 + r); }
    __device__ __forceinline__ const char* b_base(const pg8::Unit& u) const { return (const char*)Bt + (size_t)u.pn * 256 * K * 2; }
};
template <bool G_> struct SchedMoe {
    static constexpr bool GATHER = G_;
    const bf16* A; int lda; const bf16* Bt; size_t bstride; int K, nN, G, c; const int* list; volatile LAS int* MOE;
    __device__ __forceinline__ bool next(int i, pg8::Unit& u) const { const long L = (long)i * G + c; const int nP = MOE[8]; if (L >= (long)nP * nN) return false; u.pm = (int)(L / nN); u.pn = (int)(L % nN); u.kq = -1; return true; }
    __device__ __forceinline__ int k0(const pg8::Unit&) const { return 0; }
    __device__ __forceinline__ int nt(const pg8::Unit&) const { return K / 64; }
    __device__ __forceinline__ int expert(int pm) const { int e = 0;
#pragma unroll
        for (int k = 1; k < NEXP; ++k) e += (pm >= MOE[k]) ? 1 : 0;
        return e; }
    __device__ __forceinline__ unsigned a_row(const pg8::Unit& u, int r) const {
        if (!G_) return (unsigned)(u.pm * 256 + r);
        const int e = expert(u.pm), idx = (u.pm - MOE[e]) * 256 + r;
        return idx < MOE[16 + e] ? (unsigned)list[e * NTOK + idx] : 0u; }
    __device__ __forceinline__ const char* b_base(const pg8::Unit& u) const { return (const char*)Bt + (size_t)expert(u.pm) * bstride + (size_t)u.pn * 256 * K * 2; }
};

__device__ __forceinline__ unsigned cvt_pk_bf16(float lo, float hi) { unsigned r; asm volatile("v_cvt_pk_bf16_f32 %0, %1, %2" : "=v"(r) : "v"(lo), "v"(hi)); return r; }
typedef const f32x4 (&AccRef)[2][2][4][2];
__device__ __forceinline__ int swap12(int g) { return ((g & 1) << 1) | (g >> 1); }

__device__ __forceinline__ f32x4 tr4(const f32x4 a, int lane) {
    const bool o1 = lane & 1, o2 = lane & 2;
    const float t0 = __shfl_xor(o1 ? a[0] : a[1], 1), t1 = __shfl_xor(o1 ? a[2] : a[3], 1);
    const f32x4 b = o1 ? (f32x4){t0, a[1], t1, a[3]} : (f32x4){a[0], t0, a[2], t1};
    const float u0 = __shfl_xor(o2 ? b[0] : b[2], 2), u1 = __shfl_xor(o2 ? b[1] : b[3], 2);
    return o2 ? (f32x4){u0, u1, b[2], b[3]} : (f32x4){b[0], b[1], u0, u1};
}
struct EpiBf16 { static constexpr bool PERM = true;
    bf16* O; int ldc, mode;
    __device__ __forceinline__ void operator()(AccRef acc, const pg8::Unit& u, int wr, int wc, int fr, int fq) const {
        const int rbase = mode == 0 ? u.pm * 256 : (mode == 1 ? u.pn * 4096 + u.pm * 256 : NLAT + u.pn * 256 + u.pm * 256);
        const int cbase = mode == 0 ? u.pn * 256 : 768;
        const int row0 = rbase + wr * 64 + fr, col0 = cbase + wc * 32 + 8 * fq;
#pragma unroll
        for (int ai = 0; ai < 2; ++ai)
#pragma unroll
            for (int m = 0; m < 4; ++m) { bf16* rowp = O + (size_t)(row0 + ai * 128 + m * 16) * ldc + col0;
#pragma unroll
                for (int bj = 0; bj < 2; ++bj) { const f32x4 v0 = acc[ai][bj][m][0], v1 = acc[ai][bj][m][1];
                    u32x4 w; w.x = cvt_pk_bf16(v0[0], v0[1]); w.y = cvt_pk_bf16(v0[2], v0[3]); w.z = cvt_pk_bf16(v1[0], v1[1]); w.w = cvt_pk_bf16(v1[2], v1[3]);
                    *(u32x4*)(rowp + bj * 128) = w; } }
    }
};
struct EpiWin { static constexpr bool PERM = true;
    bf16* PX; bf16* GT; bf16* GTC;
    __device__ __forceinline__ void operator()(AccRef acc, const pg8::Unit& u, int wr, int wc, int fr, int fq) const {
        if (u.pn < 2) {
            const int row0 = u.pm * 256 + wr * 64 + fr, col0 = u.pn * 256 + wc * 32 + 8 * fq;
#pragma unroll
            for (int ai = 0; ai < 2; ++ai)
#pragma unroll
                for (int m = 0; m < 4; ++m) { bf16* rowp = PX + (size_t)(row0 + ai * 128 + m * 16) * 512 + col0;
#pragma unroll
                    for (int bj = 0; bj < 2; ++bj) { const f32x4 v0 = acc[ai][bj][m][0], v1 = acc[ai][bj][m][1];
                        u32x4 w; w.x = cvt_pk_bf16(v0[0], v0[1]); w.y = cvt_pk_bf16(v0[2], v0[3]); w.z = cvt_pk_bf16(v1[0], v1[1]); w.w = cvt_pk_bf16(v1[2], v1[3]);
                        *(u32x4*)(rowp + bj * 128) = w; } }
        } else {
            const int type = u.pn - 2; const bool lat = u.pm < 128;
            const int b = lat ? (u.pm >> 4) : (u.pm - 128);
            bf16* base = lat ? GT + (size_t)b * 256 * 8192 + type * 4096 + (u.pm & 15) * 256 : GTC + (size_t)b * 256 * 512 + type * 256;
            const size_t ldt = lat ? 8192 : 512;
#pragma unroll
            for (int ai = 0; ai < 2; ++ai)
#pragma unroll
                for (int m = 0; m < 4; ++m) { const int lr4 = ai * 128 + wr * 64 + m * 16 + (fr & 12);
#pragma unroll
                    for (int bj = 0; bj < 2; ++bj)
#pragma unroll
                        for (int n = 0; n < 2; ++n) { const f32x4 t = tr4(acc[ai][bj][m][n], fr); const int jc = 128 * bj + 32 * wc + 8 * fq + 4 * n + (fr & 3);
                            *(u32x2*)(base + (size_t)jc * ldt + lr4) = (u32x2){pk2(t[0], t[1]), pk2(t[2], t[3])}; }
                    if (m == 3) asm volatile("" ::: "memory"); }
        }
    }
};
struct EpiKV { static constexpr bool PERM = false;
    const bf16* PX; bf16* Kb; bf16* Vt; const float* g_k; const f32x2* rope;
    __device__ __forceinline__ void operator()(AccRef acc, const pg8::Unit& u, int wr, int wc, int fr, int fq) const {
        const int head = 2 * u.pn + (wc >> 1), part = wc & 1;
        const bool lat = u.pm < 128;
        const int b = lat ? (u.pm >> 4) : (u.pm - 128);
        const int pos0 = lat ? (u.pm & 15) * 256 : SEQ;
        const size_t bh = (size_t)b * A_HEADS + head;
#pragma unroll
        for (int ai = 0; ai < 2; ++ai)
#pragma unroll
            for (int m = 0; m < 4; ++m) {
                const int lr = ai * 128 + wr * 64 + m * 16 + fr, row = u.pm * 256 + lr, pos = pos0 + lr;
                const bf16* pxr = PX + (size_t)row * 512;
                float ss = 0.f;
#pragma unroll
                for (int q = 0; q < 4; ++q) { const u32x4 w = *(const u32x4*)(pxr + 256 + 32 * fq + 8 * q);
                    ss += bflo(w.x) * bflo(w.x) + bfhi(w.x) * bfhi(w.x) + bflo(w.y) * bflo(w.y) + bfhi(w.y) * bfhi(w.y) + bflo(w.z) * bflo(w.z) + bfhi(w.z) * bfhi(w.z) + bflo(w.w) * bflo(w.w) + bfhi(w.w) * bfhi(w.w); }
                ss += __shfl_xor(ss, 16); ss += __shfl_xor(ss, 32);
                const float rkv = 1.0f / sqrtf(ss * (1.f / 128.f) + EPS);
                if (part == 0) {
                    const u32x4 kw = *(const u32x4*)(pxr + 384 + 8 * fq);
                    float kr[8] = {bflo(kw.x), bfhi(kw.x), bflo(kw.y), bfhi(kw.y), bflo(kw.z), bfhi(kw.z), bflo(kw.w), bfhi(kw.w)};
                    float s2 = 0.f;
#pragma unroll
                    for (int q = 0; q < 8; ++q) s2 += kr[q] * kr[q];
#pragma unroll
                    for (int bj = 0; bj < 2; ++bj)
#pragma unroll
                        for (int n = 0; n < 2; ++n) { const f32x4 x = acc[ai][bj][m][n] * rkv; s2 += (x[0] * x[0] + x[1] * x[1]) + (x[2] * x[2] + x[3] * x[3]); }
                    s2 += __shfl_xor(s2, 16); s2 += __shfl_xor(s2, 32);
                    const float rs = 1.0f / sqrtf(s2 * (1.f / 96.f) + EPS);
                    bf16* kp = Kb + (bh * KPOS + pos) * 96;
#pragma unroll
                    for (int bj = 0; bj < 2; ++bj)
#pragma unroll
                        for (int n = 0; n < 2; ++n) { const int d0 = 32 * bj + 16 * n; const f32x4 g = *(const f32x4*)(g_k + d0 + 4 * fq); const f32x4 x = acc[ai][bj][m][n] * (rkv * rs) * g;
                            *(u32x2*)(kp + d0 + 4 * swap12(fq)) = (u32x2){pk2(x[0], x[1]), pk2(x[2], x[3])}; }
                    float t[8];
                    { const f32x4 ga = *(const f32x4*)(g_k + 64 + 8 * fq), gb = *(const f32x4*)(g_k + 64 + 8 * fq + 4);
                      t[0] = kr[0] * rs * ga[0]; t[1] = kr[1] * rs * ga[1]; t[2] = kr[2] * rs * ga[2]; t[3] = kr[3] * rs * ga[3];
                      t[4] = kr[4] * rs * gb[0]; t[5] = kr[5] * rs * gb[1]; t[6] = kr[6] * rs * gb[2]; t[7] = kr[7] * rs * gb[3]; }
                    if (lat) {
                        const int pidx = (fq < 2) ? (pos >> 6) : (pos & 63);
#pragma unroll
                        for (int q = 0; q < 4; ++q) { const f32x2 cs = rope[pidx * 8 + ((4 * fq + q) & 7)]; const float t0 = t[2 * q], t1 = t[2 * q + 1];
                            t[2 * q] = t0 * cs.x - t1 * cs.y; t[2 * q + 1] = t0 * cs.y + t1 * cs.x; }
                    }
                    bf16* krp = kp + 64 + 16 * (fq >> 1) + 4 * (fq & 1);
                    *(u32x2*)(krp) = (u32x2){pk2(t[0], t[1]), pk2(t[2], t[3])};
                    *(u32x2*)(krp + 8) = (u32x2){pk2(t[4], t[5]), pk2(t[6], t[7])};
                } else {
                    const int p4 = pos & ~3, pp = (p4 & ~15) | (((p4 & 4) << 1) | ((p4 & 8) >> 1));
                    bf16* vp = Vt + bh * 64 * KPOS + pp;
#pragma unroll
                    for (int bj = 0; bj < 2; ++bj)
#pragma unroll
                        for (int n = 0; n < 2; ++n) { const f32x4 t = tr4(acc[ai][bj][m][n] * rkv, fr);
                            *(u32x2*)(vp + (size_t)(32 * bj + 16 * n + 4 * fq + (fr & 3)) * KPOS) = (u32x2){pk2(t[0], t[1]), pk2(t[2], t[3])}; }
                }
                if (m & 1) asm volatile("" ::: "memory");
            }
    }
};
struct EpiResid { static constexpr bool PERM = false;
    float* out; float* hc; const float* modl; int gk; bool dry; float* part;
    __device__ __forceinline__ void operator()(AccRef acc, const pg8::Unit& u, int wr, int wc, int fr, int fq) const {
        const bool lat = u.pm < 128; const int b9 = lat ? (u.pm >> 4) : 8;
        float* base = lat ? out + (size_t)u.pm * 256 * DM : hc + (size_t)(u.pm - 128) * 256 * DM;
        const int col0 = u.pn * 256 + wc * 32 + 4 * fq;
        const float* gp = modl + (size_t)b9 * 6144 + gk * 1024 + col0;
        f32x4 gv[2][2];
#pragma unroll
        for (int bj = 0; bj < 2; ++bj)
#pragma unroll
            for (int n = 0; n < 2; ++n) gv[bj][n] = *(const f32x4*)(gp + bj * 128 + n * 16);
#pragma unroll
        for (int ai = 0; ai < 2; ++ai)
#pragma unroll
            for (int m = 0; m < 4; ++m) { float* rowp = base + (size_t)(ai * 128 + wr * 64 + m * 16 + fr) * DM + col0;
#pragma unroll
                for (int bj = 0; bj < 2; ++bj)
#pragma unroll
                    for (int n = 0; n < 2; ++n) { f32x4* p = (f32x4*)(rowp + bj * 128 + n * 16);
                        if (u.kq < 0) { const f32x4 r = *p + gv[bj][n] * acc[ai][bj][m][n]; if (!dry) *p = r; }
                        else if (!dry) *(f32x4*)(part + ((size_t)u.kq * NCTX + (size_t)(u.pm - 128) * 256 + (ai * 128 + wr * 64 + m * 16 + fr)) * DM + col0 + bj * 128 + n * 16) = gv[bj][n] * acc[ai][bj][m][n]; }
                if (m == 3) asm volatile("" ::: "memory"); }
    }
};
struct EpiSwiglu { static constexpr bool PERM = false;
    bf16* HM; int ldh;
    __device__ __forceinline__ void operator()(AccRef acc, const pg8::Unit& u, int wr, int wc, int fr, int fq) const {
        const int row0 = u.pm * 256 + wr * 64 + fr, col0 = u.pn * 128 + wc * 16 + 4 * fq;
#pragma unroll
        for (int ai = 0; ai < 2; ++ai)
#pragma unroll
            for (int m = 0; m < 4; ++m) { bf16* rowp = HM + (size_t)(row0 + ai * 128 + m * 16) * ldh + col0;
#pragma unroll
                for (int bj = 0; bj < 2; ++bj) { const f32x4 g = acc[ai][bj][m][0], up = acc[ai][bj][m][1]; float h[4];
#pragma unroll
                    for (int e = 0; e < 4; ++e) h[e] = g[e] * __builtin_amdgcn_rcpf(1.f + __builtin_amdgcn_exp2f(-g[e] * LOG2E)) * up[e];
                    *(u32x2*)(rowp + bj * 64) = (u32x2){cvt_pk_bf16(h[0], h[1]), cvt_pk_bf16(h[2], h[3])}; } }
    }
};
struct EpiNAin { static constexpr bool PERM = false;
    bf16* QN; bf16* KN; bf16* Vt; const float* g_q; const float* g_k;
    __device__ __forceinline__ void operator()(AccRef acc, const pg8::Unit& u, int wr, int wc, int fr, int fq) const {
        const int sec = u.pn >> 2, head = 4 * (u.pn & 3) + wc;
        const bool lat = u.pm < 128;
        const int b = lat ? (u.pm >> 4) : (u.pm - 128);
        const int pos0 = lat ? (u.pm & 15) * 256 : SEQ;
#pragma unroll
        for (int ai = 0; ai < 2; ++ai)
#pragma unroll
            for (int m = 0; m < 4; ++m) {
                const int lr = ai * 128 + wr * 64 + m * 16 + fr, row = u.pm * 256 + lr;
                if (sec < 2) {
                    float s2 = 0.f;
#pragma unroll
                    for (int bj = 0; bj < 2; ++bj)
#pragma unroll
                        for (int n = 0; n < 2; ++n) { const f32x4 x = acc[ai][bj][m][n]; s2 += (x[0] * x[0] + x[1] * x[1]) + (x[2] * x[2] + x[3] * x[3]); }
                    s2 += __shfl_xor(s2, 16); s2 += __shfl_xor(s2, 32);
                    const float rs = (1.0f / sqrtf(s2 * (1.f / 64.f) + EPS)) * (sec == 0 ? 0.125f * LOG2E : 1.0f);
                    const float* gp = sec == 0 ? g_q : g_k;
                    bf16* op = (sec == 0 ? QN : KN) + (size_t)row * DM + head * 64;
#pragma unroll
                    for (int bj = 0; bj < 2; ++bj)
#pragma unroll
                        for (int n = 0; n < 2; ++n) { const int d0 = 32 * bj + 16 * n + 4 * fq; const f32x4 g = *(const f32x4*)(gp + d0); const f32x4 x = acc[ai][bj][m][n] * rs * g;
                            *(u32x2*)(op + d0) = (u32x2){pk2(x[0], x[1]), pk2(x[2], x[3])}; }
                } else {
                    bf16* vp = Vt + ((size_t)b * C_HEADS + head) * 64 * KPOS + pos0 + (lr & ~3);
#pragma unroll
                    for (int bj = 0; bj < 2; ++bj)
#pragma unroll
                        for (int n = 0; n < 2; ++n) { const f32x4 t = tr4(acc[ai][bj][m][n], fr);
                            *(u32x2*)(vp + (size_t)(32 * bj + 16 * n + 4 * fq + (fr & 3)) * KPOS) = (u32x2){pk2(t[0], t[1]), pk2(t[2], t[3])}; }
                }
                if (m == 3) asm volatile("" ::: "memory");
            }
    }
};

constexpr int AT_KP = 208, AT_VP = 144;
constexpr int AT_KB = 64 * AT_KP, AT_VB = 64 * AT_VP, AT_BUF = AT_KB + AT_VB;

__device__ __forceinline__ void mla_attn_unit(Frame& F, int pair, int b, int h, int qrow0, bool lat, int key0, int nkt) {
    const int lane = F.lane, l31 = lane & 31, hi = lane >> 5;
    const bf16* PX = (const bf16*)(F.WS() + WS_PX);
    const bf16* WUQ = (const bf16*)(F.WS() + WS_W + WO_WUQ);
    const bf16* Kg = (const bf16*)(F.WS() + WS_K) + ((size_t)(b * A_HEADS + h) * KPOS + key0) * 96;
    const bf16* Vg = (const bf16*)(F.WS() + WS_VT) + (size_t)(b * A_HEADS + h) * 64 * KPOS + key0;
    bf16* MIX = (bf16*)(F.WS() + WS_ACT);
    const f32x2* rope = (const f32x2*)(F.WS() + WS_ROPE);
    const int row = qrow0 + 32 * F.wave + l31;
    const int vdv = F.tid >> 3, vpart = F.tid & 7;
    u32x4 kr0, kr1 = (u32x4){0u, 0u, 0u, 0u}, vr;
    kr0 = *(const u32x4*)((const char*)Kg + (size_t)F.tid * 16);
    if (F.tid < 256) kr1 = *(const u32x4*)((const char*)Kg + (size_t)(512 + F.tid) * 16);
    vr = *(const u32x4*)(Vg + (size_t)vdv * KPOS + vpart * 8);
    bf16x8 qf[3][2];
    {
        bf16x8 bq[16];
        const bf16* pxr = PX + (size_t)row * 512 + 8 * hi;
#pragma unroll
        for (int s = 0; s < 16; ++s) bq[s] = *(const bf16x8*)(pxr + 16 * s);
        float ss = 0.f;
#pragma unroll
        for (int s = 0; s < 16; ++s)
#pragma unroll
            for (int e = 0; e < 8; ++e) { const float x = bf2f((unsigned short)bq[s][e]); ss += x * x; }
        ss += __shfl_xor(ss, 32);
        const float rq = 1.0f / sqrtf(ss * (1.f / 256.f) + EPS);
        f32x16 qt[3];
#pragma unroll
        for (int blk = 0; blk < 3; ++blk) {
            f32x16 acc;
#pragma unroll
            for (int i = 0; i < 16; ++i) acc[i] = 0.f;
            const bf16* wrp = WUQ + (size_t)(h * 96 + 32 * blk + l31) * 256 + 8 * hi;
#pragma unroll
            for (int s = 0; s < 16; ++s) { const bf16x8 a = *(const bf16x8*)(wrp + 16 * s); acc = __builtin_amdgcn_mfma_f32_32x32x16_bf16(a, bq[s], acc, 0, 0, 0); }
            qt[blk] = acc * rq;
        }
        float s2 = 0.f;
#pragma unroll
        for (int blk = 0; blk < 3; ++blk)
#pragma unroll
            for (int i = 0; i < 16; ++i) s2 += qt[blk][i] * qt[blk][i];
        s2 += __shfl_xor(s2, 32);
        const float rs = (1.0f / sqrtf(s2 * (1.f / 96.f) + EPS));
        const float* gq = G(F.in->a_g_q) + pair * 96;
#pragma unroll
        for (int blk = 0; blk < 3; ++blk)
#pragma unroll
            for (int c = 0; c < 4; ++c) { const f32x4 g = *(const f32x4*)(gq + 32 * blk + 8 * c + 4 * hi);
#pragma unroll
                for (int e = 0; e < 4; ++e) qt[blk][4 * c + e] *= rs * g[e]; }
        if (lat) {
            const int t = row & (SEQ - 1);
#pragma unroll
            for (int c = 0; c < 4; ++c) {
                const int pidx = (c < 2) ? (t >> 6) : (t & 63);
#pragma unroll
                for (int q = 0; q < 2; ++q) { const f32x2 cs = rope[pidx * 8 + ((4 * c + 2 * hi + q) & 7)]; const float t0 = qt[2][4 * c + 2 * q], t1 = qt[2][4 * c + 2 * q + 1];
                    qt[2][4 * c + 2 * q] = t0 * cs.x - t1 * cs.y; qt[2][4 * c + 2 * q + 1] = t0 * cs.y + t1 * cs.x; }
            }
        }
        const float sc = 0.10206207261596577f * LOG2E;
#pragma unroll
        for (int blk = 0; blk < 3; ++blk)
#pragma unroll
            for (int s = 0; s < 2; ++s) { u32x4 w;
                w.x = pk2(qt[blk][8 * s + 0] * sc, qt[blk][8 * s + 1] * sc); w.y = pk2(qt[blk][8 * s + 2] * sc, qt[blk][8 * s + 3] * sc);
                w.z = pk2(qt[blk][8 * s + 4] * sc, qt[blk][8 * s + 5] * sc); w.w = pk2(qt[blk][8 * s + 6] * sc, qt[blk][8 * s + 7] * sc);
                qf[blk][s] = __builtin_bit_cast(bf16x8, w); }
    }
    LAS unsigned char* L = F.lds;
    const int kd0 = (F.tid / 12) * AT_KP + (F.tid % 12) * 16, kd1 = ((512 + F.tid) / 12) * AT_KP + ((512 + F.tid) % 12) * 16, vd = AT_KB + vdv * AT_VP + vpart * 16;
    *(LAS u32x4*)(L + kd0) = kr0; if (F.tid < 256) *(LAS u32x4*)(L + kd1) = kr1; *(LAS u32x4*)(L + vd) = vr;
    __syncthreads();
    f32x16 oT[2];
#pragma unroll
    for (int d = 0; d < 2; ++d)
#pragma unroll
        for (int i = 0; i < 16; ++i) oT[d][i] = 0.f;
    float mrun = -3.0e38f, lrun = 0.f;
    const int kro = l31 * AT_KP + hi * 16, vro = AT_KB + l31 * AT_VP + hi * 16;
    for (int t = 0; t < nkt; ++t) {
        const bool more = (t + 1 < nkt);
        if (more) {
            const char* kg = (const char*)Kg + (size_t)(t + 1) * 64 * 192;
            kr0 = *(const u32x4*)(kg + (size_t)F.tid * 16);
            if (F.tid < 256) kr1 = *(const u32x4*)(kg + (size_t)(512 + F.tid) * 16);
            vr = *(const u32x4*)(Vg + (size_t)vdv * KPOS + (t + 1) * 64 + vpart * 8);
        }
        const LAS unsigned char* Lb = L + (t & 1) * AT_BUF;
        f32x16 sT[2];
#pragma unroll
        for (int kb = 0; kb < 2; ++kb) {
            f32x16 acc;
#pragma unroll
            for (int i = 0; i < 16; ++i) acc[i] = 0.f;
#pragma unroll
            for (int blk = 0; blk < 3; ++blk)
#pragma unroll
                for (int s = 0; s < 2; ++s) { const bf16x8 a = *(const LAS bf16x8*)(Lb + kro + kb * 32 * AT_KP + (32 * blk + 16 * s) * 2);
                    acc = __builtin_amdgcn_mfma_f32_32x32x16_bf16(a, qf[blk][s], acc, 0, 0, 0); }
            sT[kb] = acc;
        }
        float mx = sT[0][0];
#pragma unroll
        for (int kb = 0; kb < 2; ++kb)
#pragma unroll
            for (int i = 0; i < 16; ++i) mx = fmaxf(mx, sT[kb][i]);
        mx = fmaxf(mx, __shfl_xor(mx, 32));
        const float mnew = fmaxf(mrun, mx);
        const float alpha = __builtin_amdgcn_exp2f(mrun - mnew);
        mrun = mnew;
        float psum = 0.f;
        bf16x8 pf[2][2];
#pragma unroll
        for (int kb = 0; kb < 2; ++kb) {
            float p[16];
#pragma unroll
            for (int i = 0; i < 16; ++i) { p[i] = __builtin_amdgcn_exp2f(sT[kb][i] - mnew); psum += p[i]; }
#pragma unroll
            for (int s = 0; s < 2; ++s) { u32x4 w; w.x = cvt_pk_bf16(p[8 * s + 0], p[8 * s + 1]); w.y = cvt_pk_bf16(p[8 * s + 2], p[8 * s + 3]); w.z = cvt_pk_bf16(p[8 * s + 4], p[8 * s + 5]); w.w = cvt_pk_bf16(p[8 * s + 6], p[8 * s + 7]);
                pf[kb][s] = __builtin_bit_cast(bf16x8, w); }
        }
        lrun = lrun * alpha + psum;
#pragma unroll
        for (int d = 0; d < 2; ++d) oT[d] = oT[d] * alpha;
#pragma unroll
        for (int d = 0; d < 2; ++d)
#pragma unroll
            for (int kb = 0; kb < 2; ++kb)
#pragma unroll
                for (int s = 0; s < 2; ++s) { const bf16x8 a = *(const LAS bf16x8*)(Lb + vro + d * 32 * AT_VP + (32 * kb + 16 * s) * 2);
                    oT[d] = __builtin_amdgcn_mfma_f32_32x32x16_bf16(a, pf[kb][s], oT[d], 0, 0, 0); }
        if (more) {
            LAS unsigned char* Ln = L + ((t + 1) & 1) * AT_BUF;
            *(LAS u32x4*)(Ln + kd0) = kr0; if (F.tid < 256) *(LAS u32x4*)(Ln + kd1) = kr1; *(LAS u32x4*)(Ln + vd) = vr;
        }
        __syncthreads();
    }
    lrun += __shfl_xor(lrun, 32);
    const float inv = 1.0f / lrun;
    bf16* op = MIX + (size_t)row * DM + h * 64 + 4 * hi;
#pragma unroll
    for (int d = 0; d < 2; ++d)
#pragma unroll
        for (int c = 0; c < 4; ++c) *(u32x2*)(op + 32 * d + 8 * c) = (u32x2){pk2(oT[d][4 * c] * inv, oT[d][4 * c + 1] * inv), pk2(oT[d][4 * c + 2] * inv, oT[d][4 * c + 3] * inv)};
}

__device__ __forceinline__ void mla_attn_phase(Frame& F, int pair, int rep) {
    constexpr int NLU = NB * A_HEADS * (SEQ / 256), NCU = NB * A_HEADS;
    for (;;) {
        if (F.tid == 0) F.MISC[0] = __hip_atomic_fetch_add(F.ctl + CW_ATTQ + 64 * pair + 32 * rep, 1u, RLX_AGENT);
        __syncthreads();
        const int u = (int)F.MISC[0];
        __syncthreads();
        if (u >= NLU + NCU) break;
        if (u < NLU) { const int qb = u & 15, bh = u >> 4, b = bh / A_HEADS, h = bh % A_HEADS; mla_attn_unit(F, pair, b, h, b * SEQ + qb * 256, true, 0, KPOS / 64); }
        else { const int bh = u - NLU, b = bh / A_HEADS, h = bh % A_HEADS; mla_attn_unit(F, pair, b, h, NLAT + b * CTXL, false, SEQ, CTXL / 64); }
    }
}

constexpr int NA_KP = 144, NA_CVP = 528, NA_LVP = 1168;
constexpr int NA_CK = 0, NA_CV = 256 * NA_KP, NA_L = NA_CV + 64 * NA_CVP, NA_RPB = NA_L + 576 * NA_KP, NA_END = NA_RPB + 15 * 31 * 4;
static_assert(NA_L == 70656 && 64 * NA_LVP <= 576 * NA_KP && NA_END <= LDSCTL_OFF, "NA LDS map");

struct NaPref { u32x4 r[9]; };
__device__ __forceinline__ void na_load_k(NaPref& p, const bf16* KN, int rowbase, int h, int tid) {
    const char* gb = (const char*)(KN + (size_t)rowbase * DM + h * 64); const unsigned lo = (unsigned)(tid >> 3) * 2048u + (unsigned)(tid & 7) * 16u;
#pragma unroll
    for (int i = 0; i < 9; ++i) p.r[i] = *(const u32x4*)(gb + (size_t)i * 131072 + lo);
}
__device__ __forceinline__ void na_store_k(const NaPref& p, LAS unsigned char* L, int tid) {
    LAS unsigned char* d = L + NA_L + (tid >> 3) * NA_KP + (tid & 7) * 16;
#pragma unroll
    for (int i = 0; i < 9; ++i) *(LAS u32x4*)(d + i * 64 * NA_KP) = p.r[i];
}
__device__ __forceinline__ void na_load_v(NaPref& p, const bf16* Vt, int pos0, int tid) {
    const char* gb = (const char*)(Vt + pos0); const unsigned lo = (unsigned)(tid >> 3) * (unsigned)(KPOS * 2) + (unsigned)(tid & 7) * 16u;
#pragma unroll
    for (int i = 0; i < 9; ++i) p.r[i] = *(const u32x4*)(gb + i * 128 + lo);
}
__device__ __forceinline__ void na_store_v(const NaPref& p, LAS unsigned char* L, int tid) {
    LAS unsigned char* d = L + NA_L + (tid >> 3) * NA_LVP + (tid & 7) * 16;
#pragma unroll
    for (int i = 0; i < 9; ++i) *(LAS u32x4*)(d + i * 128) = p.r[i];
}
__device__ __forceinline__ void na_stage_ctx(Frame& F, int b, int h) {
    const char* kb = (const char*)((const bf16*)(F.WS() + WS_KN) + (size_t)(NLAT + b * CTXL) * DM + h * 64);
    const char* vb = (const char*)((const bf16*)(F.WS() + WS_VTN) + (size_t)(b * C_HEADS + h) * 64 * KPOS + SEQ);
    const unsigned klo = (unsigned)(F.tid >> 3) * 2048u + (unsigned)(F.tid & 7) * 16u, vlo = (unsigned)(F.tid >> 3) * (unsigned)(KPOS * 2) + (unsigned)(F.tid & 7) * 16u;
    u32x4 a[4], v[4];
#pragma unroll
    for (int i = 0; i < 4; ++i) a[i] = *(const u32x4*)(kb + (size_t)i * 131072 + klo);
#pragma unroll
    for (int i = 0; i < 4; ++i) v[i] = *(const u32x4*)(vb + i * 128 + vlo);
    LAS unsigned char* kd = F.lds + NA_CK + (F.tid >> 3) * NA_KP + (F.tid & 7) * 16;
    LAS unsigned char* vd = F.lds + NA_CV + (F.tid >> 3) * NA_CVP + (F.tid & 7) * 16;
#pragma unroll
    for (int i = 0; i < 4; ++i) *(LAS u32x4*)(kd + i * 64 * NA_KP) = a[i];
#pragma unroll
    for (int i = 0; i < 4; ++i) *(LAS u32x4*)(vd + i * 128) = v[i];
}
__device__ __forceinline__ float na_scores(Frame& F, bf16x8 (&pf)[16], float& f1, const bf16x8 (&qf)[2], const int (&dco)[8], const bool (&okm)[8], bool lat, int qr, int c0, int kr0, int rs, int ks) {
    const int lane = F.lane, l15 = lane & 15, g = lane >> 4;
    const LAS float* rpbs = (const LAS float*)(F.lds + NA_RPB);
    float m1 = -3.0e38f, l1 = 0.f;
    if (lat) {
        f32x4 sc[16];
#pragma unroll
        for (int t = 0; t < 16; ++t) {
            const LAS unsigned char* kp = F.lds + NA_L + (((rs - kr0) + (t >> 1)) * 64 + ks + 16 * (t & 1) + l15) * NA_KP + g * 16;
            f32x4 acc = (f32x4){0.f, 0.f, 0.f, 0.f};
#pragma unroll
            for (int s = 0; s < 2; ++s) { const bf16x8 a = *(const LAS bf16x8*)(kp + s * 64); acc = __builtin_amdgcn_mfma_f32_16x16x32_bf16(a, qf[s], acc, 0, 0, 0); }
            const LAS float* brow = rpbs + (rs + (t >> 1) - qr + 7) * 31;
#pragma unroll
            for (int e = 0; e < 4; ++e) { const float bias = brow[dco[4 * (t & 1) + e]]; acc[e] = okm[4 * (t & 1) + e] ? acc[e] + bias : -1.0e30f; }
            sc[t] = acc;
            if ((t & 3) == 3) asm volatile("" ::: "memory");
        }
#pragma unroll
        for (int t = 0; t < 16; ++t)
#pragma unroll
            for (int e = 0; e < 4; ++e) m1 = fmaxf(m1, sc[t][e]);
        m1 = fmaxf(m1, __shfl_xor(m1, 16)); m1 = fmaxf(m1, __shfl_xor(m1, 32));
#pragma unroll
        for (int u = 0; u < 8; ++u) { float p[8];
#pragma unroll
            for (int e = 0; e < 4; ++e) { p[e] = __builtin_amdgcn_exp2f(sc[2 * u][e] - m1); p[4 + e] = __builtin_amdgcn_exp2f(sc[2 * u + 1][e] - m1); }
#pragma unroll
            for (int e = 0; e < 8; ++e) l1 += p[e];
            u32x4 w; w.x = cvt_pk_bf16(p[0], p[1]); w.y = cvt_pk_bf16(p[2], p[3]); w.z = cvt_pk_bf16(p[4], p[5]); w.w = cvt_pk_bf16(p[6], p[7]);
            pf[u] = __builtin_bit_cast(bf16x8, w); }
    } else {
#pragma unroll
        for (int u = 0; u < 8; ++u) pf[u] = (bf16x8){0, 0, 0, 0, 0, 0, 0, 0};
    }
    float m = m1, l2 = 0.f;
    {
        f32x4 sc[16];
#pragma unroll
        for (int t = 0; t < 16; ++t) {
            const LAS unsigned char* kp = F.lds + NA_CK + (16 * t + l15) * NA_KP + g * 16;
            f32x4 acc = (f32x4){0.f, 0.f, 0.f, 0.f};
#pragma unroll
            for (int s = 0; s < 2; ++s) { const bf16x8 a = *(const LAS bf16x8*)(kp + s * 64); acc = __builtin_amdgcn_mfma_f32_16x16x32_bf16(a, qf[s], acc, 0, 0, 0); }
            sc[t] = acc;
            if ((t & 3) == 3) asm volatile("" ::: "memory");
        }
        float m2 = -3.0e38f;
#pragma unroll
        for (int t = 0; t < 16; ++t)
#pragma unroll
            for (int e = 0; e < 4; ++e) m2 = fmaxf(m2, sc[t][e]);
        m2 = fmaxf(m2, __shfl_xor(m2, 16)); m2 = fmaxf(m2, __shfl_xor(m2, 32));
        m = fmaxf(m1, m2);
#pragma unroll
        for (int u = 0; u < 8; ++u) { float p[8];
#pragma unroll
            for (int e = 0; e < 4; ++e) { p[e] = __builtin_amdgcn_exp2f(sc[2 * u][e] - m); p[4 + e] = __builtin_amdgcn_exp2f(sc[2 * u + 1][e] - m); }
#pragma unroll
            for (int e = 0; e < 8; ++e) l2 += p[e];
            u32x4 w; w.x = cvt_pk_bf16(p[0], p[1]); w.y = cvt_pk_bf16(p[2], p[3]); w.z = cvt_pk_bf16(p[4], p[5]); w.w = cvt_pk_bf16(p[6], p[7]);
            pf[8 + u] = __builtin_bit_cast(bf16x8, w); }
    }
    f1 = __builtin_amdgcn_exp2f(m1 - m);
    float lsum = l1 * f1 + l2;
    lsum += __shfl_xor(lsum, 16); lsum += __shfl_xor(lsum, 32);
    return 1.0f / lsum;
}
__device__ __forceinline__ void na_pv(Frame& F, const bf16x8 (&pf)[16], float f1, float inv, bool lat, int qrow, int h, int kr0, int rs, int ks) {
    const int lane = F.lane, l15 = lane & 15, g = lane >> 4;
    bf16* MIX = (bf16*)(F.WS() + WS_ACT);
    bf16* op = MIX + (size_t)qrow * DM + h * 64 + 4 * g;
#pragma unroll
    for (int dvt = 0; dvt < 4; ++dvt) {
        f32x4 acc = (f32x4){0.f, 0.f, 0.f, 0.f};
        const int dv = 16 * dvt + l15;
        if (lat) {
#pragma unroll
            for (int u = 0; u < 8; ++u) {
                const LAS unsigned char* vp = F.lds + NA_L + dv * NA_LVP + (((rs - kr0) + u) * 64 + ks + 4 * g) * 2;
                const u32x2 lo = *(const LAS u32x2*)(vp), hi2 = *(const LAS u32x2*)(vp + 32);
                const u32x4 w = (u32x4){lo.x, lo.y, hi2.x, hi2.y};
                acc = __builtin_amdgcn_mfma_f32_16x16x32_bf16(__builtin_bit_cast(bf16x8, w), pf[u], acc, 0, 0, 0);
                if ((u & 3) == 3) asm volatile("" ::: "memory");
            }
            acc = acc * f1;
        }
#pragma unroll
        for (int u = 8; u < 16; ++u) {
            const LAS unsigned char* vp = F.lds + NA_CV + dv * NA_CVP + (32 * (u - 8) + 4 * g) * 2;
            const u32x2 lo = *(const LAS u32x2*)(vp), hi2 = *(const LAS u32x2*)(vp + 32);
            const u32x4 w = (u32x4){lo.x, lo.y, hi2.x, hi2.y};
            acc = __builtin_amdgcn_mfma_f32_16x16x32_bf16(__builtin_bit_cast(bf16x8, w), pf[u], acc, 0, 0, 0);
            if ((u & 3) == 3) asm volatile("" ::: "memory");
        }
        *(u32x2*)(op + 16 * dvt) = (u32x2){pk2(acc[0] * inv, acc[1] * inv), pk2(acc[2] * inv, acc[3] * inv)};
    }
}
__device__ __forceinline__ void na_phase(Frame& F, int pair, bool ctx_queries) {
    const bf16* KN = (const bf16*)(F.WS() + WS_KN);
    LAS float* rpbs = (LAS float*)(F.lds + NA_RPB);
    constexpr int NGRP = NB * C_HEADS * 2;
    for (int gi = F.bid; gi < NGRP; gi += F.G) {
        const int h = gi / (NB * 2), rem = gi % (NB * 2), b = rem >> 1, half = rem & 1;
        const bf16* Vt = (const bf16*)(F.WS() + WS_VTN) + (size_t)(b * C_HEADS + h) * 64 * KPOS;
        __syncthreads();
        na_stage_ctx(F, b, h);
        { const float* rp = G(F.in->c_rpb) + ((size_t)pair * C_HEADS + h) * 15 * 31; for (int i = F.tid; i < 15 * 31; i += NWAVES * 64) rpbs[i] = rp[i] * LOG2E; }
        NaPref pk, pv;
        int dco[8]; bool okm[8];
        { const int c0 = 16 * (F.wave & 3), ks = min(max(c0 - 8, 0), 32), cq = c0 + (F.lane & 15), cs = min(max(cq - 8, 0), 48);
#pragma unroll
          for (int k = 0; k < 8; ++k) { const int kc = ks + 16 * (k >> 2) + 4 * (F.lane >> 4) + (k & 3); okm[k] = (kc >= cs) && (kc < cs + 16); dco[k] = min(max(kc - cq + 15, 0), 30); } }
        { const int r0 = 2 * (16 * half), kr0 = min(max(r0 - 4, 0), 55); na_load_k(pk, KN, b * SEQ + kr0 * 64, h, F.tid); }
        for (int bi = 0; bi < 16; ++bi) {
            const int r0 = 2 * (16 * half + bi), kr0 = min(max(r0 - 4, 0), 55);
            const int qr = r0 + (F.wave >> 2), c0 = 16 * (F.wave & 3), rs = min(max(qr - 4, 0), 56), ks = min(max(c0 - 8, 0), 32);
            const int qrow = b * SEQ + qr * 64 + c0 + (F.lane & 15);
            bf16x8 qf[2];
#pragma unroll
            for (int s = 0; s < 2; ++s) qf[s] = *(const bf16x8*)((const bf16*)(F.WS() + WS_QN) + (size_t)qrow * DM + h * 64 + 32 * s + 8 * (F.lane >> 4));
            na_store_k(pk, F.lds, F.tid);
            __syncthreads();
            na_load_v(pv, Vt, kr0 * 64, F.tid);
            bf16x8 pf[16];
            float f1; const float inv = na_scores(F, pf, f1, qf, dco, okm, true, qr, c0, kr0, rs, ks);
            __syncthreads();
            na_store_v(pv, F.lds, F.tid);
            __syncthreads();
            if (bi + 1 < 16) { const int r1 = r0 + 2, kr1 = min(max(r1 - 4, 0), 55); na_load_k(pk, KN, b * SEQ + kr1 * 64, h, F.tid); }
            na_pv(F, pf, f1, inv, true, qrow, h, kr0, rs, ks);
            __syncthreads();
        }
    }
    constexpr int NCU = NB * C_HEADS * 2;
    for (int u = F.bid; ctx_queries && u < NCU; u += F.G) {
        const int h = u / (NB * 2), rem = u % (NB * 2), b = rem >> 1, ch = rem & 1;
        __syncthreads();
        na_stage_ctx(F, b, h);
        __syncthreads();
        const int qrow = NLAT + b * CTXL + ch * 128 + 16 * F.wave + (F.lane & 15);
        bf16x8 pf[16]; bf16x8 qf[2];
#pragma unroll
        for (int s = 0; s < 2; ++s) qf[s] = *(const bf16x8*)((const bf16*)(F.WS() + WS_QN) + (size_t)qrow * DM + h * 64 + 32 * s + 8 * (F.lane >> 4));
        const int dco0[8] = {0, 0, 0, 0, 0, 0, 0, 0}; const bool okm0[8] = {false, false, false, false, false, false, false, false};
        float f1; const float inv = na_scores(F, pf, f1, qf, dco0, okm0, false, 0, 0, 0, 0, 0);
        na_pv(F, pf, f1, inv, false, qrow, h, 0, 0, 0);
    }
    __syncthreads();
}

constexpr int PH_PER_PAIR = 16, N_PHASES = 2 * PH_PER_PAIR + 1;
struct Args { Inputs in; float* out; unsigned char* ws; int ph_lo, ph_hi; };
static_assert(sizeof(Args) == 27 * 8 + 8 + 8 + 8, "Args has no padding bytes");

__global__ void __launch_bounds__(NWAVES * 64, 2) dit_fwd(Args args) {
    extern __shared__ __attribute__((aligned(16))) unsigned char lds_raw[];
    Frame F;
    F.lds = (LAS unsigned char*)lds_raw;
    F.MISC = (volatile LAS unsigned*)(F.lds + MISC_OFF);
    F.tid = threadIdx.x; F.lane = F.tid & 63; F.wave = __builtin_amdgcn_readfirstlane(F.tid >> 6);
    F.G = gridDim.x; F.bid = blockIdx.x;
    F.ws_ = (GAS unsigned char*)args.ws; F.ctl = (gu32*)(args.ws + WS_CTL); F.out_ = (GAS float*)args.out; F.hc_ = (GAS float*)(args.ws + WS_HC); F.in = (const CAS Inputs*)__builtin_amdgcn_kernarg_segment_ptr();
    for (int u = F.tid; u < (LDS_BYTES - LDSCTL_OFF) / 4; u += NWAVES * 64) ((LAS unsigned*)(F.lds + LDSCTL_OFF))[u] = 0u;
    __syncthreads();
    const int lo = args.ph_lo, hi = args.ph_hi;
    const bool use_bar = (hi - lo) > 1;
    XcdBarrier bar; bar.bar = (GAS unsigned*)(F.ctl + CW_BAR); bar.x = 0; bar.st = nullptr;
    if (use_bar) bar = xcd_barrier_post((GAS unsigned*)(F.ctl + CW_BAR), F.MISC + 8);
#ifndef ONLYP
#define PH_EN(c) true
#else
#define PH_EN(c) ((c) == ONLYP)
#endif
#define INR(k) (lo <= (k) && (k) < hi)
#define PROBE_MASK 0
#define NREP(c) (((PROBE_MASK) >> (c)) & 1 ? 2 : 1)
#define FRESH() do { asm volatile("" : "+s"(F.ws_), "+s"(F.out_), "+s"(F.hc_), "+s"(F.ctl), "+s"(F.in), "+s"(F.G), "+s"(F.bid), "+s"(F.wave)); asm volatile("" : "+v"(F.tid)); F.lane = F.tid & 63; W = F.WS() + WS_W; MODB = (const float*)(F.WS() + WS_MOD); ACT = (bf16*)(F.WS() + WS_ACT); } while (0)
#define IN(k) (PH_EN((k) - P) && INR(k))
#define SEAM(k) do { if (INR(k) && INR((k) + 1)) { for (int rb = 0; rb < ((PROBE_MASK >> 20) & 1 ? 2 : 1); ++rb) { asm volatile("" : "+s"(bar.bar), "+s"(bar.x)); xcd_barrier(bar); } } } while (0)
    unsigned char* W; const float* MODB; bf16* ACT;
    volatile LAS int* MOE = (volatile LAS int*)(F.lds + MOE_LDS_OFF);
    LAS unsigned char* ring = F.lds + RING_OFF;

    for (int j = 0; j < 2; ++j) {
        const int P = j * PH_PER_PAIR, le = 2 * j, lod = 2 * j + 1;
        const int nMo = (j == 1) ? NLAT / 256 : NTOK / 256;
        if (IN(P + 0)) { for (int rep = 0; rep < NREP(0); ++rep) { FRESH(); prep_phase(F, j); } } SEAM(P + 0);
        if (IN(P + 1)) { FRESH(); norm_phase(F, NormArgs{le, 0, j == 0, j > 0 ? j - 1 : -1, -1, 0, 0}); } SEAM(P + 1);
        if (IN(P + 2)) { for (int rep = 0; rep < NREP(2); ++rep) { FRESH();
            SchedStatic S{ACT, 1024, (const bf16*)(W + WO_WIN_E), 1024, NTOK / 256, 4, F.G, F.bid};
            EpiWin E{(bf16*)(F.WS() + WS_PX), (bf16*)(F.WS() + WS_GT), (bf16*)(F.WS() + WS_GTC)};
            pg8::gemm_phase<EpiWin, SchedStatic>(ring, 1024, S, E, F.tid);
        } } SEAM(P + 2);
        if (IN(P + 3)) { for (int rep = 0; rep < NREP(3); ++rep) { FRESH();
            SchedStatic S{(const bf16*)(F.WS() + WS_PX) + 256, 512, (const bf16*)(W + WO_WUKV), 256, NTOK / 256, 6, F.G, F.bid};
            EpiKV E{(const bf16*)(F.WS() + WS_PX), (bf16*)(F.WS() + WS_K), (bf16*)(F.WS() + WS_VT), G(F.in->a_g_k) + j * 96, (const f32x2*)(F.WS() + WS_ROPE)};
            pg8::gemm_phase<EpiKV, SchedStatic>(ring, 256, S, E, F.tid);
        } } SEAM(P + 3);
        if (IN(P + 4)) { for (int rep = 0; rep < NREP(4); ++rep) { FRESH();
            {
                const bool latf = F.bid < 128; const int have = F.bid < 136;
                SchedOne S{latf ? (const bf16*)(F.WS() + WS_DFT) : (const bf16*)(F.WS() + WS_DFTC), latf ? 8192 : 512, latf ? (const bf16*)(F.WS() + WS_GT) : (const bf16*)(F.WS() + WS_GTC), latf ? 8192 : 512,
                           latf ? (F.bid >> 3) : 0, latf ? (F.bid & 7) : (F.bid - 128), have};
                EpiBf16 E{ACT, 1024, latf ? 1 : 2};
                pg8::gemm_phase<EpiBf16, SchedOne>(ring, S.K, S, E, F.tid);
            }
            __syncthreads();
            mla_attn_phase(F, j, rep);
        } } SEAM(P + 4);
        if (IN(P + 5)) { for (int rep = 0; rep < NREP(5); ++rep) { FRESH();
            SchedResid S{ACT, 1024, (const bf16*)(W + WO_WOUT_E), 1024, 8, F.G, F.bid};
            EpiResid E{F.OUT(), F.HC(), MODB + (size_t)le * 9 * 6144, 2, rep + 1 < NREP(5), (float*)(F.WS() + WS_PART)};
            pg8::gemm_phase<EpiResid, SchedResid>(ring, 1024, S, E, F.tid);
        } } SEAM(P + 5);
        if (IN(P + 6)) { for (int rep = 0; rep < NREP(6); ++rep) { FRESH(); norm_phase(F, NormArgs{le, 1, 0, -1, -1, 0, 1}); } } SEAM(P + 6);
        if (IN(P + 7)) { for (int rep = 0; rep < NREP(7); ++rep) { FRESH();
            SchedStatic S{ACT, 1024, (const bf16*)(W + WO_WGU_E), 1024, NTOK / 256, 2 * DFF / 256, F.G, F.bid};
            EpiSwiglu E{(bf16*)(F.WS() + WS_HMID), DFF};
            pg8::gemm_phase<EpiSwiglu, SchedStatic>(ring, 1024, S, E, F.tid);
        } } SEAM(P + 7);
        if (IN(P + 8)) { for (int rep = 0; rep < NREP(8); ++rep) { FRESH();
            SchedResid S{(const bf16*)(F.WS() + WS_HMID), DFF, (const bf16*)(W + WO_WDN_E), DFF, 8, F.G, F.bid};
            EpiResid E{F.OUT(), F.HC(), MODB + (size_t)le * 9 * 6144, 5, rep + 1 < NREP(8), (float*)(F.WS() + WS_PART)};
            pg8::gemm_phase<EpiResid, SchedResid>(ring, DFF, S, E, F.tid);
        } } SEAM(P + 8);
        if (IN(P + 9)) { for (int rep = 0; rep < NREP(9); ++rep) { FRESH(); norm_phase(F, NormArgs{lod, 0, 0, -1, -1, 0, 1}); } } SEAM(P + 9);
        if (IN(P + 10)) { for (int rep = 0; rep < NREP(10); ++rep) { FRESH();
            SchedStatic S{ACT, 1024, (const bf16*)(W + WO_WIN_O), 1024, NTOK / 256, 12, F.G, F.bid};
            EpiNAin E{(bf16*)(F.WS() + WS_QN), (bf16*)(F.WS() + WS_KN), (bf16*)(F.WS() + WS_VTN), G(F.in->c_g_q) + j * 64, G(F.in->c_g_k) + j * 64};
            pg8::gemm_phase<EpiNAin, SchedStatic>(ring, 1024, S, E, F.tid);
        } } SEAM(P + 10);
        if (IN(P + 11)) { for (int rep = 0; rep < NREP(11); ++rep) { FRESH(); na_phase(F, j, j == 0); } } SEAM(P + 11);
        if (IN(P + 12)) { for (int rep = 0; rep < NREP(12); ++rep) { FRESH();
            SchedResid S{ACT, 1024, (const bf16*)(W + WO_WOUT_O), 1024, nMo - 128, F.G, F.bid};
            EpiResid E{F.OUT(), F.HC(), MODB + (size_t)lod * 9 * 6144, 2, rep + 1 < NREP(12), (float*)(F.WS() + WS_PART)};
            pg8::gemm_phase<EpiResid, SchedResid>(ring, 1024, S, E, F.tid);
        } } SEAM(P + 12);
        if (IN(P + 13)) { FRESH(); norm_phase(F, NormArgs{lod, 1, 0, -1, j, j == 1, 1}); } SEAM(P + 13);
        if (IN(P + 14)) { for (int rep = 0; rep < NREP(14); ++rep) { FRESH();
            moe_panels_to_lds(F, j);
            SchedMoe<true> S{ACT, 1024, (const bf16*)(W + WO_WGU_M), (size_t)2 * DFFE * 1024 * 2, 1024, 2 * DFFE / 256, F.G, F.bid, (const int*)(F.WS() + WS_LIST), MOE};
            EpiSwiglu E{(bf16*)(F.WS() + WS_HMOE), DFFE};
            pg8::gemm_phase<EpiSwiglu, SchedMoe<true>>(ring, 1024, S, E, F.tid);
        } } SEAM(P + 14);
        if (IN(P + 15)) { for (int rep = 0; rep < NREP(15); ++rep) { FRESH();
            moe_panels_to_lds(F, j);
            SchedMoe<false> S{(const bf16*)(F.WS() + WS_HMOE), DFFE, (const bf16*)(W + WO_WDN_M), (size_t)1024 * DFFE * 2, DFFE, 4, F.G, F.bid, nullptr, MOE};
            EpiBf16 E{(bf16*)(F.WS() + WS_Y), 1024, 0};
            pg8::gemm_phase<EpiBf16, SchedMoe<false>>(ring, DFFE, S, E, F.tid);
        } } SEAM(P + 15);
    }
    { const int P = 0; if (IN(2 * PH_PER_PAIR)) { FRESH(); norm_phase(F, NormArgs{3, 0, 0, 1, -1, 1, 0}); } }
#undef IN
#undef INR
#undef SEAM
}

#if DBG

#endif

extern "C" void kernel_launch(void* const* d_in, const int* in_sizes, int n_in, void* d_out, int out_size, void* d_ws, size_t ws_size, hipStream_t stream) {
    static int grid = 0;
    if (grid == 0) {
        if (n_in != 27 || in_sizes[0] != NLAT * DM || out_size != NLAT * DM || ws_size < WS_END) {
            fprintf(stderr, "kernel_launch: built for 27 inputs, x/out of %d floats, >= %zu bytes of workspace; got n_in %d, in0 %d, out %d, ws %zu; nothing launched\n", NLAT * DM, (size_t)WS_END, n_in, n_in > 0 ? in_sizes[0] : -1, out_size, ws_size);
            grid = -1; return; }
        int dev = 0, cus = 0, per_cu = 0;
        if (hipGetDevice(&dev) != hipSuccess || hipDeviceGetAttribute(&cus, hipDeviceAttributeMultiprocessorCount, dev) != hipSuccess) { fprintf(stderr, "kernel_launch: device query failed\n"); grid = -1; return; }
        if (hipFuncSetAttribute((const void*)dit_fwd, hipFuncAttributeMaxDynamicSharedMemorySize, LDS_BYTES) != hipSuccess) { fprintf(stderr, "kernel_launch: hipFuncSetAttribute failed\n"); grid = -1; return; }
        if (hipOccupancyMaxActiveBlocksPerMultiprocessor(&per_cu, (const void*)dit_fwd, NWAVES * 64, LDS_BYTES) != hipSuccess || per_cu < 1) { fprintf(stderr, "kernel_launch: occupancy query reports %d workgroups per CU\n", per_cu); }
        (void)hipGetLastError();
        grid = cus;
    }
    if (grid < 0) return;
    if (hipMemsetAsync((char*)d_ws + WS_CTL, 0, CTL_ZERO_BYTES, stream) != hipSuccess) { fprintf(stderr, "kernel_launch: memset failed\n"); return; }
    Args a{};
    const float** ip = (const float**)(void*)&a.in;
    for (int i = 0; i < 27; ++i) ip[i] = (const float*)d_in[i];
    a.out = (float*)d_out; a.ws = (unsigned char*)d_ws;
#if DBG
    dbg_launch_all(a, grid, stream);
#else
    a.ph_lo = 0; a.ph_hi = N_PHASES;
    hipLaunchKernelGGL(dit_fwd, dim3(grid), dim3(NWAVES * 64), LDS_BYTES, stream, a);
    const hipError_t le = hipPeekAtLastError();
    if (le != hipSuccess) fprintf(stderr, "kernel_launch: launch failed: %s\n", hipGetErrorName(le));
#endif
}
```

```cpp
#include <hip/hip_runtime.h>
#include <cstdio>
#include <cstdint>

#define LAS __attribute__((address_space(3)))
#define GAS __attribute__((address_space(1)))
typedef unsigned short bf16;
typedef short bf16x8 __attribute__((ext_vector_type(8)));
typedef short bf16x4 __attribute__((ext_vector_type(4)));
typedef float f32x4 __attribute__((ext_vector_type(4)));
typedef float f32x2 __attribute__((ext_vector_type(2)));
typedef float f32x16 __attribute__((ext_vector_type(16)));
typedef unsigned u32x4 __attribute__((ext_vector_type(4)));
typedef unsigned u32x2 __attribute__((ext_vector_type(2)));

#define DBG 0

constexpr int DM = 1024, NB = 8, SEQ = 4096, CTXL = 256;
constexpr int NLAT = NB * SEQ, NCTX = NB * CTXL, NTOK = NLAT + NCTX;
constexpr int KPOS = SEQ + CTXL;
constexpr int A_HEADS = 12, A_QK = 96, A_IN_SRC = 672;
constexpr int C_HEADS = 16;
constexpr int DFF = 2816, NEXP = 8, DFFE = 1408;
constexpr int MOE_SLOTS = 2 * NTOK + NEXP * 256;
constexpr float EPS = 1e-6f;
constexpr float LOG2E = 1.4426950408889634f;

__device__ __forceinline__ unsigned f2bf(float f) { unsigned u = __builtin_bit_cast(unsigned, f); return (u + 0x7fffu + ((u >> 16) & 1u)) >> 16; }
typedef __bf16 bf16x2_hw __attribute__((ext_vector_type(2)));
__device__ __forceinline__ unsigned cvt_pk_bf16(float lo, float hi) { const f32x2 v = {lo, hi}; const bf16x2_hw b = __builtin_convertvector(v, bf16x2_hw); return __builtin_bit_cast(unsigned, b); }
__device__ __forceinline__ unsigned pk2(float lo, float hi) { return cvt_pk_bf16(lo, hi); }
__device__ __forceinline__ float bf2f(unsigned short h) { return __builtin_bit_cast(float, (unsigned)h << 16); }
__device__ __forceinline__ float bflo(unsigned w) { return __builtin_bit_cast(float, w << 16); }
__device__ __forceinline__ float bfhi(unsigned w) { return __builtin_bit_cast(float, w & 0xffff0000u); }

namespace pg8 {
typedef unsigned u32x4 __attribute__((ext_vector_type(4)));
#define PG8_LAS __attribute__((address_space(3)))
constexpr int GN_LDS_OFF = 131072;
constexpr int BM = 256, BK = 64, HALF = 128, HTB = HALF * BK * 2  , STAGE_BYTES = 8 * HTB, NXCD = 8, WGM = 8;

__host__ __device__ __forceinline__ int lds_byte(int r, int c) { const int st = (r >> 4) * 2 + (c >> 5), rr = r & 15, cc = c & 31, ob = rr * 64 + cc * 2; return st * 1024 + (ob ^ (((ob >> 9) & 1) << 5)); }
__host__ __device__ __forceinline__ void stage_rc(int b, int& R, int& C) { const int st = b / 1024, sb = b % 1024, swz = sb ^ (((sb >> 9) & 1) << 5); R = (st >> 1) * 16 + swz / 64; C = (st & 1) * 32 + (swz % 64) / 2; }
__host__ __device__ __forceinline__ int perm32(int rho) { const int n = rho >> 4, i = rho & 15; return 8 * (i >> 2) + 4 * n + (i & 3); }

struct Unit { int pm, pn, kq; };

__device__ __forceinline__ bool static_next(int i, int G, int c, int nM, int nN, Unit& u) {
    const int nwg = nM * nN;
    const long L = (long)i * G + c; if (L >= nwg) return false;
    int wgid = (int)L; { const int q = nwg / NXCD, r = nwg % NXCD, xcd = wgid % NXCD, off = wgid / NXCD; wgid = (xcd < r ? xcd * (q + 1) : r * (q + 1) + (xcd - r) * q) + off; }
    const int nig = WGM * nN, gid = wgid / nig, fm = gid * WGM, gsz = (nM - fm) < WGM ? (nM - fm) : WGM;
    u.pm = fm + ((wgid % nig) % gsz); u.pn = (wgid % nig) / gsz; u.kq = -1; return true;
}

template <class Epi, class Sched, bool ALIGN_EPI = true, bool SP2 = true>
__device__ __forceinline__ void gemm_phase(PG8_LAS unsigned char* lds, const int K, const Sched& S, const Epi& E, const int tid) {
    const int wid = __builtin_amdgcn_readfirstlane(tid >> 6), lane = tid & 63, wr = wid >> 2, wc = wid & 3, fr = lane & 15, fq = lane >> 4;
    unsigned voffB[2], voffA[2];
    const unsigned lda = (unsigned)S.lda;
#pragma unroll
    for (int i = 0; i < 2; ++i) { int R, C; stage_rc(tid * 16 + i * 8192, R, C); const int Rb = Epi::PERM ? ((R & ~31) + perm32(R & 31)) : R;
        const int Ra = Epi::RPERM ? ((R & ~63) + 4 * (R & 15) + ((R >> 4) & 3)) : R;
        voffB[i] = (unsigned)(Rb * K + C) * 2u; voffA[i] = ((unsigned)Ra * lda + (unsigned)C) * 2u; }
    const char* const Ab = (const char*)S.A;
    const size_t kstep = (size_t)(BK * 2);
    const size_t hstep = (size_t)HALF * K * 2;
    const size_t hstepA = (size_t)HALF * lda * 2;
    const unsigned ldsw = (unsigned)wid * 1024u;
    const int aoff = lds_byte(wr * 64 + fr, fq * 8), boff = lds_byte(wc * 32 + fr, fq * 8);
#define PG8_SA(b, h) (((b) * 2 + (h)) * HTB)
#define PG8_SB(b, h) ((4 + (b) * 2 + (h)) * HTB)
#define PG8_STAGE(bufoff, gbase, voff) do { _Pragma("unroll") for (int _i = 0; _i < 2; ++_i) \
        __builtin_amdgcn_global_load_lds((const unsigned*)((const char*)(gbase) + (voff)[_i]), (PG8_LAS unsigned*)(lds + (bufoff) + ldsw + _i * 8192), 16, 0, 0); } while (0)
#define PG8_LDA(dst, b, h) do { _Pragma("unroll") for (int m = 0; m < 4; ++m) _Pragma("unroll") for (int k = 0; k < 2; ++k) dst[m][k] = *(const PG8_LAS bf16x8*)(lds + PG8_SA(b, h) + aoff + m * 2048 + k * 1024); } while (0)
#define PG8_LDB(dst, b, h) do { _Pragma("unroll") for (int n = 0; n < 2; ++n) _Pragma("unroll") for (int k = 0; k < 2; ++k) dst[n][k] = *(const PG8_LAS bf16x8*)(lds + PG8_SB(b, h) + boff + n * 2048 + k * 1024); } while (0)
#define PG8_MMA(ai, bj, At, Bt) do { __builtin_amdgcn_s_setprio(1); _Pragma("unroll") for (int m = 0; m < 4; ++m) _Pragma("unroll") for (int n = 0; n < 2; ++n) _Pragma("unroll") for (int k = 0; k < 2; ++k) \
        acc[ai][bj][m][n] = __builtin_amdgcn_mfma_f32_16x16x32_bf16(Bt[n][k], At[m][k], acc[ai][bj][m][n], 0, 0, 0); __builtin_amdgcn_s_setprio(0); } while (0)
#define PG8_WAIT_V(n) asm volatile("s_waitcnt vmcnt(" #n ")" ::: "memory")
#define PG8_WAIT_L(n) asm volatile("s_waitcnt lgkmcnt(" #n ")" ::: "memory")
#define PG8_BAR __builtin_amdgcn_s_barrier()
#define PG8_SCHED __builtin_amdgcn_sched_barrier(0)
    Unit cur, nxt; int ui = 0;
    if (!S.next(0, cur)) return;
    f32x4 acc[2][2][4][2];
    bf16x8 At[4][2], B0[2][2], B1[2][2];
    constexpr bool GATHER = Sched::GATHER;
    const char* cA = Ab; const char* nA = Ab;
    unsigned ga0[2] = {0u, 0u}, ga1[2] = {0u, 0u};
    PG8_LAS u32x4* const gnslot = (PG8_LAS u32x4*)(lds + GN_LDS_OFF) + tid;
    if constexpr (GATHER) {
#pragma unroll
        for (int i = 0; i < 2; ++i) { int R, C; stage_rc(tid * 16 + i * 8192, R, C); ga0[i] = (S.a_row(cur, R) * lda + (unsigned)C) * 2u; ga1[i] = (S.a_row(cur, HALF + R) * lda + (unsigned)C) * 2u; }
    } else { cA = Ab + (size_t)S.a_row(cur, 0) * lda * 2 + (size_t)S.k0(cur) * (BK * 2); }
    const char* cB = S.b_base(cur) + (size_t)S.k0(cur) * (BK * 2);
    int nt = S.nt(cur), ntn = nt;
#define PG8_STAGE_A(bufoff, h, uptr, kb, g0, g1) do { if constexpr (GATHER) { if (h) PG8_STAGE(bufoff, Ab + (kb), g1); else PG8_STAGE(bufoff, Ab + (kb), g0); } \
        else { PG8_STAGE(bufoff, (uptr) + (h) * hstepA + (kb), voffA); } } while (0)
    static_assert(SP2, "only the SP2 loop is carried here");
    PG8_STAGE(PG8_SB(0, 0), cB, voffB); PG8_STAGE(PG8_SB(0, 1), cB + hstep, voffB); PG8_STAGE_A(PG8_SA(0, 0), 0, cA, 0, ga0, ga1); PG8_STAGE_A(PG8_SA(0, 1), 1, cA, 0, ga0, ga1);
    if (wr == 1) PG8_BAR;
    PG8_WAIT_V(2); PG8_BAR;
    PG8_STAGE(PG8_SB(1, 0), cB + kstep, voffB); PG8_STAGE_A(PG8_SA(1, 0), 0, cA, kstep, ga0, ga1); PG8_STAGE(PG8_SB(1, 1), cB + hstep + kstep, voffB);
    PG8_WAIT_V(6); PG8_BAR;
    for (;;) {
        const bool has_next = S.next(ui + 1, nxt);
        const char* nB = has_next ? S.b_base(nxt) + (size_t)S.k0(nxt) * (BK * 2) : cB;
        ntn = has_next ? S.nt(nxt) : nt;
        if constexpr (GATHER) {
            u32x4 gn = (u32x4){ga0[0], ga0[1], ga1[0], ga1[1]};
            if (has_next) { int R0, C0, R1, C1; stage_rc(tid * 16, R0, C0); stage_rc(tid * 16 + 8192, R1, C1);
                gn.x = (S.a_row(nxt, R0) * lda + (unsigned)C0) * 2u; gn.y = (S.a_row(nxt, R1) * lda + (unsigned)C1) * 2u;
                gn.z = (S.a_row(nxt, HALF + R0) * lda + (unsigned)C0) * 2u; gn.w = (S.a_row(nxt, HALF + R1) * lda + (unsigned)C1) * 2u; }
            *gnslot = gn;
        } else { nA = has_next ? Ab + (size_t)S.a_row(nxt, 0) * lda * 2 + (size_t)S.k0(nxt) * (BK * 2) : cA; }
#pragma unroll
        for (int a = 0; a < 2; ++a)
#pragma unroll
            for (int b = 0; b < 2; ++b)
#pragma unroll
                for (int m = 0; m < 4; ++m)
#pragma unroll
                    for (int n = 0; n < 2; ++n) acc[a][b][m][n] = (f32x4){0.f, 0.f, 0.f, 0.f};
#pragma nounroll
        for (int t = 0; t < nt; t += 2) {
            const bool last = (t == nt - 2);
            const size_t k1 = (size_t)(t + 1) * kstep, k2 = last ? 0 : (size_t)(t + 2) * kstep, k3 = k2 + kstep;
            const char* u2 = last ? nA : cA;
            const char* b2 = last ? nB : cB + (size_t)(t + 2) * kstep; const char* b3 = b2 + kstep;
            unsigned o20[2] = {0u, 0u}, o21[2] = {0u, 0u};
            if constexpr (GATHER) {
                if (last) { const u32x4 gn = *gnslot; o20[0] = gn.x; o20[1] = gn.y; o21[0] = gn.z; o21[1] = gn.w; }
                else { o20[0] = ga0[0]; o20[1] = ga0[1]; o21[0] = ga1[0]; o21[1] = ga1[1]; }
            }
            PG8_LDB(B0, 0, 0); PG8_LDB(B1, 0, 1); PG8_SCHED; PG8_LDA(At, 0, 0); PG8_STAGE_A(PG8_SA(1, 1), 1, cA, k1, ga0, ga1);
            PG8_WAIT_V(8); PG8_WAIT_L(0); PG8_BAR; PG8_MMA(0, 0, At, B0); PG8_MMA(0, 1, At, B1); PG8_BAR; PG8_SCHED;
            PG8_LDA(At, 0, 1); PG8_STAGE(PG8_SB(0, 0), b2, voffB); PG8_STAGE(PG8_SB(0, 1), b2 + hstep, voffB); PG8_STAGE_A(PG8_SA(0, 0), 0, u2, k2, o20, o21);
            PG8_WAIT_V(8); PG8_WAIT_L(0); PG8_BAR; PG8_MMA(1, 0, At, B0); PG8_MMA(1, 1, At, B1); PG8_BAR; PG8_SCHED;
            PG8_LDB(B0, 1, 0); PG8_LDB(B1, 1, 1); PG8_SCHED; PG8_LDA(At, 1, 0); PG8_STAGE_A(PG8_SA(0, 1), 1, u2, k2, o20, o21);
            PG8_WAIT_V(8); PG8_WAIT_L(0); PG8_BAR; PG8_MMA(0, 0, At, B0); PG8_MMA(0, 1, At, B1); PG8_BAR; PG8_SCHED;
            PG8_LDA(At, 1, 1); PG8_STAGE(PG8_SB(1, 0), b3, voffB); PG8_STAGE(PG8_SB(1, 1), b3 + hstep, voffB); PG8_STAGE_A(PG8_SA(1, 0), 0, u2, k3, o20, o21);
            PG8_WAIT_V(8); PG8_WAIT_L(0); PG8_BAR; PG8_MMA(1, 0, At, B0); PG8_MMA(1, 1, At, B1); PG8_BAR; PG8_SCHED;
        }
        if constexpr (ALIGN_EPI) { if (wr == 0) PG8_BAR; }
        { int fr_ = fr, fq_ = fq, wr_ = wr, wc_ = wc; asm volatile("" : "+v"(fr_), "+v"(fq_), "+s"(wr_), "+s"(wc_));
          E(acc, cur, wr_, wc_, fr_, fq_); }
        if (!has_next) break;
        cur = nxt; cB = nB; cA = nA; nt = ntn; ++ui;
        if constexpr (GATHER) { const u32x4 gn = *gnslot; ga0[0] = gn.x; ga0[1] = gn.y; ga1[0] = gn.z; ga1[1] = gn.w; }
        if constexpr (ALIGN_EPI) { if (wr == 1) PG8_BAR; }
    }
    PG8_WAIT_V(0);
    if constexpr (!ALIGN_EPI) { if (wr == 0) PG8_BAR; }
    PG8_BAR;
#undef PG8_SA
#undef PG8_SB
#undef PG8_STAGE
#undef PG8_STAGE_A
#undef PG8_LDA
#undef PG8_LDB
#undef PG8_MMA
#undef PG8_WAIT_V
#undef PG8_WAIT_L
#undef PG8_BAR
#undef PG8_SCHED
}
}

constexpr size_t MiB = 1u << 20;
constexpr size_t WS_CTL = 0, CTL_ZERO_BYTES = 1 * MiB;
constexpr size_t WS_MOD = 1 * MiB;
constexpr size_t WS_ROPE = 2 * MiB;
constexpr size_t WS_ROUTE = 3 * MiB;
constexpr size_t WS_LIST = 4 * MiB;
constexpr size_t WS_ROWST = 6 * MiB;
constexpr size_t WS_HC = 8 * MiB;
constexpr size_t WS_W = 16 * MiB;
constexpr size_t WS_DFT = 114 * MiB;
constexpr size_t WS_DFTC = WS_DFT + 64 * MiB;
constexpr size_t WS_SCR = 180 * MiB;
constexpr size_t WS_ACT = WS_SCR;
constexpr size_t WS_PX = WS_SCR + 68 * MiB;
constexpr size_t WS_GT = WS_SCR + 102 * MiB;
constexpr size_t WS_GTC = WS_SCR + 134 * MiB;
constexpr size_t WS_K = WS_SCR + 136 * MiB;
constexpr size_t WS_VT = WS_SCR + 213 * MiB;
constexpr size_t WS_HMID = WS_SCR + 68 * MiB;
constexpr size_t WS_QN = WS_SCR + 68 * MiB;
constexpr size_t WS_KN = WS_SCR + 136 * MiB;
constexpr size_t WS_VTN = WS_SCR + 204 * MiB;
constexpr size_t WS_HMOE = WS_SCR + 68 * MiB;
constexpr size_t WS_Y = WS_SCR + 261 * MiB;
constexpr size_t WS_GF = WS_SCR + 304 * MiB;
constexpr size_t WS_PART = WS_SCR + 272 * MiB;
constexpr size_t WS_END = WS_SCR + 401 * MiB;
static_assert((size_t)NTOK * 1024 * 2 <= 68 * MiB && (size_t)NTOK * 512 * 2 <= 34 * MiB && (size_t)NB * A_HEADS * KPOS * 96 * 2 <= 77 * MiB && (size_t)NB * A_HEADS * 64 * KPOS * 2 <= 51 * MiB, "even map");
static_assert((size_t)NTOK * DFF * 2 <= 196 * MiB && (size_t)NB * C_HEADS * 64 * KPOS * 2 <= 68 * MiB + 4 * MiB && (size_t)MOE_SLOTS * DFFE * 2 <= 193 * MiB && (size_t)MOE_SLOTS * 1024 * 2 <= 140 * MiB, "odd map");
constexpr size_t WO_WIN_E = 0, WO_WUKV = 2 * MiB, WO_WUQ = 3 * MiB, WO_WOUT_E = 4 * MiB, WO_WGU_E = 6 * MiB, WO_WDN_E = 17 * MiB;
constexpr size_t WO_WIN_O = 23 * MiB, WO_WOUT_O = 29 * MiB, WO_WGU_M = 31 * MiB, WO_WDN_M = 75 * MiB;
constexpr int CW_BAR = 4096;
constexpr int CW_MOECNT = 8192;
constexpr int CW_ATTQ = 8192 + 256;
constexpr int CW_CHK = 16384;

constexpr int RING_OFF = 0, RING_BYTES = 131072;
constexpr int LDS_BYTES = 163840;
constexpr int LDSCTL_OFF = LDS_BYTES - 1024, MISC_OFF = LDSCTL_OFF + 320;
constexpr int MOE_LDS_OFF = MISC_OFF + 128;
static_assert(MOE_LDS_OFF + 128 <= LDS_BYTES && pg8::GN_LDS_OFF == RING_BYTES && pg8::GN_LDS_OFF + 512 * 16 <= LDSCTL_OFF, "LDS map");
constexpr int NWAVES = 8;

#define CAS __attribute__((address_space(4)))
typedef GAS unsigned gu32;
#define RLX_AGENT __ATOMIC_RELAXED, __HIP_MEMORY_SCOPE_AGENT
#define LDS_WAIT() asm volatile("s_waitcnt lgkmcnt(0)" ::: "memory")
#define VM_WAIT() asm volatile("s_waitcnt vmcnt(0)" ::: "memory")

#define XB_TMO      128
#define XB_XCNT(j)  (256  + 64 * (j))
#define XB_XSUB(j)  (1280 + 64 * (j))
#define XB_XGEN(j)  (2304 + 64 * (j))
#define XB_TOP      3328
#define XB_TOPGEN   3392
#define XCD_BAR_WORDS 3456
#define XB_SPIN_CAP (1u << 18)

__device__ __forceinline__ unsigned xb_ld(GAS unsigned* p)              { return __hip_atomic_load(p, __ATOMIC_RELAXED, __HIP_MEMORY_SCOPE_AGENT); }
__device__ __forceinline__ unsigned xb_add(GAS unsigned* p, unsigned v) { return __hip_atomic_fetch_add(p, v, __ATOMIC_RELAXED, __HIP_MEMORY_SCOPE_AGENT); }
__device__ __forceinline__ unsigned xb_xcc_id() { return (unsigned)__builtin_amdgcn_s_getreg((3 << 11) | 20) & 0xFu; }
#define XB_SPIN(cond, bar) do { unsigned _sp = 0; while (cond) { __builtin_amdgcn_s_sleep(1); \
    if ((++_sp & 255u) == 0u) { if (xb_ld(&(bar)[XB_TMO])) break; if (_sp > XB_SPIN_CAP) { (void)xb_add(&(bar)[XB_TMO], 1u); break; } } } } while (0)

struct XcdBarrier {
    GAS unsigned* bar; unsigned x;
    volatile LAS unsigned* st;
};
__device__ __forceinline__ XcdBarrier xcd_barrier_post(GAS unsigned* bar, volatile LAS unsigned* st) {
    XcdBarrier b; b.bar = bar; b.x = xb_xcc_id(); b.st = st;
    if (threadIdx.x == 0) (void)xb_add(&bar[XB_XCNT(b.x)], 1u);
    return b;
}
__device__ __forceinline__ void xcd_barrier_complete(GAS unsigned* bar, unsigned x, unsigned& nloc, unsigned& nx) {
    const unsigned G = gridDim.x * gridDim.y * gridDim.z;
    unsigned sum, cnt, mine, sp = 0u;
    for (;;) {
        sum = 0u; cnt = 0u; mine = 0u;
#pragma unroll
        for (unsigned j = 0; j < 16; ++j) { const unsigned c = xb_ld(&bar[XB_XCNT(j)]); sum += c; cnt += (c > 0u) ? 1u : 0u; mine = (j == x) ? c : mine; }
        if (sum == G) break;
        __builtin_amdgcn_s_sleep(1);
        if ((++sp & 255u) == 0u) { if (xb_ld(&bar[XB_TMO])) break; if (sp > XB_SPIN_CAP) { (void)xb_add(&bar[XB_TMO], 1u); break; } }
    }
    nloc = mine > 0u ? mine : 1u; nx = cnt > 0u ? cnt : 1u;
}
__device__ __forceinline__ void xcd_barrier(const XcdBarrier& b) {
    asm volatile("s_waitcnt vmcnt(0)" ::: "memory");
    __syncthreads();
    if (threadIdx.x == 0) {
        GAS unsigned* bar = b.bar;
        __builtin_amdgcn_s_waitcnt(0);
        unsigned nloc = b.st[0], nx = b.st[1];
        if (nloc == 0u) { xcd_barrier_complete(bar, b.x, nloc, nx); b.st[0] = nloc; b.st[1] = nx; }
        const unsigned old = xb_add(&bar[XB_XSUB(b.x)], 1u);
        const unsigned gen = old / nloc;
        if (old + 1u == (gen + 1u) * nloc) {
            __builtin_amdgcn_fence(__ATOMIC_RELEASE, "agent");
            asm volatile("s_waitcnt vmcnt(0)" ::: "memory");
            const unsigned og = xb_add(&bar[XB_TOP], 1u);
            const unsigned tg = og / nx;
            if (og + 1u == (tg + 1u) * nx) xb_add(&bar[XB_TOPGEN], 1u);
            else XB_SPIN(xb_ld(&bar[XB_TOPGEN]) == tg, bar);
            __builtin_amdgcn_fence(__ATOMIC_ACQUIRE, "agent");
            xb_add(&bar[XB_XGEN(b.x)], 1u);
            asm volatile("s_waitcnt vmcnt(0)" ::: "memory");
        } else {
            XB_SPIN(xb_ld(&bar[XB_XGEN(b.x)]) == gen, bar);
            __builtin_amdgcn_fence(__ATOMIC_ACQUIRE, "agent");
            asm volatile("s_waitcnt vmcnt(0)" ::: "memory");
        }
    }
    __syncthreads();
}

struct Inputs {
    const float *x, *c, *ctx, *c_ctx, *w_mod, *b_mod, *norm_g;
    const float *a_w_in, *a_g_cq, *a_g_ckv, *a_w_uq, *a_w_ukv, *a_g_q, *a_g_k, *a_w_out;
    const float *f_w_gate, *f_w_up, *f_w_down;
    const float *c_w_in, *c_g_q, *c_g_k, *c_rpb, *c_w_out;
    const float *m_w_router, *m_w_gate, *m_w_up, *m_w_down;
};
template <class T> __device__ __forceinline__ T* G(T* p) { GAS T* g = (GAS T*)p; asm volatile("" : "+s"(g)); return (T*)g; }
struct Frame {
    LAS unsigned char* lds;
    volatile LAS unsigned* MISC;
    gu32* ctl;
    GAS unsigned char* ws_;
    GAS float* out_;
    GAS float* hc_;
    __device__ __forceinline__ unsigned char* WS() const { return (unsigned char*)ws_; }
    __device__ __forceinline__ float* OUT() const { return (float*)out_; }
    __device__ __forceinline__ float* HC() const { return (float*)hc_; }
    int tid, lane, wave, G, bid;
    const CAS Inputs* in;
};
__device__ __forceinline__ float* hrow(const Frame& F, int r) { return r < NLAT ? F.OUT() + (size_t)r * DM : F.HC() + (size_t)(r - NLAT) * DM; }
__device__ __forceinline__ int row_b9(int r) { return r < NLAT ? (r >> 12) : 8; }
__device__ __forceinline__ const float* modp(const Frame& F, int layer, int b9, int k) { return (const float*)(F.WS() + WS_MOD) + ((size_t)layer * 9 + b9) * 6144 + k * 1024; }

__device__ __forceinline__ void swap32(unsigned& a, unsigned& b) { const auto r = __builtin_amdgcn_permlane32_swap(a, b, false, false); a = r[0]; b = r[1]; }
__device__ __forceinline__ void swap16(unsigned& a, unsigned& b) { const auto r = __builtin_amdgcn_permlane16_swap(a, b, false, false); a = r[0]; b = r[1]; }
template <int CTRL> __device__ __forceinline__ float dppf(float v) { return __builtin_bit_cast(float, __builtin_amdgcn_update_dpp(0, __builtin_bit_cast(int, v), CTRL, 0xF, 0xF, true)); }
__device__ __forceinline__ float wave_sum(float v) {
    v += dppf<0xB1>(v); v += dppf<0x4E>(v); v += dppf<0x141>(v); v += dppf<0x140>(v);
    unsigned a = __builtin_bit_cast(unsigned, v), b = a; asm volatile("" : "+v"(b)); swap16(a, b); v = __builtin_bit_cast(float, a) + __builtin_bit_cast(float, b);
    a = __builtin_bit_cast(unsigned, v); b = a; asm volatile("" : "+v"(b)); swap32(a, b); v = __builtin_bit_cast(float, a) + __builtin_bit_cast(float, b);
    return v;
}

struct WMap { int which; int col; };
__device__ __forceinline__ WMap wmap(int mode, int n, int nsrc) {
    WMap r; r.which = 0;
    const int pn = n >> 8, ct = n & 255, bj = ct >> 7, wc = (ct >> 5) & 3, w = ct & 31;
    if (mode == 0) { r.col = n < nsrc ? n : -1; }
    else if (mode == 1) { const int head = 2 * pn + (wc >> 1), part = wc & 1; r.col = head * 128 + part * 64 + 32 * bj + w; }
    else if (mode == 2) { const int nn = (ct >> 4) & 1, fq = (ct >> 2) & 3, e = ct & 3; r.which = nn; r.col = pn * 128 + bj * 64 + wc * 16 + fq * 4 + e; }
    else { r.col = (pn * 4 + wc) * 64 + 32 * bj + w; }
    return r;
}
__device__ __forceinline__ void wconv_item(const float* W0, const float* W1, int ld, int Ksrc, int nsrc, const float* kscale, bf16* WT, int Kdst, int mode, int kb, int nb, LAS float* scr, int lane) {
    const int k0 = 64 * kb, n0 = 64 * nb, n4 = (lane & 15) * 4;
    const WMap mp = wmap(mode, n0 + n4, nsrc);
    const float* W = mp.which ? W1 : W0;
#pragma unroll 4
    for (int i = 0; i < 16; ++i) { const int kk = (lane >> 4) + 4 * i, k = k0 + kk; f32x4 v = (f32x4){0.f, 0.f, 0.f, 0.f};
        if (mp.col >= 0 && k < Ksrc) { v = *(const f32x4*)(W + (size_t)k * ld + mp.col); if (kscale) v = v * kscale[k]; }
        LAS float* d = scr + kk * 65 + n4; d[0] = v.x; d[1] = v.y; d[2] = v.z; d[3] = v.w; }
    LDS_WAIT(); asm volatile("" ::: "memory");
#pragma unroll
    for (int c = 0; c < 8; ++c) { const LAS float* s = scr + (8 * c) * 65 + lane;
        u32x4 o; o.x = pk2(s[0 * 65], s[1 * 65]); o.y = pk2(s[2 * 65], s[3 * 65]); o.z = pk2(s[4 * 65], s[5 * 65]); o.w = pk2(s[6 * 65], s[7 * 65]);
        *(GAS u32x4*)(WT + (size_t)(n0 + lane) * Kdst + k0 + 8 * c) = o; }
    LDS_WAIT(); asm volatile("" ::: "memory");
}
struct WJob { const float* W0; const float* W1; int ld, Ksrc, nsrc; const float* kscale; bf16* WT; int Kdst, Ndst, mode; };
__device__ __forceinline__ bool wjob_run(const WJob& J, int& r, LAS float* scr, int lane) {
    const int nblk = J.Ndst / 64, items = (J.Kdst / 64) * nblk;
    if (r < items) { wconv_item(J.W0, J.W1, J.ld, J.Ksrc, J.nsrc, J.kscale, J.WT, J.Kdst, J.mode, r / nblk, r % nblk, scr, lane); return true; }
    r -= items; return false;
}

__device__ __forceinline__ void prep_phase(Frame& F, int j) {
    const CAS Inputs& I = *F.in;
    unsigned char* W = F.WS() + WS_W;
    if (j == 0) {
        LAS float* sv = (LAS float*)(F.lds);
        LAS float* red = (LAS float*)(F.lds + 40960);
        for (int idx = F.tid; idx < 9 * 1024; idx += NWAVES * 64) { const int r = idx >> 10, k = idx & 1023; const float cv = r < 8 ? G(I.c)[r * 1024 + k] : G(I.c_ctx)[k]; sv[idx] = cv / (1.f + __expf(-cv)); }
        __syncthreads();
        for (int it = F.bid; it < 4 * 96; it += F.G) {
            const int layer = it / 96, chunk = it % 96, n = chunk * 64 + F.lane;
            const float* wm = G(I.w_mod) + (size_t)layer * 1024 * 6144 + n;
            float acc[9];
#pragma unroll
            for (int r = 0; r < 9; ++r) acc[r] = 0.f;
            const int kb = F.wave * 128;
#pragma unroll 4
            for (int k = 0; k < 128; ++k) { const float wv = wm[(size_t)(kb + k) * 6144];
#pragma unroll
                for (int r = 0; r < 9; ++r) acc[r] += sv[r * 1024 + kb + k] * wv; }
#pragma unroll
            for (int r = 0; r < 9; ++r) red[(F.wave * 9 + r) * 64 + F.lane] = acc[r];
            __syncthreads();
            for (int idx = F.tid; idx < 9 * 64; idx += NWAVES * 64) { const int r = idx >> 6, l = idx & 63; float s = 0.f;
#pragma unroll
                for (int w = 0; w < 8; ++w) s += red[(w * 9 + r) * 64 + l];
                const int nn = chunk * 64 + l;
                ((float*)(F.WS() + WS_MOD))[((size_t)layer * 9 + r) * 6144 + nn] = s + G(I.b_mod)[layer * 6144 + nn]; }
            __syncthreads();
        }
        if (F.bid == 0) { const int pos = F.tid >> 3, f = F.tid & 7; const float inv = powf(10000.f, -(float)f / 8.f); const float ang = (float)pos * inv;
            ((f32x2*)(F.WS() + WS_ROPE))[F.tid] = (f32x2){cosf(ang), sinf(ang)}; }
        __syncthreads();
        LAS f32x2* tab = (LAS f32x2*)(F.lds);
        for (int m = F.tid; m < 4096; m += NWAVES * 64) { float s, c; sincospif((float)m * (1.f / 2048.f), &s, &c); tab[m] = (f32x2){c, s}; }
        __syncthreads();
        bf16* DF = (bf16*)(F.WS() + WS_DFT);
        for (int q = F.bid * (NWAVES * 64) + F.tid; q < 4096 * 512; q += F.G * NWAVES * 64) {
            const int np = q >> 9, kk0 = (q & 511) * 8, type = kk0 >= 2048, n = kk0 & 2047; float v[8];
#pragma unroll
            for (int e = 0; e < 8; ++e) { const int nn = n + e; const f32x2 t = tab[(np * ((type && nn == 0) ? 2048 : nn)) & 4095]; v[e] = ((type && nn != 0) ? -t.y : t.x) * (1.f / 512.f); }
            u32x4 o; o.x = pk2(v[0], v[1]); o.y = pk2(v[2], v[3]); o.z = pk2(v[4], v[5]); o.w = pk2(v[6], v[7]);
            *(GAS u32x4*)(DF + (size_t)np * 4096 + kk0) = o;
        }
        bf16* DC = (bf16*)(F.WS() + WS_DFTC);
        for (int q = F.bid * (NWAVES * 64) + F.tid; q < 256 * 64; q += F.G * NWAVES * 64) {
            const int np = q >> 6, kk0 = (q & 63) * 8, type = kk0 >= 256, n = kk0 & 255; float v[8];
#pragma unroll
            for (int e = 0; e < 8; ++e) { const f32x2 t = tab[((np * (n + e)) & 255) * 16]; v[e] = (type ? -t.y : t.x) * (1.f / 128.f); }
            u32x4 o; o.x = pk2(v[0], v[1]); o.y = pk2(v[2], v[3]); o.z = pk2(v[4], v[5]); o.w = pk2(v[6], v[7]);
            *(GAS u32x4*)(DC + (size_t)np * 512 + kk0) = o;
        }
        __syncthreads();
    }
    {
        LAS float* scr = (LAS float*)(F.lds + F.wave * 16896);
        const int gw = F.bid * NWAVES + F.wave, NGW = F.G * NWAVES;
        const float* a_w_in = G(I.a_w_in) + (size_t)j * 1024 * 672;
        WJob J0{a_w_in, a_w_in, 672, 1024, 416, nullptr, (bf16*)(W + WO_WIN_E), 1024, 512, 0};
        WJob J2{G(I.a_w_ukv) + (size_t)j * 128 * 1536, nullptr, 1536, 128, 1536, G(I.a_g_ckv) + j * 128, (bf16*)(W + WO_WUKV), 256, 1536, 1};
        WJob J3{G(I.a_w_uq) + (size_t)j * 256 * 1152, nullptr, 1152, 256, 1152, G(I.a_g_cq) + j * 256, (bf16*)(W + WO_WUQ), 256, 1152, 0};
        WJob J4{G(I.a_w_out) + (size_t)j * 1024 * 1024, nullptr, 1024, 1024, 1024, nullptr, (bf16*)(W + WO_WOUT_E), 1024, 1024, 0};
        WJob J5{G(I.f_w_gate) + (size_t)j * 1024 * DFF, G(I.f_w_up) + (size_t)j * 1024 * DFF, DFF, 1024, DFF, nullptr, (bf16*)(W + WO_WGU_E), 1024, 2 * DFF, 2};
        WJob J6{G(I.f_w_down) + (size_t)j * DFF * 1024, nullptr, 1024, DFF, 1024, nullptr, (bf16*)(W + WO_WDN_E), DFF, 1024, 0};
        WJob J7{G(I.c_w_in) + (size_t)j * 1024 * 3072, nullptr, 3072, 1024, 3072, nullptr, (bf16*)(W + WO_WIN_O), 1024, 3072, 3};
        WJob J8{G(I.c_w_out) + (size_t)j * 1024 * 1024, nullptr, 1024, 1024, 1024, nullptr, (bf16*)(W + WO_WOUT_O), 1024, 1024, 0};
        constexpr int IT_GU = (1024 / 64) * (2 * DFFE / 64), IT_DN = (DFFE / 64) * (1024 / 64);
        const int fixed = 16 * 8 + 4 * 24 + 4 * 18 + 16 * 16 + 16 * 88 + 44 * 16 + 16 * 48 + 16 * 16;
        const int total = fixed + NEXP * (IT_GU + IT_DN);
        for (int it = gw; it < total; it += NGW) {
            int r = it;
            if (wjob_run(J0, r, scr, F.lane)) continue;
            if (wjob_run(J2, r, scr, F.lane)) continue;
            if (wjob_run(J3, r, scr, F.lane)) continue;
            if (wjob_run(J4, r, scr, F.lane)) continue;
            if (wjob_run(J5, r, scr, F.lane)) continue;
            if (wjob_run(J6, r, scr, F.lane)) continue;
            if (wjob_run(J7, r, scr, F.lane)) continue;
            if (wjob_run(J8, r, scr, F.lane)) continue;
            if (r < NEXP * IT_GU) { const int e = r / IT_GU, rr = r % IT_GU; const size_t eo = ((size_t)j * NEXP + e) * 1024 * DFFE;
                wconv_item(G(I.m_w_gate) + eo, G(I.m_w_up) + eo, DFFE, 1024, DFFE, nullptr, (bf16*)(W + WO_WGU_M) + (size_t)e * 2 * DFFE * 1024, 1024, 2, rr / (2 * DFFE / 64), rr % (2 * DFFE / 64), scr, F.lane); continue; }
            r -= NEXP * IT_GU;
            { const int e = r / IT_DN, rr = r % IT_DN; const size_t eo = ((size_t)j * NEXP + e) * DFFE * 1024;
                wconv_item(G(I.m_w_down) + eo, nullptr, 1024, DFFE, 1024, nullptr, (bf16*)(W + WO_WDN_M) + (size_t)e * 1024 * DFFE, DFFE, 0, rr / 16, rr % 16, scr, F.lane); }
        }
        __syncthreads();
        LAS f32x2* t64 = (LAS f32x2*)(F.lds);
        if (F.tid < 64) { float s, c; sincospif((float)F.tid * (1.f / 32.f), &s, &c); t64[F.tid] = (f32x2){c, s}; }
        __syncthreads();
        bf16* WE = (bf16*)(W + WO_WIN_E);
        for (int it = gw; it < 1024 * 4; it += NGW) {
            const int k = it >> 2, g = it & 3;
            const float f = a_w_in[(size_t)k * 672 + 416 + 64 * g + F.lane];
            float ac = 0.f, as = 0.f;
#pragma unroll 8
            for (int c = 0; c < 64; ++c) { const float fc = __shfl(f, c); const f32x2 t = t64[(c * F.lane) & 63]; ac += fc * t.x; as += fc * t.y; }
            WE[(size_t)(512 + g * 64 + F.lane) * 1024 + k] = (bf16)f2bf(ac);
            WE[(size_t)(768 + g * 64 + F.lane) * 1024 + k] = (bf16)f2bf(as);
        }
        __syncthreads();
    }
}

__device__ __forceinline__ void moe_panels_to_lds(Frame& F, int pair) {
    volatile LAS int* MOE = (volatile LAS int*)(F.lds + MOE_LDS_OFF);
    if (F.tid == 0) { int p = 0;
        for (int e = 0; e < NEXP; ++e) { const int c = (int)__hip_atomic_load(F.ctl + CW_MOECNT + 64 * pair + e, RLX_AGENT); MOE[e] = p; MOE[16 + e] = c; p += (c + 255) >> 8; }
        MOE[8] = p; }
    __syncthreads();
}
struct NormArgs { int layer, which, from_inputs, combine_pair, router_pair, lat_only, add_part; };
__device__ __forceinline__ void norm_phase(Frame& F, const NormArgs a) {
    const CAS Inputs& I = *F.in;
    volatile LAS int* MOE = (volatile LAS int*)(F.lds + MOE_LDS_OFF);
    LAS float* wr = (LAS float*)(F.lds);
    volatile LAS int* lcnt = (volatile LAS int*)(F.lds + 32768);
    volatile LAS int* stash = (volatile LAS int*)(F.lds + 32768 + 256);
    if (a.combine_pair >= 0) moe_panels_to_lds(F, a.combine_pair);
    if (a.router_pair >= 0) {
        const float* wsrc = G(I.m_w_router) + (size_t)a.router_pair * 1024 * NEXP;
        for (int idx = F.tid; idx < 1024 * NEXP; idx += NWAVES * 64) wr[(idx & 7) * 1024 + (idx >> 3)] = wsrc[idx];
        if (F.tid < 16) lcnt[F.tid] = 0;
        __syncthreads();
    }
    const int* te = (const int*)(F.WS() + WS_ROUTE); const int* tr = te + 2 * NTOK; const float* tg = (const float*)(tr + 2 * NTOK);
    const bf16* Y = (const bf16*)(F.WS() + WS_Y);
    bf16* XN = (bf16*)(F.WS() + WS_ACT);
    const int nrows = a.lat_only ? NLAT : NTOK;
    const bool final_only = a.lat_only && a.router_pair < 0;
    const int nk = (nrows - F.bid + F.G - 1) / F.G;
    for (int k = F.wave; k < nk; k += NWAVES) {
        const int row = F.bid + F.G * k;
        const int b9 = row_b9(row);
        float* hp = hrow(F, row);
        const bool from_in = a.from_inputs == 1 || (a.from_inputs == 2 && row >= NLAT);
        const float* src = from_in ? (row < NLAT ? G(I.x) + (size_t)row * DM : G(I.ctx) + (size_t)(row - NLAT) * DM) : hp;
        f32x4 v[4];
#pragma unroll
        for (int j = 0; j < 4; ++j) v[j] = ((const f32x4*)src)[F.lane + 64 * j];
        if (a.combine_pair >= 0) {
            const int e1 = te[2 * row], e2 = te[2 * row + 1], r1 = tr[2 * row], r2 = tr[2 * row + 1];
            const float g1 = tg[2 * row], g2 = tg[2 * row + 1];
            const size_t s1 = (size_t)MOE[e1] * 256 + r1, s2 = (size_t)MOE[e2] * 256 + r2;
            const float* gm = modp(F, 2 * a.combine_pair + 1, b9, 5);
#pragma unroll
            for (int j = 0; j < 4; ++j) {
                const u32x2 y1 = *(const u32x2*)(Y + s1 * 1024 + 256 * j + 4 * F.lane), y2 = *(const u32x2*)(Y + s2 * 1024 + 256 * j + 4 * F.lane);
                const f32x4 gg = ((const f32x4*)gm)[F.lane + 64 * j];
                v[j].x += gg.x * (g1 * bflo(y1.x) + g2 * bflo(y2.x)); v[j].y += gg.y * (g1 * bfhi(y1.x) + g2 * bfhi(y2.x));
                v[j].z += gg.z * (g1 * bflo(y1.y) + g2 * bflo(y2.y)); v[j].w += gg.w * (g1 * bfhi(y1.y) + g2 * bfhi(y2.y));
            }
        }
        const bool parts = a.add_part && row >= NLAT;
        if (parts) {
            const float* pp = (const float*)(F.WS() + WS_PART) + (size_t)(row - NLAT) * DM;
#pragma unroll
            for (int q = 0; q < 4; ++q)
#pragma unroll
                for (int j = 0; j < 4; ++j) v[j] = v[j] + ((const f32x4*)(pp + (size_t)q * NCTX * DM))[F.lane + 64 * j];
        }
        if (a.combine_pair >= 0 || parts) {
#pragma unroll
            for (int j = 0; j < 4; ++j) ((f32x4*)hp)[F.lane + 64 * j] = v[j];
        }
        if (final_only) continue;
        float ss = 0.f;
#pragma unroll
        for (int j = 0; j < 4; ++j) ss += (v[j].x * v[j].x + v[j].y * v[j].y) + (v[j].z * v[j].z + v[j].w * v[j].w);
        const float rstd = 1.0f / sqrtf(wave_sum(ss) * (1.f / DM) + EPS);
        const float* gp = G(I.norm_g) + ((size_t)a.layer * 2 + a.which) * DM;
        const float* shp = modp(F, a.layer, b9, a.which ? 3 : 0);
        const float* scp = modp(F, a.layer, b9, a.which ? 4 : 1);
        f32x4 xn[4];
#pragma unroll
        for (int j = 0; j < 4; ++j) { const f32x4 g = ((const f32x4*)gp)[F.lane + 64 * j], sh = ((const f32x4*)shp)[F.lane + 64 * j], sc = ((const f32x4*)scp)[F.lane + 64 * j];
            xn[j] = v[j] * rstd * g * (sc + 1.0f) + sh; }
        u32x2* o8 = (u32x2*)(XN + (size_t)row * DM) + F.lane;
#pragma unroll
        for (int j = 0; j < 4; ++j) o8[64 * j] = (u32x2){pk2(xn[j].x, xn[j].y), pk2(xn[j].z, xn[j].w)};
        if (a.router_pair >= 0) {
            float lg[NEXP];
#pragma unroll
            for (int e = 0; e < NEXP; ++e) lg[e] = 0.f;
#pragma unroll
            for (int e = 0; e < NEXP; ++e)
#pragma unroll
                for (int j = 0; j < 4; ++j) { const f32x4 w4 = *(const LAS f32x4*)(wr + e * 1024 + 256 * j + 4 * F.lane);
                    lg[e] += (xn[j].x * w4.x + xn[j].y * w4.y) + (xn[j].z * w4.z + xn[j].w * w4.w); }
#pragma unroll
            for (int e = 0; e < NEXP; ++e) lg[e] = wave_sum(lg[e]);
            int i1 = 0; float v1 = lg[0];
#pragma unroll
            for (int e = 1; e < NEXP; ++e) if (lg[e] > v1) { v1 = lg[e]; i1 = e; }
            int i2 = -1; float v2 = -3.0e38f;
#pragma unroll
            for (int e = 0; e < NEXP; ++e) if (e != i1 && lg[e] > v2) { v2 = lg[e]; i2 = e; }
            const float ga = 1.f / (1.f + __expf(v2 - v1)), gb = 1.f - ga;
            if (F.lane == 0) {
                const int l1 = __hip_atomic_fetch_add((LAS int*)(lcnt + i1), 1, __ATOMIC_RELAXED, __HIP_MEMORY_SCOPE_WORKGROUP);
                const int l2 = __hip_atomic_fetch_add((LAS int*)(lcnt + i2), 1, __ATOMIC_RELAXED, __HIP_MEMORY_SCOPE_WORKGROUP);
                stash[4 * k + 0] = i1; stash[4 * k + 1] = l1; stash[4 * k + 2] = i2; stash[4 * k + 3] = l2;
                float* tgw = (float*)(F.WS() + WS_ROUTE) + 4 * NTOK; tgw[2 * row] = ga; tgw[2 * row + 1] = gb;
            }
        }
    }
    if (a.router_pair >= 0) {
        __syncthreads();
        if (F.tid < NEXP) lcnt[8 + F.tid] = (int)__hip_atomic_fetch_add(F.ctl + CW_MOECNT + 64 * a.router_pair + F.tid, (unsigned)lcnt[F.tid], RLX_AGENT);
        __syncthreads();
        int* tew = (int*)(F.WS() + WS_ROUTE); int* trw = tew + 2 * NTOK; int* list = (int*)(F.WS() + WS_LIST);
        for (int k = F.tid; k < nk; k += NWAVES * 64) {
            const int row = F.bid + F.G * k;
            const int i1 = stash[4 * k + 0], l1 = stash[4 * k + 1], i2 = stash[4 * k + 2], l2 = stash[4 * k + 3];
            const int r1 = lcnt[8 + i1] + l1, r2 = lcnt[8 + i2] + l2;
            tew[2 * row] = i1; tew[2 * row + 1] = i2; trw[2 * row] = r1; trw[2 * row + 1] = r2;
            list[(size_t)i1 * NTOK + r1] = row; list[(size_t)i2 * NTOK + r2] = row;
        }
    }
    __syncthreads();
}

struct SchedStatic {
    static constexpr bool GATHER = false;
    const bf16* A; int lda; const bf16* Bt; int K, nM, nN, G, c;
    __device__ __forceinline__ bool next(int i, pg8::Unit& u) const { return pg8::static_next(i, G, c, nM, nN, u); }
    __device__ __forceinline__ int k0(const pg8::Unit&) const { return 0; }
    __device__ __forceinline__ int nt(const pg8::Unit&) const { return K / 64; }
    __device__ __forceinline__ unsigned a_row(const pg8::Unit& u, int r) const { return (unsigned)(u.pm * 256 + r); }
    __device__ __forceinline__ const char* b_base(const pg8::Unit& u) const { return (const char*)Bt + (size_t)u.pn * 256 * K * 2; }
};
struct SchedResid {
    static constexpr bool GATHER = false;
    const bf16* A; int lda; const bf16* Bt; int K, nctx, G, c;
    __device__ __forceinline__ bool next(int i, pg8::Unit& u) const {
        const int L = i * G + c;
        if (L < 512) return pg8::static_next(i, G, c, 128, 4, u);
        const int r = L - 512; if (r >= nctx * 16) return false;
        u.kq = r & 3; u.pn = (r >> 2) & 3; u.pm = 128 + (r >> 4); return true; }
    __device__ __forceinline__ int nt(const pg8::Unit& u) const { const int n = K / 64; if (u.kq < 0) return n; const int q = (n / 4) & ~1, rem = n - 4 * q; return q + ((u.kq * 2 < rem) ? 2 : 0); }
    __device__ __forceinline__ int k0(const pg8::Unit& u) const { if (u.kq <= 0) return 0; const int n = K / 64, q = (n / 4) & ~1, rem = n - 4 * q; int s = 0; for (int k = 0; k < u.kq; ++k) s += q + ((k * 2 < rem) ? 2 : 0); return s; }
    __device__ __forceinline__ unsigned a_row(const pg8::Unit& u, int r) const { return (unsigned)(u.pm * 256 + r); }
    __device__ __forceinline__ const char* b_base(const pg8::Unit& u) const { return (const char*)Bt + (size_t)u.pn * 256 * K * 2; }
};
struct SchedOne {
    static constexpr bool GATHER = false;
    const bf16* A; int lda; const bf16* Bt; int K, pm, pn, have;
    __device__ __forceinline__ bool next(int i, pg8::Unit& u) const { if (i != 0 || !have) return false; u.pm = pm; u.pn = pn; u.kq = -1; return true; }
    __device__ __forceinline__ int k0(const pg8::Unit&) const { return 0; }
    __device__ __forceinline__ int nt(const pg8::Unit&) const { return K / 64; }
    __device__ __forceinline__ unsigned a_row(const pg8::Unit& u, int r) const { return (unsigned)(u.pm * 256 + r); }
    __device__ __forceinline__ const char* b_base(const pg8::Unit& u) const { return (const char*)Bt + (size_t)u.pn * 256 * K * 2; }
};
template <bool G_> struct SchedMoe {
    static constexpr bool GATHER = G_;
    const bf16* A; int lda; const bf16* Bt; size_t bstride; int K, nN, G, c; const int* list; volatile LAS int* MOE;
    __device__ __forceinline__ bool next(int i, pg8::Unit& u) const { return pg8::static_next(i, G, c, MOE[8], nN, u); }
    __device__ __forceinline__ int k0(const pg8::Unit&) const { return 0; }
    __device__ __forceinline__ int nt(const pg8::Unit&) const { return K / 64; }
    __device__ __forceinline__ int expert(int pm) const { int e = 0;
#pragma unroll
        for (int k = 1; k < NEXP; ++k) e += (pm >= MOE[k]) ? 1 : 0;
        return e; }
    __device__ __forceinline__ unsigned a_row(const pg8::Unit& u, int r) const {
        if (!G_) return (unsigned)(u.pm * 256 + r);
        const int e = expert(u.pm), idx = (u.pm - MOE[e]) * 256 + r;
        return idx < MOE[16 + e] ? (unsigned)list[e * NTOK + idx] : 0u; }
    __device__ __forceinline__ const char* b_base(const pg8::Unit& u) const { return (const char*)Bt + (size_t)expert(u.pm) * bstride + (size_t)u.pn * 256 * K * 2; }
};

typedef const f32x4 (&AccRef)[2][2][4][2];
__device__ __forceinline__ int swap12(int g) { return ((g & 1) << 1) | (g >> 1); }

__device__ __forceinline__ f32x4 tr4(const f32x4 a, int lane) {
    const bool o1 = lane & 1, o2 = lane & 2;
    const float t0 = __shfl_xor(o1 ? a[0] : a[1], 1), t1 = __shfl_xor(o1 ? a[2] : a[3], 1);
    const f32x4 b = o1 ? (f32x4){t0, a[1], t1, a[3]} : (f32x4){a[0], t0, a[2], t1};
    const float u0 = __shfl_xor(o2 ? b[0] : b[2], 2), u1 = __shfl_xor(o2 ? b[1] : b[3], 2);
    return o2 ? (f32x4){u0, u1, b[2], b[3]} : (f32x4){b[0], b[1], u0, u1};
}
__device__ __forceinline__ float sum_fq(float s) {
    unsigned a = __builtin_bit_cast(unsigned, s), b = a; asm volatile("" : "+v"(b)); swap32(a, b); s = __builtin_bit_cast(float, a) + __builtin_bit_cast(float, b);
    a = __builtin_bit_cast(unsigned, s); b = a; asm volatile("" : "+v"(b)); swap16(a, b); return __builtin_bit_cast(float, a) + __builtin_bit_cast(float, b);
}
struct EpiBf16 { static constexpr bool PERM = true, RPERM = false;
    bf16* O; int ldc, mode;
    __device__ __forceinline__ void operator()(AccRef acc, const pg8::Unit& u, int wr, int wc, int fr, int fq) const {
        const int rbase = mode == 0 ? u.pm * 256 : (mode == 1 ? u.pn * 4096 + u.pm * 256 : NLAT + u.pn * 256 + u.pm * 256);
        const int cbase = mode == 0 ? u.pn * 256 : 768;
        const int row0 = rbase + wr * 64 + fr, col0 = cbase + wc * 32 + 8 * fq;
#pragma unroll
        for (int ai = 0; ai < 2; ++ai)
#pragma unroll
            for (int m = 0; m < 4; ++m) { bf16* rowp = O + (size_t)(row0 + ai * 128 + m * 16) * ldc + col0;
#pragma unroll
                for (int bj = 0; bj < 2; ++bj) { const f32x4 v0 = acc[ai][bj][m][0], v1 = acc[ai][bj][m][1];
                    u32x4 w; w.x = cvt_pk_bf16(v0[0], v0[1]); w.y = cvt_pk_bf16(v0[2], v0[3]); w.z = cvt_pk_bf16(v1[0], v1[1]); w.w = cvt_pk_bf16(v1[2], v1[3]);
                    *(u32x4*)(rowp + bj * 128) = w; } }
    }
};
struct EpiWin { static constexpr bool PERM = true, RPERM = true;
    bf16* PX; bf16* GT; bf16* GTC; float* rowst;
    __device__ __forceinline__ void operator()(AccRef acc, const pg8::Unit& u, int wr, int wc, int fr, int fq) const {
        if (u.pn < 2) {
            const int row0 = u.pm * 256 + wr * 64 + 4 * fr, col0 = u.pn * 256 + wc * 32 + 8 * fq;
#pragma unroll
            for (int ai = 0; ai < 2; ++ai)
#pragma unroll
                for (int m = 0; m < 4; ++m) { bf16* rowp = PX + (size_t)(row0 + ai * 128 + m) * 512 + col0;
#pragma unroll
                    for (int bj = 0; bj < 2; ++bj) { const f32x4 v0 = acc[ai][bj][m][0], v1 = acc[ai][bj][m][1];
                        u32x4 w; w.x = cvt_pk_bf16(v0[0], v0[1]); w.y = cvt_pk_bf16(v0[2], v0[3]); w.z = cvt_pk_bf16(v1[0], v1[1]); w.w = cvt_pk_bf16(v1[2], v1[3]);
                        *(u32x4*)(rowp + bj * 128) = w; }
                    if (u.pn == 1) {
                        const f32x4 a0 = acc[ai][0][m][0], a1 = acc[ai][0][m][1], r0 = acc[ai][1][m][0], r1 = acc[ai][1][m][1];
                        float s = (a0[0] * a0[0] + a0[1] * a0[1]) + (a0[2] * a0[2] + a0[3] * a0[3]) + (a1[0] * a1[0] + a1[1] * a1[1]) + (a1[2] * a1[2] + a1[3] * a1[3]);
                        float q = (r0[0] * r0[0] + r0[1] * r0[1]) + (r0[2] * r0[2] + r0[3] * r0[3]) + (r1[0] * r1[0] + r1[1] * r1[1]) + (r1[2] * r1[2] + r1[3] * r1[3]);
                        s = sum_fq(s); q = sum_fq(q);
                        if (fq == 0) { float* st = rowst + (size_t)(row0 + ai * 128 + m) * 8; st[wc] = s; if (wc == 0) st[4] = q; } } }
        } else {
            const int type = u.pn - 2; const bool lat = u.pm < 128;
            const int b = lat ? (u.pm >> 4) : (u.pm - 128);
            bf16* base = lat ? GT + (size_t)b * 256 * 8192 + type * 4096 + (u.pm & 15) * 256 : GTC + (size_t)b * 256 * 512 + type * 256;
            const size_t ldt = lat ? 8192 : 512;
#pragma unroll
            for (int ai = 0; ai < 2; ++ai) { const int lr4 = ai * 128 + wr * 64 + 4 * fr;
#pragma unroll
                for (int bj = 0; bj < 2; ++bj)
#pragma unroll
                    for (int n = 0; n < 2; ++n)
#pragma unroll
                        for (int e2 = 0; e2 < 4; ++e2) { const int jc = 128 * bj + 32 * wc + 8 * fq + 4 * n + e2;
                            *(u32x2*)(base + (size_t)jc * ldt + lr4) = (u32x2){pk2(acc[ai][bj][0][n][e2], acc[ai][bj][1][n][e2]), pk2(acc[ai][bj][2][n][e2], acc[ai][bj][3][n][e2])}; }
            }
        }
    }
};
struct EpiKV { static constexpr bool PERM = false, RPERM = true;
    const bf16* PX; bf16* Kb; bf16* Vt; const LAS float* tl; const float* rowst;
    __device__ __forceinline__ void operator()(AccRef acc, const pg8::Unit& u, int wr, int wc, int fr, int fq) const {
        const int head = 2 * u.pn + (wc >> 1), part = wc & 1;
        const bool lat = u.pm < 128;
        const int b = lat ? (u.pm >> 4) : (u.pm - 128);
        const int pos0 = lat ? (u.pm & 15) * 256 : SEQ;
        const size_t bh = (size_t)b * A_HEADS + head;
        float rkv[8], s5[8]; u32x4 kw[8];
#pragma unroll
        for (int i = 0; i < 8; ++i) {
            const int row = u.pm * 256 + (i >> 2) * 128 + wr * 64 + 4 * fr + (i & 3);
            const f32x4 st4 = *(const f32x4*)(rowst + (size_t)row * 8);
            rkv[i] = __builtin_amdgcn_rsqf(((st4[0] + st4[1]) + (st4[2] + st4[3])) * (1.f / 128.f) + EPS);
            if (part == 0) { s5[i] = rowst[(size_t)row * 8 + 4];
                kw[i] = *(const u32x4*)(PX + (size_t)row * 512 + 384 + 8 * fq); }
            else { s5[i] = 0.f; kw[i] = (u32x4){0u, 0u, 0u, 0u}; }
        }
        asm volatile("" ::: "memory");
        const LAS f32x2* rope = (const LAS f32x2*)tl; const LAS float* g_k = tl + 1024;
        if (part == 0) {
#pragma unroll
            for (int ai = 0; ai < 2; ++ai)
#pragma unroll
                for (int m = 0; m < 4; ++m) {
                    const int i = ai * 4 + m;
                    const int pos = pos0 + ai * 128 + wr * 64 + 4 * fr + m;
                    float kr[8] = {bflo(kw[i].x), bfhi(kw[i].x), bflo(kw[i].y), bfhi(kw[i].y), bflo(kw[i].z), bfhi(kw[i].z), bflo(kw[i].w), bfhi(kw[i].w)};
                    float s2 = 0.f;
#pragma unroll
                    for (int bj = 0; bj < 2; ++bj)
#pragma unroll
                        for (int n = 0; n < 2; ++n) { const f32x4 x = acc[ai][bj][m][n] * rkv[i]; s2 += (x[0] * x[0] + x[1] * x[1]) + (x[2] * x[2] + x[3] * x[3]); }
                    s2 = sum_fq(s2);
                    s2 += s5[i];
                    const float rs = __builtin_amdgcn_rsqf(s2 * (1.f / 96.f) + EPS);
                    bf16* kp = Kb + (bh * KPOS + pos) * 96;
                    unsigned ax[4], ay[4];
#pragma unroll
                    for (int bj = 0; bj < 2; ++bj)
#pragma unroll
                        for (int n = 0; n < 2; ++n) { const int d0 = 32 * bj + 16 * n; const f32x4 g = *(const LAS f32x4*)(g_k + d0 + 4 * fq); const f32x4 x = acc[ai][bj][m][n] * (rkv[i] * rs) * g;
                            ax[2 * bj + n] = pk2(x[0], x[1]); ay[2 * bj + n] = pk2(x[2], x[3]); }
                    swap32(ax[0], ax[1]); swap32(ay[0], ay[1]); swap32(ax[2], ax[3]); swap32(ay[2], ay[3]);
                    *(u32x4*)(kp + 8 * fq) = (u32x4){ax[0], ay[0], ax[1], ay[1]};
                    *(u32x4*)(kp + 32 + 8 * fq) = (u32x4){ax[2], ay[2], ax[3], ay[3]};
                    float t[8];
                    { const f32x4 ga = *(const LAS f32x4*)(g_k + 64 + 8 * fq), gb = *(const LAS f32x4*)(g_k + 64 + 8 * fq + 4);
                      t[0] = kr[0] * rs * ga[0]; t[1] = kr[1] * rs * ga[1]; t[2] = kr[2] * rs * ga[2]; t[3] = kr[3] * rs * ga[3];
                      t[4] = kr[4] * rs * gb[0]; t[5] = kr[5] * rs * gb[1]; t[6] = kr[6] * rs * gb[2]; t[7] = kr[7] * rs * gb[3]; }
                    if (lat) {
                        const int pidx = (fq < 2) ? (pos >> 6) : (pos & 63);
#pragma unroll
                        for (int q = 0; q < 4; ++q) { const f32x2 cs = rope[pidx * 8 + ((4 * fq + q) & 7)]; const float t0 = t[2 * q], t1 = t[2 * q + 1];
                            t[2 * q] = t0 * cs.x - t1 * cs.y; t[2 * q + 1] = t0 * cs.y + t1 * cs.x; }
                    }
                    unsigned tax = pk2(t[0], t[1]), tay = pk2(t[2], t[3]), tbx = pk2(t[4], t[5]), tby = pk2(t[6], t[7]);
                    swap16(tax, tbx); swap16(tay, tby);
                    *(u32x4*)(kp + 64 + 8 * fq) = (u32x4){tax, tay, tbx, tby};
                }
        } else {
#pragma unroll
            for (int ai = 0; ai < 2; ++ai) {
                const int p4 = pos0 + ai * 128 + wr * 64 + 4 * fr, pp = (p4 & ~15) | (((p4 & 4) << 1) | ((p4 & 8) >> 1));
                bf16* vp = Vt + bh * 64 * KPOS + pp;
#pragma unroll
                for (int bj = 0; bj < 2; ++bj)
#pragma unroll
                    for (int n = 0; n < 2; ++n)
#pragma unroll
                        for (int e2 = 0; e2 < 4; ++e2)
                            *(u32x2*)(vp + (size_t)(32 * bj + 16 * n + 4 * fq + e2) * KPOS) =
                                (u32x2){pk2(acc[ai][bj][0][n][e2] * rkv[ai * 4 + 0], acc[ai][bj][1][n][e2] * rkv[ai * 4 + 1]), pk2(acc[ai][bj][2][n][e2] * rkv[ai * 4 + 2], acc[ai][bj][3][n][e2] * rkv[ai * 4 + 3])};
            }
        }
    }
};
struct EpiResid { static constexpr bool PERM = false, RPERM = false;
    float* out; float* hc; const float* modl; int gk; bool dry; float* part; const float* src_lat;
    __device__ __forceinline__ void operator()(AccRef acc, const pg8::Unit& u, int wr, int wc, int fr, int fq) const {
        const bool lat = u.pm < 128; const int b9 = lat ? (u.pm >> 4) : 8;
        float* base = lat ? out + (size_t)u.pm * 256 * DM : hc + (size_t)(u.pm - 128) * 256 * DM;
        const float* rbase = lat ? src_lat + (size_t)u.pm * 256 * DM : base;
        const int col0 = u.pn * 256 + wc * 32 + 4 * fq;
        const float* gp = modl + (size_t)b9 * 6144 + gk * 1024 + col0;
        f32x4 gv[2][2];
#pragma unroll
        for (int bj = 0; bj < 2; ++bj)
#pragma unroll
            for (int n = 0; n < 2; ++n) gv[bj][n] = *(const f32x4*)(gp + bj * 128 + n * 16);
        if (u.kq < 0) {
            f32x4 r[2][4][2][2];
#pragma unroll
            for (int ai = 0; ai < 2; ++ai) {
#pragma unroll
                for (int m = 0; m < 4; ++m) { const float* rowp = rbase + (size_t)(ai * 128 + wr * 64 + m * 16 + fr) * DM + col0;
#pragma unroll
                    for (int bj = 0; bj < 2; ++bj)
#pragma unroll
                        for (int n = 0; n < 2; ++n) r[ai][m][bj][n] = *(const f32x4*)(rowp + bj * 128 + n * 16) + gv[bj][n] * acc[ai][bj][m][n]; }
                asm volatile("" : "+v"(r[ai][0][0][0]), "+v"(r[ai][0][0][1]), "+v"(r[ai][0][1][0]), "+v"(r[ai][0][1][1]), "+v"(r[ai][1][0][0]), "+v"(r[ai][1][0][1]), "+v"(r[ai][1][1][0]), "+v"(r[ai][1][1][1]),
                                  "+v"(r[ai][2][0][0]), "+v"(r[ai][2][0][1]), "+v"(r[ai][2][1][0]), "+v"(r[ai][2][1][1]), "+v"(r[ai][3][0][0]), "+v"(r[ai][3][0][1]), "+v"(r[ai][3][1][0]), "+v"(r[ai][3][1][1]) :: "memory"); }
            if (!dry) {
#pragma unroll
                for (int ai = 0; ai < 2; ++ai)
#pragma unroll
                    for (int m = 0; m < 4; ++m) { float* rowp = base + (size_t)(ai * 128 + wr * 64 + m * 16 + fr) * DM + col0;
#pragma unroll
                        for (int bj = 0; bj < 2; ++bj)
#pragma unroll
                            for (int n = 0; n < 2; ++n) *(f32x4*)(rowp + bj * 128 + n * 16) = r[ai][m][bj][n]; }
            }
        } else if (!dry) {
#pragma unroll
            for (int ai = 0; ai < 2; ++ai)
#pragma unroll
                for (int m = 0; m < 4; ++m)
#pragma unroll
                    for (int bj = 0; bj < 2; ++bj)
#pragma unroll
                        for (int n = 0; n < 2; ++n)
                            *(f32x4*)(part + ((size_t)u.kq * NCTX + (size_t)(u.pm - 128) * 256 + (ai * 128 + wr * 64 + m * 16 + fr)) * DM + col0 + bj * 128 + n * 16) = gv[bj][n] * acc[ai][bj][m][n];
        }
    }
};
struct EpiSwiglu { static constexpr bool PERM = false, RPERM = false;
    bf16* HM; int ldh;
    __device__ __forceinline__ void operator()(AccRef acc, const pg8::Unit& u, int wr, int wc, int fr, int fq) const {
        const int row0 = u.pm * 256 + wr * 64 + fr, col0 = u.pn * 128 + wc * 16 + 4 * fq;
#pragma unroll
        for (int ai = 0; ai < 2; ++ai)
#pragma unroll
            for (int m = 0; m < 4; ++m) { bf16* rowp = HM + (size_t)(row0 + ai * 128 + m * 16) * ldh + col0;
#pragma unroll
                for (int bj = 0; bj < 2; ++bj) { const f32x4 g = acc[ai][bj][m][0], up = acc[ai][bj][m][1]; float h[4];
#pragma unroll
                    for (int e = 0; e < 4; ++e) h[e] = g[e] * __builtin_amdgcn_rcpf(1.f + __builtin_amdgcn_exp2f(-g[e] * LOG2E)) * up[e];
                    *(u32x2*)(rowp + bj * 64) = (u32x2){cvt_pk_bf16(h[0], h[1]), cvt_pk_bf16(h[2], h[3])}; } }
    }
};
struct EpiNAin { static constexpr bool PERM = false, RPERM = true;
    bf16* QN; bf16* KN; bf16* Vt; const float* g_q; const float* g_k;
    __device__ __forceinline__ void operator()(AccRef acc, const pg8::Unit& u, int wr, int wc, int fr, int fq) const {
        const int sec = u.pn >> 2, head = 4 * (u.pn & 3) + wc;
        const bool lat = u.pm < 128;
        const int b = lat ? (u.pm >> 4) : (u.pm - 128);
        const int pos0 = lat ? (u.pm & 15) * 256 : SEQ;
        if (sec < 2) {
            const float* gp = sec == 0 ? g_q : g_k;
            f32x4 gq[2][2];
#pragma unroll
            for (int bj = 0; bj < 2; ++bj)
#pragma unroll
                for (int n = 0; n < 2; ++n) gq[bj][n] = *(const f32x4*)(gp + 32 * bj + 16 * n + 4 * fq);
            asm volatile("" ::: "memory");
            bf16* obase = (sec == 0 ? QN : KN) + head * 64 + 16 * (fq & 1) + 8 * (fq >> 1);
            const float qs = sec == 0 ? 0.125f * LOG2E : 1.0f;
#pragma unroll
            for (int ai = 0; ai < 2; ++ai)
#pragma unroll
                for (int m = 0; m < 4; ++m) {
                    const int row = u.pm * 256 + ai * 128 + wr * 64 + 4 * fr + m;
                    float s2 = 0.f;
#pragma unroll
                    for (int bj = 0; bj < 2; ++bj)
#pragma unroll
                        for (int n = 0; n < 2; ++n) { const f32x4 x = acc[ai][bj][m][n]; s2 += (x[0] * x[0] + x[1] * x[1]) + (x[2] * x[2] + x[3] * x[3]); }
                    s2 = sum_fq(s2);
                    const float rs = __builtin_amdgcn_rsqf(s2 * (1.f / 64.f) + EPS) * qs;
                    unsigned ax[4], ay[4];
#pragma unroll
                    for (int bj = 0; bj < 2; ++bj)
#pragma unroll
                        for (int n = 0; n < 2; ++n) { const f32x4 x = acc[ai][bj][m][n] * rs * gq[bj][n]; ax[2 * bj + n] = pk2(x[0], x[1]); ay[2 * bj + n] = pk2(x[2], x[3]); }
                    swap16(ax[0], ax[1]); swap16(ay[0], ay[1]); swap16(ax[2], ax[3]); swap16(ay[2], ay[3]);
                    bf16* op = obase + (size_t)row * DM;
                    *(u32x4*)(op) = (u32x4){ax[0], ay[0], ax[1], ay[1]};
                    *(u32x4*)(op + 32) = (u32x4){ax[2], ay[2], ax[3], ay[3]};
                }
        } else {
#pragma unroll
            for (int ai = 0; ai < 2; ++ai) {
                bf16* vp = Vt + ((size_t)b * C_HEADS + head) * 64 * KPOS + pos0 + ai * 128 + wr * 64 + 4 * fr;
#pragma unroll
                for (int bj = 0; bj < 2; ++bj)
#pragma unroll
                    for (int n = 0; n < 2; ++n)
#pragma unroll
                        for (int e2 = 0; e2 < 4; ++e2)
                            *(u32x2*)(vp + (size_t)(32 * bj + 16 * n + 4 * fq + e2) * KPOS) = (u32x2){pk2(acc[ai][bj][0][n][e2], acc[ai][bj][1][n][e2]), pk2(acc[ai][bj][2][n][e2], acc[ai][bj][3][n][e2])};
            }
        }
    }
};

__device__ __forceinline__ void fourier_fold(Frame& F) {
    const bf16* GT = (const bf16*)(F.WS() + WS_GT); bf16* GF = (bf16*)(F.WS() + WS_GF);
    for (int q = F.bid * (NWAVES * 64) + F.tid; q < 2048 * 512; q += F.G * NWAVES * 64) {
        const int r = q >> 9, c = q & 511, type = c >= 256, cc = c & 255;
        const bf16* row = GT + (size_t)r * 8192 + type * 4096;
        const u32x4 a = *(const u32x4*)(row + 8 * cc);
        const u32x4 m1 = *(const u32x4*)(row + 8 * (511 - cc));
        u32x4 m0 = (u32x4){0u, 0u, 0u, 0u}; if (cc > 0) m0 = *(const u32x4*)(row + 8 * (512 - cc));
        float x[8] = {bflo(a.x), bfhi(a.x), bflo(a.y), bfhi(a.y), bflo(a.z), bfhi(a.z), bflo(a.w), bfhi(a.w)};
        const float mr[8] = {bflo(m0.x), bfhi(m1.w), bflo(m1.w), bfhi(m1.z), bflo(m1.z), bfhi(m1.y), bflo(m1.y), bfhi(m1.x)};
        const float sg = type ? -1.f : 1.f;
#pragma unroll
        for (int e2 = 0; e2 < 8; ++e2) { const bool special = (cc == 0 && e2 == 0); x[e2] = special ? x[e2] : x[e2] + sg * mr[e2]; }
        if (type && cc == 0) x[0] = bf2f(GT[(size_t)r * 8192 + 2048]);
        u32x4 o; o.x = pk2(x[0], x[1]); o.y = pk2(x[2], x[3]); o.z = pk2(x[4], x[5]); o.w = pk2(x[6], x[7]);
        *(u32x4*)(GF + (size_t)r * 4096 + type * 2048 + 8 * cc) = o;
    }
}

struct EpiNull { static constexpr bool PERM = false, RPERM = false;
    float* sink;
    __device__ __forceinline__ void operator()(AccRef acc, const pg8::Unit& u, int wr, int wc, int fr, int fq) const {
        float s = 0.f;
#pragma unroll
        for (int ai = 0; ai < 2; ++ai)
#pragma unroll
            for (int bj = 0; bj < 2; ++bj)
#pragma unroll
                for (int m = 0; m < 4; ++m)
#pragma unroll
                    for (int n = 0; n < 2; ++n) s += acc[ai][bj][m][n][0];
        if (s == 1.2345e30f) sink[u.pm + wr + wc + fr + fq] = s;
    }
};

constexpr int AT_KP = 208, AT_VP = 144;
constexpr int AT_KB = 64 * AT_KP, AT_VB = 64 * AT_VP, AT_BUF = AT_KB + AT_VB;

__device__ __forceinline__ void mla_attn_unit(Frame& F, int pair, int b, int h, int qrow0, bool lat, int key0, int nkt) {
    asm volatile("" : "+v"(F.tid)); F.lane = F.tid & 63;
    const int lane = F.lane, l31 = lane & 31, hi = lane >> 5;
    const bf16* PX = (const bf16*)(F.WS() + WS_PX);
    const bf16* WUQ = (const bf16*)(F.WS() + WS_W + WO_WUQ);
    const bf16* Kg = (const bf16*)(F.WS() + WS_K) + ((size_t)(b * A_HEADS + h) * KPOS + key0) * 96;
    const bf16* Vg = (const bf16*)(F.WS() + WS_VT) + (size_t)(b * A_HEADS + h) * 64 * KPOS + key0;
    bf16* MIX = (bf16*)(F.WS() + WS_ACT);
    const f32x2* rope = (const f32x2*)(F.WS() + WS_ROPE);
    const int row = qrow0 + 32 * F.wave + l31;
    const int vdv = F.tid >> 3, vpart = F.tid & 7;
    u32x4 kr0, kr1 = (u32x4){0u, 0u, 0u, 0u}, vr;
    kr0 = *(const u32x4*)((const char*)Kg + (size_t)F.tid * 16);
    if (F.tid < 256) kr1 = *(const u32x4*)((const char*)Kg + (size_t)(512 + F.tid) * 16);
    vr = *(const u32x4*)(Vg + (size_t)vdv * KPOS + vpart * 8);
    bf16x8 qf[3][2];
    {
        bf16x8 bq[16];
        const bf16* pxr = PX + (size_t)row * 512 + 8 * hi;
#pragma unroll
        for (int s = 0; s < 16; ++s) bq[s] = *(const bf16x8*)(pxr + 16 * s);
        float ss = 0.f;
#pragma unroll
        for (int s = 0; s < 16; ++s)
#pragma unroll
            for (int e = 0; e < 8; ++e) { const float x = bf2f((unsigned short)bq[s][e]); ss += x * x; }
        ss += __shfl_xor(ss, 32);
        const float rq = 1.0f / sqrtf(ss * (1.f / 256.f) + EPS);
        f32x16 qt[3];
#pragma unroll
        for (int blk = 0; blk < 3; ++blk) {
            f32x16 acc;
#pragma unroll
            for (int i = 0; i < 16; ++i) acc[i] = 0.f;
            const bf16* wrp = WUQ + (size_t)(h * 96 + 32 * blk + l31) * 256 + 8 * hi;
#pragma unroll
            for (int s = 0; s < 16; ++s) { const bf16x8 a = *(const bf16x8*)(wrp + 16 * s); acc = __builtin_amdgcn_mfma_f32_32x32x16_bf16(a, bq[s], acc, 0, 0, 0); }
            qt[blk] = acc * rq;
        }
        float s2 = 0.f;
#pragma unroll
        for (int blk = 0; blk < 3; ++blk)
#pragma unroll
            for (int i = 0; i < 16; ++i) s2 += qt[blk][i] * qt[blk][i];
        s2 += __shfl_xor(s2, 32);
        const float rs = (1.0f / sqrtf(s2 * (1.f / 96.f) + EPS));
        const float* gq = G(F.in->a_g_q) + pair * 96;
#pragma unroll
        for (int blk = 0; blk < 3; ++blk)
#pragma unroll
            for (int c = 0; c < 4; ++c) { const f32x4 g = *(const f32x4*)(gq + 32 * blk + 8 * c + 4 * hi);
#pragma unroll
                for (int e = 0; e < 4; ++e) qt[blk][4 * c + e] *= rs * g[e]; }
        if (lat) {
            const int t = row & (SEQ - 1);
#pragma unroll
            for (int c = 0; c < 4; ++c) {
                const int pidx = (c < 2) ? (t >> 6) : (t & 63);
#pragma unroll
                for (int q = 0; q < 2; ++q) { const f32x2 cs = rope[pidx * 8 + ((4 * c + 2 * hi + q) & 7)]; const float t0 = qt[2][4 * c + 2 * q], t1 = qt[2][4 * c + 2 * q + 1];
                    qt[2][4 * c + 2 * q] = t0 * cs.x - t1 * cs.y; qt[2][4 * c + 2 * q + 1] = t0 * cs.y + t1 * cs.x; }
            }
        }
        const float sc = 0.10206207261596577f * LOG2E;
#pragma unroll
        for (int blk = 0; blk < 3; ++blk)
#pragma unroll
            for (int s = 0; s < 2; ++s) { u32x4 w;
                w.x = pk2(qt[blk][8 * s + 0] * sc, qt[blk][8 * s + 1] * sc); w.y = pk2(qt[blk][8 * s + 2] * sc, qt[blk][8 * s + 3] * sc);
                w.z = pk2(qt[blk][8 * s + 4] * sc, qt[blk][8 * s + 5] * sc); w.w = pk2(qt[blk][8 * s + 6] * sc, qt[blk][8 * s + 7] * sc);
                qf[blk][s] = __builtin_bit_cast(bf16x8, w); }
    }
    LAS unsigned char* L = F.lds;
    const int kd0 = (F.tid / 12) * AT_KP + (F.tid % 12) * 16, kd1 = ((512 + F.tid) / 12) * AT_KP + ((512 + F.tid) % 12) * 16, vd = AT_KB + vdv * AT_VP + vpart * 16;
    const int kro = l31 * AT_KP + hi * 16, vro = AT_KB + l31 * AT_VP + hi * 16;
    u32x4 kb0, kb1 = (u32x4){0u, 0u, 0u, 0u}, vb;
#define AT_LOAD(k0_, k1_, v_, t_) do { const char* kg_ = (const char*)Kg + (size_t)(t_) * 64 * 192; k0_ = *(const u32x4*)(kg_ + (size_t)F.tid * 16); \
        if (F.tid < 256) k1_ = *(const u32x4*)(kg_ + (size_t)(512 + F.tid) * 16); v_ = *(const u32x4*)(Vg + (size_t)vdv * KPOS + (t_) * 64 + vpart * 8); } while (0)
#define AT_STORE(k0_, k1_, v_, off_) do { LAS unsigned char* Ln_ = L + (off_); *(LAS u32x4*)(Ln_ + kd0) = k0_; if (F.tid < 256) *(LAS u32x4*)(Ln_ + kd1) = k1_; *(LAS u32x4*)(Ln_ + vd) = v_; } while (0)
    AT_LOAD(kb0, kb1, vb, 1);
    AT_STORE(kr0, kr1, vr, 0); AT_STORE(kb0, kb1, vb, AT_BUF);
    __syncthreads();
    f32x16 oT[2];
#pragma unroll
    for (int d = 0; d < 2; ++d)
#pragma unroll
        for (int i = 0; i < 16; ++i) oT[d][i] = 0.f;
    f32x2 lrun2[2] = {(f32x2){0.f, 0.f}, (f32x2){0.f, 0.f}};
    const int nT = nkt >> 1;
    for (int T = 0; T < nT; ++T) {
        const bool more = (T + 1 < nT);
        if (more) { AT_LOAD(kr0, kr1, vr, 2 * T + 2); AT_LOAD(kb0, kb1, vb, 2 * T + 3); }
        const LAS unsigned char* Ld = L + (T & 1) * (2 * AT_BUF);
#pragma unroll
        for (int sub = 0; sub < 2; ++sub) {
            const LAS unsigned char* Lb = Ld + sub * AT_BUF;
        bf16x8 kf[2][3][2];
#pragma unroll
        for (int kb = 0; kb < 2; ++kb)
#pragma unroll
            for (int blk = 0; blk < 3; ++blk)
#pragma unroll
                for (int s = 0; s < 2; ++s) kf[kb][blk][s] = *(const LAS bf16x8*)(Lb + kro + kb * 32 * AT_KP + (32 * blk + 16 * s) * 2);
        __builtin_amdgcn_sched_barrier(0);
        f32x16 sT[2];
#pragma unroll
        for (int kb = 0; kb < 2; ++kb)
#pragma unroll
            for (int i = 0; i < 16; ++i) sT[kb][i] = 0.f;
        __builtin_amdgcn_s_setprio(1);
#pragma unroll
        for (int blk = 0; blk < 3; ++blk)
#pragma unroll
            for (int s = 0; s < 2; ++s)
#pragma unroll
                for (int kb = 0; kb < 2; ++kb) sT[kb] = __builtin_amdgcn_mfma_f32_32x32x16_bf16(kf[kb][blk][s], qf[blk][s], sT[kb], 0, 0, 0);
        __builtin_amdgcn_s_setprio(0);
        bf16x8 vf[2][2][2];
#pragma unroll
        for (int d = 0; d < 2; ++d)
#pragma unroll
            for (int kb = 0; kb < 2; ++kb)
#pragma unroll
                for (int s = 0; s < 2; ++s) vf[d][kb][s] = *(const LAS bf16x8*)(Lb + vro + d * 32 * AT_VP + (32 * kb + 16 * s) * 2);
        __builtin_amdgcn_sched_barrier(0);
        bf16x8 pf[2][2];
#pragma unroll
        for (int kb = 0; kb < 2; ++kb) {
            float p[16];
#pragma unroll
            for (int i = 0; i < 16; ++i) p[i] = __builtin_amdgcn_exp2f(sT[kb][i]);
#pragma unroll
            for (int i = 0; i < 16; i += 4) { lrun2[0] += (f32x2){p[i], p[i + 1]}; lrun2[1] += (f32x2){p[i + 2], p[i + 3]}; }
#pragma unroll
            for (int s = 0; s < 2; ++s) { u32x4 w; w.x = cvt_pk_bf16(p[8 * s + 0], p[8 * s + 1]); w.y = cvt_pk_bf16(p[8 * s + 2], p[8 * s + 3]); w.z = cvt_pk_bf16(p[8 * s + 4], p[8 * s + 5]); w.w = cvt_pk_bf16(p[8 * s + 6], p[8 * s + 7]);
                pf[kb][s] = __builtin_bit_cast(bf16x8, w); }
        }
        __builtin_amdgcn_sched_barrier(0);
        __builtin_amdgcn_s_setprio(1);
#pragma unroll
        for (int kb = 0; kb < 2; ++kb)
#pragma unroll
            for (int s = 0; s < 2; ++s)
#pragma unroll
                for (int d = 0; d < 2; ++d) oT[d] = __builtin_amdgcn_mfma_f32_32x32x16_bf16(vf[d][kb][s], pf[kb][s], oT[d], 0, 0, 0);
        __builtin_amdgcn_s_setprio(0);
        }
        if (more) { const int o = ((T + 1) & 1) * (2 * AT_BUF); AT_STORE(kr0, kr1, vr, o); AT_STORE(kb0, kb1, vb, o + AT_BUF); }
        __syncthreads();
    }
#undef AT_LOAD
#undef AT_STORE
    float lrun = (lrun2[0].x + lrun2[0].y) + (lrun2[1].x + lrun2[1].y);
    lrun += __shfl_xor(lrun, 32);
    const float inv = 1.0f / lrun;
    bf16* op = MIX + (size_t)row * DM + h * 64 + 4 * hi;
#pragma unroll
    for (int d = 0; d < 2; ++d)
#pragma unroll
        for (int c = 0; c < 4; ++c) *(u32x2*)(op + 32 * d + 8 * c) = (u32x2){pk2(oT[d][4 * c] * inv, oT[d][4 * c + 1] * inv), pk2(oT[d][4 * c + 2] * inv, oT[d][4 * c + 3] * inv)};
}

__device__ __forceinline__ void mla_attn_phase(Frame& F, int pair, int rep) {
    constexpr int NLU = NB * A_HEADS * (SEQ / 256), NCU = NB * A_HEADS;
    for (;;) {
        if (F.tid == 0) F.MISC[0] = __hip_atomic_fetch_add(F.ctl + CW_ATTQ + 64 * pair + 32 * rep, 1u, RLX_AGENT);
        __syncthreads();
        const int u = (int)F.MISC[0];
        __syncthreads();
        if (u >= NLU + NCU) break;
        if (u < NLU) { const int qb = u & 15, bh = u >> 4, b = bh / A_HEADS, h = bh % A_HEADS; mla_attn_unit(F, pair, b, h, b * SEQ + qb * 256, true, 0, KPOS / 64); }
        else { const int bh = u - NLU, b = bh / A_HEADS, h = bh % A_HEADS; mla_attn_unit(F, pair, b, h, NLAT + b * CTXL, false, SEQ, CTXL / 64); }
    }
}

constexpr int NA_KP = 144, NA_CVP = 528, NA_LVP = 1168;
constexpr int NA_CK = 0, NA_CV = 256 * NA_KP, NA_L = NA_CV + 64 * NA_CVP, NA_RPB = NA_L + 576 * NA_KP, NA_END = NA_RPB + 15 * 31 * 4;
static_assert(NA_L == 70656 && 64 * NA_LVP <= 576 * NA_KP && NA_END <= LDSCTL_OFF, "NA LDS map");

struct NaPref { u32x4 r[9]; };
__device__ __forceinline__ void na_load_k(NaPref& p, const bf16* KN, int rowbase, int h, int tid) {
    const char* gb = (const char*)(KN + (size_t)rowbase * DM + h * 64); const unsigned lo = (unsigned)(tid >> 3) * 2048u + (unsigned)(tid & 7) * 16u;
#pragma unroll
    for (int i = 0; i < 9; ++i) p.r[i] = *(const u32x4*)(gb + (size_t)i * 131072 + lo);
}
__device__ __forceinline__ void na_store_k(const NaPref& p, LAS unsigned char* L, int tid) {
    LAS unsigned char* d = L + NA_L + (tid >> 3) * NA_KP + (tid & 7) * 16;
#pragma unroll
    for (int i = 0; i < 9; ++i) *(LAS u32x4*)(d + i * 64 * NA_KP) = p.r[i];
}
__device__ __forceinline__ void na_load_v(NaPref& p, const bf16* Vt, int pos0, int tid) {
    const char* gb = (const char*)(Vt + pos0); const unsigned lo = (unsigned)(tid >> 3) * (unsigned)(KPOS * 2) + (unsigned)(tid & 7) * 16u;
#pragma unroll
    for (int i = 0; i < 9; ++i) p.r[i] = *(const u32x4*)(gb + i * 128 + lo);
}
__device__ __forceinline__ void na_store_v(const NaPref& p, LAS unsigned char* L, int tid) {
    LAS unsigned char* d = L + NA_L + (tid >> 3) * NA_LVP + (tid & 7) * 16;
#pragma unroll
    for (int i = 0; i < 9; ++i) *(LAS u32x4*)(d + i * 128) = p.r[i];
}
__device__ __forceinline__ void na_stage_ctx(Frame& F, int b, int h) {
    const char* kb = (const char*)((const bf16*)(F.WS() + WS_KN) + (size_t)(NLAT + b * CTXL) * DM + h * 64);
    const char* vb = (const char*)((const bf16*)(F.WS() + WS_VTN) + (size_t)(b * C_HEADS + h) * 64 * KPOS + SEQ);
    const unsigned klo = (unsigned)(F.tid >> 3) * 2048u + (unsigned)(F.tid & 7) * 16u, vlo = (unsigned)(F.tid >> 3) * (unsigned)(KPOS * 2) + (unsigned)(F.tid & 7) * 16u;
    u32x4 a[4], v[4];
#pragma unroll
    for (int i = 0; i < 4; ++i) a[i] = *(const u32x4*)(kb + (size_t)i * 131072 + klo);
#pragma unroll
    for (int i = 0; i < 4; ++i) v[i] = *(const u32x4*)(vb + i * 128 + vlo);
    LAS unsigned char* kd = F.lds + NA_CK + (F.tid >> 3) * NA_KP + (F.tid & 7) * 16;
    LAS unsigned char* vd = F.lds + NA_CV + (F.tid >> 3) * NA_CVP + (F.tid & 7) * 16;
#pragma unroll
    for (int i = 0; i < 4; ++i) *(LAS u32x4*)(kd + i * 64 * NA_KP) = a[i];
#pragma unroll
    for (int i = 0; i < 4; ++i) *(LAS u32x4*)(vd + i * 128) = v[i];
}
__device__ __forceinline__ float na_scores(Frame& F, bf16x8 (&pf)[16], float& f1, const bf16x8 (&qf)[2], const int (&dco)[8], const bool (&okm)[8], bool lat, int qr, int c0, int kr0, int rs, int ks) {
    const int lane = F.lane, l15 = lane & 15, g = lane >> 4;
    const LAS float* rpbs = (const LAS float*)(F.lds + NA_RPB);
    float lsum = 0.f;
    f1 = 1.0f;
    if (lat) {
#pragma unroll
        for (int u = 0; u < 8; ++u) {
            const LAS float* brow = rpbs + (rs + u - qr + 7) * 31;
            float p[8];
#pragma unroll
            for (int hf = 0; hf < 2; ++hf) {
                const LAS unsigned char* kp = F.lds + NA_L + (((rs - kr0) + u) * 64 + ks + 16 * hf + l15) * NA_KP + g * 16;
                f32x4 acc = (f32x4){0.f, 0.f, 0.f, 0.f};
#pragma unroll
                for (int s = 0; s < 2; ++s) { const bf16x8 a = *(const LAS bf16x8*)(kp + s * 64); acc = __builtin_amdgcn_mfma_f32_16x16x32_bf16(a, qf[s], acc, 0, 0, 0); }
#pragma unroll
                for (int e = 0; e < 4; ++e) { const float bias = brow[dco[4 * hf + e]]; const float pe = __builtin_amdgcn_exp2f(acc[e] + bias); p[4 * hf + e] = okm[4 * hf + e] ? pe : 0.f; }
            }
#pragma unroll
            for (int e = 0; e < 8; ++e) lsum += p[e];
            u32x4 w; w.x = cvt_pk_bf16(p[0], p[1]); w.y = cvt_pk_bf16(p[2], p[3]); w.z = cvt_pk_bf16(p[4], p[5]); w.w = cvt_pk_bf16(p[6], p[7]);
            pf[u] = __builtin_bit_cast(bf16x8, w);
            if ((u & 1) == 1) asm volatile("" ::: "memory");
        }
    } else {
#pragma unroll
        for (int u = 0; u < 8; ++u) pf[u] = (bf16x8){0, 0, 0, 0, 0, 0, 0, 0};
    }
#pragma unroll
    for (int u = 0; u < 8; ++u) {
        float p[8];
#pragma unroll
        for (int hf = 0; hf < 2; ++hf) {
            const LAS unsigned char* kp = F.lds + NA_CK + (16 * (2 * u + hf) + l15) * NA_KP + g * 16;
            f32x4 acc = (f32x4){0.f, 0.f, 0.f, 0.f};
#pragma unroll
            for (int s = 0; s < 2; ++s) { const bf16x8 a = *(const LAS bf16x8*)(kp + s * 64); acc = __builtin_amdgcn_mfma_f32_16x16x32_bf16(a, qf[s], acc, 0, 0, 0); }
#pragma unroll
            for (int e = 0; e < 4; ++e) p[4 * hf + e] = __builtin_amdgcn_exp2f(acc[e]);
        }
#pragma unroll
        for (int e = 0; e < 8; ++e) lsum += p[e];
        u32x4 w; w.x = cvt_pk_bf16(p[0], p[1]); w.y = cvt_pk_bf16(p[2], p[3]); w.z = cvt_pk_bf16(p[4], p[5]); w.w = cvt_pk_bf16(p[6], p[7]);
        pf[8 + u] = __builtin_bit_cast(bf16x8, w);
        if ((u & 1) == 1) asm volatile("" ::: "memory");
    }
    lsum += __shfl_xor(lsum, 16); lsum += __shfl_xor(lsum, 32);
    return 1.0f / lsum;
}
__device__ __forceinline__ void na_pv(Frame& F, const bf16x8 (&pf)[16], float f1, float inv, bool lat, int qrow, int h, int kr0, int rs, int ks) {
    const int lane = F.lane, l15 = lane & 15, g = lane >> 4;
    bf16* MIX = (bf16*)(F.WS() + WS_ACT);
    bf16* op = MIX + (size_t)qrow * DM + h * 64 + 4 * g;
#pragma unroll
    for (int dvt = 0; dvt < 4; ++dvt) {
        f32x4 acc = (f32x4){0.f, 0.f, 0.f, 0.f};
        const int dv = 16 * dvt + l15;
        if (lat) {
#pragma unroll
            for (int u = 0; u < 8; ++u) {
                const LAS unsigned char* vp = F.lds + NA_L + dv * NA_LVP + (((rs - kr0) + u) * 64 + ks + 4 * g) * 2;
                const u32x2 lo = *(const LAS u32x2*)(vp), hi2 = *(const LAS u32x2*)(vp + 32);
                const u32x4 w = (u32x4){lo.x, lo.y, hi2.x, hi2.y};
                acc = __builtin_amdgcn_mfma_f32_16x16x32_bf16(__builtin_bit_cast(bf16x8, w), pf[u], acc, 0, 0, 0);
                if ((u & 3) == 3) asm volatile("" ::: "memory");
            }
            acc = acc * f1;
        }
#pragma unroll
        for (int u = 8; u < 16; ++u) {
            const LAS unsigned char* vp = F.lds + NA_CV + dv * NA_CVP + (32 * (u - 8) + 4 * g) * 2;
            const u32x2 lo = *(const LAS u32x2*)(vp), hi2 = *(const LAS u32x2*)(vp + 32);
            const u32x4 w = (u32x4){lo.x, lo.y, hi2.x, hi2.y};
            acc = __builtin_amdgcn_mfma_f32_16x16x32_bf16(__builtin_bit_cast(bf16x8, w), pf[u], acc, 0, 0, 0);
            if ((u & 3) == 3) asm volatile("" ::: "memory");
        }
        *(u32x2*)(op + 16 * dvt) = (u32x2){pk2(acc[0] * inv, acc[1] * inv), pk2(acc[2] * inv, acc[3] * inv)};
    }
}
__device__ __forceinline__ void na_phase(Frame& F, int pair, bool ctx_queries) {
    const bf16* KN = (const bf16*)(F.WS() + WS_KN);
    LAS float* rpbs = (LAS float*)(F.lds + NA_RPB);
    constexpr int NGRP = NB * C_HEADS * 2;
    for (int gi = F.bid; gi < NGRP; gi += F.G) {
        const int h = gi / (NB * 2), rem = gi % (NB * 2), b = rem >> 1, half = rem & 1;
        const bf16* Vt = (const bf16*)(F.WS() + WS_VTN) + (size_t)(b * C_HEADS + h) * 64 * KPOS;
        __syncthreads();
        na_stage_ctx(F, b, h);
        { const float* rp = G(F.in->c_rpb) + ((size_t)pair * C_HEADS + h) * 15 * 31; for (int i = F.tid; i < 15 * 31; i += NWAVES * 64) rpbs[i] = rp[i] * LOG2E; }
        NaPref pk, pv;
        int dco[8]; bool okm[8];
        { const int c0 = 16 * (F.wave & 3), ks = min(max(c0 - 8, 0), 32), cq = c0 + (F.lane & 15), cs = min(max(cq - 8, 0), 48);
#pragma unroll
          for (int k = 0; k < 8; ++k) { const int kc = ks + 16 * (k >> 2) + 4 * (F.lane >> 4) + (k & 3); okm[k] = (kc >= cs) && (kc < cs + 16); dco[k] = min(max(kc - cq + 15, 0), 30); } }
        { const int r0 = 2 * (16 * half), kr0 = min(max(r0 - 4, 0), 55); na_load_k(pk, KN, b * SEQ + kr0 * 64, h, F.tid); }
        for (int bi = 0; bi < 16; ++bi) {
            asm volatile("" : "+v"(F.tid)); F.lane = F.tid & 63;
            const int r0 = 2 * (16 * half + bi), kr0 = min(max(r0 - 4, 0), 55);
            const int qr = r0 + (F.wave >> 2), c0 = 16 * (F.wave & 3), rs = min(max(qr - 4, 0), 56), ks = min(max(c0 - 8, 0), 32);
            const int qrow = b * SEQ + qr * 64 + c0 + (F.lane & 15);
            bf16x8 qf[2];
#pragma unroll
            for (int s = 0; s < 2; ++s) qf[s] = *(const bf16x8*)((const bf16*)(F.WS() + WS_QN) + (size_t)qrow * DM + h * 64 + 32 * s + 8 * (F.lane >> 4));
            na_store_k(pk, F.lds, F.tid);
            __syncthreads();
            na_load_v(pv, Vt, kr0 * 64, F.tid);
            bf16x8 pf[16];
            float f1; const float inv = na_scores(F, pf, f1, qf, dco, okm, true, qr, c0, kr0, rs, ks);
            __syncthreads();
            na_store_v(pv, F.lds, F.tid);
            __syncthreads();
            if (bi + 1 < 16) { const int r1 = r0 + 2, kr1 = min(max(r1 - 4, 0), 55); na_load_k(pk, KN, b * SEQ + kr1 * 64, h, F.tid); }
            na_pv(F, pf, f1, inv, true, qrow, h, kr0, rs, ks);
            __syncthreads();
        }
    }
    constexpr int NCU = NB * C_HEADS * 2;
    for (int u = F.bid; ctx_queries && u < NCU; u += F.G) {
        const int h = u / (NB * 2), rem = u % (NB * 2), b = rem >> 1, ch = rem & 1;
        __syncthreads();
        na_stage_ctx(F, b, h);
        __syncthreads();
        const int qrow = NLAT + b * CTXL + ch * 128 + 16 * F.wave + (F.lane & 15);
        bf16x8 pf[16]; bf16x8 qf[2];
#pragma unroll
        for (int s = 0; s < 2; ++s) qf[s] = *(const bf16x8*)((const bf16*)(F.WS() + WS_QN) + (size_t)qrow * DM + h * 64 + 32 * s + 8 * (F.lane >> 4));
        const int dco0[8] = {0, 0, 0, 0, 0, 0, 0, 0}; const bool okm0[8] = {false, false, false, false, false, false, false, false};
        float f1; const float inv = na_scores(F, pf, f1, qf, dco0, okm0, false, 0, 0, 0, 0, 0);
        na_pv(F, pf, f1, inv, false, qrow, h, 0, 0, 0);
    }
    __syncthreads();
}

constexpr int PH_PER_PAIR = 16, N_PHASES = 2 * PH_PER_PAIR + 1;
struct Args { Inputs in; float* out; unsigned char* ws; int ph_lo, ph_hi; };
static_assert(sizeof(Args) == 27 * 8 + 8 + 8 + 8, "Args has no padding bytes");

__global__ void __launch_bounds__(NWAVES * 64, 2) dit_fwd(Args args) {
    extern __shared__ __attribute__((aligned(16))) unsigned char lds_raw[];
    Frame F;
    F.lds = (LAS unsigned char*)lds_raw;
    F.MISC = (volatile LAS unsigned*)(F.lds + MISC_OFF);
    F.tid = threadIdx.x; F.lane = F.tid & 63; F.wave = __builtin_amdgcn_readfirstlane(F.tid >> 6);
    F.G = gridDim.x; F.bid = blockIdx.x;
    F.ws_ = (GAS unsigned char*)args.ws; F.ctl = (gu32*)(args.ws + WS_CTL); F.out_ = (GAS float*)args.out; F.hc_ = (GAS float*)(args.ws + WS_HC); F.in = (const CAS Inputs*)__builtin_amdgcn_kernarg_segment_ptr();
    for (int u = F.tid; u < (LDS_BYTES - LDSCTL_OFF) / 4; u += NWAVES * 64) ((LAS unsigned*)(F.lds + LDSCTL_OFF))[u] = 0u;
    __syncthreads();
    const int lo = args.ph_lo, hi = args.ph_hi;
    const bool use_bar = (hi - lo) > 1;
    XcdBarrier bar; bar.bar = (GAS unsigned*)(F.ctl + CW_BAR); bar.x = 0; bar.st = nullptr;
    if (use_bar) bar = xcd_barrier_post((GAS unsigned*)(F.ctl + CW_BAR), F.MISC + 8);
#ifndef ONLYP
#define PH_EN(c) true
#else
#define PH_EN(c) ((c) == ONLYP)
#endif
#define INR(k) (lo <= (k) && (k) < hi)
#define PROBE_MASK 0
#define NREP(c) (((PROBE_MASK) >> (c)) & 1 ? 2 : 1)
#define TS_MASK 0
#define TS_EN(c) (((TS_MASK) >> (c)) & 1)
    unsigned long long ts_acc = 0, ts_t0 = 0;
#define FRESH() do { asm volatile("" : "+s"(F.ws_), "+s"(F.out_), "+s"(F.hc_), "+s"(F.ctl), "+s"(F.in), "+s"(F.G), "+s"(F.bid), "+s"(F.wave)); asm volatile("" : "+v"(F.tid)); F.lane = F.tid & 63; W = F.WS() + WS_W; MODB = (const float*)(F.WS() + WS_MOD); ACT = (bf16*)(F.WS() + WS_ACT); } while (0)
#define IN(k) (PH_EN((k) - P) && INR(k))
#define TS_ARRIVE 0
#define SEAM(k) do { if (INR(k) && INR((k) + 1)) { if (TS_ARRIVE && TS_EN((k) - P)) ts_t0 = __builtin_amdgcn_s_memrealtime(); for (int rb = 0; rb < ((PROBE_MASK >> 20) & 1 ? 2 : 1); ++rb) { asm volatile("" : "+s"(bar.bar), "+s"(bar.x)); xcd_barrier(bar); } if (TS_EN((k) - P)) ts_acc += __builtin_amdgcn_s_memrealtime() - ts_t0; } } while (0)
    unsigned char* W; const float* MODB; bf16* ACT;
    volatile LAS int* MOE = (volatile LAS int*)(F.lds + MOE_LDS_OFF);
    LAS unsigned char* ring = F.lds + RING_OFF;

    for (int j = 0; j < 2; ++j) {
        const int P = j * PH_PER_PAIR, le = 2 * j, lod = 2 * j + 1;
        const int nMo = (j == 1) ? NLAT / 256 : NTOK / 256;
        if (IN(P + 0)) { if (TS_EN(0)) ts_t0 = __builtin_amdgcn_s_memrealtime(); for (int rep = 0; rep < NREP(0); ++rep) { FRESH(); if (j == 0) prep_phase(F, 0); } } if (j == 0) SEAM(P + 0);
        if (IN(P + 1)) { if (TS_EN(1)) ts_t0 = __builtin_amdgcn_s_memrealtime(); FRESH(); if (j == 1) prep_phase(F, 1); norm_phase(F, NormArgs{le, 0, j == 0, j > 0 ? j - 1 : -1, -1, 0, 0}); } SEAM(P + 1);
        if (IN(P + 2)) { if (TS_EN(2)) ts_t0 = __builtin_amdgcn_s_memrealtime(); for (int rep = 0; rep < NREP(2); ++rep) { FRESH();
            SchedStatic S{ACT, 1024, (const bf16*)(W + WO_WIN_E), 1024, NTOK / 256, 4, F.G, F.bid};
            EpiWin E{(bf16*)(F.WS() + WS_PX), (bf16*)(F.WS() + WS_GT), (bf16*)(F.WS() + WS_GTC), (float*)(F.WS() + WS_ROWST)};
            pg8::gemm_phase<EpiWin, SchedStatic>(ring, 1024, S, E, F.tid);
        } } SEAM(P + 2);
        if (IN(P + 3)) { if (TS_EN(3)) ts_t0 = __builtin_amdgcn_s_memrealtime(); for (int rep = 0; rep < NREP(3); ++rep) { FRESH();
            fourier_fold(F);
            SchedStatic S{(const bf16*)(F.WS() + WS_PX) + 256, 512, (const bf16*)(W + WO_WUKV), 256, NTOK / 256, 6, F.G, F.bid};
            LAS float* tl = (LAS float*)(F.lds + pg8::GN_LDS_OFF);
            { const float* rp = (const float*)(F.WS() + WS_ROPE); const float* gk = G(F.in->a_g_k) + j * 96;
              for (int i = F.tid; i < 1024 + 96; i += NWAVES * 64) tl[i] = i < 1024 ? rp[i] : gk[i - 1024];
              __syncthreads(); }
            EpiKV E{(const bf16*)(F.WS() + WS_PX), (bf16*)(F.WS() + WS_K), (bf16*)(F.WS() + WS_VT), tl, (const float*)(F.WS() + WS_ROWST)};
            pg8::gemm_phase<EpiKV, SchedStatic>(ring, 256, S, E, F.tid);
        } } SEAM(P + 3);
        if (IN(P + 4)) { if (TS_EN(4)) ts_t0 = __builtin_amdgcn_s_memrealtime(); for (int rep = 0; rep < NREP(4); ++rep) { FRESH();
            {
                const bool latf = F.bid < 128; const int have = F.bid < 136;
                SchedOne S{latf ? (const bf16*)(F.WS() + WS_DFT) : (const bf16*)(F.WS() + WS_DFTC), latf ? 4096 : 512, latf ? (const bf16*)(F.WS() + WS_GF) : (const bf16*)(F.WS() + WS_GTC), latf ? 4096 : 512,
                           latf ? (F.bid >> 3) : 0, latf ? (F.bid & 7) : (F.bid - 128), have};
                EpiBf16 E{ACT, 1024, latf ? 1 : 2};
                pg8::gemm_phase<EpiBf16, SchedOne>(ring, S.K, S, E, F.tid);
            }
            __syncthreads();
            mla_attn_phase(F, j, rep);
        } } SEAM(P + 4);
        if (IN(P + 5)) { if (TS_EN(5)) ts_t0 = __builtin_amdgcn_s_memrealtime(); for (int rep = 0; rep < NREP(5); ++rep) { FRESH();
            SchedResid S{ACT, 1024, (const bf16*)(W + WO_WOUT_E), 1024, 8, F.G, F.bid};
            EpiResid E{F.OUT(), F.HC(), MODB + (size_t)le * 9 * 6144, 2, rep + 1 < NREP(5), (float*)(F.WS() + WS_PART), j == 0 ? G(F.in->x) : F.OUT()};
            pg8::gemm_phase<EpiResid, SchedResid>(ring, 1024, S, E, F.tid);
        } } SEAM(P + 5);
        if (IN(P + 6)) { if (TS_EN(6)) ts_t0 = __builtin_amdgcn_s_memrealtime(); for (int rep = 0; rep < NREP(6); ++rep) { FRESH(); norm_phase(F, NormArgs{le, 1, j == 0 ? 2 : 0, -1, -1, 0, 1}); } } SEAM(P + 6);
        if (IN(P + 7)) { if (TS_EN(7)) ts_t0 = __builtin_amdgcn_s_memrealtime(); for (int rep = 0; rep < NREP(7); ++rep) { FRESH();
            SchedStatic S{ACT, 1024, (const bf16*)(W + WO_WGU_E), 1024, NTOK / 256, 2 * DFF / 256, F.G, F.bid};
            EpiSwiglu E{(bf16*)(F.WS() + WS_HMID), DFF};
            pg8::gemm_phase<EpiSwiglu, SchedStatic>(ring, 1024, S, E, F.tid);
        } } SEAM(P + 7);
        if (IN(P + 8)) { if (TS_EN(8)) ts_t0 = __builtin_amdgcn_s_memrealtime(); for (int rep = 0; rep < NREP(8); ++rep) { FRESH();
            SchedResid S{(const bf16*)(F.WS() + WS_HMID), DFF, (const bf16*)(W + WO_WDN_E), DFF, 8, F.G, F.bid};
            EpiResid E{F.OUT(), F.HC(), MODB + (size_t)le * 9 * 6144, 5, rep + 1 < NREP(8), (float*)(F.WS() + WS_PART), F.OUT()};
            pg8::gemm_phase<EpiResid, SchedResid>(ring, DFF, S, E, F.tid);
        } } SEAM(P + 8);
        if (IN(P + 9)) { if (TS_EN(9)) ts_t0 = __builtin_amdgcn_s_memrealtime(); for (int rep = 0; rep < NREP(9); ++rep) { FRESH(); norm_phase(F, NormArgs{lod, 0, 0, -1, -1, 0, 1}); } } SEAM(P + 9);
        if (IN(P + 10)) { if (TS_EN(10)) ts_t0 = __builtin_amdgcn_s_memrealtime(); for (int rep = 0; rep < NREP(10); ++rep) { FRESH();
            SchedStatic S{ACT, 1024, (const bf16*)(W + WO_WIN_O), 1024, NTOK / 256, 12, F.G, F.bid};
            EpiNAin E{(bf16*)(F.WS() + WS_QN), (bf16*)(F.WS() + WS_KN), (bf16*)(F.WS() + WS_VTN), G(F.in->c_g_q) + j * 64, G(F.in->c_g_k) + j * 64};
            pg8::gemm_phase<EpiNAin, SchedStatic>(ring, 1024, S, E, F.tid);
        } } SEAM(P + 10);
        if (IN(P + 11)) { if (TS_EN(11)) ts_t0 = __builtin_amdgcn_s_memrealtime(); for (int rep = 0; rep < NREP(11); ++rep) { FRESH(); na_phase(F, j, j == 0); } } SEAM(P + 11);
        if (IN(P + 12)) { if (TS_EN(12)) ts_t0 = __builtin_amdgcn_s_memrealtime(); for (int rep = 0; rep < NREP(12); ++rep) { FRESH();
            SchedResid S{ACT, 1024, (const bf16*)(W + WO_WOUT_O), 1024, nMo - 128, F.G, F.bid};
            EpiResid E{F.OUT(), F.HC(), MODB + (size_t)lod * 9 * 6144, 2, rep + 1 < NREP(12), (float*)(F.WS() + WS_PART), F.OUT()};
            pg8::gemm_phase<EpiResid, SchedResid>(ring, 1024, S, E, F.tid);
        } } SEAM(P + 12);
        if (IN(P + 13)) { if (TS_EN(13)) ts_t0 = __builtin_amdgcn_s_memrealtime(); FRESH(); norm_phase(F, NormArgs{lod, 1, 0, -1, j, j == 1, 1}); } SEAM(P + 13);
        if (IN(P + 14)) { if (TS_EN(14)) ts_t0 = __builtin_amdgcn_s_memrealtime(); for (int rep = 0; rep < NREP(14); ++rep) { FRESH();
            moe_panels_to_lds(F, j);
            SchedMoe<true> S{ACT, 1024, (const bf16*)(W + WO_WGU_M), (size_t)2 * DFFE * 1024 * 2, 1024, 2 * DFFE / 256, F.G, F.bid, (const int*)(F.WS() + WS_LIST), MOE};
            EpiSwiglu E{(bf16*)(F.WS() + WS_HMOE), DFFE};
            pg8::gemm_phase<EpiSwiglu, SchedMoe<true>>(ring, 1024, S, E, F.tid);
        } } SEAM(P + 14);
        if (IN(P + 15)) { if (TS_EN(15)) ts_t0 = __builtin_amdgcn_s_memrealtime(); for (int rep = 0; rep < NREP(15); ++rep) { FRESH();
            moe_panels_to_lds(F, j);
            SchedMoe<false> S{(const bf16*)(F.WS() + WS_HMOE), DFFE, (const bf16*)(W + WO_WDN_M), (size_t)1024 * DFFE * 2, DFFE, 4, F.G, F.bid, nullptr, MOE};
            EpiBf16 E{(bf16*)(F.WS() + WS_Y), 1024, 0};
            pg8::gemm_phase<EpiBf16, SchedMoe<false>>(ring, DFFE, S, E, F.tid);
        } } SEAM(P + 15);
    }
    { const int P = 0; if (IN(2 * PH_PER_PAIR)) { FRESH(); norm_phase(F, NormArgs{3, 0, 0, 1, -1, 1, 0}); } }
    if (TS_MASK != 0 && F.bid == 0) { const unsigned long long t0 = __builtin_amdgcn_s_memrealtime(); while (__builtin_amdgcn_s_memrealtime() - t0 < ts_acc) __builtin_amdgcn_s_sleep(8); }
#undef IN
#undef INR
#undef SEAM
}

#if DBG

#endif

extern "C" void kernel_launch(void* const* d_in, const int* in_sizes, int n_in, void* d_out, int out_size, void* d_ws, size_t ws_size, hipStream_t stream) {
    static int grid = 0;
    if (grid == 0) {
        if (n_in != 27 || in_sizes[0] != NLAT * DM || out_size != NLAT * DM || ws_size < WS_END) {
            fprintf(stderr, "kernel_launch: built for 27 inputs, x/out of %d floats, >= %zu bytes of workspace; got n_in %d, in0 %d, out %d, ws %zu; nothing launched\n", NLAT * DM, (size_t)WS_END, n_in, n_in > 0 ? in_sizes[0] : -1, out_size, ws_size);
            grid = -1; return; }
        int dev = 0, cus = 0, per_cu = 0;
        if (hipGetDevice(&dev) != hipSuccess || hipDeviceGetAttribute(&cus, hipDeviceAttributeMultiprocessorCount, dev) != hipSuccess) { fprintf(stderr, "kernel_launch: device query failed\n"); grid = -1; return; }
        if (hipFuncSetAttribute((const void*)dit_fwd, hipFuncAttributeMaxDynamicSharedMemorySize, LDS_BYTES) != hipSuccess) { fprintf(stderr, "kernel_launch: hipFuncSetAttribute failed\n"); grid = -1; return; }
        if (hipOccupancyMaxActiveBlocksPerMultiprocessor(&per_cu, (const void*)dit_fwd, NWAVES * 64, LDS_BYTES) != hipSuccess || per_cu < 1) { fprintf(stderr, "kernel_launch: occupancy query reports %d workgroups per CU\n", per_cu); }
        (void)hipGetLastError();
        grid = cus;
    }
    if (grid < 0) return;
    if (hipMemsetAsync((char*)d_ws + WS_CTL, 0, CTL_ZERO_BYTES, stream) != hipSuccess) { fprintf(stderr, "kernel_launch: memset failed\n"); return; }
    Args a{};
    const float** ip = (const float**)(void*)&a.in;
    for (int i = 0; i < 27; ++i) ip[i] = (const float*)d_in[i];
    a.out = (float*)d_out; a.ws = (unsigned char*)d_ws;
#if DBG
    dbg_launch_all(a, grid, stream);
#else
    a.ph_lo = 0; a.ph_hi = N_PHASES;
    hipLaunchKernelGGL(dit_fwd, dim3(grid), dim3(NWAVES * 64), LDS_BYTES, stream, a);
    const hipError_t le = hipPeekAtLastError();
    if (le != hipSuccess) fprintf(stderr, "kernel_launch: launch failed: %s\n", hipGetErrorName(le));
#endif
}
```

```cpp
#include <hip/hip_runtime.h>
#include <cstdio>
#include <cstdint>

#define LAS __attribute__((address_space(3)))
#define GAS __attribute__((address_space(1)))
typedef unsigned short bf16;
typedef short bf16x8 __attribute__((ext_vector_type(8)));
typedef short bf16x4 __attribute__((ext_vector_type(4)));
typedef float f32x4 __attribute__((ext_vector_type(4)));
typedef float f32x2 __attribute__((ext_vector_type(2)));
typedef float f32x16 __attribute__((ext_vector_type(16)));
typedef unsigned u32x4 __attribute__((ext_vector_type(4)));
typedef unsigned u32x2 __attribute__((ext_vector_type(2)));

#define DBG 0

constexpr int DM = 1024, NB = 8, SEQ = 4096, CTXL = 256;
constexpr int NLAT = NB * SEQ, NCTX = NB * CTXL, NTOK = NLAT + NCTX;
constexpr int KPOS = SEQ + CTXL;
constexpr int A_HEADS = 12, A_QK = 96, A_IN_SRC = 672;
constexpr int C_HEADS = 16;
constexpr int DFF = 2816, NEXP = 8, DFFE = 1408;
constexpr int MOE_SLOTS = 2 * NTOK + NEXP * 256;
constexpr float EPS = 1e-6f;
constexpr float LOG2E = 1.4426950408889634f;

__device__ __forceinline__ unsigned f2bf(float f) { unsigned u = __builtin_bit_cast(unsigned, f); return (u + 0x7fffu + ((u >> 16) & 1u)) >> 16; }
typedef __bf16 bf16x2_hw __attribute__((ext_vector_type(2)));
__device__ __forceinline__ unsigned cvt_pk_bf16(float lo, float hi) { const f32x2 v = {lo, hi}; const bf16x2_hw b = __builtin_convertvector(v, bf16x2_hw); return __builtin_bit_cast(unsigned, b); }
__device__ __forceinline__ unsigned pk2(float lo, float hi) { return cvt_pk_bf16(lo, hi); }
__device__ __forceinline__ float bf2f(unsigned short h) { return __builtin_bit_cast(float, (unsigned)h << 16); }
__device__ __forceinline__ float bflo(unsigned w) { return __builtin_bit_cast(float, w << 16); }
__device__ __forceinline__ float bfhi(unsigned w) { return __builtin_bit_cast(float, w & 0xffff0000u); }

namespace pg8 {
typedef unsigned u32x4 __attribute__((ext_vector_type(4)));
#define PG8_LAS __attribute__((address_space(3)))
constexpr int GN_LDS_OFF = 131072;
constexpr int BM = 256, BK = 64, HALF = 128, HTB = HALF * BK * 2  , STAGE_BYTES = 8 * HTB, NXCD = 8, WGM = 8;

__host__ __device__ __forceinline__ int lds_byte(int r, int c) { const int st = (r >> 4) * 2 + (c >> 5), rr = r & 15, cc = c & 31, ob = rr * 64 + cc * 2; return st * 1024 + (ob ^ (((ob >> 9) & 1) << 5)); }
__host__ __device__ __forceinline__ void stage_rc(int b, int& R, int& C) { const int st = b / 1024, sb = b % 1024, swz = sb ^ (((sb >> 9) & 1) << 5); R = (st >> 1) * 16 + swz / 64; C = (st & 1) * 32 + (swz % 64) / 2; }
__host__ __device__ __forceinline__ int perm32(int rho) { const int n = rho >> 4, i = rho & 15; return 8 * (i >> 2) + 4 * n + (i & 3); }

struct Unit { int pm, pn, kq; };

__device__ __forceinline__ bool static_next(int i, int G, int c, int nM, int nN, Unit& u) {
    const int nwg = nM * nN;
    const long L = (long)i * G + c; if (L >= nwg) return false;
    int wgid = (int)L; { const int q = nwg / NXCD, r = nwg % NXCD, xcd = wgid % NXCD, off = wgid / NXCD; wgid = (xcd < r ? xcd * (q + 1) : r * (q + 1) + (xcd - r) * q) + off; }
    const int nig = WGM * nN, gid = wgid / nig, fm = gid * WGM, gsz = (nM - fm) < WGM ? (nM - fm) : WGM;
    u.pm = fm + ((wgid % nig) % gsz); u.pn = (wgid % nig) / gsz; u.kq = -1; return true;
}

template <class Epi, class Sched, bool ALIGN_EPI = true, bool SP2 = true>
__device__ __forceinline__ void gemm_phase(PG8_LAS unsigned char* lds, const int K, const Sched& S, const Epi& E, const int tid) {
    const int wid = __builtin_amdgcn_readfirstlane(tid >> 6), lane = tid & 63, wr = wid >> 2, wc = wid & 3, fr = lane & 15, fq = lane >> 4;
    unsigned voffB[2], voffA[2];
    const unsigned lda = (unsigned)S.lda;
#pragma unroll
    for (int i = 0; i < 2; ++i) { int R, C; stage_rc(tid * 16 + i * 8192, R, C); const int Rb = Epi::PERM ? ((R & ~31) + perm32(R & 31)) : R;
        const int Ra = Epi::RPERM ? ((R & ~63) + 4 * (R & 15) + ((R >> 4) & 3)) : R;
        voffB[i] = (unsigned)(Rb * K + C) * 2u; voffA[i] = ((unsigned)Ra * lda + (unsigned)C) * 2u; }
    const char* const Ab = (const char*)S.A;
    const size_t kstep = (size_t)(BK * 2);
    const size_t hstep = (size_t)HALF * K * 2;
    const size_t hstepA = (size_t)HALF * lda * 2;
    const unsigned ldsw = (unsigned)wid * 1024u;
    const int aoff = lds_byte(wr * 64 + fr, fq * 8), boff = lds_byte(wc * 32 + fr, fq * 8);
#define PG8_SA(b, h) (((b) * 2 + (h)) * HTB)
#define PG8_SB(b, h) ((4 + (b) * 2 + (h)) * HTB)
#define PG8_STAGE(bufoff, gbase, voff) do { _Pragma("unroll") for (int _i = 0; _i < 2; ++_i) \
        __builtin_amdgcn_global_load_lds((const unsigned*)((const char*)(gbase) + (voff)[_i]), (PG8_LAS unsigned*)(lds + (bufoff) + ldsw + _i * 8192), 16, 0, 0); } while (0)
#define PG8_LDA(dst, b, h) do { _Pragma("unroll") for (int m = 0; m < 4; ++m) _Pragma("unroll") for (int k = 0; k < 2; ++k) dst[m][k] = *(const PG8_LAS bf16x8*)(lds + PG8_SA(b, h) + aoff + m * 2048 + k * 1024); } while (0)
#define PG8_LDB(dst, b, h) do { _Pragma("unroll") for (int n = 0; n < 2; ++n) _Pragma("unroll") for (int k = 0; k < 2; ++k) dst[n][k] = *(const PG8_LAS bf16x8*)(lds + PG8_SB(b, h) + boff + n * 2048 + k * 1024); } while (0)
#define PG8_MMA(ai, bj, At, Bt) do { __builtin_amdgcn_s_setprio(1); _Pragma("unroll") for (int m = 0; m < 4; ++m) _Pragma("unroll") for (int n = 0; n < 2; ++n) _Pragma("unroll") for (int k = 0; k < 2; ++k) \
        acc[ai][bj][m][n] = __builtin_amdgcn_mfma_f32_16x16x32_bf16(Bt[n][k], At[m][k], acc[ai][bj][m][n], 0, 0, 0); __builtin_amdgcn_s_setprio(0); } while (0)
#define PG8_WAIT_V(n) asm volatile("s_waitcnt vmcnt(" #n ")" ::: "memory")
#define PG8_WAIT_L(n) asm volatile("s_waitcnt lgkmcnt(" #n ")" ::: "memory")
#define PG8_BAR __builtin_amdgcn_s_barrier()
#define PG8_SCHED __builtin_amdgcn_sched_barrier(0)
    Unit cur, nxt; int ui = 0;
    if (!S.next(0, cur)) return;
    f32x4 acc[2][2][4][2];
    bf16x8 At[4][2], B0[2][2], B1[2][2];
    constexpr bool GATHER = Sched::GATHER;
    const char* cA = Ab; const char* nA = Ab;
    unsigned ga0[2] = {0u, 0u}, ga1[2] = {0u, 0u};
    PG8_LAS u32x4* const gnslot = (PG8_LAS u32x4*)(lds + GN_LDS_OFF) + tid;
    if constexpr (GATHER) {
#pragma unroll
        for (int i = 0; i < 2; ++i) { int R, C; stage_rc(tid * 16 + i * 8192, R, C); ga0[i] = (S.a_row(cur, R) * lda + (unsigned)C) * 2u; ga1[i] = (S.a_row(cur, HALF + R) * lda + (unsigned)C) * 2u; }
    } else { cA = Ab + (size_t)S.a_row(cur, 0) * lda * 2 + (size_t)S.k0(cur) * (BK * 2); }
    const char* cB = S.b_base(cur) + (size_t)S.k0(cur) * (BK * 2);
    int nt = S.nt(cur), ntn = nt;
#define PG8_STAGE_A(bufoff, h, uptr, kb, g0, g1) do { if constexpr (GATHER) { if (h) PG8_STAGE(bufoff, Ab + (kb), g1); else PG8_STAGE(bufoff, Ab + (kb), g0); } \
        else { PG8_STAGE(bufoff, (uptr) + (h) * hstepA + (kb), voffA); } } while (0)
    static_assert(SP2, "only the SP2 loop is carried here");
    PG8_STAGE(PG8_SB(0, 0), cB, voffB); PG8_STAGE(PG8_SB(0, 1), cB + hstep, voffB); PG8_STAGE_A(PG8_SA(0, 0), 0, cA, 0, ga0, ga1); PG8_STAGE_A(PG8_SA(0, 1), 1, cA, 0, ga0, ga1);
    if (wr == 1) PG8_BAR;
    PG8_WAIT_V(2); PG8_BAR;
    PG8_STAGE(PG8_SB(1, 0), cB + kstep, voffB); PG8_STAGE_A(PG8_SA(1, 0), 0, cA, kstep, ga0, ga1); PG8_STAGE(PG8_SB(1, 1), cB + hstep + kstep, voffB);
    PG8_WAIT_V(6); PG8_BAR;
    for (;;) {
        const bool has_next = S.next(ui + 1, nxt);
        const char* nB = has_next ? S.b_base(nxt) + (size_t)S.k0(nxt) * (BK * 2) : cB;
        ntn = has_next ? S.nt(nxt) : nt;
        if constexpr (GATHER) {
            u32x4 gn = (u32x4){ga0[0], ga0[1], ga1[0], ga1[1]};
            if (has_next) { int R0, C0, R1, C1; stage_rc(tid * 16, R0, C0); stage_rc(tid * 16 + 8192, R1, C1);
                gn.x = (S.a_row(nxt, R0) * lda + (unsigned)C0) * 2u; gn.y = (S.a_row(nxt, R1) * lda + (unsigned)C1) * 2u;
                gn.z = (S.a_row(nxt, HALF + R0) * lda + (unsigned)C0) * 2u; gn.w = (S.a_row(nxt, HALF + R1) * lda + (unsigned)C1) * 2u; }
            *gnslot = gn;
        } else { nA = has_next ? Ab + (size_t)S.a_row(nxt, 0) * lda * 2 + (size_t)S.k0(nxt) * (BK * 2) : cA; }
#pragma unroll
        for (int a = 0; a < 2; ++a)
#pragma unroll
            for (int b = 0; b < 2; ++b)
#pragma unroll
                for (int m = 0; m < 4; ++m)
#pragma unroll
                    for (int n = 0; n < 2; ++n) acc[a][b][m][n] = (f32x4){0.f, 0.f, 0.f, 0.f};
#pragma nounroll
        for (int t = 0; t < nt; t += 2) {
            const bool last = (t == nt - 2);
            const size_t k1 = (size_t)(t + 1) * kstep, k2 = last ? 0 : (size_t)(t + 2) * kstep, k3 = k2 + kstep;
            const char* u2 = last ? nA : cA;
            const char* b2 = last ? nB : cB + (size_t)(t + 2) * kstep; const char* b3 = b2 + kstep;
            unsigned o20[2] = {0u, 0u}, o21[2] = {0u, 0u};
            if constexpr (GATHER) {
                if (last) { const u32x4 gn = *gnslot; o20[0] = gn.x; o20[1] = gn.y; o21[0] = gn.z; o21[1] = gn.w; }
                else { o20[0] = ga0[0]; o20[1] = ga0[1]; o21[0] = ga1[0]; o21[1] = ga1[1]; }
            }
            PG8_LDB(B0, 0, 0); PG8_LDB(B1, 0, 1); PG8_SCHED; PG8_LDA(At, 0, 0); PG8_STAGE_A(PG8_SA(1, 1), 1, cA, k1, ga0, ga1);
            PG8_WAIT_V(8); PG8_WAIT_L(0); PG8_BAR; PG8_MMA(0, 0, At, B0); PG8_MMA(0, 1, At, B1); PG8_BAR; PG8_SCHED;
            PG8_LDA(At, 0, 1); PG8_STAGE(PG8_SB(0, 0), b2, voffB); PG8_STAGE(PG8_SB(0, 1), b2 + hstep, voffB); PG8_STAGE_A(PG8_SA(0, 0), 0, u2, k2, o20, o21);
            PG8_WAIT_V(8); PG8_WAIT_L(0); PG8_BAR; PG8_MMA(1, 0, At, B0); PG8_MMA(1, 1, At, B1); PG8_BAR; PG8_SCHED;
            PG8_LDB(B0, 1, 0); PG8_LDB(B1, 1, 1); PG8_SCHED; PG8_LDA(At, 1, 0); PG8_STAGE_A(PG8_SA(0, 1), 1, u2, k2, o20, o21);
            PG8_WAIT_V(8); PG8_WAIT_L(0); PG8_BAR; PG8_MMA(0, 0, At, B0); PG8_MMA(0, 1, At, B1); PG8_BAR; PG8_SCHED;
            PG8_LDA(At, 1, 1); PG8_STAGE(PG8_SB(1, 0), b3, voffB); PG8_STAGE(PG8_SB(1, 1), b3 + hstep, voffB); PG8_STAGE_A(PG8_SA(1, 0), 0, u2, k3, o20, o21);
            PG8_WAIT_V(8); PG8_WAIT_L(0); PG8_BAR; PG8_MMA(1, 0, At, B0); PG8_MMA(1, 1, At, B1); PG8_BAR; PG8_SCHED;
        }
        if constexpr (ALIGN_EPI) { if (wr == 0) PG8_BAR; }
        { int fr_ = fr, fq_ = fq, wr_ = wr, wc_ = wc; asm volatile("" : "+v"(fr_), "+v"(fq_), "+s"(wr_), "+s"(wc_));
          E(acc, cur, wr_, wc_, fr_, fq_); }
        if (!has_next) break;
        cur = nxt; cB = nB; cA = nA; nt = ntn; ++ui;
        if constexpr (GATHER) { const u32x4 gn = *gnslot; ga0[0] = gn.x; ga0[1] = gn.y; ga1[0] = gn.z; ga1[1] = gn.w; }
        if constexpr (ALIGN_EPI) { if (wr == 1) PG8_BAR; }
    }
    PG8_WAIT_V(0);
    if constexpr (!ALIGN_EPI) { if (wr == 0) PG8_BAR; }
    PG8_BAR;
#undef PG8_SA
#undef PG8_SB
#undef PG8_STAGE
#undef PG8_STAGE_A
#undef PG8_LDA
#undef PG8_LDB
#undef PG8_MMA
#undef PG8_WAIT_V
#undef PG8_WAIT_L
#undef PG8_BAR
#undef PG8_SCHED
}
}

constexpr size_t MiB = 1u << 20;
constexpr size_t WS_CTL = 0, CTL_ZERO_BYTES = 1 * MiB;
constexpr size_t WS_MOD = 1 * MiB;
constexpr size_t WS_ROPE = 2 * MiB;
constexpr size_t WS_ROUTE = 3 * MiB;
constexpr size_t WS_LIST = 4 * MiB;
constexpr size_t WS_ROWST = 6 * MiB;
constexpr size_t WS_HC = 8 * MiB;
constexpr size_t WS_W = 16 * MiB;
constexpr size_t WS_DFT = 114 * MiB;
constexpr size_t WS_DFTC = WS_DFT + 64 * MiB;
constexpr size_t WS_SCR = 180 * MiB;
constexpr size_t WS_ACT = WS_SCR;
constexpr size_t WS_PX = WS_SCR + 68 * MiB;
constexpr size_t WS_GT = WS_SCR + 102 * MiB;
constexpr size_t WS_GTC = WS_SCR + 134 * MiB;
constexpr size_t WS_K = WS_SCR + 136 * MiB;
constexpr size_t WS_VT = WS_SCR + 213 * MiB;
constexpr size_t WS_HMID = WS_SCR + 68 * MiB;
constexpr size_t WS_QN = WS_SCR + 68 * MiB;
constexpr size_t WS_KN = WS_SCR + 136 * MiB;
constexpr size_t WS_VTN = WS_SCR + 204 * MiB;
constexpr size_t WS_HMOE = WS_SCR + 68 * MiB;
constexpr size_t WS_Y = WS_SCR + 261 * MiB;
constexpr size_t WS_GF = WS_SCR + 304 * MiB;
constexpr size_t WS_PART = WS_SCR + 272 * MiB;
constexpr size_t WS_END = WS_SCR + 401 * MiB;
static_assert((size_t)NTOK * 1024 * 2 <= 68 * MiB && (size_t)NTOK * 512 * 2 <= 34 * MiB && (size_t)NB * A_HEADS * KPOS * 96 * 2 <= 77 * MiB && (size_t)NB * A_HEADS * 64 * KPOS * 2 <= 51 * MiB, "even map");
static_assert((size_t)NTOK * DFF * 2 <= 196 * MiB && (size_t)NB * C_HEADS * 64 * KPOS * 2 <= 68 * MiB + 4 * MiB && (size_t)MOE_SLOTS * DFFE * 2 <= 193 * MiB && (size_t)MOE_SLOTS * 1024 * 2 <= 140 * MiB, "odd map");
constexpr size_t WO_WIN_E = 0, WO_WUKV = 2 * MiB, WO_WUQ = 3 * MiB, WO_WOUT_E = 4 * MiB, WO_WGU_E = 6 * MiB, WO_WDN_E = 17 * MiB;
constexpr size_t WO_WIN_O = 23 * MiB, WO_WOUT_O = 29 * MiB, WO_WGU_M = 31 * MiB, WO_WDN_M = 75 * MiB;
constexpr int CW_BAR = 4096;
constexpr int CW_MOECNT = 8192;
constexpr int CW_ATTQ = 8192 + 256;
constexpr int CW_CHK = 16384;

constexpr int RING_OFF = 0, RING_BYTES = 131072;
constexpr int LDS_BYTES = 163840;
constexpr int LDSCTL_OFF = LDS_BYTES - 1024, MISC_OFF = LDSCTL_OFF + 320;
constexpr int MOE_LDS_OFF = MISC_OFF + 128;
static_assert(MOE_LDS_OFF + 128 <= LDS_BYTES && pg8::GN_LDS_OFF == RING_BYTES && pg8::GN_LDS_OFF + 512 * 16 <= LDSCTL_OFF, "LDS map");
constexpr int NWAVES = 8;

#define CAS __attribute__((address_space(4)))
typedef GAS unsigned gu32;
#define RLX_AGENT __ATOMIC_RELAXED, __HIP_MEMORY_SCOPE_AGENT
#define LDS_WAIT() asm volatile("s_waitcnt lgkmcnt(0)" ::: "memory")
#define VM_WAIT() asm volatile("s_waitcnt vmcnt(0)" ::: "memory")

#define XB_TMO      128
#define XB_XCNT(j)  (256  + 64 * (j))
#define XB_XSUB(j)  (1280 + 64 * (j))
#define XB_XGEN(j)  (2304 + 64 * (j))
#define XB_TOP      3328
#define XB_TOPGEN   3392
#define XCD_BAR_WORDS 3456
#define XB_SPIN_CAP (1u << 18)

__device__ __forceinline__ unsigned xb_ld(GAS unsigned* p)              { return __hip_atomic_load(p, __ATOMIC_RELAXED, __HIP_MEMORY_SCOPE_AGENT); }
__device__ __forceinline__ unsigned xb_add(GAS unsigned* p, unsigned v) { return __hip_atomic_fetch_add(p, v, __ATOMIC_RELAXED, __HIP_MEMORY_SCOPE_AGENT); }
__device__ __forceinline__ unsigned xb_xcc_id() { return (unsigned)__builtin_amdgcn_s_getreg((3 << 11) | 20) & 0xFu; }
#define XB_SPIN(cond, bar) do { unsigned _sp = 0; while (cond) { __builtin_amdgcn_s_sleep(1); \
    if ((++_sp & 255u) == 0u) { if (xb_ld(&(bar)[XB_TMO])) break; if (_sp > XB_SPIN_CAP) { (void)xb_add(&(bar)[XB_TMO], 1u); break; } } } } while (0)

struct XcdBarrier {
    GAS unsigned* bar; unsigned x;
    volatile LAS unsigned* st;
};
__device__ __forceinline__ XcdBarrier xcd_barrier_post(GAS unsigned* bar, volatile LAS unsigned* st) {
    XcdBarrier b; b.bar = bar; b.x = xb_xcc_id(); b.st = st;
    if (threadIdx.x == 0) (void)xb_add(&bar[XB_XCNT(b.x)], 1u);
    return b;
}
__device__ __forceinline__ void xcd_barrier_complete(GAS unsigned* bar, unsigned x, unsigned& nloc, unsigned& nx) {
    const unsigned G = gridDim.x * gridDim.y * gridDim.z;
    unsigned sum, cnt, mine, sp = 0u;
    for (;;) {
        sum = 0u; cnt = 0u; mine = 0u;
#pragma unroll
        for (unsigned j = 0; j < 16; ++j) { const unsigned c = xb_ld(&bar[XB_XCNT(j)]); sum += c; cnt += (c > 0u) ? 1u : 0u; mine = (j == x) ? c : mine; }
        if (sum == G) break;
        __builtin_amdgcn_s_sleep(1);
        if ((++sp & 255u) == 0u) { if (xb_ld(&bar[XB_TMO])) break; if (sp > XB_SPIN_CAP) { (void)xb_add(&bar[XB_TMO], 1u); break; } }
    }
    nloc = mine > 0u ? mine : 1u; nx = cnt > 0u ? cnt : 1u;
}
__device__ __forceinline__ void xcd_barrier(const XcdBarrier& b) {
    asm volatile("s_waitcnt vmcnt(0)" ::: "memory");
    __syncthreads();
    if (threadIdx.x == 0) {
        GAS unsigned* bar = b.bar;
        __builtin_amdgcn_s_waitcnt(0);
        unsigned nloc = b.st[0], nx = b.st[1];
        if (nloc == 0u) { xcd_barrier_complete(bar, b.x, nloc, nx); b.st[0] = nloc; b.st[1] = nx; }
        const unsigned old = xb_add(&bar[XB_XSUB(b.x)], 1u);
        const unsigned gen = old / nloc;
        if (old + 1u == (gen + 1u) * nloc) {
            __builtin_amdgcn_fence(__ATOMIC_RELEASE, "agent");
            asm volatile("s_waitcnt vmcnt(0)" ::: "memory");
            const unsigned og = xb_add(&bar[XB_TOP], 1u);
            const unsigned tg = og / nx;
            if (og + 1u == (tg + 1u) * nx) xb_add(&bar[XB_TOPGEN], 1u);
            else XB_SPIN(xb_ld(&bar[XB_TOPGEN]) == tg, bar);
            __builtin_amdgcn_fence(__ATOMIC_ACQUIRE, "agent");
            xb_add(&bar[XB_XGEN(b.x)], 1u);
            asm volatile("s_waitcnt vmcnt(0)" ::: "memory");
        } else {
            XB_SPIN(xb_ld(&bar[XB_XGEN(b.x)]) == gen, bar);
            __builtin_amdgcn_fence(__ATOMIC_ACQUIRE, "agent");
            asm volatile("s_waitcnt vmcnt(0)" ::: "memory");
        }
    }
    __syncthreads();
}

struct Inputs {
    const float *x, *c, *ctx, *c_ctx, *w_mod, *b_mod, *norm_g;
    const float *a_w_in, *a_g_cq, *a_g_ckv, *a_w_uq, *a_w_ukv, *a_g_q, *a_g_k, *a_w_out;
    const float *f_w_gate, *f_w_up, *f_w_down;
    const float *c_w_in, *c_g_q, *c_g_k, *c_rpb, *c_w_out;
    const float *m_w_router, *m_w_gate, *m_w_up, *m_w_down;
};
template <class T> __device__ __forceinline__ T* G(T* p) { GAS T* g = (GAS T*)p; asm volatile("" : "+s"(g)); return (T*)g; }
struct Frame {
    LAS unsigned char* lds;
    volatile LAS unsigned* MISC;
    gu32* ctl;
    GAS unsigned char* ws_;
    GAS float* out_;
    GAS float* hc_;
    __device__ __forceinline__ unsigned char* WS() const { return (unsigned char*)ws_; }
    __device__ __forceinline__ float* OUT() const { return (float*)out_; }
    __device__ __forceinline__ float* HC() const { return (float*)hc_; }
    int tid, lane, wave, G, bid;
    const CAS Inputs* in;
};
__device__ __forceinline__ float* hrow(const Frame& F, int r) { return r < NLAT ? F.OUT() + (size_t)r * DM : F.HC() + (size_t)(r - NLAT) * DM; }
__device__ __forceinline__ int row_b9(int r) { return r < NLAT ? (r >> 12) : 8; }
__device__ __forceinline__ const float* modp(const Frame& F, int layer, int b9, int k) { return (const float*)(F.WS() + WS_MOD) + ((size_t)layer * 9 + b9) * 6144 + k * 1024; }

__device__ __forceinline__ void swap32(unsigned& a, unsigned& b) { const auto r = __builtin_amdgcn_permlane32_swap(a, b, false, false); a = r[0]; b = r[1]; }
__device__ __forceinline__ void swap16(unsigned& a, unsigned& b) { const auto r = __builtin_amdgcn_permlane16_swap(a, b, false, false); a = r[0]; b = r[1]; }
template <int CTRL> __device__ __forceinline__ float dppf(float v) { return __builtin_bit_cast(float, __builtin_amdgcn_update_dpp(0, __builtin_bit_cast(int, v), CTRL, 0xF, 0xF, true)); }
__device__ __forceinline__ float wave_sum(float v) {
    v += dppf<0xB1>(v); v += dppf<0x4E>(v); v += dppf<0x141>(v); v += dppf<0x140>(v);
    unsigned a = __builtin_bit_cast(unsigned, v), b = a; asm volatile("" : "+v"(b)); swap16(a, b); v = __builtin_bit_cast(float, a) + __builtin_bit_cast(float, b);
    a = __builtin_bit_cast(unsigned, v); b = a; asm volatile("" : "+v"(b)); swap32(a, b); v = __builtin_bit_cast(float, a) + __builtin_bit_cast(float, b);
    return v;
}

struct WMap { int which; int col; };
__device__ __forceinline__ WMap wmap(int mode, int n, int nsrc) {
    WMap r; r.which = 0;
    const int pn = n >> 8, ct = n & 255, bj = ct >> 7, wc = (ct >> 5) & 3, w = ct & 31;
    if (mode == 0) { r.col = n < nsrc ? n : -1; }
    else if (mode == 1) { const int head = 2 * pn + (wc >> 1), part = wc & 1; r.col = head * 128 + part * 64 + 32 * bj + w; }
    else if (mode == 2) { const int nn = (ct >> 4) & 1, fq = (ct >> 2) & 3, e = ct & 3; r.which = nn; r.col = pn * 128 + bj * 64 + wc * 16 + fq * 4 + e; }
    else { r.col = (pn * 4 + wc) * 64 + 32 * bj + w; }
    return r;
}
__device__ __forceinline__ void wconv_item(const float* W0, const float* W1, int ld, int Ksrc, int nsrc, const float* kscale, bf16* WT, int Kdst, int mode, int kb, int nb, LAS float* scr, int lane) {
    const int k0 = 64 * kb, n0 = 64 * nb, n4 = (lane & 15) * 4;
    const WMap mp = wmap(mode, n0 + n4, nsrc);
    const float* W = mp.which ? W1 : W0;
#pragma unroll 4
    for (int i = 0; i < 16; ++i) { const int kk = (lane >> 4) + 4 * i, k = k0 + kk; f32x4 v = (f32x4){0.f, 0.f, 0.f, 0.f};
        if (mp.col >= 0 && k < Ksrc) { v = *(const f32x4*)(W + (size_t)k * ld + mp.col); if (kscale) v = v * kscale[k]; }
        LAS float* d = scr + kk * 65 + n4; d[0] = v.x; d[1] = v.y; d[2] = v.z; d[3] = v.w; }
    LDS_WAIT(); asm volatile("" ::: "memory");
#pragma unroll
    for (int c = 0; c < 8; ++c) { const LAS float* s = scr + (8 * c) * 65 + lane;
        u32x4 o; o.x = pk2(s[0 * 65], s[1 * 65]); o.y = pk2(s[2 * 65], s[3 * 65]); o.z = pk2(s[4 * 65], s[5 * 65]); o.w = pk2(s[6 * 65], s[7 * 65]);
        *(GAS u32x4*)(WT + (size_t)(n0 + lane) * Kdst + k0 + 8 * c) = o; }
    LDS_WAIT(); asm volatile("" ::: "memory");
}
struct WJob { const float* W0; const float* W1; int ld, Ksrc, nsrc; const float* kscale; bf16* WT; int Kdst, Ndst, mode; };
__device__ __forceinline__ bool wjob_run(const WJob& J, int& r, LAS float* scr, int lane) {
    const int nblk = J.Ndst / 64, items = (J.Kdst / 64) * nblk;
    if (r < items) { wconv_item(J.W0, J.W1, J.ld, J.Ksrc, J.nsrc, J.kscale, J.WT, J.Kdst, J.mode, r / nblk, r % nblk, scr, lane); return true; }
    r -= items; return false;
}

__device__ __forceinline__ void prep_phase(Frame& F, int j) {
    const CAS Inputs& I = *F.in;
    unsigned char* W = F.WS() + WS_W;
    if (j == 0) {
        LAS float* sv = (LAS float*)(F.lds);
        LAS float* red = (LAS float*)(F.lds + 40960);
        for (int idx = F.tid; idx < 9 * 1024; idx += NWAVES * 64) { const int r = idx >> 10, k = idx & 1023; const float cv = r < 8 ? G(I.c)[r * 1024 + k] : G(I.c_ctx)[k]; sv[idx] = cv / (1.f + __expf(-cv)); }
        __syncthreads();
        for (int it = F.bid; it < 4 * 96; it += F.G) {
            const int layer = it / 96, chunk = it % 96, n = chunk * 64 + F.lane;
            const float* wm = G(I.w_mod) + (size_t)layer * 1024 * 6144 + n;
            float acc[9];
#pragma unroll
            for (int r = 0; r < 9; ++r) acc[r] = 0.f;
            const int kb = F.wave * 128;
#pragma unroll 4
            for (int k = 0; k < 128; ++k) { const float wv = wm[(size_t)(kb + k) * 6144];
#pragma unroll
                for (int r = 0; r < 9; ++r) acc[r] += sv[r * 1024 + kb + k] * wv; }
#pragma unroll
            for (int r = 0; r < 9; ++r) red[(F.wave * 9 + r) * 64 + F.lane] = acc[r];
            __syncthreads();
            for (int idx = F.tid; idx < 9 * 64; idx += NWAVES * 64) { const int r = idx >> 6, l = idx & 63; float s = 0.f;
#pragma unroll
                for (int w = 0; w < 8; ++w) s += red[(w * 9 + r) * 64 + l];
                const int nn = chunk * 64 + l;
                ((float*)(F.WS() + WS_MOD))[((size_t)layer * 9 + r) * 6144 + nn] = s + G(I.b_mod)[layer * 6144 + nn]; }
            __syncthreads();
        }
        if (F.bid == 0) { const int pos = F.tid >> 3, f = F.tid & 7; const float inv = powf(10000.f, -(float)f / 8.f); const float ang = (float)pos * inv;
            ((f32x2*)(F.WS() + WS_ROPE))[F.tid] = (f32x2){cosf(ang), sinf(ang)}; }
        __syncthreads();
        LAS f32x2* tab = (LAS f32x2*)(F.lds);
        for (int m = F.tid; m < 4096; m += NWAVES * 64) { float s, c; sincospif((float)m * (1.f / 2048.f), &s, &c); tab[m] = (f32x2){c, s}; }
        __syncthreads();
        bf16* DF = (bf16*)(F.WS() + WS_DFT);
        for (int q = F.bid * (NWAVES * 64) + F.tid; q < 4096 * 512; q += F.G * NWAVES * 64) {
            const int np = q >> 9, kk0 = (q & 511) * 8, type = kk0 >= 2048, n = kk0 & 2047; float v[8];
#pragma unroll
            for (int e = 0; e < 8; ++e) { const int nn = n + e; const f32x2 t = tab[(np * ((type && nn == 0) ? 2048 : nn)) & 4095]; v[e] = ((type && nn != 0) ? -t.y : t.x) * (1.f / 512.f); }
            u32x4 o; o.x = pk2(v[0], v[1]); o.y = pk2(v[2], v[3]); o.z = pk2(v[4], v[5]); o.w = pk2(v[6], v[7]);
            *(GAS u32x4*)(DF + (size_t)np * 4096 + kk0) = o;
        }
        bf16* DC = (bf16*)(F.WS() + WS_DFTC);
        for (int q = F.bid * (NWAVES * 64) + F.tid; q < 256 * 64; q += F.G * NWAVES * 64) {
            const int np = q >> 6, kk0 = (q & 63) * 8, type = kk0 >= 256, n = kk0 & 255; float v[8];
#pragma unroll
            for (int e = 0; e < 8; ++e) { const f32x2 t = tab[((np * (n + e)) & 255) * 16]; v[e] = (type ? -t.y : t.x) * (1.f / 128.f); }
            u32x4 o; o.x = pk2(v[0], v[1]); o.y = pk2(v[2], v[3]); o.z = pk2(v[4], v[5]); o.w = pk2(v[6], v[7]);
            *(GAS u32x4*)(DC + (size_t)np * 512 + kk0) = o;
        }
        __syncthreads();
    }
    {
        LAS float* scr = (LAS float*)(F.lds + F.wave * 16896);
        const int gw = F.bid * NWAVES + F.wave, NGW = F.G * NWAVES;
        const float* a_w_in = G(I.a_w_in) + (size_t)j * 1024 * 672;
        WJob J0{a_w_in, a_w_in, 672, 1024, 416, nullptr, (bf16*)(W + WO_WIN_E), 1024, 512, 0};
        WJob J2{G(I.a_w_ukv) + (size_t)j * 128 * 1536, nullptr, 1536, 128, 1536, G(I.a_g_ckv) + j * 128, (bf16*)(W + WO_WUKV), 256, 1536, 1};
        WJob J3{G(I.a_w_uq) + (size_t)j * 256 * 1152, nullptr, 1152, 256, 1152, G(I.a_g_cq) + j * 256, (bf16*)(W + WO_WUQ), 256, 1152, 0};
        WJob J4{G(I.a_w_out) + (size_t)j * 1024 * 1024, nullptr, 1024, 1024, 1024, nullptr, (bf16*)(W + WO_WOUT_E), 1024, 1024, 0};
        WJob J5{G(I.f_w_gate) + (size_t)j * 1024 * DFF, G(I.f_w_up) + (size_t)j * 1024 * DFF, DFF, 1024, DFF, nullptr, (bf16*)(W + WO_WGU_E), 1024, 2 * DFF, 2};
        WJob J6{G(I.f_w_down) + (size_t)j * DFF * 1024, nullptr, 1024, DFF, 1024, nullptr, (bf16*)(W + WO_WDN_E), DFF, 1024, 0};
        WJob J7{G(I.c_w_in) + (size_t)j * 1024 * 3072, nullptr, 3072, 1024, 3072, nullptr, (bf16*)(W + WO_WIN_O), 1024, 3072, 3};
        WJob J8{G(I.c_w_out) + (size_t)j * 1024 * 1024, nullptr, 1024, 1024, 1024, nullptr, (bf16*)(W + WO_WOUT_O), 1024, 1024, 0};
        constexpr int IT_GU = (1024 / 64) * (2 * DFFE / 64), IT_DN = (DFFE / 64) * (1024 / 64);
        const int fixed = 16 * 8 + 4 * 24 + 4 * 18 + 16 * 16 + 16 * 88 + 44 * 16 + 16 * 48 + 16 * 16;
        const int total = fixed + NEXP * (IT_GU + IT_DN);
        for (int it = gw; it < total; it += NGW) {
            int r = it;
            if (wjob_run(J0, r, scr, F.lane)) continue;
            if (wjob_run(J2, r, scr, F.lane)) continue;
            if (wjob_run(J3, r, scr, F.lane)) continue;
            if (wjob_run(J4, r, scr, F.lane)) continue;
            if (wjob_run(J5, r, scr, F.lane)) continue;
            if (wjob_run(J6, r, scr, F.lane)) continue;
            if (wjob_run(J7, r, scr, F.lane)) continue;
            if (wjob_run(J8, r, scr, F.lane)) continue;
            if (r < NEXP * IT_GU) { const int e = r / IT_GU, rr = r % IT_GU; const size_t eo = ((size_t)j * NEXP + e) * 1024 * DFFE;
                wconv_item(G(I.m_w_gate) + eo, G(I.m_w_up) + eo, DFFE, 1024, DFFE, nullptr, (bf16*)(W + WO_WGU_M) + (size_t)e * 2 * DFFE * 1024, 1024, 2, rr / (2 * DFFE / 64), rr % (2 * DFFE / 64), scr, F.lane); continue; }
            r -= NEXP * IT_GU;
            { const int e = r / IT_DN, rr = r % IT_DN; const size_t eo = ((size_t)j * NEXP + e) * DFFE * 1024;
                wconv_item(G(I.m_w_down) + eo, nullptr, 1024, DFFE, 1024, nullptr, (bf16*)(W + WO_WDN_M) + (size_t)e * 1024 * DFFE, DFFE, 0, rr / 16, rr % 16, scr, F.lane); }
        }
        __syncthreads();
        LAS f32x2* t64 = (LAS f32x2*)(F.lds);
        if (F.tid < 64) { float s, c; sincospif((float)F.tid * (1.f / 32.f), &s, &c); t64[F.tid] = (f32x2){c, s}; }
        __syncthreads();
        bf16* WE = (bf16*)(W + WO_WIN_E);
        for (int it = gw; it < 1024 * 4; it += NGW) {
            const int k = it >> 2, g = it & 3;
            const float f = a_w_in[(size_t)k * 672 + 416 + 64 * g + F.lane];
            float ac = 0.f, as = 0.f;
#pragma unroll 8
            for (int c = 0; c < 64; ++c) { const float fc = __shfl(f, c); const f32x2 t = t64[(c * F.lane) & 63]; ac += fc * t.x; as += fc * t.y; }
            WE[(size_t)(512 + g * 64 + F.lane) * 1024 + k] = (bf16)f2bf(ac);
            WE[(size_t)(768 + g * 64 + F.lane) * 1024 + k] = (bf16)f2bf(as);
        }
        __syncthreads();
    }
}

__device__ __forceinline__ void moe_panels_to_lds(Frame& F, int pair) {
    volatile LAS int* MOE = (volatile LAS int*)(F.lds + MOE_LDS_OFF);
    if (F.tid == 0) { int p = 0;
        for (int e = 0; e < NEXP; ++e) { const int c = (int)__hip_atomic_load(F.ctl + CW_MOECNT + 64 * pair + e, RLX_AGENT); MOE[e] = p; MOE[16 + e] = c; p += (c + 255) >> 8; }
        MOE[8] = p; }
    __syncthreads();
}
struct NormArgs { int layer, which, from_inputs, combine_pair, router_pair, lat_only, add_part; };
__device__ __forceinline__ void norm_phase(Frame& F, const NormArgs a) {
    const CAS Inputs& I = *F.in;
    volatile LAS int* MOE = (volatile LAS int*)(F.lds + MOE_LDS_OFF);
    LAS float* wr = (LAS float*)(F.lds);
    volatile LAS int* lcnt = (volatile LAS int*)(F.lds + 32768);
    volatile LAS int* stash = (volatile LAS int*)(F.lds + 32768 + 256);
    if (a.combine_pair >= 0) moe_panels_to_lds(F, a.combine_pair);
    if (a.router_pair >= 0) {
        const float* wsrc = G(I.m_w_router) + (size_t)a.router_pair * 1024 * NEXP;
        for (int idx = F.tid; idx < 1024 * NEXP; idx += NWAVES * 64) wr[(idx & 7) * 1024 + (idx >> 3)] = wsrc[idx];
        if (F.tid < 16) lcnt[F.tid] = 0;
        __syncthreads();
    }
    const int* te = (const int*)(F.WS() + WS_ROUTE); const int* tr = te + 2 * NTOK; const float* tg = (const float*)(tr + 2 * NTOK);
    const bf16* Y = (const bf16*)(F.WS() + WS_Y);
    bf16* XN = (bf16*)(F.WS() + WS_ACT);
    const int nrows = a.lat_only ? NLAT : NTOK;
    const bool final_only = a.lat_only && a.router_pair < 0;
    const int nk = (nrows - F.bid + F.G - 1) / F.G;
    int cb9 = -1; f32x4 gs[4], shv[4], gmv[4];
#pragma unroll
    for (int j = 0; j < 4; ++j) { gs[j] = (f32x4){0.f, 0.f, 0.f, 0.f}; shv[j] = gs[j]; gmv[j] = gs[j]; }
    for (int k = F.wave; k < nk; k += NWAVES) {
        const int row = F.bid + F.G * k;
        const int b9 = row_b9(row);
        if (b9 != cb9) {
            cb9 = b9;
            if (!final_only) {
                const float* gp = G(I.norm_g) + ((size_t)a.layer * 2 + a.which) * DM;
                const float* shp = modp(F, a.layer, b9, a.which ? 3 : 0);
                const float* scp = modp(F, a.layer, b9, a.which ? 4 : 1);
#pragma unroll
                for (int j = 0; j < 4; ++j) { const f32x4 g = ((const f32x4*)gp)[F.lane + 64 * j], sc = ((const f32x4*)scp)[F.lane + 64 * j]; gs[j] = g * (sc + 1.0f); shv[j] = ((const f32x4*)shp)[F.lane + 64 * j]; }
            }
            if (a.combine_pair >= 0) { const float* gm = modp(F, 2 * a.combine_pair + 1, b9, 5);
#pragma unroll
                for (int j = 0; j < 4; ++j) gmv[j] = ((const f32x4*)gm)[F.lane + 64 * j]; }
        }
        float* hp = hrow(F, row);
        const bool from_in = a.from_inputs == 1 || (a.from_inputs == 2 && row >= NLAT);
        const float* src = from_in ? (row < NLAT ? G(I.x) + (size_t)row * DM : G(I.ctx) + (size_t)(row - NLAT) * DM) : hp;
        f32x4 v[4];
#pragma unroll
        for (int j = 0; j < 4; ++j) v[j] = ((const f32x4*)src)[F.lane + 64 * j];
        if (a.combine_pair >= 0) {
            const int e1 = te[2 * row], e2 = te[2 * row + 1], r1 = tr[2 * row], r2 = tr[2 * row + 1];
            const float g1 = tg[2 * row], g2 = tg[2 * row + 1];
            const size_t s1 = (size_t)MOE[e1] * 256 + r1, s2 = (size_t)MOE[e2] * 256 + r2;
#pragma unroll
            for (int j = 0; j < 4; ++j) {
                const u32x2 y1 = *(const u32x2*)(Y + s1 * 1024 + 256 * j + 4 * F.lane), y2 = *(const u32x2*)(Y + s2 * 1024 + 256 * j + 4 * F.lane);
                const f32x4 gg = gmv[j];
                v[j].x += gg.x * (g1 * bflo(y1.x) + g2 * bflo(y2.x)); v[j].y += gg.y * (g1 * bfhi(y1.x) + g2 * bfhi(y2.x));
                v[j].z += gg.z * (g1 * bflo(y1.y) + g2 * bflo(y2.y)); v[j].w += gg.w * (g1 * bfhi(y1.y) + g2 * bfhi(y2.y));
            }
        }
        const bool parts = a.add_part && row >= NLAT;
        if (parts) {
            const float* pp = (const float*)(F.WS() + WS_PART) + (size_t)(row - NLAT) * DM;
#pragma unroll
            for (int q = 0; q < 4; ++q)
#pragma unroll
                for (int j = 0; j < 4; ++j) v[j] = v[j] + ((const f32x4*)(pp + (size_t)q * NCTX * DM))[F.lane + 64 * j];
        }
        if (a.combine_pair >= 0 || parts) {
#pragma unroll
            for (int j = 0; j < 4; ++j) ((f32x4*)hp)[F.lane + 64 * j] = v[j];
        }
        if (final_only) continue;
        float ss = 0.f;
#pragma unroll
        for (int j = 0; j < 4; ++j) ss += (v[j].x * v[j].x + v[j].y * v[j].y) + (v[j].z * v[j].z + v[j].w * v[j].w);
        const float rstd = 1.0f / sqrtf(wave_sum(ss) * (1.f / DM) + EPS);
        f32x4 xn[4];
#pragma unroll
        for (int j = 0; j < 4; ++j) xn[j] = v[j] * rstd * gs[j] + shv[j];
        u32x2* o8 = (u32x2*)(XN + (size_t)row * DM) + F.lane;
#pragma unroll
        for (int j = 0; j < 4; ++j) o8[64 * j] = (u32x2){pk2(xn[j].x, xn[j].y), pk2(xn[j].z, xn[j].w)};
        if (a.router_pair >= 0) {
            float lg[NEXP];
#pragma unroll
            for (int e = 0; e < NEXP; ++e) lg[e] = 0.f;
#pragma unroll
            for (int e = 0; e < NEXP; ++e)
#pragma unroll
                for (int j = 0; j < 4; ++j) { const f32x4 w4 = *(const LAS f32x4*)(wr + e * 1024 + 256 * j + 4 * F.lane);
                    lg[e] += (xn[j].x * w4.x + xn[j].y * w4.y) + (xn[j].z * w4.z + xn[j].w * w4.w); }
#pragma unroll
            for (int e = 0; e < NEXP; ++e) lg[e] = wave_sum(lg[e]);
            int i1 = 0; float v1 = lg[0];
#pragma unroll
            for (int e = 1; e < NEXP; ++e) if (lg[e] > v1) { v1 = lg[e]; i1 = e; }
            int i2 = -1; float v2 = -3.0e38f;
#pragma unroll
            for (int e = 0; e < NEXP; ++e) if (e != i1 && lg[e] > v2) { v2 = lg[e]; i2 = e; }
            const float ga = 1.f / (1.f + __expf(v2 - v1)), gb = 1.f - ga;
            if (F.lane == 0) {
                const int l1 = __hip_atomic_fetch_add((LAS int*)(lcnt + i1), 1, __ATOMIC_RELAXED, __HIP_MEMORY_SCOPE_WORKGROUP);
                const int l2 = __hip_atomic_fetch_add((LAS int*)(lcnt + i2), 1, __ATOMIC_RELAXED, __HIP_MEMORY_SCOPE_WORKGROUP);
                stash[4 * k + 0] = i1; stash[4 * k + 1] = l1; stash[4 * k + 2] = i2; stash[4 * k + 3] = l2;
                float* tgw = (float*)(F.WS() + WS_ROUTE) + 4 * NTOK; tgw[2 * row] = ga; tgw[2 * row + 1] = gb;
            }
        }
    }
    if (a.router_pair >= 0) {
        __syncthreads();
        if (F.tid < NEXP) lcnt[8 + F.tid] = (int)__hip_atomic_fetch_add(F.ctl + CW_MOECNT + 64 * a.router_pair + F.tid, (unsigned)lcnt[F.tid], RLX_AGENT);
        __syncthreads();
        int* tew = (int*)(F.WS() + WS_ROUTE); int* trw = tew + 2 * NTOK; int* list = (int*)(F.WS() + WS_LIST);
        for (int k = F.tid; k < nk; k += NWAVES * 64) {
            const int row = F.bid + F.G * k;
            const int i1 = stash[4 * k + 0], l1 = stash[4 * k + 1], i2 = stash[4 * k + 2], l2 = stash[4 * k + 3];
            const int r1 = lcnt[8 + i1] + l1, r2 = lcnt[8 + i2] + l2;
            tew[2 * row] = i1; tew[2 * row + 1] = i2; trw[2 * row] = r1; trw[2 * row + 1] = r2;
            list[(size_t)i1 * NTOK + r1] = row; list[(size_t)i2 * NTOK + r2] = row;
        }
    }
    __syncthreads();
}

struct SchedStatic {
    static constexpr bool GATHER = false;
    const bf16* A; int lda; const bf16* Bt; int K, nM, nN, G, c;
    __device__ __forceinline__ bool next(int i, pg8::Unit& u) const { return pg8::static_next(i, G, c, nM, nN, u); }
    __device__ __forceinline__ int k0(const pg8::Unit&) const { return 0; }
    __device__ __forceinline__ int nt(const pg8::Unit&) const { return K / 64; }
    __device__ __forceinline__ unsigned a_row(const pg8::Unit& u, int r) const { return (unsigned)(u.pm * 256 + r); }
    __device__ __forceinline__ const char* b_base(const pg8::Unit& u) const { return (const char*)Bt + (size_t)u.pn * 256 * K * 2; }
};
struct SchedResid {
    static constexpr bool GATHER = false;
    const bf16* A; int lda; const bf16* Bt; int K, nctx, G, c;
    __device__ __forceinline__ bool next(int i, pg8::Unit& u) const {
        const int L = i * G + c;
        if (L < 512) return pg8::static_next(i, G, c, 128, 4, u);
        const int r = L - 512; if (r >= nctx * 16) return false;
        u.kq = r & 3; u.pn = (r >> 2) & 3; u.pm = 128 + (r >> 4); return true; }
    __device__ __forceinline__ int nt(const pg8::Unit& u) const { const int n = K / 64; if (u.kq < 0) return n; const int q = (n / 4) & ~1, rem = n - 4 * q; return q + ((u.kq * 2 < rem) ? 2 : 0); }
    __device__ __forceinline__ int k0(const pg8::Unit& u) const { if (u.kq <= 0) return 0; const int n = K / 64, q = (n / 4) & ~1, rem = n - 4 * q; int s = 0; for (int k = 0; k < u.kq; ++k) s += q + ((k * 2 < rem) ? 2 : 0); return s; }
    __device__ __forceinline__ unsigned a_row(const pg8::Unit& u, int r) const { return (unsigned)(u.pm * 256 + r); }
    __device__ __forceinline__ const char* b_base(const pg8::Unit& u) const { return (const char*)Bt + (size_t)u.pn * 256 * K * 2; }
};
struct SchedOne {
    static constexpr bool GATHER = false;
    const bf16* A; int lda; const bf16* Bt; int K, pm, pn, have;
    __device__ __forceinline__ bool next(int i, pg8::Unit& u) const { if (i != 0 || !have) return false; u.pm = pm; u.pn = pn; u.kq = -1; return true; }
    __device__ __forceinline__ int k0(const pg8::Unit&) const { return 0; }
    __device__ __forceinline__ int nt(const pg8::Unit&) const { return K / 64; }
    __device__ __forceinline__ unsigned a_row(const pg8::Unit& u, int r) const { return (unsigned)(u.pm * 256 + r); }
    __device__ __forceinline__ const char* b_base(const pg8::Unit& u) const { return (const char*)Bt + (size_t)u.pn * 256 * K * 2; }
};
template <bool G_> struct SchedMoe {
    static constexpr bool GATHER = G_;
    const bf16* A; int lda; const bf16* Bt; size_t bstride; int K, nN, G, c; const int* list; volatile LAS int* MOE;
    __device__ __forceinline__ bool next(int i, pg8::Unit& u) const { return pg8::static_next(i, G, c, MOE[8], nN, u); }
    __device__ __forceinline__ int k0(const pg8::Unit&) const { return 0; }
    __device__ __forceinline__ int nt(const pg8::Unit&) const { return K / 64; }
    __device__ __forceinline__ int expert(int pm) const { int e = 0;
#pragma unroll
        for (int k = 1; k < NEXP; ++k) e += (pm >= MOE[k]) ? 1 : 0;
        return e; }
    __device__ __forceinline__ unsigned a_row(const pg8::Unit& u, int r) const {
        if (!G_) return (unsigned)(u.pm * 256 + r);
        const int e = expert(u.pm), idx = (u.pm - MOE[e]) * 256 + r;
        return idx < MOE[16 + e] ? (unsigned)list[e * NTOK + idx] : 0u; }
    __device__ __forceinline__ const char* b_base(const pg8::Unit& u) const { return (const char*)Bt + (size_t)expert(u.pm) * bstride + (size_t)u.pn * 256 * K * 2; }
};

typedef const f32x4 (&AccRef)[2][2][4][2];
__device__ __forceinline__ int swap12(int g) { return ((g & 1) << 1) | (g >> 1); }

__device__ __forceinline__ f32x4 tr4(const f32x4 a, int lane) {
    const bool o1 = lane & 1, o2 = lane & 2;
    const float t0 = __shfl_xor(o1 ? a[0] : a[1], 1), t1 = __shfl_xor(o1 ? a[2] : a[3], 1);
    const f32x4 b = o1 ? (f32x4){t0, a[1], t1, a[3]} : (f32x4){a[0], t0, a[2], t1};
    const float u0 = __shfl_xor(o2 ? b[0] : b[2], 2), u1 = __shfl_xor(o2 ? b[1] : b[3], 2);
    return o2 ? (f32x4){u0, u1, b[2], b[3]} : (f32x4){b[0], b[1], u0, u1};
}
__device__ __forceinline__ float sum_fq(float s) {
    unsigned a = __builtin_bit_cast(unsigned, s), b = a; asm volatile("" : "+v"(b)); swap32(a, b); s = __builtin_bit_cast(float, a) + __builtin_bit_cast(float, b);
    a = __builtin_bit_cast(unsigned, s); b = a; asm volatile("" : "+v"(b)); swap16(a, b); return __builtin_bit_cast(float, a) + __builtin_bit_cast(float, b);
}
struct EpiBf16 { static constexpr bool PERM = true, RPERM = false;
    bf16* O; int ldc, mode;
    __device__ __forceinline__ void operator()(AccRef acc, const pg8::Unit& u, int wr, int wc, int fr, int fq) const {
        const int rbase = mode == 0 ? u.pm * 256 : (mode == 1 ? u.pn * 4096 + u.pm * 256 : NLAT + u.pn * 256 + u.pm * 256);
        const int cbase = mode == 0 ? u.pn * 256 : 768;
        const int row0 = rbase + wr * 64 + fr, col0 = cbase + wc * 32 + 8 * fq;
#pragma unroll
        for (int ai = 0; ai < 2; ++ai)
#pragma unroll
            for (int m = 0; m < 4; ++m) { bf16* rowp = O + (size_t)(row0 + ai * 128 + m * 16) * ldc + col0;
#pragma unroll
                for (int bj = 0; bj < 2; ++bj) { const f32x4 v0 = acc[ai][bj][m][0], v1 = acc[ai][bj][m][1];
                    u32x4 w; w.x = cvt_pk_bf16(v0[0], v0[1]); w.y = cvt_pk_bf16(v0[2], v0[3]); w.z = cvt_pk_bf16(v1[0], v1[1]); w.w = cvt_pk_bf16(v1[2], v1[3]);
                    *(u32x4*)(rowp + bj * 128) = w; } }
    }
};
struct EpiWin { static constexpr bool PERM = true, RPERM = true;
    bf16* PX; bf16* GT; bf16* GTC; float* rowst;
    __device__ __forceinline__ void operator()(AccRef acc, const pg8::Unit& u, int wr, int wc, int fr, int fq) const {
        if (u.pn < 2) {
            const int row0 = u.pm * 256 + wr * 64 + 4 * fr, col0 = u.pn * 256 + wc * 32 + 8 * fq;
#pragma unroll
            for (int ai = 0; ai < 2; ++ai)
#pragma unroll
                for (int m = 0; m < 4; ++m) { bf16* rowp = PX + (size_t)(row0 + ai * 128 + m) * 512 + col0;
#pragma unroll
                    for (int bj = 0; bj < 2; ++bj) { const f32x4 v0 = acc[ai][bj][m][0], v1 = acc[ai][bj][m][1];
                        u32x4 w; w.x = cvt_pk_bf16(v0[0], v0[1]); w.y = cvt_pk_bf16(v0[2], v0[3]); w.z = cvt_pk_bf16(v1[0], v1[1]); w.w = cvt_pk_bf16(v1[2], v1[3]);
                        *(u32x4*)(rowp + bj * 128) = w; }
                    if (u.pn == 1) {
                        const f32x4 a0 = acc[ai][0][m][0], a1 = acc[ai][0][m][1], r0 = acc[ai][1][m][0], r1 = acc[ai][1][m][1];
                        float s = (a0[0] * a0[0] + a0[1] * a0[1]) + (a0[2] * a0[2] + a0[3] * a0[3]) + (a1[0] * a1[0] + a1[1] * a1[1]) + (a1[2] * a1[2] + a1[3] * a1[3]);
                        float q = (r0[0] * r0[0] + r0[1] * r0[1]) + (r0[2] * r0[2] + r0[3] * r0[3]) + (r1[0] * r1[0] + r1[1] * r1[1]) + (r1[2] * r1[2] + r1[3] * r1[3]);
                        s = sum_fq(s); q = sum_fq(q);
                        if (fq == 0) { float* st = rowst + (size_t)(row0 + ai * 128 + m) * 8; st[wc] = s; if (wc == 0) st[4] = q; } } }
        } else {
            const int type = u.pn - 2; const bool lat = u.pm < 128;
            const int b = lat ? (u.pm >> 4) : (u.pm - 128);
            bf16* base = lat ? GT + (size_t)b * 256 * 8192 + type * 4096 + (u.pm & 15) * 256 : GTC + (size_t)b * 256 * 512 + type * 256;
            const size_t ldt = lat ? 8192 : 512;
#pragma unroll
            for (int ai = 0; ai < 2; ++ai) { const int lr4 = ai * 128 + wr * 64 + 4 * fr;
#pragma unroll
                for (int bj = 0; bj < 2; ++bj)
#pragma unroll
                    for (int n = 0; n < 2; ++n)
#pragma unroll
                        for (int e2 = 0; e2 < 4; ++e2) { const int jc = 128 * bj + 32 * wc + 8 * fq + 4 * n + e2;
                            *(u32x2*)(base + (size_t)jc * ldt + lr4) = (u32x2){pk2(acc[ai][bj][0][n][e2], acc[ai][bj][1][n][e2]), pk2(acc[ai][bj][2][n][e2], acc[ai][bj][3][n][e2])}; }
            }
        }
    }
};
struct EpiKV { static constexpr bool PERM = false, RPERM = true;
    const bf16* PX; bf16* Kb; bf16* Vt; const LAS float* tl; const float* rowst;
    __device__ __forceinline__ void operator()(AccRef acc, const pg8::Unit& u, int wr, int wc, int fr, int fq) const {
        const int head = 2 * u.pn + (wc >> 1), part = wc & 1;
        const bool lat = u.pm < 128;
        const int b = lat ? (u.pm >> 4) : (u.pm - 128);
        const int pos0 = lat ? (u.pm & 15) * 256 : SEQ;
        const size_t bh = (size_t)b * A_HEADS + head;
        float rkv[8], s5[8]; u32x4 kw[8];
#pragma unroll
        for (int i = 0; i < 8; ++i) {
            const int row = u.pm * 256 + (i >> 2) * 128 + wr * 64 + 4 * fr + (i & 3);
            const f32x4 st4 = *(const f32x4*)(rowst + (size_t)row * 8);
            rkv[i] = __builtin_amdgcn_rsqf(((st4[0] + st4[1]) + (st4[2] + st4[3])) * (1.f / 128.f) + EPS);
            if (part == 0) { s5[i] = rowst[(size_t)row * 8 + 4];
                kw[i] = *(const u32x4*)(PX + (size_t)row * 512 + 384 + 8 * fq); }
            else { s5[i] = 0.f; kw[i] = (u32x4){0u, 0u, 0u, 0u}; }
        }
        asm volatile("" ::: "memory");
        const LAS f32x2* rope = (const LAS f32x2*)tl; const LAS float* g_k = tl + 1024;
        if (part == 0) {
#pragma unroll
            for (int ai = 0; ai < 2; ++ai)
#pragma unroll
                for (int m = 0; m < 4; ++m) {
                    const int i = ai * 4 + m;
                    const int pos = pos0 + ai * 128 + wr * 64 + 4 * fr + m;
                    float kr[8] = {bflo(kw[i].x), bfhi(kw[i].x), bflo(kw[i].y), bfhi(kw[i].y), bflo(kw[i].z), bfhi(kw[i].z), bflo(kw[i].w), bfhi(kw[i].w)};
                    float s2 = 0.f;
#pragma unroll
                    for (int bj = 0; bj < 2; ++bj)
#pragma unroll
                        for (int n = 0; n < 2; ++n) { const f32x4 x = acc[ai][bj][m][n] * rkv[i]; s2 += (x[0] * x[0] + x[1] * x[1]) + (x[2] * x[2] + x[3] * x[3]); }
                    s2 = sum_fq(s2);
                    s2 += s5[i];
                    const float rs = __builtin_amdgcn_rsqf(s2 * (1.f / 96.f) + EPS);
                    bf16* kp = Kb + (bh * KPOS + pos) * 96;
                    unsigned ax[4], ay[4];
#pragma unroll
                    for (int bj = 0; bj < 2; ++bj)
#pragma unroll
                        for (int n = 0; n < 2; ++n) { const int d0 = 32 * bj + 16 * n; const f32x4 g = *(const LAS f32x4*)(g_k + d0 + 4 * fq); const f32x4 x = acc[ai][bj][m][n] * (rkv[i] * rs) * g;
                            ax[2 * bj + n] = pk2(x[0], x[1]); ay[2 * bj + n] = pk2(x[2], x[3]); }
                    swap32(ax[0], ax[1]); swap32(ay[0], ay[1]); swap32(ax[2], ax[3]); swap32(ay[2], ay[3]);
                    *(u32x4*)(kp + 8 * fq) = (u32x4){ax[0], ay[0], ax[1], ay[1]};
                    *(u32x4*)(kp + 32 + 8 * fq) = (u32x4){ax[2], ay[2], ax[3], ay[3]};
                    float t[8];
                    { const f32x4 ga = *(const LAS f32x4*)(g_k + 64 + 8 * fq), gb = *(const LAS f32x4*)(g_k + 64 + 8 * fq + 4);
                      t[0] = kr[0] * rs * ga[0]; t[1] = kr[1] * rs * ga[1]; t[2] = kr[2] * rs * ga[2]; t[3] = kr[3] * rs * ga[3];
                      t[4] = kr[4] * rs * gb[0]; t[5] = kr[5] * rs * gb[1]; t[6] = kr[6] * rs * gb[2]; t[7] = kr[7] * rs * gb[3]; }
                    if (lat) {
                        const int pidx = (fq < 2) ? (pos >> 6) : (pos & 63);
#pragma unroll
                        for (int q = 0; q < 4; ++q) { const f32x2 cs = rope[pidx * 8 + ((4 * fq + q) & 7)]; const float t0 = t[2 * q], t1 = t[2 * q + 1];
                            t[2 * q] = t0 * cs.x - t1 * cs.y; t[2 * q + 1] = t0 * cs.y + t1 * cs.x; }
                    }
                    unsigned tax = pk2(t[0], t[1]), tay = pk2(t[2], t[3]), tbx = pk2(t[4], t[5]), tby = pk2(t[6], t[7]);
                    swap16(tax, tbx); swap16(tay, tby);
                    *(u32x4*)(kp + 64 + 8 * fq) = (u32x4){tax, tay, tbx, tby};
                }
        } else {
#pragma unroll
            for (int ai = 0; ai < 2; ++ai) {
                const int p4 = pos0 + ai * 128 + wr * 64 + 4 * fr, pp = (p4 & ~15) | (((p4 & 4) << 1) | ((p4 & 8) >> 1));
                bf16* vp = Vt + bh * 64 * KPOS + pp;
#pragma unroll
                for (int bj = 0; bj < 2; ++bj)
#pragma unroll
                    for (int n = 0; n < 2; ++n)
#pragma unroll
                        for (int e2 = 0; e2 < 4; ++e2)
                            *(u32x2*)(vp + (size_t)(32 * bj + 16 * n + 4 * fq + e2) * KPOS) =
                                (u32x2){pk2(acc[ai][bj][0][n][e2] * rkv[ai * 4 + 0], acc[ai][bj][1][n][e2] * rkv[ai * 4 + 1]), pk2(acc[ai][bj][2][n][e2] * rkv[ai * 4 + 2], acc[ai][bj][3][n][e2] * rkv[ai * 4 + 3])};
            }
        }
    }
};
struct EpiResid { static constexpr bool PERM = false, RPERM = false;
    float* out; float* hc; const float* modl; int gk; bool dry; float* part; const float* src_lat;
    __device__ __forceinline__ void operator()(AccRef acc, const pg8::Unit& u, int wr, int wc, int fr, int fq) const {
        const bool lat = u.pm < 128; const int b9 = lat ? (u.pm >> 4) : 8;
        float* base = lat ? out + (size_t)u.pm * 256 * DM : hc + (size_t)(u.pm - 128) * 256 * DM;
        const float* rbase = lat ? src_lat + (size_t)u.pm * 256 * DM : base;
        const int col0 = u.pn * 256 + wc * 32 + 4 * fq;
        const float* gp = modl + (size_t)b9 * 6144 + gk * 1024 + col0;
        f32x4 gv[2][2];
#pragma unroll
        for (int bj = 0; bj < 2; ++bj)
#pragma unroll
            for (int n = 0; n < 2; ++n) gv[bj][n] = *(const f32x4*)(gp + bj * 128 + n * 16);
        if (u.kq < 0) {
            f32x4 r[2][4][2][2];
#pragma unroll
            for (int ai = 0; ai < 2; ++ai) {
#pragma unroll
                for (int m = 0; m < 4; ++m) { const float* rowp = rbase + (size_t)(ai * 128 + wr * 64 + m * 16 + fr) * DM + col0;
#pragma unroll
                    for (int bj = 0; bj < 2; ++bj)
#pragma unroll
                        for (int n = 0; n < 2; ++n) r[ai][m][bj][n] = *(const f32x4*)(rowp + bj * 128 + n * 16) + gv[bj][n] * acc[ai][bj][m][n]; }
                asm volatile("" : "+v"(r[ai][0][0][0]), "+v"(r[ai][0][0][1]), "+v"(r[ai][0][1][0]), "+v"(r[ai][0][1][1]), "+v"(r[ai][1][0][0]), "+v"(r[ai][1][0][1]), "+v"(r[ai][1][1][0]), "+v"(r[ai][1][1][1]),
                                  "+v"(r[ai][2][0][0]), "+v"(r[ai][2][0][1]), "+v"(r[ai][2][1][0]), "+v"(r[ai][2][1][1]), "+v"(r[ai][3][0][0]), "+v"(r[ai][3][0][1]), "+v"(r[ai][3][1][0]), "+v"(r[ai][3][1][1]) :: "memory"); }
            if (!dry) {
#pragma unroll
                for (int ai = 0; ai < 2; ++ai)
#pragma unroll
                    for (int m = 0; m < 4; ++m) { float* rowp = base + (size_t)(ai * 128 + wr * 64 + m * 16 + fr) * DM + col0;
#pragma unroll
                        for (int bj = 0; bj < 2; ++bj)
#pragma unroll
                            for (int n = 0; n < 2; ++n) *(f32x4*)(rowp + bj * 128 + n * 16) = r[ai][m][bj][n]; }
            }
        } else if (!dry) {
#pragma unroll
            for (int ai = 0; ai < 2; ++ai)
#pragma unroll
                for (int m = 0; m < 4; ++m)
#pragma unroll
                    for (int bj = 0; bj < 2; ++bj)
#pragma unroll
                        for (int n = 0; n < 2; ++n)
                            *(f32x4*)(part + ((size_t)u.kq * NCTX + (size_t)(u.pm - 128) * 256 + (ai * 128 + wr * 64 + m * 16 + fr)) * DM + col0 + bj * 128 + n * 16) = gv[bj][n] * acc[ai][bj][m][n];
        }
    }
};
struct EpiSwiglu { static constexpr bool PERM = false, RPERM = false;
    bf16* HM; int ldh;
    __device__ __forceinline__ void operator()(AccRef acc, const pg8::Unit& u, int wr, int wc, int fr, int fq) const {
        const int row0 = u.pm * 256 + wr * 64 + fr, col0 = u.pn * 128 + wc * 16 + 4 * fq;
#pragma unroll
        for (int ai = 0; ai < 2; ++ai)
#pragma unroll
            for (int m = 0; m < 4; ++m) { bf16* rowp = HM + (size_t)(row0 + ai * 128 + m * 16) * ldh + col0;
#pragma unroll
                for (int bj = 0; bj < 2; ++bj) { const f32x4 g = acc[ai][bj][m][0], up = acc[ai][bj][m][1]; float h[4];
#pragma unroll
                    for (int e = 0; e < 4; ++e) h[e] = g[e] * __builtin_amdgcn_rcpf(1.f + __builtin_amdgcn_exp2f(-g[e] * LOG2E)) * up[e];
                    *(u32x2*)(rowp + bj * 64) = (u32x2){cvt_pk_bf16(h[0], h[1]), cvt_pk_bf16(h[2], h[3])}; } }
    }
};
struct EpiNAin { static constexpr bool PERM = false, RPERM = true;
    bf16* QN; bf16* KN; bf16* Vt; const float* g_q; const float* g_k;
    __device__ __forceinline__ void operator()(AccRef acc, const pg8::Unit& u, int wr, int wc, int fr, int fq) const {
        const int sec = u.pn >> 2, head = 4 * (u.pn & 3) + wc;
        const bool lat = u.pm < 128;
        const int b = lat ? (u.pm >> 4) : (u.pm - 128);
        const int pos0 = lat ? (u.pm & 15) * 256 : SEQ;
        if (sec < 2) {
            const float* gp = sec == 0 ? g_q : g_k;
            f32x4 gq[2][2];
#pragma unroll
            for (int bj = 0; bj < 2; ++bj)
#pragma unroll
                for (int n = 0; n < 2; ++n) gq[bj][n] = *(const f32x4*)(gp + 32 * bj + 16 * n + 4 * fq);
            asm volatile("" ::: "memory");
            bf16* obase = (sec == 0 ? QN : KN) + head * 64 + 16 * (fq & 1) + 8 * (fq >> 1);
            const float qs = sec == 0 ? 0.125f * LOG2E : 1.0f;
#pragma unroll
            for (int ai = 0; ai < 2; ++ai)
#pragma unroll
                for (int m = 0; m < 4; ++m) {
                    const int row = u.pm * 256 + ai * 128 + wr * 64 + 4 * fr + m;
                    float s2 = 0.f;
#pragma unroll
                    for (int bj = 0; bj < 2; ++bj)
#pragma unroll
                        for (int n = 0; n < 2; ++n) { const f32x4 x = acc[ai][bj][m][n]; s2 += (x[0] * x[0] + x[1] * x[1]) + (x[2] * x[2] + x[3] * x[3]); }
                    s2 = sum_fq(s2);
                    const float rs = __builtin_amdgcn_rsqf(s2 * (1.f / 64.f) + EPS) * qs;
                    unsigned ax[4], ay[4];
#pragma unroll
                    for (int bj = 0; bj < 2; ++bj)
#pragma unroll
                        for (int n = 0; n < 2; ++n) { const f32x4 x = acc[ai][bj][m][n] * rs * gq[bj][n]; ax[2 * bj + n] = pk2(x[0], x[1]); ay[2 * bj + n] = pk2(x[2], x[3]); }
                    swap16(ax[0], ax[1]); swap16(ay[0], ay[1]); swap16(ax[2], ax[3]); swap16(ay[2], ay[3]);
                    bf16* op = obase + (size_t)row * DM;
                    *(u32x4*)(op) = (u32x4){ax[0], ay[0], ax[1], ay[1]};
                    *(u32x4*)(op + 32) = (u32x4){ax[2], ay[2], ax[3], ay[3]};
                }
        } else {
#pragma unroll
            for (int ai = 0; ai < 2; ++ai) {
                bf16* vp = Vt + ((size_t)b * C_HEADS + head) * 64 * KPOS + pos0 + ai * 128 + wr * 64 + 4 * fr;
#pragma unroll
                for (int bj = 0; bj < 2; ++bj)
#pragma unroll
                    for (int n = 0; n < 2; ++n)
#pragma unroll
                        for (int e2 = 0; e2 < 4; ++e2)
                            *(u32x2*)(vp + (size_t)(32 * bj + 16 * n + 4 * fq + e2) * KPOS) = (u32x2){pk2(acc[ai][bj][0][n][e2], acc[ai][bj][1][n][e2]), pk2(acc[ai][bj][2][n][e2], acc[ai][bj][3][n][e2])};
            }
        }
    }
};

__device__ __forceinline__ void fourier_fold(Frame& F) {
    const bf16* GT = (const bf16*)(F.WS() + WS_GT); bf16* GF = (bf16*)(F.WS() + WS_GF);
    for (int q = F.bid * (NWAVES * 64) + F.tid; q < 2048 * 512; q += F.G * NWAVES * 64) {
        const int r = q >> 9, c = q & 511, type = c >= 256, cc = c & 255;
        const bf16* row = GT + (size_t)r * 8192 + type * 4096;
        const u32x4 a = *(const u32x4*)(row + 8 * cc);
        const u32x4 m1 = *(const u32x4*)(row + 8 * (511 - cc));
        u32x4 m0 = (u32x4){0u, 0u, 0u, 0u}; if (cc > 0) m0 = *(const u32x4*)(row + 8 * (512 - cc));
        float x[8] = {bflo(a.x), bfhi(a.x), bflo(a.y), bfhi(a.y), bflo(a.z), bfhi(a.z), bflo(a.w), bfhi(a.w)};
        const float mr[8] = {bflo(m0.x), bfhi(m1.w), bflo(m1.w), bfhi(m1.z), bflo(m1.z), bfhi(m1.y), bflo(m1.y), bfhi(m1.x)};
        const float sg = type ? -1.f : 1.f;
#pragma unroll
        for (int e2 = 0; e2 < 8; ++e2) { const bool special = (cc == 0 && e2 == 0); x[e2] = special ? x[e2] : x[e2] + sg * mr[e2]; }
        if (type && cc == 0) x[0] = bf2f(GT[(size_t)r * 8192 + 2048]);
        u32x4 o; o.x = pk2(x[0], x[1]); o.y = pk2(x[2], x[3]); o.z = pk2(x[4], x[5]); o.w = pk2(x[6], x[7]);
        *(u32x4*)(GF + (size_t)r * 4096 + type * 2048 + 8 * cc) = o;
    }
}

struct EpiNull { static constexpr bool PERM = false, RPERM = false;
    float* sink;
    __device__ __forceinline__ void operator()(AccRef acc, const pg8::Unit& u, int wr, int wc, int fr, int fq) const {
        float s = 0.f;
#pragma unroll
        for (int ai = 0; ai < 2; ++ai)
#pragma unroll
            for (int bj = 0; bj < 2; ++bj)
#pragma unroll
                for (int m = 0; m < 4; ++m)
#pragma unroll
                    for (int n = 0; n < 2; ++n) s += acc[ai][bj][m][n][0];
        if (s == 1.2345e30f) sink[u.pm + wr + wc + fr + fq] = s;
    }
};

constexpr int AT_KP = 208, AT_VP = 144;
constexpr int AT_KB = 64 * AT_KP, AT_VB = 64 * AT_VP, AT_BUF = AT_KB + AT_VB;

__device__ __forceinline__ void mla_attn_unit(Frame& F, int pair, int b, int h, int qrow0, bool lat, int key0, int nkt) {
    asm volatile("" : "+v"(F.tid)); F.lane = F.tid & 63;
    const int lane = F.lane, l31 = lane & 31, hi = lane >> 5;
    const bf16* PX = (const bf16*)(F.WS() + WS_PX);
    const bf16* WUQ = (const bf16*)(F.WS() + WS_W + WO_WUQ);
    const bf16* Kg = (const bf16*)(F.WS() + WS_K) + ((size_t)(b * A_HEADS + h) * KPOS + key0) * 96;
    const bf16* Vg = (const bf16*)(F.WS() + WS_VT) + (size_t)(b * A_HEADS + h) * 64 * KPOS + key0;
    bf16* MIX = (bf16*)(F.WS() + WS_ACT);
    const f32x2* rope = (const f32x2*)(F.WS() + WS_ROPE);
    const int row = qrow0 + 32 * F.wave + l31;
    const int vdv = F.tid >> 3, vpart = F.tid & 7;
    u32x4 kr0, kr1 = (u32x4){0u, 0u, 0u, 0u}, vr;
    kr0 = *(const u32x4*)((const char*)Kg + (size_t)F.tid * 16);
    if (F.tid < 256) kr1 = *(const u32x4*)((const char*)Kg + (size_t)(512 + F.tid) * 16);
    vr = *(const u32x4*)(Vg + (size_t)vdv * KPOS + vpart * 8);
    bf16x8 qf[3][2];
    {
        bf16x8 bq[16];
        const bf16* pxr = PX + (size_t)row * 512 + 8 * hi;
#pragma unroll
        for (int s = 0; s < 16; ++s) bq[s] = *(const bf16x8*)(pxr + 16 * s);
        float ss = 0.f;
#pragma unroll
        for (int s = 0; s < 16; ++s)
#pragma unroll
            for (int e = 0; e < 8; ++e) { const float x = bf2f((unsigned short)bq[s][e]); ss += x * x; }
        ss += __shfl_xor(ss, 32);
        const float rq = 1.0f / sqrtf(ss * (1.f / 256.f) + EPS);
        f32x16 qt[3];
#pragma unroll
        for (int blk = 0; blk < 3; ++blk) {
            f32x16 acc;
#pragma unroll
            for (int i = 0; i < 16; ++i) acc[i] = 0.f;
            const bf16* wrp = WUQ + (size_t)(h * 96 + 32 * blk + l31) * 256 + 8 * hi;
#pragma unroll
            for (int s = 0; s < 16; ++s) { const bf16x8 a = *(const bf16x8*)(wrp + 16 * s); acc = __builtin_amdgcn_mfma_f32_32x32x16_bf16(a, bq[s], acc, 0, 0, 0); }
            qt[blk] = acc * rq;
        }
        float s2 = 0.f;
#pragma unroll
        for (int blk = 0; blk < 3; ++blk)
#pragma unroll
            for (int i = 0; i < 16; ++i) s2 += qt[blk][i] * qt[blk][i];
        s2 += __shfl_xor(s2, 32);
        const float rs = (1.0f / sqrtf(s2 * (1.f / 96.f) + EPS));
        const float* gq = G(F.in->a_g_q) + pair * 96;
#pragma unroll
        for (int blk = 0; blk < 3; ++blk)
#pragma unroll
            for (int c = 0; c < 4; ++c) { const f32x4 g = *(const f32x4*)(gq + 32 * blk + 8 * c + 4 * hi);
#pragma unroll
                for (int e = 0; e < 4; ++e) qt[blk][4 * c + e] *= rs * g[e]; }
        if (lat) {
            const int t = row & (SEQ - 1);
#pragma unroll
            for (int c = 0; c < 4; ++c) {
                const int pidx = (c < 2) ? (t >> 6) : (t & 63);
#pragma unroll
                for (int q = 0; q < 2; ++q) { const f32x2 cs = rope[pidx * 8 + ((4 * c + 2 * hi + q) & 7)]; const float t0 = qt[2][4 * c + 2 * q], t1 = qt[2][4 * c + 2 * q + 1];
                    qt[2][4 * c + 2 * q] = t0 * cs.x - t1 * cs.y; qt[2][4 * c + 2 * q + 1] = t0 * cs.y + t1 * cs.x; }
            }
        }
        const float sc = 0.10206207261596577f * LOG2E;
#pragma unroll
        for (int blk = 0; blk < 3; ++blk)
#pragma unroll
            for (int s = 0; s < 2; ++s) { u32x4 w;
                w.x = pk2(qt[blk][8 * s + 0] * sc, qt[blk][8 * s + 1] * sc); w.y = pk2(qt[blk][8 * s + 2] * sc, qt[blk][8 * s + 3] * sc);
                w.z = pk2(qt[blk][8 * s + 4] * sc, qt[blk][8 * s + 5] * sc); w.w = pk2(qt[blk][8 * s + 6] * sc, qt[blk][8 * s + 7] * sc);
                qf[blk][s] = __builtin_bit_cast(bf16x8, w); }
    }
    LAS unsigned char* L = F.lds;
    const int kd0 = (F.tid / 12) * AT_KP + (F.tid % 12) * 16, kd1 = ((512 + F.tid) / 12) * AT_KP + ((512 + F.tid) % 12) * 16, vd = AT_KB + vdv * AT_VP + vpart * 16;
    const int kro = l31 * AT_KP + hi * 16, vro = AT_KB + l31 * AT_VP + hi * 16;
    u32x4 kb0, kb1 = (u32x4){0u, 0u, 0u, 0u}, vb;
#define AT_LOAD(k0_, k1_, v_, t_) do { const char* kg_ = (const char*)Kg + (size_t)(t_) * 64 * 192; k0_ = *(const u32x4*)(kg_ + (size_t)F.tid * 16); \
        if (F.tid < 256) k1_ = *(const u32x4*)(kg_ + (size_t)(512 + F.tid) * 16); v_ = *(const u32x4*)(Vg + (size_t)vdv * KPOS + (t_) * 64 + vpart * 8); } while (0)
#define AT_STORE(k0_, k1_, v_, off_) do { LAS unsigned char* Ln_ = L + (off_); *(LAS u32x4*)(Ln_ + kd0) = k0_; if (F.tid < 256) *(LAS u32x4*)(Ln_ + kd1) = k1_; *(LAS u32x4*)(Ln_ + vd) = v_; } while (0)
    AT_LOAD(kb0, kb1, vb, 1);
    AT_STORE(kr0, kr1, vr, 0); AT_STORE(kb0, kb1, vb, AT_BUF);
    __syncthreads();
    f32x16 oT[2];
#pragma unroll
    for (int d = 0; d < 2; ++d)
#pragma unroll
        for (int i = 0; i < 16; ++i) oT[d][i] = 0.f;
    f32x2 lrun2[2] = {(f32x2){0.f, 0.f}, (f32x2){0.f, 0.f}};
    const int nT = nkt >> 1;
    for (int T = 0; T < nT; ++T) {
        const bool more = (T + 1 < nT);
        if (more) { AT_LOAD(kr0, kr1, vr, 2 * T + 2); AT_LOAD(kb0, kb1, vb, 2 * T + 3); }
        const LAS unsigned char* Ld = L + (T & 1) * (2 * AT_BUF);
#pragma unroll
        for (int sub = 0; sub < 2; ++sub) {
            const LAS unsigned char* Lb = Ld + sub * AT_BUF;
        bf16x8 kf[2][3][2];
#pragma unroll
        for (int kb = 0; kb < 2; ++kb)
#pragma unroll
            for (int blk = 0; blk < 3; ++blk)
#pragma unroll
                for (int s = 0; s < 2; ++s) kf[kb][blk][s] = *(const LAS bf16x8*)(Lb + kro + kb * 32 * AT_KP + (32 * blk + 16 * s) * 2);
        __builtin_amdgcn_sched_barrier(0);
        f32x16 sT[2];
#pragma unroll
        for (int kb = 0; kb < 2; ++kb)
#pragma unroll
            for (int i = 0; i < 16; ++i) sT[kb][i] = 0.f;
        __builtin_amdgcn_s_setprio(1);
#pragma unroll
        for (int blk = 0; blk < 3; ++blk)
#pragma unroll
            for (int s = 0; s < 2; ++s)
#pragma unroll
                for (int kb = 0; kb < 2; ++kb) sT[kb] = __builtin_amdgcn_mfma_f32_32x32x16_bf16(kf[kb][blk][s], qf[blk][s], sT[kb], 0, 0, 0);
        __builtin_amdgcn_s_setprio(0);
        bf16x8 vf[2][2][2];
#pragma unroll
        for (int d = 0; d < 2; ++d)
#pragma unroll
            for (int kb = 0; kb < 2; ++kb)
#pragma unroll
                for (int s = 0; s < 2; ++s) vf[d][kb][s] = *(const LAS bf16x8*)(Lb + vro + d * 32 * AT_VP + (32 * kb + 16 * s) * 2);
        __builtin_amdgcn_sched_barrier(0);
        bf16x8 pf[2][2];
#pragma unroll
        for (int kb = 0; kb < 2; ++kb) {
            float p[16];
#pragma unroll
            for (int i = 0; i < 16; ++i) p[i] = __builtin_amdgcn_exp2f(sT[kb][i]);
#pragma unroll
            for (int i = 0; i < 16; i += 4) { lrun2[0] += (f32x2){p[i], p[i + 1]}; lrun2[1] += (f32x2){p[i + 2], p[i + 3]}; }
#pragma unroll
            for (int s = 0; s < 2; ++s) { u32x4 w; w.x = cvt_pk_bf16(p[8 * s + 0], p[8 * s + 1]); w.y = cvt_pk_bf16(p[8 * s + 2], p[8 * s + 3]); w.z = cvt_pk_bf16(p[8 * s + 4], p[8 * s + 5]); w.w = cvt_pk_bf16(p[8 * s + 6], p[8 * s + 7]);
                pf[kb][s] = __builtin_bit_cast(bf16x8, w); }
        }
        __builtin_amdgcn_sched_barrier(0);
        __builtin_amdgcn_s_setprio(1);
#pragma unroll
        for (int kb = 0; kb < 2; ++kb)
#pragma unroll
            for (int s = 0; s < 2; ++s)
#pragma unroll
                for (int d = 0; d < 2; ++d) oT[d] = __builtin_amdgcn_mfma_f32_32x32x16_bf16(vf[d][kb][s], pf[kb][s], oT[d], 0, 0, 0);
        __builtin_amdgcn_s_setprio(0);
        }
        if (more) { const int o = ((T + 1) & 1) * (2 * AT_BUF); AT_STORE(kr0, kr1, vr, o); AT_STORE(kb0, kb1, vb, o + AT_BUF); }
        __syncthreads();
    }
#undef AT_LOAD
#undef AT_STORE
    float lrun = (lrun2[0].x + lrun2[0].y) + (lrun2[1].x + lrun2[1].y);
    lrun += __shfl_xor(lrun, 32);
    const float inv = 1.0f / lrun;
    bf16* op = MIX + (size_t)row * DM + h * 64 + 4 * hi;
#pragma unroll
    for (int d = 0; d < 2; ++d)
#pragma unroll
        for (int c = 0; c < 4; ++c) *(u32x2*)(op + 32 * d + 8 * c) = (u32x2){pk2(oT[d][4 * c] * inv, oT[d][4 * c + 1] * inv), pk2(oT[d][4 * c + 2] * inv, oT[d][4 * c + 3] * inv)};
}

__device__ __forceinline__ void mla_attn_phase(Frame& F, int pair, int rep) {
    constexpr int NLU = NB * A_HEADS * (SEQ / 256), NCU = NB * A_HEADS;
    for (;;) {
        if (F.tid == 0) F.MISC[0] = __hip_atomic_fetch_add(F.ctl + CW_ATTQ + 64 * pair + 32 * rep, 1u, RLX_AGENT);
        __syncthreads();
        const int u = (int)F.MISC[0];
        __syncthreads();
        if (u >= NLU + NCU) break;
        if (u < NLU) { const int qb = u & 15, bh = u >> 4, b = bh / A_HEADS, h = bh % A_HEADS; mla_attn_unit(F, pair, b, h, b * SEQ + qb * 256, true, 0, KPOS / 64); }
        else { const int bh = u - NLU, b = bh / A_HEADS, h = bh % A_HEADS; mla_attn_unit(F, pair, b, h, NLAT + b * CTXL, false, SEQ, CTXL / 64); }
    }
}

constexpr int NA_KP = 144, NA_CVP = 528, NA_LVP = 1168;
constexpr int NA_CK = 0, NA_CV = 256 * NA_KP, NA_L = NA_CV + 64 * NA_CVP, NA_RPB = NA_L + 576 * NA_KP, NA_END = NA_RPB + 15 * 31 * 4;
static_assert(NA_L == 70656 && 64 * NA_LVP <= 576 * NA_KP && NA_END <= LDSCTL_OFF, "NA LDS map");

struct NaPref { u32x4 r[9]; };
__device__ __forceinline__ void na_load_k(NaPref& p, const bf16* KN, int rowbase, int h, int tid) {
    const char* gb = (const char*)(KN + (size_t)rowbase * DM + h * 64); const unsigned lo = (unsigned)(tid >> 3) * 2048u + (unsigned)(tid & 7) * 16u;
#pragma unroll
    for (int i = 0; i < 9; ++i) p.r[i] = *(const u32x4*)(gb + (size_t)i * 131072 + lo);
}
__device__ __forceinline__ void na_store_k(const NaPref& p, LAS unsigned char* L, int tid) {
    LAS unsigned char* d = L + NA_L + (tid >> 3) * NA_KP + (tid & 7) * 16;
#pragma unroll
    for (int i = 0; i < 9; ++i) *(LAS u32x4*)(d + i * 64 * NA_KP) = p.r[i];
}
__device__ __forceinline__ void na_load_v(NaPref& p, const bf16* Vt, int pos0, int tid) {
    const char* gb = (const char*)(Vt + pos0); const unsigned lo = (unsigned)(tid >> 3) * (unsigned)(KPOS * 2) + (unsigned)(tid & 7) * 16u;
#pragma unroll
    for (int i = 0; i < 9; ++i) p.r[i] = *(const u32x4*)(gb + i * 128 + lo);
}
__device__ __forceinline__ void na_store_v(const NaPref& p, LAS unsigned char* L, int tid) {
    LAS unsigned char* d = L + NA_L + (tid >> 3) * NA_LVP + (tid & 7) * 16;
#pragma unroll
    for (int i = 0; i < 9; ++i) *(LAS u32x4*)(d + i * 128) = p.r[i];
}
__device__ __forceinline__ void na_stage_ctx(Frame& F, int b, int h) {
    const char* kb = (const char*)((const bf16*)(F.WS() + WS_KN) + (size_t)(NLAT + b * CTXL) * DM + h * 64);
    const char* vb = (const char*)((const bf16*)(F.WS() + WS_VTN) + (size_t)(b * C_HEADS + h) * 64 * KPOS + SEQ);
    const unsigned klo = (unsigned)(F.tid >> 3) * 2048u + (unsigned)(F.tid & 7) * 16u, vlo = (unsigned)(F.tid >> 3) * (unsigned)(KPOS * 2) + (unsigned)(F.tid & 7) * 16u;
    u32x4 a[4], v[4];
#pragma unroll
    for (int i = 0; i < 4; ++i) a[i] = *(const u32x4*)(kb + (size_t)i * 131072 + klo);
#pragma unroll
    for (int i = 0; i < 4; ++i) v[i] = *(const u32x4*)(vb + i * 128 + vlo);
    LAS unsigned char* kd = F.lds + NA_CK + (F.tid >> 3) * NA_KP + (F.tid & 7) * 16;
    LAS unsigned char* vd = F.lds + NA_CV + (F.tid >> 3) * NA_CVP + (F.tid & 7) * 16;
#pragma unroll
    for (int i = 0; i < 4; ++i) *(LAS u32x4*)(kd + i * 64 * NA_KP) = a[i];
#pragma unroll
    for (int i = 0; i < 4; ++i) *(LAS u32x4*)(vd + i * 128) = v[i];
}
__device__ __forceinline__ float na_scores(Frame& F, bf16x8 (&pf)[16], float& f1, const bf16x8 (&qf)[2], const int (&dco)[8], const bool (&okm)[8], bool lat, int qr, int c0, int kr0, int rs, int ks) {
    const int lane = F.lane, l15 = lane & 15, g = lane >> 4;
    const LAS float* rpbs = (const LAS float*)(F.lds + NA_RPB);
    float lsum = 0.f;
    f1 = 1.0f;
    if (lat) {
#pragma unroll
        for (int u = 0; u < 8; ++u) {
            const LAS float* brow = rpbs + (rs + u - qr + 7) * 31;
            float p[8];
#pragma unroll
            for (int hf = 0; hf < 2; ++hf) {
                const LAS unsigned char* kp = F.lds + NA_L + (((rs - kr0) + u) * 64 + ks + 16 * hf + l15) * NA_KP + g * 16;
                f32x4 acc = (f32x4){0.f, 0.f, 0.f, 0.f};
#pragma unroll
                for (int s = 0; s < 2; ++s) { const bf16x8 a = *(const LAS bf16x8*)(kp + s * 64); acc = __builtin_amdgcn_mfma_f32_16x16x32_bf16(a, qf[s], acc, 0, 0, 0); }
#pragma unroll
                for (int e = 0; e < 4; ++e) { const float bias = brow[dco[4 * hf + e]]; const float pe = __builtin_amdgcn_exp2f(acc[e] + bias); p[4 * hf + e] = okm[4 * hf + e] ? pe : 0.f; }
            }
#pragma unroll
            for (int e = 0; e < 8; ++e) lsum += p[e];
            u32x4 w; w.x = cvt_pk_bf16(p[0], p[1]); w.y = cvt_pk_bf16(p[2], p[3]); w.z = cvt_pk_bf16(p[4], p[5]); w.w = cvt_pk_bf16(p[6], p[7]);
            pf[u] = __builtin_bit_cast(bf16x8, w);
            if ((u & 1) == 1) asm volatile("" ::: "memory");
        }
    } else {
#pragma unroll
        for (int u = 0; u < 8; ++u) pf[u] = (bf16x8){0, 0, 0, 0, 0, 0, 0, 0};
    }
#pragma unroll
    for (int u = 0; u < 8; ++u) {
        float p[8];
#pragma unroll
        for (int hf = 0; hf < 2; ++hf) {
            const LAS unsigned char* kp = F.lds + NA_CK + (16 * (2 * u + hf) + l15) * NA_KP + g * 16;
            f32x4 acc = (f32x4){0.f, 0.f, 0.f, 0.f};
#pragma unroll
            for (int s = 0; s < 2; ++s) { const bf16x8 a = *(const LAS bf16x8*)(kp + s * 64); acc = __builtin_amdgcn_mfma_f32_16x16x32_bf16(a, qf[s], acc, 0, 0, 0); }
#pragma unroll
            for (int e = 0; e < 4; ++e) p[4 * hf + e] = __builtin_amdgcn_exp2f(acc[e]);
        }
#pragma unroll
        for (int e = 0; e < 8; ++e) lsum += p[e];
        u32x4 w; w.x = cvt_pk_bf16(p[0], p[1]); w.y = cvt_pk_bf16(p[2], p[3]); w.z = cvt_pk_bf16(p[4], p[5]); w.w = cvt_pk_bf16(p[6], p[7]);
        pf[8 + u] = __builtin_bit_cast(bf16x8, w);
        if ((u & 1) == 1) asm volatile("" ::: "memory");
    }
    lsum += __shfl_xor(lsum, 16); lsum += __shfl_xor(lsum, 32);
    return 1.0f / lsum;
}
__device__ __forceinline__ void na_pv(Frame& F, const bf16x8 (&pf)[16], float f1, float inv, bool lat, int qrow, int h, int kr0, int rs, int ks) {
    const int lane = F.lane, l15 = lane & 15, g = lane >> 4;
    bf16* MIX = (bf16*)(F.WS() + WS_ACT);
    bf16* op = MIX + (size_t)qrow * DM + h * 64 + 4 * g;
#pragma unroll
    for (int dvt = 0; dvt < 4; ++dvt) {
        f32x4 acc = (f32x4){0.f, 0.f, 0.f, 0.f};
        const int dv = 16 * dvt + l15;
        if (lat) {
#pragma unroll
            for (int u = 0; u < 8; ++u) {
                const LAS unsigned char* vp = F.lds + NA_L + dv * NA_LVP + (((rs - kr0) + u) * 64 + ks + 4 * g) * 2;
                const u32x2 lo = *(const LAS u32x2*)(vp), hi2 = *(const LAS u32x2*)(vp + 32);
                const u32x4 w = (u32x4){lo.x, lo.y, hi2.x, hi2.y};
                acc = __builtin_amdgcn_mfma_f32_16x16x32_bf16(__builtin_bit_cast(bf16x8, w), pf[u], acc, 0, 0, 0);
                if ((u & 3) == 3) asm volatile("" ::: "memory");
            }
            acc = acc * f1;
        }
#pragma unroll
        for (int u = 8; u < 16; ++u) {
            const LAS unsigned char* vp = F.lds + NA_CV + dv * NA_CVP + (32 * (u - 8) + 4 * g) * 2;
            const u32x2 lo = *(const LAS u32x2*)(vp), hi2 = *(const LAS u32x2*)(vp + 32);
            const u32x4 w = (u32x4){lo.x, lo.y, hi2.x, hi2.y};
            acc = __builtin_amdgcn_mfma_f32_16x16x32_bf16(__builtin_bit_cast(bf16x8, w), pf[u], acc, 0, 0, 0);
            if ((u & 3) == 3) asm volatile("" ::: "memory");
        }
        *(u32x2*)(op + 16 * dvt) = (u32x2){pk2(acc[0] * inv, acc[1] * inv), pk2(acc[2] * inv, acc[3] * inv)};
    }
}
__device__ __forceinline__ void na_phase(Frame& F, int pair, bool ctx_queries) {
    const bf16* KN = (const bf16*)(F.WS() + WS_KN);
    LAS float* rpbs = (LAS float*)(F.lds + NA_RPB);
    constexpr int NGRP = NB * C_HEADS * 2;
    for (int gi = F.bid; gi < NGRP; gi += F.G) {
        const int h = gi / (NB * 2), rem = gi % (NB * 2), b = rem >> 1, half = rem & 1;
        const bf16* Vt = (const bf16*)(F.WS() + WS_VTN) + (size_t)(b * C_HEADS + h) * 64 * KPOS;
        __syncthreads();
        na_stage_ctx(F, b, h);
        { const float* rp = G(F.in->c_rpb) + ((size_t)pair * C_HEADS + h) * 15 * 31; for (int i = F.tid; i < 15 * 31; i += NWAVES * 64) rpbs[i] = rp[i] * LOG2E; }
        NaPref pk, pv;
        int dco[8]; bool okm[8];
        { const int c0 = 16 * (F.wave & 3), ks = min(max(c0 - 8, 0), 32), cq = c0 + (F.lane & 15), cs = min(max(cq - 8, 0), 48);
#pragma unroll
          for (int k = 0; k < 8; ++k) { const int kc = ks + 16 * (k >> 2) + 4 * (F.lane >> 4) + (k & 3); okm[k] = (kc >= cs) && (kc < cs + 16); dco[k] = min(max(kc - cq + 15, 0), 30); } }
        { const int r0 = 2 * (16 * half), kr0 = min(max(r0 - 4, 0), 55); na_load_k(pk, KN, b * SEQ + kr0 * 64, h, F.tid); }
        for (int bi = 0; bi < 16; ++bi) {
            asm volatile("" : "+v"(F.tid)); F.lane = F.tid & 63;
            const int r0 = 2 * (16 * half + bi), kr0 = min(max(r0 - 4, 0), 55);
            const int qr = r0 + (F.wave >> 2), c0 = 16 * (F.wave & 3), rs = min(max(qr - 4, 0), 56), ks = min(max(c0 - 8, 0), 32);
            const int qrow = b * SEQ + qr * 64 + c0 + (F.lane & 15);
            bf16x8 qf[2];
#pragma unroll
            for (int s = 0; s < 2; ++s) qf[s] = *(const bf16x8*)((const bf16*)(F.WS() + WS_QN) + (size_t)qrow * DM + h * 64 + 32 * s + 8 * (F.lane >> 4));
            na_store_k(pk, F.lds, F.tid);
            __syncthreads();
            na_load_v(pv, Vt, kr0 * 64, F.tid);
            bf16x8 pf[16];
            float f1; const float inv = na_scores(F, pf, f1, qf, dco, okm, true, qr, c0, kr0, rs, ks);
            __syncthreads();
            na_store_v(pv, F.lds, F.tid);
            __syncthreads();
            if (bi + 1 < 16) { const int r1 = r0 + 2, kr1 = min(max(r1 - 4, 0), 55); na_load_k(pk, KN, b * SEQ + kr1 * 64, h, F.tid); }
            na_pv(F, pf, f1, inv, true, qrow, h, kr0, rs, ks);
            __syncthreads();
        }
    }
    constexpr int NCU = NB * C_HEADS * 2;
    for (int u = F.bid; ctx_queries && u < NCU; u += F.G) {
        const int h = u / (NB * 2), rem = u % (NB * 2), b = rem >> 1, ch = rem & 1;
        __syncthreads();
        na_stage_ctx(F, b, h);
        __syncthreads();
        const int qrow = NLAT + b * CTXL + ch * 128 + 16 * F.wave + (F.lane & 15);
        bf16x8 pf[16]; bf16x8 qf[2];
#pragma unroll
        for (int s = 0; s < 2; ++s) qf[s] = *(const bf16x8*)((const bf16*)(F.WS() + WS_QN) + (size_t)qrow * DM + h * 64 + 32 * s + 8 * (F.lane >> 4));
        const int dco0[8] = {0, 0, 0, 0, 0, 0, 0, 0}; const bool okm0[8] = {false, false, false, false, false, false, false, false};
        float f1; const float inv = na_scores(F, pf, f1, qf, dco0, okm0, false, 0, 0, 0, 0, 0);
        na_pv(F, pf, f1, inv, false, qrow, h, 0, 0, 0);
    }
    __syncthreads();
}

constexpr int PH_PER_PAIR = 16, N_PHASES = 2 * PH_PER_PAIR + 1;
struct Args { Inputs in; float* out; unsigned char* ws; int ph_lo, ph_hi; };
static_assert(sizeof(Args) == 27 * 8 + 8 + 8 + 8, "Args has no padding bytes");

__global__ void __launch_bounds__(NWAVES * 64, 2) dit_fwd(Args args) {
    extern __shared__ __attribute__((aligned(16))) unsigned char lds_raw[];
    Frame F;
    F.lds = (LAS unsigned char*)lds_raw;
    F.MISC = (volatile LAS unsigned*)(F.lds + MISC_OFF);
    F.tid = threadIdx.x; F.lane = F.tid & 63; F.wave = __builtin_amdgcn_readfirstlane(F.tid >> 6);
    F.G = gridDim.x; F.bid = blockIdx.x;
    F.ws_ = (GAS unsigned char*)args.ws; F.ctl = (gu32*)(args.ws + WS_CTL); F.out_ = (GAS float*)args.out; F.hc_ = (GAS float*)(args.ws + WS_HC); F.in = (const CAS Inputs*)__builtin_amdgcn_kernarg_segment_ptr();
    for (int u = F.tid; u < (LDS_BYTES - LDSCTL_OFF) / 4; u += NWAVES * 64) ((LAS unsigned*)(F.lds + LDSCTL_OFF))[u] = 0u;
    __syncthreads();
    const int lo = args.ph_lo, hi = args.ph_hi;
    const bool use_bar = (hi - lo) > 1;
    XcdBarrier bar; bar.bar = (GAS unsigned*)(F.ctl + CW_BAR); bar.x = 0; bar.st = nullptr;
    if (use_bar) bar = xcd_barrier_post((GAS unsigned*)(F.ctl + CW_BAR), F.MISC + 8);
#ifndef ONLYP
#define PH_EN(c) true
#else
#define PH_EN(c) ((c) == ONLYP)
#endif
#define INR(k) (lo <= (k) && (k) < hi)
#define PROBE_MASK 0
#define NREP(c) (((PROBE_MASK) >> (c)) & 1 ? 2 : 1)
#define TS_MASK 0
#define TS_EN(c) (((TS_MASK) >> (c)) & 1)
    unsigned long long ts_acc = 0, ts_t0 = 0;
#define FRESH() do { asm volatile("" : "+s"(F.ws_), "+s"(F.out_), "+s"(F.hc_), "+s"(F.ctl), "+s"(F.in), "+s"(F.G), "+s"(F.bid), "+s"(F.wave)); asm volatile("" : "+v"(F.tid)); F.lane = F.tid & 63; W = F.WS() + WS_W; MODB = (const float*)(F.WS() + WS_MOD); ACT = (bf16*)(F.WS() + WS_ACT); } while (0)
#define IN(k) (PH_EN((k) - P) && INR(k))
#define TS_ARRIVE 0
#define SEAM(k) do { if (INR(k) && INR((k) + 1)) { if (TS_ARRIVE && TS_EN((k) - P)) ts_t0 = __builtin_amdgcn_s_memrealtime(); for (int rb = 0; rb < ((PROBE_MASK >> 20) & 1 ? 2 : 1); ++rb) { asm volatile("" : "+s"(bar.bar), "+s"(bar.x)); xcd_barrier(bar); } if (TS_EN((k) - P)) ts_acc += __builtin_amdgcn_s_memrealtime() - ts_t0; } } while (0)
    unsigned char* W; const float* MODB; bf16* ACT;
    volatile LAS int* MOE = (volatile LAS int*)(F.lds + MOE_LDS_OFF);
    LAS unsigned char* ring = F.lds + RING_OFF;

    for (int j = 0; j < 2; ++j) {
        const int P = j * PH_PER_PAIR, le = 2 * j, lod = 2 * j + 1;
        const int nMo = (j == 1) ? NLAT / 256 : NTOK / 256;
        if (IN(P + 0)) { if (TS_EN(0)) ts_t0 = __builtin_amdgcn_s_memrealtime(); for (int rep = 0; rep < NREP(0); ++rep) { FRESH(); if (j == 0) prep_phase(F, 0); } } if (j == 0) SEAM(P + 0);
        if (IN(P + 1)) { if (TS_EN(1)) ts_t0 = __builtin_amdgcn_s_memrealtime(); FRESH(); if (j == 1) prep_phase(F, 1); norm_phase(F, NormArgs{le, 0, j == 0, j > 0 ? j - 1 : -1, -1, 0, 0}); } SEAM(P + 1);
        if (IN(P + 2)) { if (TS_EN(2)) ts_t0 = __builtin_amdgcn_s_memrealtime(); for (int rep = 0; rep < NREP(2); ++rep) { FRESH();
            SchedStatic S{ACT, 1024, (const bf16*)(W + WO_WIN_E), 1024, NTOK / 256, 4, F.G, F.bid};
            EpiWin E{(bf16*)(F.WS() + WS_PX), (bf16*)(F.WS() + WS_GT), (bf16*)(F.WS() + WS_GTC), (float*)(F.WS() + WS_ROWST)};
            pg8::gemm_phase<EpiWin, SchedStatic>(ring, 1024, S, E, F.tid);
        } } SEAM(P + 2);
        if (IN(P + 3)) { if (TS_EN(3)) ts_t0 = __builtin_amdgcn_s_memrealtime(); for (int rep = 0; rep < NREP(3); ++rep) { FRESH();
            fourier_fold(F);
            SchedStatic S{(const bf16*)(F.WS() + WS_PX) + 256, 512, (const bf16*)(W + WO_WUKV), 256, NTOK / 256, 6, F.G, F.bid};
            LAS float* tl = (LAS float*)(F.lds + pg8::GN_LDS_OFF);
            { const float* rp = (const float*)(F.WS() + WS_ROPE); const float* gk = G(F.in->a_g_k) + j * 96;
              for (int i = F.tid; i < 1024 + 96; i += NWAVES * 64) tl[i] = i < 1024 ? rp[i] : gk[i - 1024];
              __syncthreads(); }
            EpiKV E{(const bf16*)(F.WS() + WS_PX), (bf16*)(F.WS() + WS_K), (bf16*)(F.WS() + WS_VT), tl, (const float*)(F.WS() + WS_ROWST)};
            pg8::gemm_phase<EpiKV, SchedStatic>(ring, 256, S, E, F.tid);
        } } SEAM(P + 3);
        if (IN(P + 4)) { if (TS_EN(4)) ts_t0 = __builtin_amdgcn_s_memrealtime(); for (int rep = 0; rep < NREP(4); ++rep) { FRESH();
            {
                const bool latf = F.bid < 128; const int have = F.bid < 136;
                SchedOne S{latf ? (const bf16*)(F.WS() + WS_DFT) : (const bf16*)(F.WS() + WS_DFTC), latf ? 4096 : 512, latf ? (const bf16*)(F.WS() + WS_GF) : (const bf16*)(F.WS() + WS_GTC), latf ? 4096 : 512,
                           latf ? (F.bid >> 3) : 0, latf ? (F.bid & 7) : (F.bid - 128), have};
                EpiBf16 E{ACT, 1024, latf ? 1 : 2};
                pg8::gemm_phase<EpiBf16, SchedOne>(ring, S.K, S, E, F.tid);
            }
            __syncthreads();
            mla_attn_phase(F, j, rep);
        } } SEAM(P + 4);
        if (IN(P + 5)) { if (TS_EN(5)) ts_t0 = __builtin_amdgcn_s_memrealtime(); for (int rep = 0; rep < NREP(5); ++rep) { FRESH();
            SchedResid S{ACT, 1024, (const bf16*)(W + WO_WOUT_E), 1024, 8, F.G, F.bid};
            EpiResid E{F.OUT(), F.HC(), MODB + (size_t)le * 9 * 6144, 2, rep + 1 < NREP(5), (float*)(F.WS() + WS_PART), j == 0 ? G(F.in->x) : F.OUT()};
            pg8::gemm_phase<EpiResid, SchedResid>(ring, 1024, S, E, F.tid);
        } } SEAM(P + 5);
        if (IN(P + 6)) { if (TS_EN(6)) ts_t0 = __builtin_amdgcn_s_memrealtime(); for (int rep = 0; rep < NREP(6); ++rep) { FRESH(); norm_phase(F, NormArgs{le, 1, j == 0 ? 2 : 0, -1, -1, 0, 1}); } } SEAM(P + 6);
        if (IN(P + 7)) { if (TS_EN(7)) ts_t0 = __builtin_amdgcn_s_memrealtime(); for (int rep = 0; rep < NREP(7); ++rep) { FRESH();
            SchedStatic S{ACT, 1024, (const bf16*)(W + WO_WGU_E), 1024, NTOK / 256, 2 * DFF / 256, F.G, F.bid};
            EpiSwiglu E{(bf16*)(F.WS() + WS_HMID), DFF};
            pg8::gemm_phase<EpiSwiglu, SchedStatic>(ring, 1024, S, E, F.tid);
        } } SEAM(P + 7);
        if (IN(P + 8)) { if (TS_EN(8)) ts_t0 = __builtin_amdgcn_s_memrealtime(); for (int rep = 0; rep < NREP(8); ++rep) { FRESH();
            SchedResid S{(const bf16*)(F.WS() + WS_HMID), DFF, (const bf16*)(W + WO_WDN_E), DFF, 8, F.G, F.bid};
            EpiResid E{F.OUT(), F.HC(), MODB + (size_t)le * 9 * 6144, 5, rep + 1 < NREP(8), (float*)(F.WS() + WS_PART), F.OUT()};
            pg8::gemm_phase<EpiResid, SchedResid>(ring, DFF, S, E, F.tid);
        } } SEAM(P + 8);
        if (IN(P + 9)) { if (TS_EN(9)) ts_t0 = __builtin_amdgcn_s_memrealtime(); for (int rep = 0; rep < NREP(9); ++rep) { FRESH(); norm_phase(F, NormArgs{lod, 0, 0, -1, -1, 0, 1}); } } SEAM(P + 9);
        if (IN(P + 10)) { if (TS_EN(10)) ts_t0 = __builtin_amdgcn_s_memrealtime(); for (int rep = 0; rep < NREP(10); ++rep) { FRESH();
            SchedStatic S{ACT, 1024, (const bf16*)(W + WO_WIN_O), 1024, NTOK / 256, 12, F.G, F.bid};
            EpiNAin E{(bf16*)(F.WS() + WS_QN), (bf16*)(F.WS() + WS_KN), (bf16*)(F.WS() + WS_VTN), G(F.in->c_g_q) + j * 64, G(F.in->c_g_k) + j * 64};
            pg8::gemm_phase<EpiNAin, SchedStatic>(ring, 1024, S, E, F.tid);
        } } SEAM(P + 10);
        if (IN(P + 11)) { if (TS_EN(11)) ts_t0 = __builtin_amdgcn_s_memrealtime(); for (int rep = 0; rep < NREP(11); ++rep) { FRESH(); na_phase(F, j, j == 0); } } SEAM(P + 11);
        if (IN(P + 12)) { if (TS_EN(12)) ts_t0 = __builtin_amdgcn_s_memrealtime(); for (int rep = 0; rep < NREP(12); ++rep) { FRESH();
            SchedResid S{ACT, 1024, (const bf16*)(W + WO_WOUT_O), 1024, nMo - 128, F.G, F.bid};
            EpiResid E{F.OUT(), F.HC(), MODB + (size_t)lod * 9 * 6144, 2, rep + 1 < NREP(12), (float*)(F.WS() + WS_PART), F.OUT()};
            pg8::gemm_phase<EpiResid, SchedResid>(ring, 1024, S, E, F.tid);
        } } SEAM(P + 12);
        if (IN(P + 13)) { if (TS_EN(13)) ts_t0 = __builtin_amdgcn_s_memrealtime(); FRESH(); norm_phase(F, NormArgs{lod, 1, 0, -1, j, j == 1, 1}); } SEAM(P + 13);
        if (IN(P + 14)) { if (TS_EN(14)) ts_t0 = __builtin_amdgcn_s_memrealtime(); for (int rep = 0; rep < NREP(14); ++rep) { FRESH();
            moe_panels_to_lds(F, j);
            SchedMoe<true> S{ACT, 1024, (const bf16*)(W + WO_WGU_M), (size_t)2 * DFFE * 1024 * 2, 1024, 2 * DFFE / 256, F.G, F.bid, (const int*)(F.WS() + WS_LIST), MOE};
            EpiSwiglu E{(bf16*)(F.WS() + WS_HMOE), DFFE};
            pg8::gemm_phase<EpiSwiglu, SchedMoe<true>>(ring, 1024, S, E, F.tid);
        } } SEAM(P + 14);
        if (IN(P + 15)) { if (TS_EN(15)) ts_t0 = __builtin_amdgcn_s_memrealtime(); for (int rep = 0; rep < NREP(15); ++rep) { FRESH();
            moe_panels_to_lds(F, j);
            SchedMoe<false> S{(const bf16*)(F.WS() + WS_HMOE), DFFE, (const bf16*)(W + WO_WDN_M), (size_t)1024 * DFFE * 2, DFFE, 4, F.G, F.bid, nullptr, MOE};
            EpiBf16 E{(bf16*)(F.WS() + WS_Y), 1024, 0};
            pg8::gemm_phase<EpiBf16, SchedMoe<false>>(ring, DFFE, S, E, F.tid);
        } } SEAM(P + 15);
    }
    { const int P = 0; if (IN(2 * PH_PER_PAIR)) { FRESH(); norm_phase(F, NormArgs{3, 0, 0, 1, -1, 1, 0}); } }
    if (TS_MASK != 0 && F.bid == 0) { const unsigned long long t0 = __builtin_amdgcn_s_memrealtime(); while (__builtin_amdgcn_s_memrealtime() - t0 < ts_acc) __builtin_amdgcn_s_sleep(8); }
#undef IN
#undef INR
#undef SEAM
}

#if DBG

#endif

extern "C" void kernel_launch(void* const* d_in, const int* in_sizes, int n_in, void* d_out, int out_size, void* d_ws, size_t ws_size, hipStream_t stream) {
    static int grid = 0;
    if (grid == 0) {
        if (n_in != 27 || in_sizes[0] != NLAT * DM || out_size != NLAT * DM || ws_size < WS_END) {
            fprintf(stderr, "kernel_launch: built for 27 inputs, x/out of %d floats, >= %zu bytes of workspace; got n_in %d, in0 %d, out %d, ws %zu; nothing launched\n", NLAT * DM, (size_t)WS_END, n_in, n_in > 0 ? in_sizes[0] : -1, out_size, ws_size);
            grid = -1; return; }
        int dev = 0, cus = 0, per_cu = 0;
        if (hipGetDevice(&dev) != hipSuccess || hipDeviceGetAttribute(&cus, hipDeviceAttributeMultiprocessorCount, dev) != hipSuccess) { fprintf(stderr, "kernel_launch: device query failed\n"); grid = -1; return; }
        if (hipFuncSetAttribute((const void*)dit_fwd, hipFuncAttributeMaxDynamicSharedMemorySize, LDS_BYTES) != hipSuccess) { fprintf(stderr, "kernel_launch: hipFuncSetAttribute failed\n"); grid = -1; return; }
        if (hipOccupancyMaxActiveBlocksPerMultiprocessor(&per_cu, (const void*)dit_fwd, NWAVES * 64, LDS_BYTES) != hipSuccess || per_cu < 1) { fprintf(stderr, "kernel_launch: occupancy query reports %d workgroups per CU\n", per_cu); }
        (void)hipGetLastError();
        grid = cus;
    }
    if (grid < 0) return;
    if (hipMemsetAsync((char*)d_ws + WS_CTL, 0, CTL_ZERO_BYTES, stream) != hipSuccess) { fprintf(stderr, "kernel_launch: memset failed\n"); return; }
    Args a{};
    const float** ip = (const float**)(void*)&a.in;
    for (int i = 0; i < 27; ++i) ip[i] = (const float*)d_in[i];
    a.out = (float*)d_out; a.ws = (unsigned char*)d_ws;
#if DBG
    dbg_launch_all(a, grid, stream);
#else
    a.ph_lo = 0; a.ph_hi = N_PHASES;
    hipLaunchKernelGGL(dit_fwd, dim3(grid), dim3(NWAVES * 64), LDS_BYTES, stream, a);
    const hipError_t le = hipPeekAtLastError();
    if (le != hipSuccess) fprintf(stderr, "kernel_launch: launch failed: %s\n", hipGetErrorName(le));
#endif
}
```
